# Optimizing an MI355X kernel written in HIP

```python
import jax, jax.numpy as jnp
from jax import lax
import numpy as np

D_MODEL = 1024
BATCH = 16
SEQ = 2048
DEPTH = 2

N_MIXERS = 2
N_CONV = (DEPTH + 1) // 2
N_NSA = DEPTH // 2

CONV_WIDTH = 31

HEAD_DIM = 64
N_HEADS = D_MODEL // HEAD_DIM
N_KV = 4
GROUP = N_HEADS // N_KV
CMP_BLOCK = 32
CMP_STRIDE = 16
CMP_HIDDEN = 256
SLC_BLOCK = 64
N_SEL = 16
WINDOW = 512
Q_BLOCK = 32
ROPE_THETA = 10000.0
NSA_IN = N_HEADS * HEAD_DIM + 6 * N_KV * HEAD_DIM + 3 * N_HEADS

N_GROUPS = 4
EXPERTS_PER_GROUP = 8
N_EXPERTS = N_GROUPS * EXPERTS_PER_GROUP
EXPERT_TOPK = 2
D_EXPERT = 512
EXPERT_BLOCK = 256

PLE_DIM = 256

EPS = 1e-6
NEG = -1e30

kernel_name = "hybrid_conv_nsa_hmoe_ple"


def rms_norm(x, g):
    xf = x.astype(jnp.float32)
    y = xf * lax.rsqrt(jnp.mean(xf * xf, axis=-1, keepdims=True) + EPS)
    return (y * g.astype(jnp.float32)).astype(x.dtype)


def layer_norm(x, g, b):
    xf = x.astype(jnp.float32)
    mu = jnp.mean(xf, axis=-1, keepdims=True)
    var = jnp.mean(jnp.square(xf - mu), axis=-1, keepdims=True)
    y = (xf - mu) * lax.rsqrt(var + EPS)
    return (y * g.astype(jnp.float32) + b.astype(jnp.float32)).astype(x.dtype)


def rope(x, pos):
    half = x.shape[-1] // 2
    inv = 1.0 / (ROPE_THETA ** (jnp.arange(half, dtype=jnp.float32) / half))
    ang = pos.astype(jnp.float32)[..., None] * inv
    cos = jnp.cos(ang)[:, :, None, :]
    sin = jnp.sin(ang)[:, :, None, :]
    xf = x.astype(jnp.float32)
    x1, x2 = xf[..., :half], xf[..., half:]
    return jnp.concatenate([x1 * cos - x2 * sin, x2 * cos + x1 * sin], axis=-1).astype(x.dtype)


def masked_softmax(s, mask):
    p = jax.nn.softmax(jnp.where(mask, s, NEG), axis=-1)
    return p * mask


def conv_module(xn, w_pw1, b_pw1, w_dw, b_dw, ln_g, ln_b, w_pw2, b_pw2):
    u = xn @ w_pw1 + b_pw1
    a, g = jnp.split(u, 2, axis=-1)
    u = a * jax.nn.sigmoid(g)
    u = lax.conv_general_dilated(
        u, w_dw[:, None, :].astype(u.dtype), window_strides=(1,),
        padding=[(CONV_WIDTH - 1, 0)], dimension_numbers=("NWC", "WIO", "NWC"),
        feature_group_count=u.shape[-1]) + b_dw
    u = jax.nn.silu(layer_norm(u, ln_g, ln_b))
    return u @ w_pw2 + b_pw2


def compress(x, pe, w1, w2):
    B, T, G, dh = x.shape
    xr = x.reshape(B, T // CMP_STRIDE, CMP_STRIDE, G, dh)
    blocks = jnp.concatenate([xr[:, :-1], xr[:, 1:]], axis=2)
    blocks = blocks + pe[None, None, :, None, :]
    blocks = jnp.transpose(blocks, (0, 1, 3, 2, 4)).reshape(B, -1, G, CMP_BLOCK * dh)
    return jax.nn.gelu(blocks @ w1) @ w2


def nsa_attention(xn, positions, w_in, q_norm, k_norm, cmp_pe, cmp_w1, cmp_w2, w_out):
    B, T, _ = xn.shape
    H, G, R, dh = N_HEADS, N_KV, GROUP, HEAD_DIM
    HD, KD = H * dh, G * dh
    NC = T // CMP_STRIDE - 1
    NS = T // SLC_BLOCK
    NQ = T // Q_BLOCK
    n_sel = min(N_SEL, NS)
    a = SLC_BLOCK // CMP_STRIDE
    b = CMP_BLOCK // CMP_STRIDE
    scale = HEAD_DIM ** -0.5

    proj = xn @ w_in
    q = proj[..., :HD].reshape(B, T, H, dh)
    kv = proj[..., HD:HD + 6 * KD].reshape(B, T, 6, G, dh)
    gate = jax.nn.sigmoid(proj[..., HD + 6 * KD:].astype(jnp.float32)).reshape(B, T, G, R, 3)

    q = rope(rms_norm(q, q_norm), positions)
    k_s = rope(rms_norm(kv[:, :, 2], k_norm[1]), positions)
    k_w = rope(rms_norm(kv[:, :, 4], k_norm[2]), positions)
    kc = compress(kv[:, :, 0], cmp_pe[0], cmp_w1[0], cmp_w2[0])
    kc = rope(rms_norm(kc, k_norm[0]), positions[:, CMP_BLOCK - 1::CMP_STRIDE])
    vc = compress(kv[:, :, 1], cmp_pe[1], cmp_w1[1], cmp_w2[1])

    to_g = lambda t: jnp.moveaxis(t, 2, 1)
    kc, vc = to_g(kc), to_g(vc)
    ks_blk = to_g(k_s).reshape(B, G, NS, SLC_BLOCK, dh)
    vs_blk = to_g(kv[:, :, 3]).reshape(B, G, NS, SLC_BLOCK, dh)
    pad_w = ((0, 0), (0, 0), (WINDOW, 0), (0, 0))
    kw_pad = jnp.pad(to_g(k_w), pad_w)
    vw_pad = jnp.pad(to_g(kv[:, :, 5]), pad_w)

    q_chunks = jnp.moveaxis(jnp.transpose(q.reshape(B, T, G, R, dh), (0, 2, 3, 1, 4))
                            .reshape(B, G, R, NQ, Q_BLOCK, dh), 3, 0)
    g_chunks = jnp.moveaxis(jnp.transpose(gate, (0, 2, 3, 1, 4))
                            .reshape(B, G, R, NQ, Q_BLOCK, 3), 3, 0)

    cmp_end = CMP_STRIDE * jnp.arange(NC) + CMP_BLOCK - 1
    blk = jnp.arange(NS)
    bi = jnp.arange(B)[:, None, None, None]
    gi = jnp.arange(G)[None, :, None, None]

    def block_fn(args):
        qc, gc, c = args
        t0 = c * Q_BLOCK
        tq = t0 + jnp.arange(Q_BLOCK)
        s = jnp.einsum('bgrqd,bgkd->bgrqk', qc, kc, preferred_element_type=jnp.float32) * scale
        p_c = masked_softmax(s, cmp_end[None, :] <= tq[:, None])
        o_c = jnp.einsum('bgrqk,bgkd->bgrqd', p_c.astype(vc.dtype), vc)
        imp = p_c.sum(axis=2)
        imp = jnp.pad(imp, ((0, 0), (0, 0), (0, 0), (0, a * NS + a + b - NC)))
        p_slc = sum(imp[..., m + n: m + n + a * NS: a] for m in range(a) for n in range(b))
        cur = tq // SLC_BLOCK
        forced = (blk[None, :] == 0) | (blk[None, :] == cur[:, None]) | (blk[None, :] == cur[:, None] - 1)
        valid = blk[None, :] * SLC_BLOCK <= tq[:, None]
        score = jnp.where(forced, jnp.inf, jnp.where(valid, p_slc, -jnp.inf))
        _, idx = lax.top_k(score, n_sel)
        k_sel = ks_blk[bi, gi, idx].reshape(B, G, Q_BLOCK, n_sel * SLC_BLOCK, dh)
        v_sel = vs_blk[bi, gi, idx].reshape(B, G, Q_BLOCK, n_sel * SLC_BLOCK, dh)
        kpos = (idx[..., None] * SLC_BLOCK + jnp.arange(SLC_BLOCK)).reshape(B, G, Q_BLOCK, -1)
        mask_s = (kpos <= tq[None, None, :, None])[:, :, None]
        s = jnp.einsum('bgrqd,bgqkd->bgrqk', qc, k_sel, preferred_element_type=jnp.float32) * scale
        p_s = masked_softmax(s, mask_s)
        o_s = jnp.einsum('bgrqk,bgqkd->bgrqd', p_s.astype(v_sel.dtype), v_sel)
        kw = lax.dynamic_slice_in_dim(kw_pad, t0, WINDOW + Q_BLOCK, axis=2)
        vw = lax.dynamic_slice_in_dim(vw_pad, t0, WINDOW + Q_BLOCK, axis=2)
        kpos_w = t0 - WINDOW + jnp.arange(WINDOW + Q_BLOCK)
        mask_w = ((kpos_w[None, :] <= tq[:, None]) & (kpos_w[None, :] > tq[:, None] - WINDOW)
                  & (kpos_w[None, :] >= 0))
        s = jnp.einsum('bgrqd,bgkd->bgrqk', qc, kw, preferred_element_type=jnp.float32) * scale
        p_w = masked_softmax(s, mask_w)
        o_w = jnp.einsum('bgrqk,bgkd->bgrqd', p_w.astype(vw.dtype), vw)
        o = gc[..., 0:1] * o_c + gc[..., 1:2] * o_s + gc[..., 2:3] * o_w
        return o.astype(qc.dtype)

    out = lax.map(block_fn, (q_chunks, g_chunks, jnp.arange(NQ)))
    out = jnp.transpose(out, (1, 0, 4, 2, 3, 5)).reshape(B, T, HD)
    return out @ w_out


def hier_moe(xn, w_rg, b_rg, w_re, b_re, w_gate, w_up, w_down):
    B, T, D = xn.shape
    N = B * T
    xf = xn.reshape(N, D)
    lg = (xf @ w_rg + b_rg).astype(jnp.float32)
    pg = jax.nn.softmax(lg, axis=-1)
    pg_sel, grp = lax.top_k(pg, 1)
    le = (xf @ w_re + b_re).astype(jnp.float32).reshape(N, N_GROUPS, EXPERTS_PER_GROUP)
    le_g = jnp.take_along_axis(le, grp[:, :, None], axis=1)[:, 0]
    top_v, top_i = lax.top_k(le_g, EXPERT_TOPK)
    wts = jax.nn.softmax(top_v, axis=-1) * pg_sel
    eid = grp * EXPERTS_PER_GROUP + top_i
    A = N * EXPERT_TOPK
    e_flat = eid.reshape(A)
    tok = jnp.repeat(jnp.arange(N), EXPERT_TOPK)
    w_flat = wts.reshape(A)
    order = jnp.argsort(e_flat)
    e_s = e_flat[order]
    counts = jnp.zeros((N_EXPERTS,), jnp.int32).at[e_flat].add(1)
    pc = (counts + EXPERT_BLOCK - 1) // EXPERT_BLOCK * EXPERT_BLOCK
    ends = jnp.cumsum(pc)
    starts = jnp.cumsum(counts) - counts
    dest = (ends - pc)[e_s] + jnp.arange(A) - starts[e_s]
    n_blocks = -(-A // EXPERT_BLOCK) + N_EXPERTS
    P = n_blocks * EXPERT_BLOCK
    slot_tok = jnp.zeros((P,), jnp.int32).at[dest].set(tok[order])
    slot_w = jnp.zeros((P,), jnp.float32).at[dest].set(w_flat[order])
    blk_e = jnp.minimum(jnp.searchsorted(ends, jnp.arange(n_blocks) * EXPERT_BLOCK, side='right'),
                        N_EXPERTS - 1)
    xb = xf[slot_tok].reshape(n_blocks, EXPERT_BLOCK, D)

    def expert_block(args):
        xblk, e = args
        h = jax.nn.silu(xblk @ w_gate[e]) * (xblk @ w_up[e])
        return h @ w_down[e]

    yb = lax.map(expert_block, (xb, blk_e)).reshape(P, D)
    out = jnp.zeros((N, D), yb.dtype).at[slot_tok].add(yb * slot_w[:, None].astype(yb.dtype))
    return out.reshape(B, T, D)


def setup_inputs(seed: int = 0) -> dict:
    key = jax.random.key(seed)
    ks = iter(jax.random.split(key, 40))
    D, F = D_MODEL, D_EXPERT

    def nrm(shape, fan_in):
        return jax.random.normal(next(ks), shape, jnp.float32) * (fan_in ** -0.5)

    def gain(shape):
        return 1.0 + 0.02 * jax.random.normal(next(ks), shape, jnp.float32)

    def small(shape, s=0.02):
        return s * jax.random.normal(next(ks), shape, jnp.float32)

    x = jax.random.normal(next(ks), (BATCH, SEQ, D), jnp.float32)
    p = jax.random.normal(next(ks), (DEPTH, BATCH, SEQ, PLE_DIM), jnp.float32)
    offset = jax.random.randint(next(ks), (BATCH, 1), 0, 1024, dtype=jnp.int32)
    positions = (offset + jnp.arange(SEQ, dtype=jnp.int32)[None, :]).astype(jnp.int32)
    return {
        "x": x, "p": p, "positions": positions,
        "g_mix": gain((DEPTH, D)), "g_ffn": gain((DEPTH, D)), "g_ple": gain((DEPTH, D)),
        "conv_w_pw1": nrm((N_CONV, D, 2 * D), D), "conv_b_pw1": small((N_CONV, 2 * D)),
        "conv_w_dw": nrm((N_CONV, CONV_WIDTH, D), CONV_WIDTH), "conv_b_dw": small((N_CONV, D)),
        "conv_ln_g": gain((N_CONV, D)), "conv_ln_b": small((N_CONV, D)),
        "conv_w_pw2": nrm((N_CONV, D, D), D), "conv_b_pw2": small((N_CONV, D)),
        "nsa_w_in": nrm((N_NSA, D, NSA_IN), D),
        "nsa_q_norm": gain((N_NSA, HEAD_DIM)), "nsa_k_norm": gain((N_NSA, 3, HEAD_DIM)),
        "nsa_cmp_pe": small((N_NSA, 2, CMP_BLOCK, HEAD_DIM), 0.1),
        "nsa_cmp_w1": nrm((N_NSA, 2, CMP_BLOCK * HEAD_DIM, CMP_HIDDEN), CMP_BLOCK * HEAD_DIM),
        "nsa_cmp_w2": nrm((N_NSA, 2, CMP_HIDDEN, HEAD_DIM), CMP_HIDDEN),
        "nsa_w_out": nrm((N_NSA, N_HEADS * HEAD_DIM, D), N_HEADS * HEAD_DIM),
        "moe_w_rg": nrm((DEPTH, D, N_GROUPS), D), "moe_b_rg": small((DEPTH, N_GROUPS), 0.01),
        "moe_w_re": nrm((DEPTH, D, N_EXPERTS), D), "moe_b_re": small((DEPTH, N_EXPERTS), 0.01),
        "moe_w_gate": nrm((DEPTH, N_EXPERTS, D, F), D), "moe_w_up": nrm((DEPTH, N_EXPERTS, D, F), D),
        "moe_w_down": nrm((DEPTH, N_EXPERTS, F, D), F),
        "ple_w_proj": nrm((DEPTH, PLE_DIM, D), PLE_DIM), "ple_w_gate": nrm((DEPTH, D, D), D),
    }


def reference(x, p, positions, g_mix, g_ffn, g_ple, conv_w_pw1, conv_b_pw1, conv_w_dw, conv_b_dw,
              conv_ln_g, conv_ln_b, conv_w_pw2, conv_b_pw2, nsa_w_in, nsa_q_norm, nsa_k_norm,
              nsa_cmp_pe, nsa_cmp_w1, nsa_cmp_w2, nsa_w_out, moe_w_rg, moe_b_rg, moe_w_re, moe_b_re,
              moe_w_gate, moe_w_up, moe_w_down, ple_w_proj, ple_w_gate):
    h = x
    for i in range(DEPTH):
        xn = rms_norm(h, g_mix[i])
        j = i // N_MIXERS
        if i % N_MIXERS == 0:
            h = h + conv_module(xn, conv_w_pw1[j], conv_b_pw1[j], conv_w_dw[j], conv_b_dw[j],
                                conv_ln_g[j], conv_ln_b[j], conv_w_pw2[j], conv_b_pw2[j])
        else:
            h = h + nsa_attention(xn, positions, nsa_w_in[j], nsa_q_norm[j], nsa_k_norm[j],
                                  nsa_cmp_pe[j], nsa_cmp_w1[j], nsa_cmp_w2[j], nsa_w_out[j])
        h = h + hier_moe(rms_norm(h, g_ffn[i]), moe_w_rg[i], moe_b_rg[i], moe_w_re[i], moe_b_re[i],
                         moe_w_gate[i], moe_w_up[i], moe_w_down[i])
        gate = jax.nn.sigmoid(rms_norm(h, g_ple[i]) @ ple_w_gate[i])
        h = h + gate * (p[i] @ ple_w_proj[i])
    return h
```

```cpp
#define PROBE 0
#define REP_MASK 0u
#include <hip/hip_runtime.h>
#include <hip/hip_bf16.h>
#include <cstdio>
#include <cstdint>
#include <cmath>

#ifndef PROBE
#define PROBE 0
#endif
#define DEVI __device__ __forceinline__
#define GAS __attribute__((address_space(1)))
#define LAS __attribute__((address_space(3)))
typedef unsigned short bf16_t;
typedef short bf16x8 __attribute__((ext_vector_type(8)));
typedef short s16x4 __attribute__((ext_vector_type(4)));
typedef float f32x2 __attribute__((ext_vector_type(2)));
typedef float f32x4 __attribute__((ext_vector_type(4)));
typedef float f32x16 __attribute__((ext_vector_type(16)));
typedef unsigned u32x2 __attribute__((ext_vector_type(2)));
typedef unsigned u32x4 __attribute__((ext_vector_type(4)));
typedef __bf16 bf16x2_t __attribute__((ext_vector_type(2)));
typedef GAS unsigned gu32;

#define LDS_WAIT() asm volatile("s_waitcnt lgkmcnt(0)" ::: "memory")
#define VM_WAIT() asm volatile("s_waitcnt vmcnt(0)" ::: "memory")
#define RLX_AGENT __ATOMIC_RELAXED, __HIP_MEMORY_SCOPE_AGENT

DEVI unsigned pk2(float lo, float hi) { f32x2 v = {lo, hi}; bf16x2_t b = __builtin_convertvector(v, bf16x2_t); return __builtin_bit_cast(unsigned, b); }
DEVI float bflo(unsigned u) { return __uint_as_float(u << 16); }
DEVI float bfhi(unsigned u) { return __uint_as_float(u & 0xffff0000u); }
DEVI f32x4 unpack4(u32x2 w) { return (f32x4){bflo(w.x), bfhi(w.x), bflo(w.y), bfhi(w.y)}; }
DEVI u32x2 pack4(f32x4 v) { u32x2 w; w.x = pk2(v[0], v[1]); w.y = pk2(v[2], v[3]); return w; }
DEVI float sigmoid_f(float x) { return __builtin_amdgcn_rcpf(1.0f + __expf(-x)); }
DEVI const char* sgpr_ptr(const char* p) { const unsigned long long u = (unsigned long long)p; const unsigned lo = (unsigned)__builtin_amdgcn_readfirstlane((int)(unsigned)u), hi = (unsigned)__builtin_amdgcn_readfirstlane((int)(unsigned)(u >> 32)); return (const char*)(((unsigned long long)hi << 32) | lo); }
DEVI float wave_sum(float v) {
#pragma unroll
    for (int o = 1; o < 64; o <<= 1) v += __shfl_xor(v, o);
    return v;
}

namespace pg8 {
constexpr int BM = 256, BK = 64, HALF = 128, HTB = HALF * BK * 2  , STAGE_BYTES = 8 * HTB;
DEVI int lds_byte(int r, int c) { const int st = (r >> 4) * 2 + (c >> 5), rr = r & 15, cc = c & 31, ob = rr * 64 + cc * 2; return st * 1024 + (ob ^ (((ob >> 9) & 1) << 5)); }
DEVI void stage_rc(int b, int& R, int& C) { const int st = b / 1024, sb = b % 1024, swz = sb ^ (((sb >> 9) & 1) << 5); R = (st >> 1) * 16 + swz / 64; C = (st & 1) * 32 + (swz % 64) / 2; }
struct Unit { int pm, pn, e, v; };

template <class P>
DEVI void gemm_phase(LAS unsigned char* lds, const P& S) {
    int tid = threadIdx.x; asm volatile("" : "+v"(tid));
    const int wid = __builtin_amdgcn_readfirstlane(tid >> 6), lane = tid & 63, wr = wid >> 2, wc = wid & 3, fr = lane & 15, fq = lane >> 4;
    const int nt = S.K / BK;
    int Rp[2], Cp[2]; unsigned voffB[2];
#pragma unroll
    for (int i = 0; i < 2; ++i) { stage_rc(tid * 16 + i * 8192, Rp[i], Cp[i]); voffB[i] = (unsigned)Rp[i] * S.ldb + (unsigned)Cp[i] * 2u; }
    const size_t hstepB = (size_t)HALF * S.ldb;
    const unsigned ldsw = (unsigned)wid * 1024u;
    const int aoff = lds_byte(wr * 64 + fr, fq * 8), boff = lds_byte(wc * 32 + fr, fq * 8);
    const char* const Abase = S.A;
#define PG8_SA(b, h) (((b) * 2 + (h)) * HTB)
#define PG8_SB(b, h) ((4 + (b) * 2 + (h)) * HTB)
#define PG8_STAGE_A(bufoff, ao, sp) do { _Pragma("unroll") for (int _i = 0; _i < 2; ++_i) \
        __builtin_amdgcn_global_load_lds((const unsigned*)((sp) + (ao)[_i]), (LAS unsigned*)(lds + (bufoff) + ldsw + _i * 8192), 16, 0, 0); } while (0)
#define PG8_PIN(p) do { (p) = sgpr_ptr(p); asm volatile("" : "+s"(p)); } while (0)
#define PG8_STAGE_B(bufoff, bp) do { _Pragma("unroll") for (int _i = 0; _i < 2; ++_i) \
        __builtin_amdgcn_global_load_lds((const unsigned*)((bp) + voffB[_i]), (LAS unsigned*)(lds + (bufoff) + ldsw + _i * 8192), 16, 0, 0); } while (0)
#define PG8_LDA(dst, b, h) do { _Pragma("unroll") for (int m = 0; m < 4; ++m) _Pragma("unroll") for (int k = 0; k < 2; ++k) dst[m][k] = *(const LAS bf16x8*)(lds + PG8_SA(b, h) + aoff + m * 2048 + k * 1024); } while (0)
#define PG8_LDB(dst, b, h) do { _Pragma("unroll") for (int n = 0; n < 2; ++n) _Pragma("unroll") for (int k = 0; k < 2; ++k) dst[n][k] = *(const LAS bf16x8*)(lds + PG8_SB(b, h) + boff + n * 2048 + k * 1024); } while (0)
#define PG8_MMA(ai, bj, At, Bt) do { __builtin_amdgcn_s_setprio(1); _Pragma("unroll") for (int m = 0; m < 4; ++m) _Pragma("unroll") for (int n = 0; n < 2; ++n) _Pragma("unroll") for (int k = 0; k < 2; ++k) \
        acc[ai][bj][m][n] = __builtin_amdgcn_mfma_f32_16x16x32_bf16(Bt[n][k], At[m][k], acc[ai][bj][m][n], 0, 0, 0); __builtin_amdgcn_s_setprio(0); } while (0)
#define PG8_WAIT_V(n) asm volatile("s_waitcnt vmcnt(" #n ")" ::: "memory")
#define PG8_WAIT_L(n) asm volatile("s_waitcnt lgkmcnt(" #n ")" ::: "memory")
#define PG8_BAR __builtin_amdgcn_s_barrier()
#define PG8_SCHED __builtin_amdgcn_sched_barrier(0)
    Unit cur, nxt; int ui = 0;
    if (!S.next(0, cur)) return;
    f32x4 acc[2][2][4][2];
#pragma unroll
    for (int a = 0; a < 2; ++a)
#pragma unroll
        for (int b = 0; b < 2; ++b)
#pragma unroll
            for (int m = 0; m < 4; ++m)
#pragma unroll
                for (int n = 0; n < 2; ++n) acc[a][b][m][n] = (f32x4){0.f, 0.f, 0.f, 0.f};
    bf16x8 At[4][2], B0[2][2], B1[2][2];
    unsigned ac0[2], ac1[2], an0[2], an1[2];
#pragma unroll
    for (int i = 0; i < 2; ++i) { ac0[i] = S.a_off(cur, Rp[i]) + (unsigned)Cp[i] * 2u; ac1[i] = S.a_off(cur, Rp[i] + HALF) + (unsigned)Cp[i] * 2u; }
    const char* cB = S.Bt + S.b_off(cur);
    { const char* q0 = cB; const char* q1 = cB + hstepB; const char* q2 = Abase; const char* q3 = cB + 128; const char* q4 = Abase + 128; const char* q5 = cB + hstepB + 128;
      PG8_PIN(q0); PG8_PIN(q1); PG8_PIN(q2); PG8_PIN(q3); PG8_PIN(q4); PG8_PIN(q5);
    PG8_STAGE_B(PG8_SB(0, 0), q0); PG8_STAGE_B(PG8_SB(0, 1), q1); PG8_STAGE_A(PG8_SA(0, 0), ac0, q2); PG8_STAGE_A(PG8_SA(0, 1), ac1, q2);
    if (wr == 1) PG8_BAR;
    PG8_WAIT_V(2); PG8_BAR;
    PG8_STAGE_B(PG8_SB(1, 0), q3); PG8_STAGE_A(PG8_SA(1, 0), ac0, q4); PG8_STAGE_B(PG8_SB(1, 1), q5);
    PG8_WAIT_V(6); PG8_BAR; }
    for (;;) {
        const bool has_next = S.next(ui + 1, nxt);
        const char* nB = cB;
        if (has_next) {
#pragma unroll
            for (int i = 0; i < 2; ++i) { an0[i] = S.a_off(nxt, Rp[i]) + (unsigned)Cp[i] * 2u; an1[i] = S.a_off(nxt, Rp[i] + HALF) + (unsigned)Cp[i] * 2u; }
            nB = S.Bt + S.b_off(nxt);
        } else {
#pragma unroll
            for (int i = 0; i < 2; ++i) { an0[i] = ac0[i]; an1[i] = ac1[i]; }
        }
        for (int t = 0; t < nt; t += 2) {
            const bool last = (t == nt - 2);
            unsigned a20[2], a21[2];
#pragma unroll
            for (int i = 0; i < 2; ++i) { a20[i] = last ? an0[i] : ac0[i]; a21[i] = last ? an1[i] : ac1[i]; }
            const int k1 = (t + 1) * 128, k2 = last ? 0 : (t + 2) * 128;
            const char* b2 = last ? nB : cB + (size_t)(t + 2) * 128; const char* b3 = b2 + 128; const char* b2h = b2 + hstepB; const char* b3h = b3 + hstepB;
            const char* pa1 = Abase + k1; const char* pa2 = Abase + k2; const char* pa3 = pa2 + 128;
            PG8_PIN(b2); PG8_PIN(b3); PG8_PIN(b2h); PG8_PIN(b3h); PG8_PIN(pa1); PG8_PIN(pa2); PG8_PIN(pa3);
            PG8_LDB(B0, 0, 0); PG8_LDB(B1, 0, 1); PG8_SCHED; PG8_LDA(At, 0, 0); PG8_STAGE_A(PG8_SA(1, 1), ac1, pa1);
            PG8_WAIT_V(8); PG8_WAIT_L(0); PG8_BAR; PG8_MMA(0, 0, At, B0); PG8_MMA(0, 1, At, B1); PG8_BAR; PG8_SCHED;
            PG8_LDA(At, 0, 1); PG8_STAGE_B(PG8_SB(0, 0), b2); PG8_STAGE_B(PG8_SB(0, 1), b2h); PG8_STAGE_A(PG8_SA(0, 0), a20, pa2);
            PG8_WAIT_V(8); PG8_WAIT_L(0); PG8_BAR; PG8_MMA(1, 0, At, B0); PG8_MMA(1, 1, At, B1); PG8_BAR; PG8_SCHED;
            PG8_LDB(B0, 1, 0); PG8_LDB(B1, 1, 1); PG8_SCHED; PG8_LDA(At, 1, 0); PG8_STAGE_A(PG8_SA(0, 1), a21, pa2);
            PG8_WAIT_V(8); PG8_WAIT_L(0); PG8_BAR; PG8_MMA(0, 0, At, B0); PG8_MMA(0, 1, At, B1); PG8_BAR; PG8_SCHED;
            PG8_LDA(At, 1, 1); PG8_STAGE_B(PG8_SB(1, 0), b3); PG8_STAGE_B(PG8_SB(1, 1), b3h); PG8_STAGE_A(PG8_SA(1, 0), a20, pa3);
            PG8_WAIT_V(8); PG8_WAIT_L(0); PG8_BAR; PG8_MMA(1, 0, At, B0); PG8_MMA(1, 1, At, B1); PG8_BAR; PG8_SCHED;
        }
        if (wr == 0) PG8_BAR;
        S.epi(acc, cur, wr, wc, fr, fq);
        if (!has_next) break;
#pragma unroll
        for (int a = 0; a < 2; ++a)
#pragma unroll
            for (int b = 0; b < 2; ++b)
#pragma unroll
                for (int m = 0; m < 4; ++m)
#pragma unroll
                    for (int n = 0; n < 2; ++n) acc[a][b][m][n] = (f32x4){0.f, 0.f, 0.f, 0.f};
        cur = nxt; cB = nB; ++ui;
#pragma unroll
        for (int i = 0; i < 2; ++i) { ac0[i] = an0[i]; ac1[i] = an1[i]; }
        if (wr == 1) PG8_BAR;
    }
    PG8_WAIT_V(0);
    PG8_BAR;
#undef PG8_SA
#undef PG8_SB
#undef PG8_STAGE_A
#undef PG8_STAGE_B
#undef PG8_PIN
#undef PG8_LDA
#undef PG8_LDB
#undef PG8_MMA
#undef PG8_WAIT_V
#undef PG8_WAIT_L
#undef PG8_BAR
#undef PG8_SCHED
}
}
#define XB_TMO      128
#define XB_XCNT(j)  (256  + 64 * (j))
#define XB_XSUB(j)  (1280 + 64 * (j))
#define XB_XGEN(j)  (2304 + 64 * (j))
#define XB_TOP      3328
#define XB_TOPGEN   3392
#define XCD_BAR_WORDS 3456
#define XB_SPIN_CAP (1u << 18)

__device__ __forceinline__ unsigned xb_ld(unsigned* p)              { return __hip_atomic_load(p, __ATOMIC_RELAXED, __HIP_MEMORY_SCOPE_AGENT); }
__device__ __forceinline__ unsigned xb_add(unsigned* p, unsigned v) { return __hip_atomic_fetch_add(p, v, __ATOMIC_RELAXED, __HIP_MEMORY_SCOPE_AGENT); }
__device__ __forceinline__ unsigned xb_xcc_id() { return (unsigned)__builtin_amdgcn_s_getreg((3 << 11) | 20) & 0xFu; }
#define XB_SPIN(cond, bar) do { unsigned _sp = 0; while (cond) { __builtin_amdgcn_s_sleep(1); \
    if ((++_sp & 255u) == 0u) { if (xb_ld(&(bar)[XB_TMO])) break; if (_sp > XB_SPIN_CAP) { atomicAdd(&(bar)[XB_TMO], 1u); break; } } } } while (0)

struct XcdBarrier {
    unsigned* bar; unsigned x;
    volatile LAS unsigned* st;
};

__device__ __forceinline__ XcdBarrier xcd_barrier_post(unsigned* bar, volatile LAS unsigned* st) {
    XcdBarrier b; b.bar = bar; b.x = xb_xcc_id(); b.st = st;
    if (threadIdx.x == 0) (void)xb_add(&bar[XB_XCNT(b.x)], 1u);
    return b;
}
__device__ __forceinline__ void xcd_barrier_complete(unsigned* bar, unsigned x, unsigned& nloc, unsigned& nx) {
    const unsigned G = gridDim.x * gridDim.y * gridDim.z;
    unsigned sum, cnt, mine, sp = 0u;
    for (;;) {
        sum = 0u; cnt = 0u; mine = 0u;
#pragma unroll
        for (unsigned j = 0; j < 16; ++j) { const unsigned c = xb_ld(&bar[XB_XCNT(j)]); sum += c; cnt += (c > 0u) ? 1u : 0u; mine = (j == x) ? c : mine; }
        if (sum == G) break;
        __builtin_amdgcn_s_sleep(1);
        if ((++sp & 255u) == 0u) { if (xb_ld(&bar[XB_TMO])) break; if (sp > XB_SPIN_CAP) { atomicAdd(&bar[XB_TMO], 1u); break; } }
    }
    nloc = mine > 0u ? mine : 1u; nx = cnt > 0u ? cnt : 1u;
}

__device__ __forceinline__ void xcd_barrier(const XcdBarrier& b) {
    asm volatile("s_waitcnt vmcnt(0)" ::: "memory");
    __syncthreads();
    if (threadIdx.x == 0) {
        unsigned* bar = b.bar;
        __builtin_amdgcn_s_waitcnt(0);
        unsigned nloc = b.st[0], nx = b.st[1];
        if (nloc == 0u) { xcd_barrier_complete(bar, b.x, nloc, nx); b.st[0] = nloc; b.st[1] = nx; }
        const unsigned old = xb_add(&bar[XB_XSUB(b.x)], 1u);
        const unsigned gen = old / nloc;
        if (old + 1u == (gen + 1u) * nloc) {
            __builtin_amdgcn_fence(__ATOMIC_RELEASE, "agent");
            asm volatile("s_waitcnt vmcnt(0)" ::: "memory");
            const unsigned og = xb_add(&bar[XB_TOP], 1u);
            const unsigned tg = og / nx;
            if (og + 1u == (tg + 1u) * nx) xb_add(&bar[XB_TOPGEN], 1u);
            else XB_SPIN(xb_ld(&bar[XB_TOPGEN]) == tg, bar);
            __builtin_amdgcn_fence(__ATOMIC_ACQUIRE, "agent");
            xb_add(&bar[XB_XGEN(b.x)], 1u);
            asm volatile("s_waitcnt vmcnt(0)" ::: "memory");
        } else {
            XB_SPIN(xb_ld(&bar[XB_XGEN(b.x)]) == gen, bar);
            __builtin_amdgcn_fence(__ATOMIC_ACQUIRE, "agent");
            asm volatile("s_waitcnt vmcnt(0)" ::: "memory");
        }
    }
    __syncthreads();
}

constexpr int NTOK = 32768, DM = 1024, SEQ = 2048, NBATCH = 16, NEXP = 32, DEXP = 512, PLE = 256;
constexpr int NWIN = 2608, NWIN_PAD = 2816;
constexpr float EPS = 1e-6f;
constexpr float C2 = 0.125f * 1.4426950408889634f;
constexpr int NWAVES = 8;

constexpr size_t MiB = 1u << 20;
constexpr size_t WS_CTL = 0, CTL_ZERO_BYTES = 1 * MiB;
constexpr int CW_TMO = 0, CW_BAR = 4096;
constexpr size_t WS_RS0 = 1 * MiB;
constexpr size_t WS_RS1 = WS_RS0 + 131072;
constexpr size_t WS_RS2 = WS_RS1 + 131072;
constexpr size_t WS_ASGE = WS_RS2 + 131072;
constexpr size_t WS_ASGR = WS_ASGE + 262144;
constexpr size_t WS_ASGW = WS_ASGR + 262144;
constexpr size_t WS_TSLOT = WS_ASGW + 262144;
constexpr int NSLOT = 2 * NTOK, NSLOT_PAD = NSLOT + 256;
constexpr size_t WS_STOK = WS_TSLOT + 262144;
constexpr size_t WS_SW = WS_STOK + 266240;
constexpr size_t WS_SRS = WS_SW + 266240;
constexpr size_t WS_CNT = WS_SRS + 266240;
constexpr size_t WS_MTOT = WS_CNT + 32768;
constexpr size_t WS_CBP = WS_MTOT + 1024;
constexpr size_t WS_RW = WS_CBP + 65536;
constexpr size_t WS_CB = WS_RW + 393216;
constexpr size_t WS_W2T = WS_CB + 2048;
constexpr size_t WS_SSQ = 4 * MiB;
constexpr size_t WS_ROPE = 6 * MiB;
static_assert(WS_W2T + 2 * 64 * 256 * 2 <= WS_SSQ, "tables");
constexpr size_t WS_WPW1 = 16 * MiB, WS_WPW2 = 20 * MiB, WS_WIN = 22 * MiB, WS_WOUT = 28 * MiB, WS_WC1 = 30 * MiB, WS_WPP = 32 * MiB, WS_WPG = 33 * MiB;
constexpr size_t WS_WGU = 40 * MiB, WS_WDN = 104 * MiB;
constexpr size_t WS_HA = 136 * MiB, WS_HB = 200 * MiB, WS_PP = 264 * MiB, WS_PB = 328 * MiB;
constexpr size_t WS_YB = 344 * MiB, WS_HBUF = 473 * MiB;
constexpr size_t WS_U = 344 * MiB, WS_V = 408 * MiB;
constexpr size_t WS_Q = WS_PP, WS_KV = 344 * MiB, WS_O = 440 * MiB, WS_CP = WS_HA  , WS_GATES = 504 * MiB, WS_KC = 510 * MiB, WS_VC = 511 * MiB;
constexpr size_t WS_END = 538 * MiB;
constexpr size_t KVS = (size_t)NTOK * 256;

constexpr int RING_OFF = 0, RING_BYTES = 131072;
constexpr int LDSCTL_OFF = RING_BYTES;
constexpr int MISC_OFF = LDSCTL_OFF + 320;
constexpr int TAB_OFF = LDSCTL_OFF + 1024;
constexpr int SCR_OFF = LDSCTL_OFF + 4096;
constexpr int LDS_BYTES = 147456;

struct Args { const float* in[30]; float* out; unsigned char* ws; float inv_freq[32]; };
struct Frame {
    LAS unsigned char* lds;
    gu32* ctl;
    unsigned char* ws;
    int tid, lane, wave, vcu, G;
};
DEVI void wg_sync() { __syncthreads(); }

DEVI int rowmap(int mode, int half, int n) {
    if (mode == 0) return n;
    if (mode == 1) return 256 * (n >> 7) + 128 * half + (n & 127);
    if (n < 2560) { const int hd = n >> 6, d = n & 63; return 256 * (hd >> 2) + 128 * (d >> 5) + 32 * (hd & 3) + (d & 31); }
    return n;
}
DEVI void p0_item(const float* W, int ld, int ncols, int K, const float* gain, bf16_t* dst, int mode, int half, LAS unsigned char* scr, int item, int lane) {
    const int nblk = (ncols + 63) >> 6, kb = item / nblk, nb = item % nblk, k0 = 64 * kb, n0 = 64 * nb;
    const int lr = lane >> 4, lc = 4 * (lane & 15);
    f32x4 v[16];
#pragma unroll
    for (int i = 0; i < 16; ++i) v[i] = (n0 + lc < ncols) ? *(const f32x4*)(W + (size_t)(k0 + 4 * i + lr) * ld + n0 + lc) : (f32x4){0.f, 0.f, 0.f, 0.f};
#pragma unroll
    for (int i = 0; i < 16; ++i) { const float g = gain ? gain[k0 + 4 * i + lr] : 1.0f; const f32x4 x = v[i] * g; *(LAS u32x2*)(scr + (4 * i + lr) * 136 + lc * 2) = pack4(x); }
    LDS_WAIT();
    const int c = lane & 7;
#pragma unroll
    for (int j = 0; j < 8; ++j) { const int n = (lane >> 3) + 8 * j; const LAS unsigned short* t = (const LAS unsigned short*)(scr + (8 * c) * 136 + n * 2);
        u32x4 o; o.x = (unsigned)t[0 * 68] | ((unsigned)t[1 * 68] << 16); o.y = (unsigned)t[2 * 68] | ((unsigned)t[3 * 68] << 16); o.z = (unsigned)t[4 * 68] | ((unsigned)t[5 * 68] << 16); o.w = (unsigned)t[6 * 68] | ((unsigned)t[7 * 68] << 16);
        if (n0 + n < ncols) *(u32x4*)(dst + (size_t)rowmap(mode, half, n0 + n) * K + k0 + 8 * c) = o; }
    LDS_WAIT();
}
DEVI void p0_load(f32x4 (&v)[16], const float* W, int ld, int ncols, int item, int lane) {
    const int nblk = (ncols + 63) >> 6, kb = item / nblk, nb = item % nblk, k0 = 64 * kb, n0 = 64 * nb, lr = lane >> 4, lc = 4 * (lane & 15);
#pragma unroll
    for (int i = 0; i < 16; ++i) v[i] = (n0 + lc < ncols) ? *(const f32x4*)(W + (size_t)(k0 + 4 * i + lr) * ld + n0 + lc) : (f32x4){0.f, 0.f, 0.f, 0.f};
}
DEVI void p0_finish(const f32x4 (&v)[16], int ncols, int K, const float* gain, bf16_t* dst, int mode, int half, LAS unsigned char* scr, int item, int lane) {
    const int nblk = (ncols + 63) >> 6, kb = item / nblk, nb = item % nblk, k0 = 64 * kb, n0 = 64 * nb, lr = lane >> 4, lc = 4 * (lane & 15);
#pragma unroll
    for (int i = 0; i < 16; ++i) { const float g = gain ? gain[k0 + 4 * i + lr] : 1.0f; const f32x4 x = v[i] * g; *(LAS u32x2*)(scr + (4 * i + lr) * 136 + lc * 2) = pack4(x); }
    LDS_WAIT();
    const int c = lane & 7;
#pragma unroll
    for (int j = 0; j < 8; ++j) { const int n = (lane >> 3) + 8 * j; const LAS unsigned short* t = (const LAS unsigned short*)(scr + (8 * c) * 136 + n * 2);
        u32x4 o; o.x = (unsigned)t[0 * 68] | ((unsigned)t[1 * 68] << 16); o.y = (unsigned)t[2 * 68] | ((unsigned)t[3 * 68] << 16); o.z = (unsigned)t[4 * 68] | ((unsigned)t[5 * 68] << 16); o.w = (unsigned)t[6 * 68] | ((unsigned)t[7 * 68] << 16);
        if (n0 + n < ncols) *(u32x4*)(dst + (size_t)rowmap(mode, half, n0 + n) * K + k0 + 8 * c) = o; }
    LDS_WAIT();
}
DEVI void prep_layer(const Frame& F, const Args& a, int L) {
    LAS unsigned char* scr = F.lds + RING_OFF + F.wave * 16384;
    const int gw = F.vcu * NWAVES + F.wave, NGW = F.G * NWAVES;
    const float* gf = a.in[4] + (size_t)L * DM;
    bf16_t* wgu = (bf16_t*)(F.ws + WS_WGU); bf16_t* wdn = (bf16_t*)(F.ws + WS_WDN);
#define PREP_SRC(it_) ((((it_) % 384) >> 7) == 0 ? a.in[25] + ((size_t)L * NEXP + (it_) / 384) * DM * DEXP : (((it_) % 384) >> 7) == 1 ? a.in[26] + ((size_t)L * NEXP + (it_) / 384) * DM * DEXP : a.in[27] + ((size_t)L * NEXP + (it_) / 384) * DEXP * DM)
    f32x4 vc[16], vn[16];
    int it = gw;
    if (it < NEXP * 384) { const int wh = (it % 384) >> 7; p0_load(vc, PREP_SRC(it), wh == 2 ? DM : DEXP, wh == 2 ? DM : DEXP, it & 127, F.lane); }
    for (; it < NEXP * 384; it += NGW) {
        const int itn = it + NGW;
        if (itn < NEXP * 384) { const int wh = (itn % 384) >> 7; p0_load(vn, PREP_SRC(itn), wh == 2 ? DM : DEXP, wh == 2 ? DM : DEXP, itn & 127, F.lane); }
        { const int e = it / 384, wh = (it % 384) >> 7, item = it & 127;
          if (wh == 2) p0_finish(vc, DM, DEXP, nullptr, wdn + (size_t)e * 1024 * 512, 0, 0, scr, item, F.lane);
          else p0_finish(vc, DEXP, DM, gf, wgu + (size_t)e * 1024 * 1024, 1, wh, scr, item, F.lane); }
#pragma unroll
        for (int i = 0; i < 16; ++i) vc[i] = vn[i];
    }
#undef PREP_SRC
    const float* p = a.in[1] + (size_t)L * NTOK * PLE; bf16_t* pb = (bf16_t*)(F.ws + WS_PB);
    const size_t n8 = (size_t)NTOK * PLE / 8;
#pragma unroll 4
    for (size_t i = (size_t)F.vcu * 512 + F.tid; i < n8; i += (size_t)F.G * 512) {
        const f32x4 v0 = *(const f32x4*)(p + i * 8), v1 = *(const f32x4*)(p + i * 8 + 4);
        u32x4 o; o.x = pk2(v0[0], v0[1]); o.y = pk2(v0[2], v0[3]); o.z = pk2(v1[0], v1[1]); o.w = pk2(v1[2], v1[3]);
        *(u32x4*)(pb + i * 8) = o; }
}
DEVI void p0_prologue(const Frame& F, const Args& a) {
    LAS unsigned char* scr = F.lds + RING_OFF + F.wave * 16384;
    const int gw = F.vcu * NWAVES + F.wave, NGW = F.G * NWAVES;
    unsigned char* ws = F.ws;
    constexpr int I_PW1 = 16 * 16 * 2, I_PW2 = 16 * 16, I_WIN = 16 * 41, I_WOUT = 16 * 16, I_C1 = 32 * 4 * 2, I_PP = 4 * 16 * 2, I_PG = 16 * 16 * 2;
    constexpr int NIT = I_PW1 + I_PW2 + I_WIN + I_WOUT + I_C1 + I_PP + I_PG;
    for (int it = gw; it < NIT; it += NGW) {
        int r = it;
        if (r < I_PW1) { const int half = r / 256; p0_item(a.in[6] + half * 1024, 2048, 1024, DM, a.in[3], (bf16_t*)(ws + WS_WPW1), 1, half, scr, r % 256, F.lane); continue; } r -= I_PW1;
        if (r < I_PW2) { p0_item(a.in[12], DM, DM, DM, nullptr, (bf16_t*)(ws + WS_WPW2), 0, 0, scr, r, F.lane); continue; } r -= I_PW2;
        if (r < I_WIN) { p0_item(a.in[14], NWIN, NWIN, DM, a.in[3] + DM, (bf16_t*)(ws + WS_WIN), 2, 0, scr, r, F.lane); continue; } r -= I_WIN;
        if (r < I_WOUT) { p0_item(a.in[20], DM, DM, DM, nullptr, (bf16_t*)(ws + WS_WOUT), 0, 0, scr, r, F.lane); continue; } r -= I_WOUT;
        if (r < I_C1) { const int j = r / 128; p0_item(a.in[18] + (size_t)j * 2048 * 256, 256, 256, 2048, nullptr, (bf16_t*)(ws + WS_WC1) + (size_t)j * 256 * 2048, 0, 0, scr, r % 128, F.lane); continue; } r -= I_C1;
        if (r < I_PP) { const int L = r / 64; p0_item(a.in[28] + (size_t)L * PLE * DM, DM, DM, PLE, nullptr, (bf16_t*)(ws + WS_WPP) + (size_t)L * DM * PLE, 0, 0, scr, r % 64, F.lane); continue; } r -= I_PP;
        { const int L = r / 256; p0_item(a.in[29] + (size_t)L * DM * DM, DM, DM, DM, a.in[5] + (size_t)L * DM, (bf16_t*)(ws + WS_WPG) + (size_t)L * DM * DM, 0, 0, scr, r % 256, F.lane); }
    }
    { u32x4* z = (u32x4*)((bf16_t*)(ws + WS_WIN) + (size_t)NWIN * DM); const int n16 = (NWIN_PAD - NWIN) * DM / 8;
      for (int i = F.vcu * 512 + F.tid; i < n16; i += F.G * 512) z[i] = (u32x4){0u, 0u, 0u, 0u}; }
    { bf16_t* rw = (bf16_t*)(ws + WS_RW);
      for (int i = F.vcu * 512 + F.tid; i < 2 * 48 * 1024; i += F.G * 512) {
          const int L = i / (48 * 1024), j = (i / 1024) % 48, k = i & 1023;
          float w = 0.f;
          if (j < 4) w = a.in[21][((size_t)L * DM + k) * 4 + j]; else if (j < 36) w = a.in[23][((size_t)L * DM + k) * 32 + (j - 4)];
          w *= a.in[4][(size_t)L * DM + k];
          const unsigned hi = pk2(w, 0.f) & 0xffffu; const float lo = w - bflo(hi);
          rw[((size_t)(L * 2 + 0) * 48 + j) * 1024 + k] = (bf16_t)hi; rw[((size_t)(L * 2 + 1) * 48 + j) * 1024 + k] = (bf16_t)(pk2(lo, 0.f) & 0xffffu); } }
    { bf16_t* w2t = (bf16_t*)(ws + WS_W2T);
      for (int i = F.vcu * 512 + F.tid; i < 2 * 64 * 256; i += F.G * 512) { const int j = i >> 14, n = (i >> 8) & 63, k = i & 255; w2t[i] = (bf16_t)(pk2(a.in[19][(size_t)(j * 256 + k) * 64 + n], 0.f) & 0xffffu); } }
    for (int it = gw; it < 2 * 4 * 32; it += NGW) {
        const int j = it >> 7, cg = (it >> 5) & 3, kr = it & 31;
        const float* pe = a.in[17] + (size_t)j * 2048 + kr * 64; const float* w1 = a.in[18] + ((size_t)j * 2048 + kr * 64) * 256 + cg * 64 + F.lane;
        float s = 0.f;
#pragma unroll 16
        for (int k = 0; k < 64; ++k) s += pe[k] * w1[(size_t)k * 256];
        ((float*)(ws + WS_CBP))[(j * 32 + kr) * 256 + cg * 64 + F.lane] = s; }
    { float* rope = (float*)(ws + WS_ROPE); const int* pos = (const int*)a.in[2];
      for (int i = F.vcu * 512 + F.tid; i < NTOK * 32; i += F.G * 512) {
          const int row = i >> 5, fi = i & 31;
          const float ang = (float)pos[row] * a.inv_freq[fi];
          const double rev = (double)ang * 0.15915494309189533577; const float fr = (float)(rev - floor(rev));
          rope[(size_t)row * 64 + fi] = __builtin_amdgcn_cosf(fr); rope[(size_t)row * 64 + 32 + fi] = __builtin_amdgcn_sinf(fr); } }
    { const float* x = a.in[0]; bf16_t* ha = (bf16_t*)(ws + WS_HA); float* rs0 = (float*)(ws + WS_RS0);
      f32x4 va[4], vb[4], na[4], nb[4];
#define XR(m_, j_) (((const f32x4*)(x + (size_t)(m_) * DM) + F.lane)[64 * (j_)])
      if (gw < NTOK) {
#pragma unroll
          for (int j = 0; j < 4; ++j) { na[j] = XR(gw, j); nb[j] = (gw + NGW < NTOK) ? XR(gw + NGW, j) : (f32x4){0.f, 0.f, 0.f, 0.f}; } }
      for (int m = gw; m < NTOK; m += 2 * NGW) {
#pragma unroll
          for (int j = 0; j < 4; ++j) { va[j] = na[j]; vb[j] = nb[j]; }
          if (m + 2 * NGW < NTOK) {
#pragma unroll
              for (int j = 0; j < 4; ++j) { na[j] = XR(m + 2 * NGW, j); nb[j] = (m + 3 * NGW < NTOK) ? XR(m + 3 * NGW, j) : (f32x4){0.f, 0.f, 0.f, 0.f}; } }
          float sa = 0.f, sb = 0.f;
#pragma unroll
          for (int j = 0; j < 4; ++j) { sa += (va[j][0] * va[j][0] + va[j][1] * va[j][1]) + (va[j][2] * va[j][2] + va[j][3] * va[j][3]); sb += (vb[j][0] * vb[j][0] + vb[j][1] * vb[j][1]) + (vb[j][2] * vb[j][2] + vb[j][3] * vb[j][3]); }
          sa = wave_sum(sa); sb = wave_sum(sb);
          u32x2* oa = (u32x2*)(ha + (size_t)m * DM) + F.lane; u32x2* ob = (u32x2*)(ha + (size_t)(m + NGW) * DM) + F.lane;
#pragma unroll
          for (int j = 0; j < 4; ++j) { oa[64 * j] = pack4(va[j]); if (m + NGW < NTOK) ob[64 * j] = pack4(vb[j]); }
          if (F.lane == 0) { rs0[m] = 1.0f / sqrtf(sa * (1.0f / DM) + EPS); if (m + NGW < NTOK) rs0[m + NGW] = 1.0f / sqrtf(sb * (1.0f / DM) + EPS); } }
#undef XR
      }

}

using pg8::Unit;
typedef f32x4 AccT[2][2][4][2];
struct ProbBase { const char* A; const char* Bt; int K; unsigned ldb; int G, c; };

#define EPI_FENCE() asm volatile("" ::: "memory")
struct ProbPw1 : ProbBase {
    const float* __restrict__ rstd; const float* __restrict__ bias; bf16_t* __restrict__ U;
    DEVI bool next(int i, Unit& u) const { const int L = i * G + c; if (L >= 128 * 8) return false; u.pm = L >> 3; u.pn = L & 7; u.e = 0; u.v = 256; return true; }
    DEVI unsigned a_off(const Unit& u, int R) const { return (unsigned)(u.pm * 256 + R) * 2048u; }
    DEVI size_t b_off(const Unit& u) const { return (size_t)u.pn * 256 * ldb; }
    DEVI void epi(const AccT& acc, const Unit& u, int wr, int wc, int fr, int fq) const {
        const int q0 = 32 * wc + 4 * fq;
        f32x4 ba[2], bg[2]; float rs[2][4];
#pragma unroll
        for (int n = 0; n < 2; ++n) { ba[n] = *(const f32x4*)(bias + 128 * u.pn + q0 + 16 * n); bg[n] = *(const f32x4*)(bias + 1024 + 128 * u.pn + q0 + 16 * n); }
#pragma unroll
        for (int ai = 0; ai < 2; ++ai)
#pragma unroll
            for (int m = 0; m < 4; ++m) rs[ai][m] = rstd[u.pm * 256 + 128 * ai + 64 * wr + 16 * m + fr];
        EPI_FENCE();
#pragma unroll
        for (int ai = 0; ai < 2; ++ai)
#pragma unroll
            for (int m = 0; m < 4; ++m) {
                const int row = u.pm * 256 + 128 * ai + 64 * wr + 16 * m + fr;
#pragma unroll
                for (int n = 0; n < 2; ++n) {
                    const f32x4 av = acc[ai][0][m][n] * rs[ai][m] + ba[n], gv = acc[ai][1][m][n] * rs[ai][m] + bg[n]; f32x4 o;
#pragma unroll
                    for (int j = 0; j < 4; ++j) o[j] = av[j] * sigmoid_f(gv[j]);
                    *(u32x2*)(U + (size_t)row * DM + 128 * u.pn + q0 + 16 * n) = pack4(o); } }
    }
};
struct ProbPP : ProbBase {
    bf16_t* O; int tail_lo;
    DEVI bool next(int i, Unit& u) const { if (c < tail_lo) return false; const int L = i * (G - tail_lo) + (c - tail_lo); if (L >= 128 * 4) return false; u.pm = L >> 2; u.pn = L & 3; u.e = 0; u.v = 256; return true; }
    DEVI unsigned a_off(const Unit& u, int R) const { return (unsigned)(u.pm * 256 + R) * 512u; }
    DEVI size_t b_off(const Unit& u) const { return (size_t)u.pn * 256 * ldb; }
    DEVI void epi(const AccT& acc, const Unit& u, int wr, int wc, int fr, int fq) const {
#pragma unroll
        for (int ai = 0; ai < 2; ++ai)
#pragma unroll
            for (int m = 0; m < 4; ++m) {
                const int row = u.pm * 256 + 128 * ai + 64 * wr + 16 * m + fr;
#pragma unroll
                for (int bj = 0; bj < 2; ++bj)
#pragma unroll
                    for (int n = 0; n < 2; ++n) *(u32x2*)(O + (size_t)row * DM + 256 * u.pn + 128 * bj + 32 * wc + 16 * n + 4 * fq) = pack4(acc[ai][bj][m][n]); }
    }
};
struct ProbRes : ProbBase {
    const bf16_t* __restrict__ RES; bf16_t* __restrict__ OUT; const float* __restrict__ bias;
    DEVI bool next(int i, Unit& u) const { const int L = i * G + c; if (L >= 128 * 4) return false; u.pm = L >> 2; u.pn = L & 3; u.e = 0; u.v = 256; return true; }
    DEVI unsigned a_off(const Unit& u, int R) const { return (unsigned)(u.pm * 256 + R) * 2048u; }
    DEVI size_t b_off(const Unit& u) const { return (size_t)u.pn * 256 * ldb; }
    DEVI void epi(const AccT& acc, const Unit& u, int wr, int wc, int fr, int fq) const {
        const int col0 = 256 * u.pn + 32 * wc + 4 * fq;
        f32x4 bv[2][2];
#pragma unroll
        for (int bj = 0; bj < 2; ++bj)
#pragma unroll
            for (int n = 0; n < 2; ++n) bv[bj][n] = bias ? *(const f32x4*)(bias + col0 + 128 * bj + 16 * n) : (f32x4){0.f, 0.f, 0.f, 0.f};
#pragma unroll
        for (int ai = 0; ai < 2; ++ai) {
            u32x2 r[4][2][2];
#pragma unroll
            for (int m = 0; m < 4; ++m) { const size_t o = (size_t)(u.pm * 256 + 128 * ai + 64 * wr + 16 * m + fr) * DM + col0;
#pragma unroll
                for (int bj = 0; bj < 2; ++bj)
#pragma unroll
                    for (int n = 0; n < 2; ++n) r[m][bj][n] = *(const u32x2*)(RES + o + 128 * bj + 16 * n); }
            EPI_FENCE();
#pragma unroll
            for (int m = 0; m < 4; ++m) { const size_t o = (size_t)(u.pm * 256 + 128 * ai + 64 * wr + 16 * m + fr) * DM + col0;
#pragma unroll
                for (int bj = 0; bj < 2; ++bj)
#pragma unroll
                    for (int n = 0; n < 2; ++n) *(u32x2*)(OUT + o + 128 * bj + 16 * n) = pack4(unpack4(r[m][bj][n]) + acc[ai][bj][m][n] + bv[bj][n]); }
            EPI_FENCE();
        }
    }
};
struct ProbPle : ProbBase {
    const bf16_t* __restrict__ H2; const bf16_t* __restrict__ PPp; const float* __restrict__ rstd; bf16_t* __restrict__ OUTB; float* __restrict__ OUTF; float* __restrict__ ssq; int last;
    DEVI bool next(int i, Unit& u) const { const int L = i * G + c; if (L >= 128 * 4) return false; u.pm = L >> 2; u.pn = L & 3; u.e = 0; u.v = 256; return true; }
    DEVI unsigned a_off(const Unit& u, int R) const { return (unsigned)(u.pm * 256 + R) * 2048u; }
    DEVI size_t b_off(const Unit& u) const { return (size_t)u.pn * 256 * ldb; }
    DEVI void epi(const AccT& acc, const Unit& u, int wr, int wc, int fr, int fq) const {
        const int col0 = 256 * u.pn + 32 * wc + 4 * fq;
#pragma unroll
        for (int ai = 0; ai < 2; ++ai) {
            u32x2 h[4][2][2], q[4][2][2]; float rs[4];
#pragma unroll
            for (int m = 0; m < 4; ++m) { const int row = u.pm * 256 + 128 * ai + 64 * wr + 16 * m + fr; const size_t o = (size_t)row * DM + col0; rs[m] = rstd[row];
#pragma unroll
                for (int bj = 0; bj < 2; ++bj)
#pragma unroll
                    for (int n = 0; n < 2; ++n) { h[m][bj][n] = *(const u32x2*)(H2 + o + 128 * bj + 16 * n); q[m][bj][n] = *(const u32x2*)(PPp + o + 128 * bj + 16 * n); } }
            EPI_FENCE();
#pragma unroll
            for (int m = 0; m < 4; ++m) { const int row = u.pm * 256 + 128 * ai + 64 * wr + 16 * m + fr; const size_t o = (size_t)row * DM + col0; float ss = 0.f;
#pragma unroll
                for (int bj = 0; bj < 2; ++bj)
#pragma unroll
                    for (int n = 0; n < 2; ++n) {
                        const f32x4 h2 = unpack4(h[m][bj][n]), pp = unpack4(q[m][bj][n]), a4 = acc[ai][bj][m][n] * rs[m]; f32x4 v;
#pragma unroll
                        for (int j = 0; j < 4; ++j) v[j] = h2[j] + sigmoid_f(a4[j]) * pp[j];
                        if (last) *(f32x4*)(OUTF + o + 128 * bj + 16 * n) = v;
                        else { *(u32x2*)(OUTB + o + 128 * bj + 16 * n) = pack4(v); ss += (v[0] * v[0] + v[1] * v[1]) + (v[2] * v[2] + v[3] * v[3]); } }
                if (!last) { ss += __shfl_xor(ss, 16); ss += __shfl_xor(ss, 32); if (fq == 0) ssq[(size_t)row * 16 + u.pn * 4 + wc] = ss; } }
            EPI_FENCE();
        }
    }
};
struct ProbGateUp : ProbBase {
    const LAS int* tab_row; const LAS int* tab_ev; int nblk;
    const LAS unsigned* goff;
    const float* __restrict__ slot_rs; bf16_t* __restrict__ HBUF;
    DEVI bool next(int i, Unit& u) const { const int L = i * G + c; if (L >= nblk * 4) return false; const int b = L >> 2; u.pn = L & 3; u.pm = tab_row[b]; const int ev = tab_ev[b]; u.e = (ev >> 9) | (i << 8); u.v = ev & 511; return true; }
    DEVI unsigned a_off(const Unit& u, int R) const { return goff[(u.e >> 8) * 256 + R]; }
    DEVI size_t b_off(const Unit& u) const { return ((size_t)(u.e & 255) * 1024 + (size_t)u.pn * 256) * ldb; }
    DEVI void epi(const AccT& acc, const Unit& u, int wr, int wc, int fr, int fq) const {
        float rsv[2][4];
#pragma unroll
        for (int ai = 0; ai < 2; ++ai)
#pragma unroll
            for (int m = 0; m < 4; ++m) rsv[ai][m] = slot_rs[u.pm + 128 * ai + 64 * wr + 16 * m + fr];
        EPI_FENCE();
#pragma unroll
        for (int ai = 0; ai < 2; ++ai)
#pragma unroll
            for (int m = 0; m < 4; ++m) {
                const int R = 128 * ai + 64 * wr + 16 * m + fr;
                if (R < u.v) { const int slot = u.pm + R; const float rs = rsv[ai][m];
#pragma unroll
                    for (int n = 0; n < 2; ++n) { const f32x4 g = acc[ai][0][m][n] * rs, up = acc[ai][1][m][n] * rs; f32x4 o;
#pragma unroll
                        for (int j = 0; j < 4; ++j) o[j] = g[j] * sigmoid_f(g[j]) * up[j];
                        *(u32x2*)(HBUF + (size_t)slot * DEXP + 128 * u.pn + 32 * wc + 16 * n + 4 * fq) = pack4(o); } } }
    }
};
struct ProbDown : ProbBase {
    const LAS int* tab_row; const LAS int* tab_ev; int nblk;
    const float* __restrict__ slot_w; bf16_t* __restrict__ YB;
    DEVI bool next(int i, Unit& u) const { const int L = i * G + c; if (L >= nblk * 4) return false; const int b = L >> 2; u.pn = L & 3; u.pm = tab_row[b]; const int ev = tab_ev[b]; u.e = ev >> 9; u.v = ev & 511; return true; }
    DEVI unsigned a_off(const Unit& u, int R) const { return (unsigned)(u.pm + R) * 1024u; }
    DEVI size_t b_off(const Unit& u) const { return ((size_t)u.e * 1024 + (size_t)u.pn * 256) * ldb; }
    DEVI void epi(const AccT& acc, const Unit& u, int wr, int wc, int fr, int fq) const {
        float wv[2][4];
#pragma unroll
        for (int ai = 0; ai < 2; ++ai)
#pragma unroll
            for (int m = 0; m < 4; ++m) wv[ai][m] = slot_w[u.pm + 128 * ai + 64 * wr + 16 * m + fr];
        EPI_FENCE();
#pragma unroll
        for (int ai = 0; ai < 2; ++ai)
#pragma unroll
            for (int m = 0; m < 4; ++m) {
                const int R = 128 * ai + 64 * wr + 16 * m + fr;
                if (R < u.v) { const int slot = u.pm + R; const float w = wv[ai][m];
#pragma unroll
                    for (int bj = 0; bj < 2; ++bj)
#pragma unroll
                        for (int n = 0; n < 2; ++n) *(u32x2*)(YB + (size_t)slot * DM + 256 * u.pn + 128 * bj + 32 * wc + 16 * n + 4 * fq) = pack4(acc[ai][bj][m][n] * w); } }
    }
};
struct ProbWin : ProbBase {
    const float* __restrict__ rstd; const float* __restrict__ rope; const float* __restrict__ qnorm; const float* __restrict__ knorm; bf16_t* __restrict__ Q; bf16_t* __restrict__ KV; float* __restrict__ gates;
    DEVI bool next(int i, Unit& u) const { const int L = i * G + c; if (L >= 128 * 11) return false; u.pm = L / 11; u.pn = L % 11; u.e = 0; u.v = 256; return true; }
    DEVI unsigned a_off(const Unit& u, int R) const { return (unsigned)(u.pm * 256 + R) * 2048u; }
    DEVI size_t b_off(const Unit& u) const { return (size_t)u.pn * 256 * ldb; }
    DEVI void epi(const AccT& acc, const Unit& u, int wr, int wc, int fr, int fq) const {
        const int pn = u.pn;
        float rsv[2][4];
#pragma unroll
        for (int ai = 0; ai < 2; ++ai)
#pragma unroll
            for (int m = 0; m < 4; ++m) { const f32x4* pp = (const f32x4*)(rstd + (size_t)(u.pm * 256 + 128 * ai + 64 * wr + 16 * m + fr) * 16);
                const f32x4 s0 = pp[0], s1 = pp[1], s2 = pp[2], s3 = pp[3]; const f32x4 st = (s0 + s1) + (s2 + s3);
                rsv[ai][m] = 1.0f / sqrtf(((st[0] + st[1]) + (st[2] + st[3])) * (1.0f / DM) + EPS); }
        if (pn == 10) {
            EPI_FENCE();
            if (wc < 2) {
#pragma unroll
                for (int ai = 0; ai < 2; ++ai)
#pragma unroll
                    for (int m = 0; m < 4; ++m) {
                        const int row = u.pm * 256 + 128 * ai + 64 * wr + 16 * m + fr; const float rs = rsv[ai][m];
#pragma unroll
                        for (int n = 0; n < 2; ++n) if (wc == 0 || n == 0) { const f32x4 a4 = acc[ai][0][m][n] * rs; f32x4 o;
#pragma unroll
                            for (int j = 0; j < 4; ++j) o[j] = sigmoid_f(a4[j]);
                            *(f32x4*)(gates + (size_t)row * 48 + 32 * wc + 16 * n + 4 * fq) = o; } } }
            return;
        }
        const bool isq = pn < 4, dorope = isq || pn == 6 || pn == 8;
        const float* gvec = isq ? qnorm : (knorm + (pn == 6 ? 64 : 128));
        f32x4 g1[2], g2[2];
#pragma unroll
        for (int n = 0; n < 2; ++n) { g1[n] = *(const f32x4*)(gvec + 16 * n + 4 * fq); g2[n] = *(const f32x4*)(gvec + 32 + 16 * n + 4 * fq); }
        const float oscale = isq ? C2 : 1.0f;
#pragma unroll
        for (int g = 0; g < 8; ++g) { const int ai = g >> 2, m = g & 3;
            const int row = u.pm * 256 + 128 * ai + 64 * wr + 16 * m + fr; const float rs = rsv[ai][m];
            f32x4 cs[2], sn[2];
            if (dorope) { const size_t ro = (size_t)row * 64 + 4 * fq;
#pragma unroll
                for (int n = 0; n < 2; ++n) { cs[n] = *(const f32x4*)(rope + ro + 16 * n); sn[n] = *(const f32x4*)(rope + ro + 32 + 16 * n); } }
            f32x4 x1[2], x2[2];
#pragma unroll
            for (int n = 0; n < 2; ++n) { x1[n] = acc[ai][0][m][n] * rs; x2[n] = acc[ai][1][m][n] * rs; }
            if (dorope) {
                float ss = 0.f;
#pragma unroll
                for (int n = 0; n < 2; ++n)
#pragma unroll
                    for (int j = 0; j < 4; ++j) ss += x1[n][j] * x1[n][j] + x2[n][j] * x2[n][j];
                ss += __shfl_xor(ss, 16); ss += __shfl_xor(ss, 32);
                const float inv = 1.0f / sqrtf(ss * (1.0f / 64.0f) + EPS);
#pragma unroll
                for (int n = 0; n < 2; ++n) {
                    const f32x4 y1 = x1[n] * inv * g1[n], y2 = x2[n] * inv * g2[n];
                    x1[n] = (y1 * cs[n] - y2 * sn[n]) * oscale; x2[n] = (y2 * cs[n] + y1 * sn[n]) * oscale; } }
            bf16_t* dst;
            if (isq) dst = Q + (size_t)row * DM + (4 * pn + wc) * 64;
            else { const int b = row >> 11, t = row & 2047; dst = KV + (size_t)(pn - 4) * KVS + ((size_t)(b * 4 + wc) * SEQ + t) * 64; }
#pragma unroll
            for (int n = 0; n < 2; ++n) { *(u32x2*)(dst + 16 * n + 4 * fq) = pack4(x1[n]); *(u32x2*)(dst + 32 + 16 * n + 4 * fq) = pack4(x2[n]); }
        }
    }
};
struct ProbCmp : ProbBase {
    float* CP;
    DEVI bool next(int i, Unit& u) const { const int L = i * G + c; if (L >= 256) return false; u.e = L >> 7; u.pm = (L >> 2) & 31; u.v = L & 3; u.pn = 0; return true; }
    DEVI unsigned a_off(const Unit& u, int R) const { return (unsigned)u.e * (unsigned)(KVS * 2) + (unsigned)(u.pm * 256 + R) * 2048u + (unsigned)u.v * 1024u; }
    DEVI size_t b_off(const Unit& u) const { return (size_t)u.e * 256 * ldb + (size_t)u.v * 1024; }
    DEVI void epi(const AccT& acc, const Unit& u, int wr, int wc, int fr, int fq) const {
        float* base = CP + ((size_t)(u.e * 4 + u.v) * 8192) * 256;
#pragma unroll
        for (int ai = 0; ai < 2; ++ai)
#pragma unroll
            for (int m = 0; m < 4; ++m) {
                const int rho = u.pm * 256 + 128 * ai + 64 * wr + 16 * m + fr;
#pragma unroll
                for (int bj = 0; bj < 2; ++bj)
#pragma unroll
                    for (int n = 0; n < 2; ++n) *(f32x4*)(base + (size_t)rho * 256 + 128 * bj + 32 * wc + 16 * n + 4 * fq) = acc[ai][bj][m][n]; }
    }
};

#define CONV_BAR() asm volatile("s_waitcnt lgkmcnt(0)\n\ts_barrier" ::: "memory")
DEVI void conv_phase(const Frame& F, const Args& a) {
    const bf16_t* U = (const bf16_t*)(F.ws + WS_U); bf16_t* V = (bf16_t*)(F.ws + WS_V);
    LAS float* red = (LAS float*)(F.lds + SCR_OFF);
    LAS float* fin = red + 256;
    const int tid = F.tid, c0 = 2 * tid;
    f32x2 w2[31];
#pragma unroll
    for (int k = 0; k < 31; ++k) w2[k] = *(const f32x2*)(a.in[8] + (size_t)k * DM + c0);
    const f32x2 bdw = *(const f32x2*)(a.in[9] + c0), lg = *(const f32x2*)(a.in[10] + c0), lb = *(const f32x2*)(a.in[11] + c0);
    for (int ch = F.vcu; ch < 256; ch += F.G) {
        const int tokbase = ch * 128, t0 = tokbase & (SEQ - 1);
        const unsigned* Up = (const unsigned*)U + (size_t)tokbase * 512 + tid;
        unsigned win[46];
#pragma unroll
        for (int i = 0; i < 46; ++i) { const int rel = i - 30; win[i] = (rel >= 0 || t0 != 0) ? Up[(ptrdiff_t)rel * 512] : 0u; }
#pragma unroll
        for (int s = 0; s < 8; ++s) {
            unsigned nxt[16];
            if (s < 7) {
#pragma unroll
                for (int i = 0; i < 16; ++i) nxt[i] = Up[(ptrdiff_t)(16 * (s + 1) + i) * 512]; }
            f32x2 y[16];
#pragma unroll
            for (int tt = 0; tt < 16; ++tt) y[tt] = bdw;
#pragma unroll
            for (int rr = 0; rr < 46; ++rr) {
                const f32x2 v = {bflo(win[rr]), bfhi(win[rr])};
#pragma unroll
                for (int tt = 0; tt < 16; ++tt) { const int k = rr - tt; if (k >= 0 && k <= 30) y[tt] += w2[k] * v; }
            }
            float v16[16];
            { const bool h5 = (F.lane & 32) != 0;
#pragma unroll
              for (int i = 0; i < 16; ++i) { const float sA = y[i][0] + y[i][1], sB = y[i][0] * y[i][0] + y[i][1] * y[i][1]; const float keep = h5 ? sB : sA, send = h5 ? sA : sB; v16[i] = keep + __shfl_xor(send, 32); } }
            float v8[8], v4[4], v2[2], v1r;
            { const bool h = (F.lane & 16) != 0;
#pragma unroll
              for (int i = 0; i < 8; ++i) { const float keep = h ? v16[i + 8] : v16[i], send = h ? v16[i] : v16[i + 8]; v8[i] = keep + __shfl_xor(send, 16); } }
            { const bool h = (F.lane & 8) != 0;
#pragma unroll
              for (int i = 0; i < 4; ++i) { const float keep = h ? v8[i + 4] : v8[i], send = h ? v8[i] : v8[i + 4]; v4[i] = keep + __shfl_xor(send, 8); } }
            { const bool h = (F.lane & 4) != 0;
#pragma unroll
              for (int i = 0; i < 2; ++i) { const float keep = h ? v4[i + 2] : v4[i], send = h ? v4[i] : v4[i + 2]; v2[i] = keep + __shfl_xor(send, 4); } }
            { const bool h = (F.lane & 2) != 0; const float keep = h ? v2[1] : v2[0], send = h ? v2[0] : v2[1]; v1r = keep + __shfl_xor(send, 2); }
            v1r += __shfl_xor(v1r, 1);
            CONV_BAR();
            if ((F.lane & 1) == 0) red[F.wave * 32 + (F.lane >> 1)] = v1r;
            CONV_BAR();
            if (tid < 16) { float t = 0.f, q = 0.f;
#pragma unroll
                for (int w = 0; w < 8; ++w) { t += red[w * 32 + tid]; q += red[w * 32 + 16 + tid]; }
                const float mean = t * (1.0f / DM), var = q * (1.0f / DM) - mean * mean;
                fin[tid] = mean; fin[16 + tid] = 1.0f / sqrtf(var + EPS); }
            CONV_BAR();
#pragma unroll
            for (int tt = 0; tt < 16; ++tt) {
                const float mean = fin[tt], rstd = fin[16 + tt];
                const float z0 = (y[tt][0] - mean) * rstd * lg[0] + lb[0], z1 = (y[tt][1] - mean) * rstd * lg[1] + lb[1];
                *(unsigned*)(V + (size_t)(tokbase + 16 * s + tt) * DM + c0) = pk2(z0 * sigmoid_f(z0), z1 * sigmoid_f(z1)); }
            if (s < 7) {
#pragma unroll
                for (int i = 0; i < 30; ++i) win[i] = win[i + 16];
#pragma unroll
                for (int i = 0; i < 16; ++i) win[30 + i] = nxt[i]; }
        }
    }
}
DEVI void router_phase(const Frame& F, const Args& a, int L, const bf16_t* H) {
    const bf16_t* rw = (const bf16_t*)(F.ws + WS_RW) + (size_t)(L * 2) * 48 * 1024;
    float* rs1 = (float*)(F.ws + WS_RS1); int* asg_e = (int*)(F.ws + WS_ASGE); int* asg_r = (int*)(F.ws + WS_ASGR); float* asg_w = (float*)(F.ws + WS_ASGW); int* cnt = (int*)(F.ws + WS_CNT);
    LAS unsigned char* wst = F.lds + RING_OFF;
    LAS float* lg = (LAS float*)(F.lds + RING_OFF + 65536) + F.wave * (16 * 48);
    LAS int* elist = (LAS int*)(F.lds + RING_OFF + 98304);
    LAS float* bias = (LAS float*)(F.lds + RING_OFF + 98304 + 1024);
    if (F.tid < 4) bias[F.tid] = a.in[22][L * 4 + F.tid]; else if (F.tid < 36) bias[F.tid] = a.in[24][L * 32 + F.tid - 4];
    const LAS float* brg = bias; const LAS float* bre = bias + 4;
    const int fr = F.lane & 15, fq = F.lane >> 4;
    for (int ch = F.vcu; ch < 256; ch += F.G) {
        const int tok0 = ch * 128 + F.wave * 16;
        f32x4 acc[3];
#pragma unroll
        for (int t = 0; t < 3; ++t) acc[t] = (f32x4){0.f, 0.f, 0.f, 0.f};
        float ss = 0.f;
        const bf16_t* hp = H + (size_t)(tok0 + fr) * DM + 8 * fq;
        for (int kc4 = 0; kc4 < 4; ++kc4) {
            const int kc = (kc4 + F.vcu) & 3;
            bf16x8 hf[8];
#pragma unroll
            for (int sl = 0; sl < 8; ++sl) hf[sl] = *(const bf16x8*)(hp + kc * 256 + 32 * sl);
            u32x4 wv[6];
#pragma unroll
            for (int i = 0; i < 6; ++i) { const int idx = F.tid + 512 * i, hl = idx / 1536, rem = idx % 1536, row = rem >> 5, c = rem & 31;
                wv[i] = *(const u32x4*)(rw + ((size_t)(hl * 48 + row)) * 1024 + kc * 256 + c * 8); }
            wg_sync();
#pragma unroll
            for (int i = 0; i < 6; ++i) { const int idx = F.tid + 512 * i, hl = idx / 1536, rem = idx % 1536, row = rem >> 5, c = rem & 31;
                *(LAS u32x4*)(wst + hl * 25344 + row * 528 + c * 16) = wv[i]; }
            wg_sync();
#pragma unroll
            for (int sl = 0; sl < 8; ++sl) {
#pragma unroll
                for (int t = 0; t < 3; ++t) {
                    const bf16x8 wh = *(const LAS bf16x8*)(wst + (16 * t + fr) * 528 + (32 * sl + 8 * fq) * 2), wl = *(const LAS bf16x8*)(wst + 25344 + (16 * t + fr) * 528 + (32 * sl + 8 * fq) * 2);
                    acc[t] = __builtin_amdgcn_mfma_f32_16x16x32_bf16(wh, hf[sl], acc[t], 0, 0, 0);
                    acc[t] = __builtin_amdgcn_mfma_f32_16x16x32_bf16(wl, hf[sl], acc[t], 0, 0, 0); }
                const u32x4 hu = __builtin_bit_cast(u32x4, hf[sl]);
#pragma unroll
                for (int j = 0; j < 4; ++j) { const float x0 = bflo(hu[j]), x1 = bfhi(hu[j]); ss += x0 * x0 + x1 * x1; }
            }
        }
        ss += __shfl_xor(ss, 16); ss += __shfl_xor(ss, 32);
        const float rs = 1.0f / sqrtf(ss * (1.0f / DM) + EPS);
        if (fq == 0) rs1[tok0 + fr] = rs;
#pragma unroll
        for (int t = 0; t < 3; ++t)
#pragma unroll
            for (int r = 0; r < 4; ++r) lg[fr * 48 + 16 * t + 4 * fq + r] = acc[t][r] * rs;
        LDS_WAIT();
        if (F.lane < 16) {
            const LAS float* my = lg + F.lane * 48;
            float g[4]; int gi = 0; float gm;
#pragma unroll
            for (int j = 0; j < 4; ++j) g[j] = my[j] + brg[j];
            gm = g[0];
#pragma unroll
            for (int j = 1; j < 4; ++j) if (g[j] > gm) { gm = g[j]; gi = j; }
            float den = 0.f;
#pragma unroll
            for (int j = 0; j < 4; ++j) den += __expf(g[j] - gm);
            const float pg = 1.0f / den;
            float v1 = -INFINITY, v2 = -INFINITY; int i1 = 0, i2 = 0;
            for (int j = 0; j < 8; ++j) { const float v = my[4 + gi * 8 + j] + bre[gi * 8 + j];
                if (v > v1) { v2 = v1; i2 = i1; v1 = v; i1 = j; } else if (v > v2) { v2 = v; i2 = j; } }
            const float e2 = __expf(v2 - v1), wa = pg / (1.0f + e2), wb = pg * e2 / (1.0f + e2);
            const int tl = F.wave * 16 + F.lane;
            elist[2 * tl] = gi * 8 + i1; elist[2 * tl + 1] = gi * 8 + i2;
            asg_w[(size_t)ch * 256 + 2 * tl] = wa; asg_w[(size_t)ch * 256 + 2 * tl + 1] = wb;
        }
        wg_sync();
        if (F.tid < 288) {
            const bool isr = F.tid < 256; const int e = isr ? elist[F.tid] : F.tid - 256, lim = isr ? F.tid : 256; int r = 0;
            typedef int i32x4 __attribute__((ext_vector_type(4)));
#pragma unroll 8
            for (int q = 0; q < 256; q += 4) { const i32x4 v = *(const LAS i32x4*)(elist + q);
                r += ((v[0] == e) & (q < lim)) + ((v[1] == e) & (q + 1 < lim)) + ((v[2] == e) & (q + 2 < lim)) + ((v[3] == e) & (q + 3 < lim)); }
            if (isr) { asg_e[(size_t)ch * 256 + F.tid] = e; asg_r[(size_t)ch * 256 + F.tid] = r; } else cnt[ch * 32 + e] = r; }
        wg_sync();
    }
}
DEVI void fill_phase(const Frame& F) {
    const int* cnt = (const int*)(F.ws + WS_CNT); const int* asg_e = (const int*)(F.ws + WS_ASGE); const int* asg_r = (const int*)(F.ws + WS_ASGR); const float* asg_w = (const float*)(F.ws + WS_ASGW);
    const float* rs1 = (const float*)(F.ws + WS_RS1);
    int* tslot = (int*)(F.ws + WS_TSLOT); int* stok = (int*)(F.ws + WS_STOK); float* sw = (float*)(F.ws + WS_SW); float* srs = (float*)(F.ws + WS_SRS); int* mtot = (int*)(F.ws + WS_MTOT);
    LAS int* ptot = (LAS int*)(F.lds + RING_OFF);
    LAS int* ppre = ptot + 512;
    LAS int* tot = ppre + 512; LAS int* start = tot + 32; LAS int* pre = start + 32;
    for (int ch = F.vcu; ch < 256; ch += F.G) {
        wg_sync();
        { const int e = F.tid & 31, part = F.tid >> 5; int t = 0, p = 0;
          for (int w = part * 16; w < part * 16 + 16; ++w) { const int c = cnt[w * 32 + e]; t += c; if (w < ch) p += c; }
          ptot[part * 32 + e] = t; ppre[part * 32 + e] = p; }
        wg_sync();
        if (F.tid < 32) { int t = 0, p = 0;
#pragma unroll
            for (int q = 0; q < 16; ++q) { t += ptot[q * 32 + F.tid]; p += ppre[q * 32 + F.tid]; }
            tot[F.tid] = t; pre[F.tid] = p; }
        wg_sync();
        if (F.tid == 0) { int s = 0; for (int e = 0; e < 32; ++e) { start[e] = s; s += tot[e]; } }
        wg_sync();
        if (F.tid < 256) { const size_t ag = (size_t)ch * 256 + F.tid; const int e = asg_e[ag], slot = start[e] + pre[e] + asg_r[ag], tok = ch * 128 + (F.tid >> 1);
            stok[slot] = tok; sw[slot] = asg_w[ag]; srs[slot] = rs1[tok]; tslot[ag] = slot; }
        if (ch == 0) {
            if (F.tid < 32) { mtot[F.tid] = tot[F.tid]; mtot[32 + F.tid] = start[F.tid]; }
            if (F.tid >= 256) { const int i = NSLOT + F.tid - 256; stok[i] = 0; sw[i] = 0.f; srs[i] = 0.f; }
            { const float* cbp = (const float*)(F.ws + WS_CBP); const int j = F.tid >> 8, c = F.tid & 255; float s2 = 0.f;
              for (int kr = 0; kr < 32; ++kr) s2 += cbp[(j * 32 + kr) * 256 + c];
              ((float*)(F.ws + WS_CB))[F.tid] = s2; } }
    }
}
DEVI int build_moe_table(const Frame& F) {
    const int* mtot = (const int*)(F.ws + WS_MTOT);
    LAS int* trow = (LAS int*)(F.lds + TAB_OFF); LAS int* tev = trow + 320; LAS int* tn = tev + 320;
    LAS int* mt = (LAS int*)(F.lds + SCR_OFF);
    if (F.tid < 64) mt[F.tid] = mtot[F.tid];
    wg_sync();
    if (F.tid == 0) { int nb = 0;
        for (int e = 0; e < 32; ++e) { const int t = mt[e], s = mt[32 + e];
            for (int o = 0; o < t; o += 256) { trow[nb] = s + o; tev[nb] = e * 512 + ((t - o) < 256 ? (t - o) : 256); ++nb; } }
        tn[0] = nb; }
    wg_sync();
    return tn[0];
}
DEVI void combine_phase(const Frame& F, const bf16_t* H, bf16_t* OUT, int zero_y) {
    const bf16_t* YB = (const bf16_t*)(F.ws + WS_YB); const int* tslot = (const int*)(F.ws + WS_TSLOT); float* rs2 = (float*)(F.ws + WS_RS2);
    const int gw = F.vcu * NWAVES + F.wave, NGW = F.G * NWAVES;
    for (int row = gw; row < NTOK; row += NGW) {
        const int s0 = tslot[2 * row], s1 = tslot[2 * row + 1]; float ss = 0.f;
#pragma unroll
        for (int hx = 0; hx < 2; ++hx) {
            const int col = 512 * hx + 8 * F.lane;
            const u32x4 h = *(const u32x4*)(H + (size_t)row * DM + col), y0 = *(const u32x4*)(YB + (size_t)s0 * DM + col), y1 = *(const u32x4*)(YB + (size_t)s1 * DM + col); u32x4 o;
#pragma unroll
            for (int j = 0; j < 4; ++j) { float lo = bflo(h[j]) + bflo(y0[j]) + bflo(y1[j]), hi = bfhi(h[j]) + bfhi(y0[j]) + bfhi(y1[j]); if (zero_y) { lo = bflo(h[j]); hi = bfhi(h[j]); } ss += lo * lo + hi * hi; o[j] = pk2(lo, hi); }
            *(u32x4*)(OUT + (size_t)row * DM + col) = o; }
        ss = wave_sum(ss);
        if (F.lane == 0) rs2[row] = 1.0f / sqrtf(ss * (1.0f / DM) + EPS);
    }
}
DEVI void rstd_from_partials(const Frame& F) {
    const float* ssq = (const float*)(F.ws + WS_SSQ); float* rs0 = (float*)(F.ws + WS_RS0);
    for (int row = F.vcu * 512 + F.tid; row < NTOK; row += F.G * 512) {
        const f32x4* p = (const f32x4*)(ssq + (size_t)row * 16); float s = 0.f;
#pragma unroll
        for (int q = 0; q < 4; ++q) { const f32x4 v = p[q]; s += (v[0] + v[1]) + (v[2] + v[3]); }
        rs0[row] = 1.0f / sqrtf(s * (1.0f / DM) + EPS); }
}
DEVI void cmpb_phase(const Frame& F, const Args& a) {
    const float* CP = (const float*)(F.ws + WS_CP); const float* CB = (const float*)(F.ws + WS_CB); const float* rope = (const float*)(F.ws + WS_ROPE);
    const bf16_t* W2T = (const bf16_t*)(F.ws + WS_W2T);
    bf16_t* KC = (bf16_t*)(F.ws + WS_KC); bf16_t* VC = (bf16_t*)(F.ws + WS_VC);
    LAS unsigned char* hl = F.lds + RING_OFF;
    LAS float* ol = (LAS float*)(F.lds + RING_OFF + 65536);
    const float kn = a.in[16][F.lane];
    const int fr = F.lane & 15, fq = F.lane >> 4;
    for (int wg = F.vcu; wg < 256; wg += F.G) {
        const int row0 = wg * 64, j = row0 >> 13, rho0 = row0 & 8191;
        { const int r = F.tid >> 3, c0 = (F.tid & 7) * 32;
          f32x4 acc8[8];
#pragma unroll
          for (int q = 0; q < 8; ++q) acc8[q] = *(const f32x4*)(CB + j * 256 + c0 + 4 * q);
#pragma unroll
          for (int ks = 0; ks < 4; ++ks) { const float* src = CP + ((size_t)(j * 4 + ks) * 8192 + rho0 + r) * 256 + c0;
#pragma unroll
              for (int q = 0; q < 8; ++q) acc8[q] += *(const f32x4*)(src + 4 * q); }
#pragma unroll
          for (int q = 0; q < 8; ++q) { f32x4 g;
#pragma unroll
              for (int e = 0; e < 4; ++e) { const float x = acc8[q][e], uu = 0.7978845608028654f * (x + 0.044715f * x * x * x); g[e] = x * sigmoid_f(2.0f * uu); }
              *(LAS u32x2*)(hl + r * 528 + (c0 + 4 * q) * 2) = pack4(g); } }
        wg_sync();
        { const int mt = F.wave & 3, np = F.wave >> 2;
          f32x4 d[2]; d[0] = (f32x4){0.f, 0.f, 0.f, 0.f}; d[1] = d[0];
#pragma unroll
          for (int st = 0; st < 8; ++st) {
              const bf16x8 hf = *(const LAS bf16x8*)(hl + (16 * mt + fr) * 528 + (32 * st + 8 * fq) * 2);
#pragma unroll
              for (int t = 0; t < 2; ++t) { const bf16x8 wf = *(const bf16x8*)(W2T + ((size_t)(j * 64 + 32 * np + 16 * t + fr)) * 256 + 32 * st + 8 * fq);
                  d[t] = __builtin_amdgcn_mfma_f32_16x16x32_bf16(wf, hf, d[t], 0, 0, 0); } }
#pragma unroll
          for (int t = 0; t < 2; ++t) *(LAS f32x4*)(ol + (16 * mt + fr) * 64 + 32 * np + 16 * t + 4 * fq) = d[t]; }
        wg_sync();
#pragma unroll
        for (int q = 0; q < 8; ++q) {
            const int r = F.wave * 8 + q, rho = rho0 + r, bg = rho >> 7, n = rho & 127;
            bf16_t* dst = (j == 0 ? KC : VC) + (size_t)rho * 64 + F.lane;
            float o = ol[r * 64 + F.lane];
            if (n == 127) { *dst = 0; continue; }
            if (j == 0) {
                const float ms = wave_sum(o * o) * (1.0f / 64.0f); const float y = o * (1.0f / sqrtf(ms + EPS)) * kn;
                const float other = __shfl_xor(y, 32);
                const int row = (bg >> 2) * SEQ + 16 * n + 31; const float cs = rope[(size_t)row * 64 + (F.lane & 31)], sn = rope[(size_t)row * 64 + 32 + (F.lane & 31)];
                o = (F.lane < 32) ? (y * cs - other * sn) : (y * cs + other * sn);
            }
            *dst = (bf16_t)(pk2(o, 0.f) & 0xffffu);
        }
        wg_sync();
    }
}

#ifndef ATT_REP
#define ATT_REP 1
#endif
namespace att {
constexpr int KS0 = 0, VS0 = 24576, WSF = 49152, OFN = 51200, UNI = 116736;
typedef const LAS char* lptr;
DEVI int crow(int r, int hi) { return (r & 3) + 8 * (r >> 2) + 4 * hi; }
DEVI void glds16(const void* gsrc, unsigned lds_dst) { unsigned keep;
    asm volatile("s_mov_b32 %0, m0\n\ts_mov_b32 m0, %2\n\ts_nop 0\n\tglobal_load_lds_dwordx4 %1, off\n\ts_mov_b32 m0, %0" : "=&s"(keep) : "v"(gsrc), "s"(lds_dst) : "memory"); }
DEVI float xlane32(float v) { return __shfl_xor(v, 32); }
DEVI void qkt(f32x16& p0, f32x16& p1, lptr Kslot, const bf16x8* qr, float cinit, int r32, int hi) {
    lptr kb = Kslot + hi * 1024 + r32 * 16;
#pragma unroll
    for (int r = 0; r < 16; ++r) { p0[r] = cinit; p1[r] = cinit; }
#pragma unroll
    for (int d0 = 0; d0 < 4; ++d0) {
        const bf16x8 b0 = *(const LAS bf16x8*)(kb + d0 * 2048), b1 = *(const LAS bf16x8*)(kb + d0 * 2048 + 512);
        p0 = __builtin_amdgcn_mfma_f32_32x32x16_bf16(b0, qr[d0], p0, 0, 0, 0); p1 = __builtin_amdgcn_mfma_f32_32x32x16_bf16(b1, qr[d0], p1, 0, 0, 0); }
}
DEVI float rowmax(const f32x16& p0, const f32x16& p1) {
    float m = fmaxf(p0[0], p1[0]);
#pragma unroll
    for (int r = 1; r < 16; ++r) m = fmaxf(m, fmaxf(p0[r], p1[r]));
    return fmaxf(m, xlane32(m));
}
DEVI float max3f(float a, float b, float c) { float r; asm("v_max3_f32 %0, %1, %2, %3" : "=v"(r) : "v"(a), "v"(b), "v"(c)); return r; }
DEVI float rowmax3(const f32x16& p0, const f32x16& p1) {
    float a = max3f(p0[0], p0[1], p1[0]), b = max3f(p0[2], p0[3], p1[1]); a = max3f(a, p1[2], p1[3]);
#pragma unroll
    for (int r = 4; r < 16; r += 4) { a = max3f(a, p0[r], p0[r + 1]); b = max3f(b, p0[r + 2], p0[r + 3]); a = max3f(a, p1[r], p1[r + 1]); b = max3f(b, p1[r + 2], p1[r + 3]); }
    const float m = max3f(a, b, b);
    return max3f(m, xlane32(m), m);
}
DEVI void qk2(f32x16& p0, f32x16& p1, lptr Kslot, const bf16x8* qr, const f32x16& negm, int r32, int hi) {
    lptr kb = Kslot + hi * 1024 + r32 * 16;
    bf16x8 kf[8];
#pragma unroll
    for (int d0 = 0; d0 < 4; ++d0) { kf[2 * d0] = *(const LAS bf16x8*)(kb + d0 * 2048); kf[2 * d0 + 1] = *(const LAS bf16x8*)(kb + d0 * 2048 + 512); }
    asm volatile("s_waitcnt lgkmcnt(0)" : "+v"(kf[0]), "+v"(kf[1]), "+v"(kf[2]), "+v"(kf[3]), "+v"(kf[4]), "+v"(kf[5]), "+v"(kf[6]), "+v"(kf[7]) :: "memory");
    p0 = __builtin_amdgcn_mfma_f32_32x32x16_bf16(kf[0], qr[0], negm, 0, 0, 0); p1 = __builtin_amdgcn_mfma_f32_32x32x16_bf16(kf[1], qr[0], negm, 0, 0, 0);
#pragma unroll
    for (int d0 = 1; d0 < 4; ++d0) { p0 = __builtin_amdgcn_mfma_f32_32x32x16_bf16(kf[2 * d0], qr[d0], p0, 0, 0, 0); p1 = __builtin_amdgcn_mfma_f32_32x32x16_bf16(kf[2 * d0 + 1], qr[d0], p1, 0, 0, 0); }
}
DEVI void pv(f32x16* o, int vb, bf16x8 pa0, bf16x8 pa1, bf16x8 pa2, bf16x8 pa3) {
#pragma unroll
    for (int d0 = 0; d0 < 2; ++d0) { s16x4 lo[4], hi[4];
#pragma unroll
        for (int ks = 0; ks < 4; ++ks) {
            asm volatile("ds_read_b64_tr_b16 %0,%1 offset:%c2" : "=&v"(lo[ks]) : "v"(vb), "i"(d0 * 4096 + ks * 1024) : "memory");
            asm volatile("ds_read_b64_tr_b16 %0,%1 offset:%c2" : "=&v"(hi[ks]) : "v"(vb), "i"(d0 * 4096 + ks * 1024 + 512) : "memory"); }
        asm volatile("s_waitcnt lgkmcnt(0)" ::: "memory"); __builtin_amdgcn_sched_barrier(0);
#define ATT_PK(k) (bf16x8){lo[k][0], lo[k][1], lo[k][2], lo[k][3], hi[k][0], hi[k][1], hi[k][2], hi[k][3]}
        o[d0] = __builtin_amdgcn_mfma_f32_32x32x16_bf16(pa0, ATT_PK(0), o[d0], 0, 0, 0);
        o[d0] = __builtin_amdgcn_mfma_f32_32x32x16_bf16(pa1, ATT_PK(1), o[d0], 0, 0, 0);
        o[d0] = __builtin_amdgcn_mfma_f32_32x32x16_bf16(pa2, ATT_PK(2), o[d0], 0, 0, 0);
        o[d0] = __builtin_amdgcn_mfma_f32_32x32x16_bf16(pa3, ATT_PK(3), o[d0], 0, 0, 0);
#undef ATT_PK
    }
}
DEVI bf16x8 packp(const f32x16& p, int b) { u32x4 w; w.x = pk2(p[b], p[b + 1]); w.y = pk2(p[b + 2], p[b + 3]); w.z = pk2(p[b + 4], p[b + 5]); w.w = pk2(p[b + 6], p[b + 7]); return __builtin_bit_cast(bf16x8, w); }
DEVI void scale_rows(f32x16* o, LAS float* wsf, float fac, int r32, int hi) {
    if (hi == 0) wsf[r32] = fac;
    LDS_WAIT();
#pragma unroll
    for (int r = 0; r < 16; ++r) { const float f = wsf[crow(r, hi)]; o[0][r] *= f; o[1][r] *= f; }
    LDS_WAIT();
}
DEVI void fold_rows(const f32x16* o, LAS float* ofl, LAS float* wsf, float fac, int r32, int hi) {
    if (hi == 0) wsf[r32] = fac;
    LDS_WAIT();
#pragma unroll
    for (int r = 0; r < 16; ++r) { const int q = crow(r, hi); const float f = wsf[q]; ofl[q * 64 + r32] += o[0][r] * f; ofl[q * 64 + 32 + r32] += o[1][r] * f; }
    LDS_WAIT();
}
DEVI void tile_step(f32x16* o, float& m, float& l, const bf16x8* qr, lptr Kslot, int vb, LAS float* wsf, int r32, int hi, float cinit, bool domask, int kbase, int lo, int hi_) {
    f32x16 p0, p1;
    qkt(p0, p1, Kslot, qr, cinit, r32, hi);
    if (domask) {
#pragma unroll
        for (int r = 0; r < 16; ++r) { const int kp = kbase + crow(r, hi); if (kp < lo || kp > hi_) p0[r] = -INFINITY; if (kp + 32 < lo || kp + 32 > hi_) p1[r] = -INFINITY; } }
    const float rm = rowmax(p0, p1);
    if (__builtin_amdgcn_ballot_w64(rm > m + 8.0f) != 0ull) {
        const float mn = fmaxf(m, rm), f = __builtin_amdgcn_exp2f(m - mn); m = mn;
        l *= f;
        scale_rows(o, wsf, f, r32, hi);
    }
    float ps = 0.f;
#pragma unroll
    for (int r = 0; r < 16; ++r) { p0[r] = __builtin_amdgcn_exp2f(p0[r] - m); p1[r] = __builtin_amdgcn_exp2f(p1[r] - m); ps += p0[r] + p1[r]; }
    l += ps;
    pv(o, vb, packp(p0, 0), packp(p0, 8), packp(p1, 0), packp(p1, 8));
}

DEVI void attn_unit(int b, int g, int qb, const bf16_t* Q, const bf16_t* KV, const bf16_t* KC, const bf16_t* VC, const float* gates, bf16_t* O, LAS char* shm) {
    const int tid = threadIdx.x, lane = tid & 63, r32 = lane & 31, hi = lane >> 5; const int wid = __builtin_amdgcn_readfirstlane(tid >> 6);
    const int tl = r32 >> 2, head = r32 & 3, tq0 = qb * 64, tq = tq0 + 8 * wid + tl, row = b * SEQ + tq, bg = b * 4 + g;
    const unsigned lds0 = (unsigned)(uintptr_t)shm;
    LAS float* wsf = (LAS float*)(shm + WSF) + wid * 64;
    const bf16_t* Ks = KV + 2 * KVS + (size_t)bg * SEQ * 64; const bf16_t* Vs = KV + 3 * KVS + (size_t)bg * SEQ * 64;
    const bf16_t* Kw = KV + 4 * KVS + (size_t)bg * SEQ * 64; const bf16_t* Vw = KV + 5 * KVS + (size_t)bg * SEQ * 64;
    const bf16_t* Kc = KC + (size_t)bg * 128 * 64; const bf16_t* Vc = VC + (size_t)bg * 128 * 64;
    const int koff = lane * 64 + wid * 8, voff = (16 * (wid & 3) + (lane >> 2)) * 64 + (wid >> 2) * 32 + (lane & 3) * 8;
#define ATT_DMA(Kt, Vt, slot) do { glds16((Kt) + koff, (unsigned)__builtin_amdgcn_readfirstlane(lds0 + KS0 + (slot) * 8192 + wid * 1024)); \
                                   glds16((Vt) + voff, (unsigned)__builtin_amdgcn_readfirstlane(lds0 + VS0 + (slot) * 8192 + wid * 1024)); } while (0)
#define ATT_WAITBAR() asm volatile("s_waitcnt vmcnt(0) lgkmcnt(0)\n\ts_barrier" ::: "memory")
    const int vb0 = (int)(lds0 + VS0) + ((lane >> 4) & 1) * 32 + (lane & 3) * 8 + (4 * hi + ((lane & 15) >> 2)) * 64;
    const lptr kslot0 = (lptr)(shm + KS0);
    ATT_WAITBAR();
    const int nC = (qb >= 16) ? 2 : 1;
    const int wlo = qb >= 8 ? qb - 8 : 0, nW = qb - wlo + 1;
    bf16x8 qr[4];
    { const bf16_t* qp = Q + (size_t)row * DM + (4 * g + head) * 64 + 8 * hi;
#pragma unroll
      for (int d0 = 0; d0 < 4; ++d0) qr[d0] = *(const bf16x8*)(qp + 16 * d0); }
    const float* gp = gates + (size_t)row * 48 + (g * 4 + head) * 3; const float gate_c = (PROBE == 4) ? 0.f : gp[0], gate_s = (PROBE == 5) ? 0.f : gp[1], gate_w = (PROBE == 6) ? 0.f : gp[2];
    ATT_DMA(Kc, Vc, 0); if (nC == 2) ATT_DMA(Kc + 64 * 64, Vc + 64 * 64, 1);
    ATT_DMA(Kw + (size_t)wlo * 4096, Vw + (size_t)wlo * 4096, 2);
    f32x16 o[2];
    LAS float* ofl = (LAS float*)(shm + OFN) + wid * 2048;
#pragma unroll
    for (int r = 0; r < 16; ++r) { ofl[crow(r, hi) * 64 + r32] = 0.f; ofl[crow(r, hi) * 64 + 32 + r32] = 0.f; }
    unsigned selmask = (qb == 31) ? 0xffffffffu : ((2u << qb) - 1u);
    asm volatile("s_waitcnt vmcnt(2) lgkmcnt(0)\n\ts_barrier" ::: "memory");
    {
        const int nmax = (tq - 31) >> 4;
        f32x16 pa0, pa1, pb0, pb1;
        qkt(pa0, pa1, kslot0, qr, 0.f, r32, hi);
        if (nC == 2) qkt(pb0, pb1, kslot0 + 8192, qr, 0.f, r32, hi);
        else {
#pragma unroll
            for (int r = 0; r < 16; ++r) { pb0[r] = -INFINITY; pb1[r] = -INFINITY; } }
#pragma unroll
        for (int r = 0; r < 16; ++r) { const int n0 = crow(r, hi);
            if (n0 > nmax) pa0[r] = -INFINITY; if (n0 + 32 > nmax) pa1[r] = -INFINITY; if (n0 + 64 > nmax) pb0[r] = -INFINITY; if (n0 + 96 > nmax) pb1[r] = -INFINITY; }
        float m = fmaxf(rowmax(pa0, pa1), rowmax(pb0, pb1));
        if (m == -INFINITY) m = 0.f;
        float ps = 0.f;
#pragma unroll
        for (int r = 0; r < 16; ++r) { pa0[r] = __builtin_amdgcn_exp2f(pa0[r] - m); pa1[r] = __builtin_amdgcn_exp2f(pa1[r] - m); pb0[r] = __builtin_amdgcn_exp2f(pb0[r] - m); pb1[r] = __builtin_amdgcn_exp2f(pb1[r] - m);
            ps += (pa0[r] + pa1[r]) + (pb0[r] + pb1[r]); }
        ps += xlane32(ps);
        const float inv = ps > 0.f ? __builtin_amdgcn_rcpf(ps) : 0.f;
#pragma unroll
        for (int r = 0; r < 16; ++r) { o[0][r] = 0.f; o[1][r] = 0.f; }
        pv(o, vb0, packp(pa0, 0), packp(pa0, 8), packp(pa1, 0), packp(pa1, 8));
        if (nC == 2) pv(o, vb0 + 8192, packp(pb0, 0), packp(pb0, 8), packp(pb1, 0), packp(pb1, 8));
        fold_rows(o, ofl, wsf, gate_c * inv, r32, hi);
        if (qb >= 16) {
#define ATT_QSUM(x) do { float t_ = (x) * inv; t_ += __builtin_bit_cast(float, __builtin_amdgcn_update_dpp(0, __builtin_bit_cast(int, t_), 0xB1, 0xf, 0xf, false)); \
                         t_ += __builtin_bit_cast(float, __builtin_amdgcn_update_dpp(0, __builtin_bit_cast(int, t_), 0x4E, 0xf, 0xf, false)); (x) = t_; } while (0)
#pragma unroll
            for (int r = 0; r < 16; ++r) { ATT_QSUM(pa0[r]); ATT_QSUM(pa1[r]); ATT_QSUM(pb0[r]); ATT_QSUM(pb1[r]); }
#undef ATT_QSUM
            float sc[16], fo[16];
#define ATT_H4(h4, r) ((h4) == 0 ? pa0[r] : (h4) == 1 ? pa1[r] : (h4) == 2 ? pb0[r] : pb1[r])
#pragma unroll
            for (int h4 = 0; h4 < 4; ++h4)
#pragma unroll
                for (int gq = 0; gq < 4; ++gq) fo[h4 * 4 + gq] = xlane32(ATT_H4(h4, 4 * gq));
#pragma unroll
            for (int h4 = 0; h4 < 4; ++h4)
#pragma unroll
                for (int gq = 0; gq < 4; ++gq) {
                    const int s = h4 * 4 + gq;
                    const float nxt_lo = fo[s];
                    const float nxt_hi = (s < 15) ? fo[s + 1] : 0.f;
                    float v = ATT_H4(h4, 4 * gq) + 2.0f * (ATT_H4(h4, 4 * gq + 1) + ATT_H4(h4, 4 * gq + 2) + ATT_H4(h4, 4 * gq + 3)) + (hi ? nxt_hi : nxt_lo);
                    const int j = 8 * h4 + 2 * gq + hi;
                    if (j == 0 || j == qb || j == qb - 1) v = INFINITY; else if (j > qb) v = -INFINITY;
                    sc[s] = v; }
#undef ATT_H4
            float so[16];
#pragma unroll
            for (int s = 0; s < 16; ++s) so[s] = xlane32(sc[s]);
            unsigned own = 0u;
#pragma unroll
            for (int s = 0; s < 16; ++s) {
                int rk = 0;
#pragma unroll
                for (int s2 = 0; s2 < 16; ++s2) {
                    if (s2 < s) rk += (sc[s2] >= sc[s]) ? 1 : 0; else if (s2 > s) rk += (sc[s2] > sc[s]) ? 1 : 0;
                    if (s2 < s) rk += (so[s2] >= sc[s]) ? 1 : 0; else if (s2 > s) rk += (so[s2] > sc[s]) ? 1 : 0;
                    else rk += hi ? ((so[s2] >= sc[s]) ? 1 : 0) : ((so[s2] > sc[s]) ? 1 : 0); }
                if (rk < 16) own |= 1u << (2 * s);
            }
            own <<= hi;
            selmask = own | (unsigned)__shfl_xor((int)own, 32);
        }
    }
    unsigned uni = selmask, wuni = selmask;
    if (qb >= 16) {
#pragma unroll
        for (int off = 1; off < 64; off <<= 1) uni |= (unsigned)__shfl_xor((int)uni, off);
        wuni = (unsigned)__builtin_amdgcn_readfirstlane((int)uni);
        LAS unsigned* uw = (LAS unsigned*)(shm + UNI);
        if (lane == 0) uw[wid] = uni;
        ATT_WAITBAR();
        uni = 0u;
#pragma unroll
        for (int w = 0; w < 8; ++w) uni |= uw[w];
        uni = (unsigned)__builtin_amdgcn_readfirstlane((int)uni);
    } else { ATT_WAITBAR(); }
    const unsigned smask = uni & ((qb == 31) ? 0xffffffffu : ((2u << qb) - 1u));
    const int nS = __builtin_popcount(smask), nT = nW + nS;
    unsigned rem_issue = smask, rem_qk = smask;
#define ATT_ISSUE(tt) do { const int sl_ = ((tt) + 2) % 3; \
        if ((tt) < nW) { const int j_ = wlo + (tt); ATT_DMA(Kw + (size_t)j_ * 4096, Vw + (size_t)j_ * 4096, sl_); } \
        else { const int j_ = __builtin_ctz(rem_issue); rem_issue &= rem_issue - 1u; ATT_DMA(Ks + (size_t)j_ * 4096, Vs + (size_t)j_ * 4096, sl_); } } while (0)
    if (nT > 1) ATT_ISSUE(1);
    ATT_WAITBAR();
    if (nT > 2) ATT_ISSUE(2);
    float mref = 0.f, l = 0.f;
#pragma unroll
    for (int r = 0; r < 16; ++r) { o[0][r] = 0.f; o[1][r] = 0.f; }
    f32x16 pc0, pc1, negm;
#pragma unroll
    for (int r = 0; r < 16; ++r) negm[r] = 0.f;
    qk2(pc0, pc1, kslot0 + 2 * 8192, qr, negm, r32, hi);
    int jc = wlo; bool cS = false, cskip = false;
    for (int t = 0; t < nT; ++t) {
        const bool hasn = t + 1 < nT; int jn = 0; bool nSel = false, nskip = true;
        if (hasn) { if (t + 1 < nW) { jn = wlo + t + 1; nskip = false; } else { jn = __builtin_ctz(rem_qk); rem_qk &= rem_qk - 1u; nSel = true; nskip = ((wuni >> jn) & 1u) == 0u; } }
        if (t > 0) { ATT_WAITBAR(); if (t + 2 < nT) ATT_ISSUE(t + 2); }
        f32x16 pn0, pn1;
        if (!nskip) {
            const float nm = (nSel && ((selmask >> jn) & 1u) == 0u) ? -INFINITY : -mref;
#pragma unroll
            for (int r = 0; r < 16; ++r) negm[r] = nm;
            qk2(pn0, pn1, kslot0 + ((t + 3) % 3) * 8192, qr, negm, r32, hi);
        }
        if (!cskip) {
            const bool dm = cS ? (jc == qb) : ((jc == qb) || (jc + 8 == qb));
            if (dm) { const int lo = cS ? 0 : tq - 511, kbase = 64 * jc;
#pragma unroll
                for (int r = 0; r < 16; ++r) { const int kp = kbase + crow(r, hi); if (kp < lo || kp > tq) pc0[r] = -INFINITY; if (kp + 32 < lo || kp + 32 > tq) pc1[r] = -INFINITY; } }
            const float rm = rowmax3(pc0, pc1);
            if (__builtin_amdgcn_ballot_w64(rm > 8.0f) != 0ull) {
                const float dl = fmaxf(rm, 0.f), f = __builtin_amdgcn_exp2f(-dl); mref += dl; l *= f;
#pragma unroll
                for (int r = 0; r < 16; ++r) { pc0[r] -= dl; pc1[r] -= dl; }
                if (!nskip) {
#pragma unroll
                    for (int r = 0; r < 16; ++r) { pn0[r] -= dl; pn1[r] -= dl; } }
                scale_rows(o, wsf, f, r32, hi);
            }
            float ps = 0.f;
#pragma unroll
            for (int r = 0; r < 16; ++r) { pc0[r] = __builtin_amdgcn_exp2f(pc0[r]); pc1[r] = __builtin_amdgcn_exp2f(pc1[r]); ps = (ps + pc0[r]) + pc1[r]; }
            l += ps;
            pv(o, vb0 + ((t + 2) % 3) * 8192, packp(pc0, 0), packp(pc0, 8), packp(pc1, 0), packp(pc1, 8));
        }
        if (t + 1 == nW) {
            l += xlane32(l); fold_rows(o, ofl, wsf, gate_w * (l > 0.f ? __builtin_amdgcn_rcpf(l) : 0.f), r32, hi);
#pragma unroll
            for (int r = 0; r < 16; ++r) { o[0][r] = 0.f; o[1][r] = 0.f; }
            l = 0.f; }
        pc0 = pn0; pc1 = pn1; jc = jn; cS = nSel; cskip = nskip;
    }
#undef ATT_ISSUE
    l += xlane32(l); fold_rows(o, ofl, wsf, gate_s * (l > 0.f ? __builtin_amdgcn_rcpf(l) : 0.f), r32, hi);
    {
#pragma unroll
      for (int i = 0; i < 4; ++i) { const int q = i * 8 + (lane >> 3), chn = lane & 7; const f32x4 v0 = *(const LAS f32x4*)(ofl + q * 64 + chn * 8), v1 = *(const LAS f32x4*)(ofl + q * 64 + chn * 8 + 4);
          u32x4 v; v.x = pk2(v0[0], v0[1]); v.y = pk2(v0[2], v0[3]); v.z = pk2(v1[0], v1[1]); v.w = pk2(v1[2], v1[3]);
          *(u32x4*)(O + (size_t)(b * SEQ + tq0 + 8 * wid + (q >> 2)) * DM + (4 * g + (q & 3)) * 64 + chn * 8) = v; }
      LDS_WAIT(); }
#undef ATT_DMA
#undef ATT_WAITBAR
}
DEVI void attn_phase(const Frame& F, const Args& args) {
    const bf16_t* Q = (const bf16_t*)(F.ws + WS_Q); const bf16_t* KV = (const bf16_t*)(F.ws + WS_KV); const bf16_t* KC = (const bf16_t*)(F.ws + WS_KC); const bf16_t* VC = (const bf16_t*)(F.ws + WS_VC);
    const float* gates = (const float*)(F.ws + WS_GATES); bf16_t* O = (bf16_t*)(F.ws + WS_O);
#if PROBE == 1
    { u32x4* z = (u32x4*)O; for (size_t i = (size_t)F.vcu * 512 + F.tid; i < (size_t)NTOK * DM / 8; i += (size_t)F.G * 512) z[i] = (u32x4){0u, 0u, 0u, 0u}; return; }
#endif
    for (int i = 0;; ++i) {
        const int idx = (i / ATT_REP) * F.G + F.vcu; if (idx >= 2048) break;
        const int ii = idx >> 8, bgq = idx & 255, bg = bgq >> 2, qt = bgq & 3;

        const int qb = 8 * (ii >> 1) + ((ii & 1) ? 7 - qt : qt) + ((ii & 1) ? 0 : 0);
        attn_unit(bg >> 2, bg & 3, (ii & 1) ? (8 * (ii >> 1) + 7 - qt) : (8 * (ii >> 1) + qt), Q, KV, KC, VC, gates, O, (LAS char*)(F.lds + RING_OFF));
        (void)qb;
    }
    asm volatile("s_waitcnt vmcnt(0) lgkmcnt(0)\n\ts_barrier" ::: "memory");
}
}

#ifndef PH_MASK
#define PH_MASK 0xffffffffu
#endif
#ifndef REP_MASK
#define REP_MASK 0u
#endif
#define PH(k) (((PH_MASK) >> (k)) & 1u)
#define REPB(k) (((REP_MASK) >> (k)) & 1u)
#define GRID_BAR() xcd_barrier(bar)
#define REFRESH() do { int t_ = threadIdx.x; asm volatile("" : "+v"(t_)); F.tid = t_; F.lane = t_ & 63; F.wave = __builtin_amdgcn_readfirstlane(t_ >> 6); } while (0)
template <int K, int L>
DEVI void phase(Frame& F, const Args& args, int nblk) {
    unsigned char* ws = args.ws;
    LAS unsigned char* ring = F.lds + RING_OFF;
    bf16_t* const HA = (bf16_t*)(ws + WS_HA); bf16_t* const HB = (bf16_t*)(ws + WS_HB);
    bf16_t* const hin = (L == 0) ? HA : HB;
    bf16_t* const hmx = (L == 0) ? HB : HA;
    REFRESH();
    if constexpr (K == 0) p0_prologue(F, args);
    if constexpr (K == 2) { ProbPw1 P; P.A = (const char*)HA; P.Bt = (const char*)(ws + WS_WPW1); P.K = DM; P.ldb = 2048; P.G = F.G; P.c = F.vcu;
          P.rstd = (const float*)(ws + WS_RS0); P.bias = args.in[7]; P.U = (bf16_t*)(ws + WS_U);
          pg8::gemm_phase(ring, P); }
    if constexpr (K == 3) {
        if (F.vcu & 1) { prep_layer(F, args, 0); wg_sync(); conv_phase(F, args); }
        else { conv_phase(F, args); wg_sync(); prep_layer(F, args, 0); } }
    if constexpr (K == 4) { ProbRes P; P.A = (const char*)(ws + WS_V); P.Bt = (const char*)(ws + WS_WPW2); P.K = DM; P.ldb = 2048; P.G = F.G; P.c = F.vcu;
          P.RES = HA; P.OUT = HB; P.bias = args.in[13];
          pg8::gemm_phase(ring, P); }
    if constexpr (K == 5) { ProbWin P; P.A = (const char*)HB; P.Bt = (const char*)(ws + WS_WIN); P.K = DM; P.ldb = 2048; P.G = F.G; P.c = F.vcu;
          P.rstd = (const float*)(ws + WS_SSQ); P.rope = (const float*)(ws + WS_ROPE); P.qnorm = args.in[15]; P.knorm = args.in[16];
          P.Q = (bf16_t*)(ws + WS_Q); P.KV = (bf16_t*)(ws + WS_KV); P.gates = (float*)(ws + WS_GATES);
          pg8::gemm_phase(ring, P); }
    if constexpr (K == 6) { ProbCmp P; P.A = (const char*)(ws + WS_KV); P.Bt = (const char*)(ws + WS_WC1); P.K = 512; P.ldb = 4096; P.G = F.G; P.c = F.vcu;
          P.CP = (float*)(ws + WS_CP);
          pg8::gemm_phase(ring, P); }
    if constexpr (K == 7) cmpb_phase(F, args);
    if constexpr (K == 8) {
        if (F.vcu & 1) { prep_layer(F, args, 1); wg_sync(); REFRESH(); }
        att::attn_phase(F, args);
        if (!(F.vcu & 1)) { REFRESH(); prep_layer(F, args, 1); } }
    if constexpr (K == 9) { ProbRes P; P.A = (const char*)(ws + WS_O); P.Bt = (const char*)(ws + WS_WOUT); P.K = DM; P.ldb = 2048; P.G = F.G; P.c = F.vcu;
          P.RES = HB; P.OUT = HA; P.bias = nullptr;
          pg8::gemm_phase(ring, P); }
    if constexpr (K == 11) router_phase(F, args, L, hmx);
    if constexpr (K == 12) fill_phase(F);
    if constexpr (K == 13) { ProbGateUp P; P.A = (const char*)hmx; P.Bt = (const char*)(ws + WS_WGU); P.K = DM; P.ldb = 2048; P.G = F.G; P.c = F.vcu;
          P.tab_row = (const LAS int*)(F.lds + TAB_OFF); P.tab_ev = P.tab_row + 320; P.nblk = nblk;
          P.slot_rs = (const float*)(ws + WS_SRS); P.HBUF = (bf16_t*)(ws + WS_HBUF);
          { LAS unsigned* go = (LAS unsigned*)(F.lds + SCR_OFF); const int* stok = (const int*)(ws + WS_STOK);
            for (int idx = F.tid; idx < 8 * 256; idx += 512) { const int Lq = (idx >> 8) * F.G + F.vcu; if (Lq < nblk * 4) go[idx] = (unsigned)stok[P.tab_row[Lq >> 2] + (idx & 255)] * 2048u; }
            wg_sync(); P.goff = go; }
          pg8::gemm_phase(ring, P);
          ProbPP Q2; Q2.A = (const char*)(ws + WS_PB); Q2.Bt = (const char*)(ws + WS_WPP) + (size_t)L * DM * PLE * 2; Q2.K = PLE; Q2.ldb = 512; Q2.G = F.G; Q2.c = F.vcu;
          Q2.O = (bf16_t*)(ws + WS_PP);
          { const int nun = nblk * 4, maxu = (nun + F.G - 1) / F.G; int tl = nun - (maxu - 1) * F.G; if (tl >= F.G || tl < 0) tl = 0; Q2.tail_lo = tl; }
          pg8::gemm_phase(ring, Q2); }
    if constexpr (K == 14) { ProbDown P; P.A = (const char*)(ws + WS_HBUF); P.Bt = (const char*)(ws + WS_WDN); P.K = DEXP; P.ldb = 1024; P.G = F.G; P.c = F.vcu;
          P.tab_row = (const LAS int*)(F.lds + TAB_OFF); P.tab_ev = P.tab_row + 320; P.nblk = nblk;
          P.slot_w = (const float*)(ws + WS_SW); P.YB = (bf16_t*)(ws + WS_YB);
          pg8::gemm_phase(ring, P); }
    if constexpr (K == 15) combine_phase(F, hmx, hin, (PROBE == 2 && L == 1) || (PROBE == 3 && L == 0));
    if constexpr (K == 16) { ProbPle P; P.A = (const char*)hin; P.Bt = (const char*)(ws + WS_WPG) + (size_t)L * DM * DM * 2; P.K = DM; P.ldb = 2048; P.G = F.G; P.c = F.vcu;
          P.H2 = hin; P.PPp = (const bf16_t*)(ws + WS_PP); P.rstd = (const float*)(ws + WS_RS2); P.OUTB = hmx; P.OUTF = args.out; P.ssq = (float*)(ws + WS_SSQ); P.last = L;
          pg8::gemm_phase(ring, P); }
}
#define PHASE(k) do { if (PH(k)) phase<k, L>(F, args, nblk); if (PH(k) && REPB(k)) phase<k, L>(F, args, nblk); } while (0)
template <int L>
DEVI void layer_program(Frame& F, const Args& args, const XcdBarrier& bar) {
    int nblk = 0;
    if (L == 0) {
        PHASE(2); GRID_BAR();
        PHASE(3); GRID_BAR();
        PHASE(4);
    } else {
        PHASE(5); GRID_BAR();
        PHASE(6); GRID_BAR();
        PHASE(7); GRID_BAR();
        PHASE(8); GRID_BAR();
        PHASE(9);
    }
    GRID_BAR();
    PHASE(11); GRID_BAR();
    PHASE(12); GRID_BAR();
    REFRESH(); nblk = build_moe_table(F);
    PHASE(13); GRID_BAR();
    PHASE(14); GRID_BAR();
    PHASE(15); GRID_BAR();
    PHASE(16);
    if (L == 0) GRID_BAR();
}
__global__ void __launch_bounds__(NWAVES * 64, 2) hybrid_fwd(Args args) {
    extern __shared__ __attribute__((aligned(16))) unsigned char lds[];
    Frame F;
    F.lds = (LAS unsigned char*)lds; F.ws = args.ws; F.ctl = (gu32*)(args.ws + WS_CTL);
    F.tid = threadIdx.x; F.lane = F.tid & 63; F.wave = __builtin_amdgcn_readfirstlane(F.tid >> 6);
    F.G = gridDim.x; { const int bx = blockIdx.x; F.vcu = (F.G % 8 == 0) ? (bx % 8) * (F.G / 8) + bx / 8 : bx; }
    for (int u = F.tid; u < (LDS_BYTES - LDSCTL_OFF) / 4; u += NWAVES * 64) ((LAS unsigned*)(F.lds + LDSCTL_OFF))[u] = 0u;
    __syncthreads();
    XcdBarrier bar = xcd_barrier_post((unsigned*)(F.ctl + CW_BAR), (volatile LAS unsigned*)(F.lds + MISC_OFF) + 8);
    { constexpr int L = 0; const int nblk = 0; PHASE(0); }
    GRID_BAR();
#ifdef EXTRA_BARS
    GRID_BAR(); GRID_BAR(); GRID_BAR(); GRID_BAR(); GRID_BAR(); GRID_BAR(); GRID_BAR(); GRID_BAR(); GRID_BAR(); GRID_BAR();
#endif
    layer_program<0>(F, args, bar);
    layer_program<1>(F, args, bar);
}
#undef GRID_BAR

extern "C" void kernel_launch(void* const* d_in, const int* in_sizes, int n_in, void* d_out, int out_size, void* d_ws, size_t ws_size, hipStream_t stream) {
    static int grid = 0;
    if (grid == 0) {
        if (n_in != 30 || out_size != NTOK * DM || ws_size < WS_END) { fprintf(stderr, "kernel_launch: unexpected shapes (n_in %d, out %d, ws %zu < %zu)\n", n_in, out_size, ws_size, (size_t)WS_END); grid = -1; return; }
        int dev = 0, cus = 0, per_cu = 0;
        if (hipGetDevice(&dev) != hipSuccess || hipDeviceGetAttribute(&cus, hipDeviceAttributeMultiprocessorCount, dev) != hipSuccess) { grid = -1; return; }
        if (hipFuncSetAttribute((const void*)hybrid_fwd, hipFuncAttributeMaxDynamicSharedMemorySize, LDS_BYTES) != hipSuccess) { fprintf(stderr, "kernel_launch: hipFuncSetAttribute failed\n"); grid = -1; return; }
        if (hipOccupancyMaxActiveBlocksPerMultiprocessor(&per_cu, (const void*)hybrid_fwd, NWAVES * 64, LDS_BYTES) != hipSuccess || per_cu < 1)
            fprintf(stderr, "kernel_launch: occupancy query reports %d workgroups per CU\n", per_cu);
        (void)hipGetLastError();
        grid = cus;
    }
    if (grid < 0) return;
    if (hipMemsetAsync((char*)d_ws + WS_CTL, 0, CTL_ZERO_BYTES, stream) != hipSuccess) return;
    Args a{};
    for (int i = 0; i < 30; ++i) a.in[i] = (const float*)d_in[i];
    a.out = (float*)d_out; a.ws = (unsigned char*)d_ws;
    for (int i = 0; i < 32; ++i) { const float p = powf(10000.0f, (float)i / 32.0f); a.inv_freq[i] = 1.0f / p; }
    hipLaunchKernelGGL(hybrid_fwd, dim3(grid), dim3(NWAVES * 64), LDS_BYTES, stream, a);
}
```

```cpp
#define PROBE 0
#define REP_MASK 0u
#include <hip/hip_runtime.h>
#include <hip/hip_bf16.h>
#include <cstdio>
#include <cstdint>
#include <cmath>

#ifndef PROBE
#define PROBE 0
#endif
#define DEVI __device__ __forceinline__
#define GAS __attribute__((address_space(1)))
#define LAS __attribute__((address_space(3)))
typedef unsigned short bf16_t;
typedef short bf16x8 __attribute__((ext_vector_type(8)));
typedef short s16x4 __attribute__((ext_vector_type(4)));
typedef float f32x2 __attribute__((ext_vector_type(2)));
typedef float f32x4 __attribute__((ext_vector_type(4)));
typedef float f32x16 __attribute__((ext_vector_type(16)));
typedef unsigned u32x2 __attribute__((ext_vector_type(2)));
typedef unsigned u32x4 __attribute__((ext_vector_type(4)));
typedef __bf16 bf16x2_t __attribute__((ext_vector_type(2)));
typedef GAS unsigned gu32;

#define LDS_WAIT() asm volatile("s_waitcnt lgkmcnt(0)" ::: "memory")
#define VM_WAIT() asm volatile("s_waitcnt vmcnt(0)" ::: "memory")
#define RLX_AGENT __ATOMIC_RELAXED, __HIP_MEMORY_SCOPE_AGENT

DEVI unsigned pk2(float lo, float hi) { f32x2 v = {lo, hi}; bf16x2_t b = __builtin_convertvector(v, bf16x2_t); return __builtin_bit_cast(unsigned, b); }
DEVI float bflo(unsigned u) { return __uint_as_float(u << 16); }
DEVI float bfhi(unsigned u) { return __uint_as_float(u & 0xffff0000u); }
DEVI f32x4 unpack4(u32x2 w) { return (f32x4){bflo(w.x), bfhi(w.x), bflo(w.y), bfhi(w.y)}; }
DEVI u32x2 pack4(f32x4 v) { u32x2 w; w.x = pk2(v[0], v[1]); w.y = pk2(v[2], v[3]); return w; }
DEVI float sigmoid_f(float x) { return __builtin_amdgcn_rcpf(1.0f + __expf(-x)); }
DEVI const char* sgpr_ptr(const char* p) { const unsigned long long u = (unsigned long long)p; const unsigned lo = (unsigned)__builtin_amdgcn_readfirstlane((int)(unsigned)u), hi = (unsigned)__builtin_amdgcn_readfirstlane((int)(unsigned)(u >> 32)); return (const char*)(((unsigned long long)hi << 32) | lo); }
DEVI float wave_sum(float v) {
#pragma unroll
    for (int o = 1; o < 64; o <<= 1) v += __shfl_xor(v, o);
    return v;
}

namespace pg8 {
constexpr int BM = 256, BK = 64, HALF = 128, HTB = HALF * BK * 2  , STAGE_BYTES = 8 * HTB;
DEVI int lds_byte(int r, int c) { const int st = (r >> 4) * 2 + (c >> 5), rr = r & 15, cc = c & 31, ob = rr * 64 + cc * 2; return st * 1024 + (ob ^ (((ob >> 9) & 1) << 5)); }
DEVI void stage_rc(int b, int& R, int& C) { const int st = b / 1024, sb = b % 1024, swz = sb ^ (((sb >> 9) & 1) << 5); R = (st >> 1) * 16 + swz / 64; C = (st & 1) * 32 + (swz % 64) / 2; }
struct Unit { int pm, pn, e, v; };

template <class P>
DEVI void gemm_phase(LAS unsigned char* lds, const P& S) {
    int tid = threadIdx.x; asm volatile("" : "+v"(tid));
    const int wid = __builtin_amdgcn_readfirstlane(tid >> 6), lane = tid & 63, wr = wid >> 2, wc = wid & 3, fr = lane & 15, fq = lane >> 4;
    const int nt = S.K / BK;
    int Rp[2], Cp[2]; unsigned voffB[2];
#pragma unroll
    for (int i = 0; i < 2; ++i) { stage_rc(tid * 16 + i * 8192, Rp[i], Cp[i]); voffB[i] = (unsigned)Rp[i] * S.ldb + (unsigned)Cp[i] * 2u; }
    const size_t hstepB = (size_t)HALF * S.ldb;
    const unsigned ldsw = (unsigned)wid * 1024u;
    const int aoff = lds_byte(wr * 64 + fr, fq * 8), boff = lds_byte(wc * 32 + fr, fq * 8);
    const char* const Abase = S.A;
#define PG8_SA(b, h) (((b) * 2 + (h)) * HTB)
#define PG8_SB(b, h) ((4 + (b) * 2 + (h)) * HTB)
#define PG8_STAGE_A(bufoff, ao, sp) do { _Pragma("unroll") for (int _i = 0; _i < 2; ++_i) \
        __builtin_amdgcn_global_load_lds((const unsigned*)((sp) + (ao)[_i]), (LAS unsigned*)(lds + (bufoff) + ldsw + _i * 8192), 16, 0, 0); } while (0)
#define PG8_PIN(p) do { (p) = sgpr_ptr(p); asm volatile("" : "+s"(p)); } while (0)
#define PG8_STAGE_B(bufoff, bp) do { _Pragma("unroll") for (int _i = 0; _i < 2; ++_i) \
        __builtin_amdgcn_global_load_lds((const unsigned*)((bp) + voffB[_i]), (LAS unsigned*)(lds + (bufoff) + ldsw + _i * 8192), 16, 0, 0); } while (0)
#define PG8_LDA(dst, b, h) do { _Pragma("unroll") for (int m = 0; m < 4; ++m) _Pragma("unroll") for (int k = 0; k < 2; ++k) dst[m][k] = *(const LAS bf16x8*)(lds + PG8_SA(b, h) + aoff + m * 2048 + k * 1024); } while (0)
#define PG8_LDB(dst, b, h) do { _Pragma("unroll") for (int n = 0; n < 2; ++n) _Pragma("unroll") for (int k = 0; k < 2; ++k) dst[n][k] = *(const LAS bf16x8*)(lds + PG8_SB(b, h) + boff + n * 2048 + k * 1024); } while (0)
#define PG8_MMA(ai, bj, At, Bt) do { __builtin_amdgcn_s_setprio(1); _Pragma("unroll") for (int m = 0; m < 4; ++m) _Pragma("unroll") for (int n = 0; n < 2; ++n) _Pragma("unroll") for (int k = 0; k < 2; ++k) \
        acc[ai][bj][m][n] = __builtin_amdgcn_mfma_f32_16x16x32_bf16(Bt[n][k], At[m][k], acc[ai][bj][m][n], 0, 0, 0); __builtin_amdgcn_s_setprio(0); } while (0)
#define PG8_WAIT_V(n) asm volatile("s_waitcnt vmcnt(" #n ")" ::: "memory")
#define PG8_WAIT_L(n) asm volatile("s_waitcnt lgkmcnt(" #n ")" ::: "memory")
#define PG8_BAR __builtin_amdgcn_s_barrier()
#define PG8_SCHED __builtin_amdgcn_sched_barrier(0)
    Unit cur, nxt; int ui = 0;
    if (!S.next(0, cur)) return;
    f32x4 acc[2][2][4][2];
#pragma unroll
    for (int a = 0; a < 2; ++a)
#pragma unroll
        for (int b = 0; b < 2; ++b)
#pragma unroll
            for (int m = 0; m < 4; ++m)
#pragma unroll
                for (int n = 0; n < 2; ++n) acc[a][b][m][n] = (f32x4){0.f, 0.f, 0.f, 0.f};
    bf16x8 At[4][2], B0[2][2], B1[2][2];
    unsigned ac0[2], ac1[2], an0[2], an1[2];
#pragma unroll
    for (int i = 0; i < 2; ++i) { ac0[i] = S.a_off(cur, Rp[i]) + (unsigned)Cp[i] * 2u; ac1[i] = S.a_off(cur, Rp[i] + HALF) + (unsigned)Cp[i] * 2u; }
    const char* cB = S.Bt + S.b_off(cur);
    { const char* q0 = cB; const char* q1 = cB + hstepB; const char* q2 = Abase; const char* q3 = cB + 128; const char* q4 = Abase + 128; const char* q5 = cB + hstepB + 128;
      PG8_PIN(q0); PG8_PIN(q1); PG8_PIN(q2); PG8_PIN(q3); PG8_PIN(q4); PG8_PIN(q5);
    PG8_STAGE_B(PG8_SB(0, 0), q0); PG8_STAGE_B(PG8_SB(0, 1), q1); PG8_STAGE_A(PG8_SA(0, 0), ac0, q2); PG8_STAGE_A(PG8_SA(0, 1), ac1, q2);
    if (wr == 1) PG8_BAR;
    PG8_WAIT_V(2); PG8_BAR;
    PG8_STAGE_B(PG8_SB(1, 0), q3); PG8_STAGE_A(PG8_SA(1, 0), ac0, q4); PG8_STAGE_B(PG8_SB(1, 1), q5);
    PG8_WAIT_V(6); PG8_BAR; }
    for (;;) {
        const bool has_next = S.next(ui + 1, nxt);
        const char* nB = cB;
        if (has_next) {
#pragma unroll
            for (int i = 0; i < 2; ++i) { an0[i] = S.a_off(nxt, Rp[i]) + (unsigned)Cp[i] * 2u; an1[i] = S.a_off(nxt, Rp[i] + HALF) + (unsigned)Cp[i] * 2u; }
            nB = S.Bt + S.b_off(nxt);
        } else {
#pragma unroll
            for (int i = 0; i < 2; ++i) { an0[i] = ac0[i]; an1[i] = ac1[i]; }
        }
        for (int t = 0; t < nt; t += 2) {
            const bool last = (t == nt - 2);
            unsigned a20[2], a21[2];
#pragma unroll
            for (int i = 0; i < 2; ++i) { a20[i] = last ? an0[i] : ac0[i]; a21[i] = last ? an1[i] : ac1[i]; }
            const int k1 = (t + 1) * 128, k2 = last ? 0 : (t + 2) * 128;
            const char* b2 = last ? nB : cB + (size_t)(t + 2) * 128; const char* b3 = b2 + 128; const char* b2h = b2 + hstepB; const char* b3h = b3 + hstepB;
            const char* pa1 = Abase + k1; const char* pa2 = Abase + k2; const char* pa3 = pa2 + 128;
            PG8_PIN(b2); PG8_PIN(b3); PG8_PIN(b2h); PG8_PIN(b3h); PG8_PIN(pa1); PG8_PIN(pa2); PG8_PIN(pa3);
            PG8_LDB(B0, 0, 0); PG8_LDB(B1, 0, 1); PG8_SCHED; PG8_LDA(At, 0, 0); PG8_STAGE_A(PG8_SA(1, 1), ac1, pa1);
            PG8_WAIT_V(8); PG8_WAIT_L(0); PG8_BAR; PG8_MMA(0, 0, At, B0); PG8_MMA(0, 1, At, B1); PG8_BAR; PG8_SCHED;
            PG8_LDA(At, 0, 1); PG8_STAGE_B(PG8_SB(0, 0), b2); PG8_STAGE_B(PG8_SB(0, 1), b2h); PG8_STAGE_A(PG8_SA(0, 0), a20, pa2);
            PG8_WAIT_V(8); PG8_WAIT_L(0); PG8_BAR; PG8_MMA(1, 0, At, B0); PG8_MMA(1, 1, At, B1); PG8_BAR; PG8_SCHED;
            PG8_LDB(B0, 1, 0); PG8_LDB(B1, 1, 1); PG8_SCHED; PG8_LDA(At, 1, 0); PG8_STAGE_A(PG8_SA(0, 1), a21, pa2);
            PG8_WAIT_V(8); PG8_WAIT_L(0); PG8_BAR; PG8_MMA(0, 0, At, B0); PG8_MMA(0, 1, At, B1); PG8_BAR; PG8_SCHED;
            PG8_LDA(At, 1, 1); PG8_STAGE_B(PG8_SB(1, 0), b3); PG8_STAGE_B(PG8_SB(1, 1), b3h); PG8_STAGE_A(PG8_SA(1, 0), a20, pa3);
            PG8_WAIT_V(8); PG8_WAIT_L(0); PG8_BAR; PG8_MMA(1, 0, At, B0); PG8_MMA(1, 1, At, B1); PG8_BAR; PG8_SCHED;
        }
        if (wr == 0) PG8_BAR;
        S.epi(acc, cur, wr, wc, fr, fq);
        if (!has_next) break;
#pragma unroll
        for (int a = 0; a < 2; ++a)
#pragma unroll
            for (int b = 0; b < 2; ++b)
#pragma unroll
                for (int m = 0; m < 4; ++m)
#pragma unroll
                    for (int n = 0; n < 2; ++n) acc[a][b][m][n] = (f32x4){0.f, 0.f, 0.f, 0.f};
        cur = nxt; cB = nB; ++ui;
#pragma unroll
        for (int i = 0; i < 2; ++i) { ac0[i] = an0[i]; ac1[i] = an1[i]; }
        if (wr == 1) PG8_BAR;
    }
    PG8_WAIT_V(0);
    PG8_BAR;
#undef PG8_SA
#undef PG8_SB
#undef PG8_STAGE_A
#undef PG8_STAGE_B
#undef PG8_PIN
#undef PG8_LDA
#undef PG8_LDB
#undef PG8_MMA
#undef PG8_WAIT_V
#undef PG8_WAIT_L
#undef PG8_BAR
#undef PG8_SCHED
}
}
#define XB_TMO      128
#define XB_XCNT(j)  (256  + 64 * (j))
#define XB_XSUB(j)  (1280 + 64 * (j))
#define XB_XGEN(j)  (2304 + 64 * (j))
#define XB_TOP      3328
#define XB_TOPGEN   3392
#define XCD_BAR_WORDS 3456
#define XB_SPIN_CAP (1u << 18)

__device__ __forceinline__ unsigned xb_ld(unsigned* p)              { return __hip_atomic_load(p, __ATOMIC_RELAXED, __HIP_MEMORY_SCOPE_AGENT); }
__device__ __forceinline__ unsigned xb_add(unsigned* p, unsigned v) { return __hip_atomic_fetch_add(p, v, __ATOMIC_RELAXED, __HIP_MEMORY_SCOPE_AGENT); }
__device__ __forceinline__ unsigned xb_xcc_id() { return (unsigned)__builtin_amdgcn_s_getreg((3 << 11) | 20) & 0xFu; }
#define XB_SPIN(cond, bar) do { unsigned _sp = 0; while (cond) { __builtin_amdgcn_s_sleep(1); \
    if ((++_sp & 255u) == 0u) { if (xb_ld(&(bar)[XB_TMO])) break; if (_sp > XB_SPIN_CAP) { atomicAdd(&(bar)[XB_TMO], 1u); break; } } } } while (0)

struct XcdBarrier {
    unsigned* bar; unsigned x;
    volatile LAS unsigned* st;
};

__device__ __forceinline__ XcdBarrier xcd_barrier_post(unsigned* bar, volatile LAS unsigned* st) {
    XcdBarrier b; b.bar = bar; b.x = xb_xcc_id(); b.st = st;
    if (threadIdx.x == 0) (void)xb_add(&bar[XB_XCNT(b.x)], 1u);
    return b;
}
__device__ __forceinline__ void xcd_barrier_complete(unsigned* bar, unsigned x, unsigned& nloc, unsigned& nx) {
    const unsigned G = gridDim.x * gridDim.y * gridDim.z;
    unsigned sum, cnt, mine, sp = 0u;
    for (;;) {
        sum = 0u; cnt = 0u; mine = 0u;
#pragma unroll
        for (unsigned j = 0; j < 16; ++j) { const unsigned c = xb_ld(&bar[XB_XCNT(j)]); sum += c; cnt += (c > 0u) ? 1u : 0u; mine = (j == x) ? c : mine; }
        if (sum == G) break;
        __builtin_amdgcn_s_sleep(1);
        if ((++sp & 255u) == 0u) { if (xb_ld(&bar[XB_TMO])) break; if (sp > XB_SPIN_CAP) { atomicAdd(&bar[XB_TMO], 1u); break; } }
    }
    nloc = mine > 0u ? mine : 1u; nx = cnt > 0u ? cnt : 1u;
}

__device__ __forceinline__ void xcd_barrier(const XcdBarrier& b) {
    asm volatile("s_waitcnt vmcnt(0)" ::: "memory");
    __syncthreads();
    if (threadIdx.x == 0) {
        unsigned* bar = b.bar;
        __builtin_amdgcn_s_waitcnt(0);
        unsigned nloc = b.st[0], nx = b.st[1];
        if (nloc == 0u) { xcd_barrier_complete(bar, b.x, nloc, nx); b.st[0] = nloc; b.st[1] = nx; }
        const unsigned old = xb_add(&bar[XB_XSUB(b.x)], 1u);
        const unsigned gen = old / nloc;
        if (old + 1u == (gen + 1u) * nloc) {
            __builtin_amdgcn_fence(__ATOMIC_RELEASE, "agent");
            asm volatile("s_waitcnt vmcnt(0)" ::: "memory");
            const unsigned og = xb_add(&bar[XB_TOP], 1u);
            const unsigned tg = og / nx;
            if (og + 1u == (tg + 1u) * nx) xb_add(&bar[XB_TOPGEN], 1u);
            else XB_SPIN(xb_ld(&bar[XB_TOPGEN]) == tg, bar);
            __builtin_amdgcn_fence(__ATOMIC_ACQUIRE, "agent");
            xb_add(&bar[XB_XGEN(b.x)], 1u);
            asm volatile("s_waitcnt vmcnt(0)" ::: "memory");
        } else {
            XB_SPIN(xb_ld(&bar[XB_XGEN(b.x)]) == gen, bar);
            __builtin_amdgcn_fence(__ATOMIC_ACQUIRE, "agent");
            asm volatile("s_waitcnt vmcnt(0)" ::: "memory");
        }
    }
    __syncthreads();
}

constexpr int NTOK = 32768, DM = 1024, SEQ = 2048, NBATCH = 16, NEXP = 32, DEXP = 512, PLE = 256;
constexpr int NWIN = 2608, NWIN_PAD = 2816;
constexpr float EPS = 1e-6f;
constexpr float C2 = 0.125f * 1.4426950408889634f;
constexpr int NWAVES = 8;

constexpr size_t MiB = 1u << 20;
constexpr size_t WS_CTL = 0, CTL_ZERO_BYTES = 1 * MiB;
constexpr int CW_TMO = 0, CW_BAR = 4096;
constexpr size_t WS_RS0 = 1 * MiB;
constexpr size_t WS_RS1 = WS_RS0 + 131072;
constexpr size_t WS_RS2 = WS_RS1 + 131072;
constexpr size_t WS_ASGE = WS_RS2 + 131072;
constexpr size_t WS_ASGR = WS_ASGE + 262144;
constexpr size_t WS_ASGW = WS_ASGR + 262144;
constexpr size_t WS_TSLOT = WS_ASGW + 262144;
constexpr int NSLOT = 2 * NTOK, NSLOT_PAD = NSLOT + 256;
constexpr size_t WS_STOK = WS_TSLOT + 262144;
constexpr size_t WS_SW = WS_STOK + 266240;
constexpr size_t WS_SRS = WS_SW + 266240;
constexpr size_t WS_CNT = WS_SRS + 266240;
constexpr size_t WS_MTOT = WS_CNT + 32768;
constexpr size_t WS_CBP = WS_MTOT + 1024;
constexpr size_t WS_RW = WS_CBP + 65536;
constexpr size_t WS_CB = WS_RW + 393216;
constexpr size_t WS_W2T = WS_CB + 2048;
constexpr size_t WS_SSQ = 4 * MiB;
constexpr size_t WS_ROPE = 6 * MiB;
static_assert(WS_W2T + 2 * 64 * 256 * 2 <= WS_SSQ, "tables");
constexpr size_t WS_WPW1 = 16 * MiB, WS_WPW2 = 20 * MiB, WS_WIN = 22 * MiB, WS_WOUT = 28 * MiB, WS_WC1 = 30 * MiB, WS_WPP = 32 * MiB, WS_WPG = 33 * MiB;
constexpr size_t WS_WGU = 40 * MiB, WS_WDN = 104 * MiB;
constexpr size_t WS_HA = 136 * MiB, WS_HB = 200 * MiB, WS_PP = 264 * MiB, WS_PB = 328 * MiB;
constexpr size_t WS_YB = 344 * MiB, WS_HBUF = 473 * MiB;
constexpr size_t WS_U = 344 * MiB, WS_V = 408 * MiB;
constexpr size_t WS_Q = WS_PP, WS_KV = 344 * MiB, WS_O = 440 * MiB, WS_CP = WS_HA  , WS_GATES = 504 * MiB, WS_KC = 510 * MiB, WS_VC = 511 * MiB;
constexpr size_t WS_END = 538 * MiB;
constexpr size_t KVS = (size_t)NTOK * 256;

constexpr int RING_OFF = 0, RING_BYTES = 131072;
constexpr int LDSCTL_OFF = RING_BYTES;
constexpr int MISC_OFF = LDSCTL_OFF + 320;
constexpr int TAB_OFF = LDSCTL_OFF + 1024;
constexpr int SCR_OFF = LDSCTL_OFF + 4096;
constexpr int LDS_BYTES = 147456;

struct Args { const float* in[30]; float* out; unsigned char* ws; float inv_freq[32]; };
struct Frame {
    LAS unsigned char* lds;
    gu32* ctl;
    unsigned char* ws;
    int tid, lane, wave, vcu, G;
};
DEVI void wg_sync() { __syncthreads(); }

DEVI int rowmap(int mode, int half, int n) {
    if (mode == 0) return n;
    if (mode == 1) return 256 * (n >> 7) + 128 * half + (n & 127);
    if (n < 2560) { const int hd = n >> 6, d = n & 63; return 256 * (hd >> 2) + 128 * (d >> 5) + 32 * (hd & 3) + (d & 31); }
    return n;
}
DEVI void p0_item(const float* W, int ld, int ncols, int K, const float* gain, bf16_t* dst, int mode, int half, LAS unsigned char* scr, int item, int lane) {
    const int nblk = (ncols + 63) >> 6, kb = item / nblk, nb = item % nblk, k0 = 64 * kb, n0 = 64 * nb;
    const int lr = lane >> 4, lc = 4 * (lane & 15);
    f32x4 v[16];
#pragma unroll
    for (int i = 0; i < 16; ++i) v[i] = (n0 + lc < ncols) ? *(const f32x4*)(W + (size_t)(k0 + 4 * i + lr) * ld + n0 + lc) : (f32x4){0.f, 0.f, 0.f, 0.f};
#pragma unroll
    for (int i = 0; i < 16; ++i) { const float g = gain ? gain[k0 + 4 * i + lr] : 1.0f; const f32x4 x = v[i] * g; *(LAS u32x2*)(scr + (4 * i + lr) * 136 + lc * 2) = pack4(x); }
    LDS_WAIT();
    const int c = lane & 7;
#pragma unroll
    for (int j = 0; j < 8; ++j) { const int n = (lane >> 3) + 8 * j; const LAS unsigned short* t = (const LAS unsigned short*)(scr + (8 * c) * 136 + n * 2);
        u32x4 o; o.x = (unsigned)t[0 * 68] | ((unsigned)t[1 * 68] << 16); o.y = (unsigned)t[2 * 68] | ((unsigned)t[3 * 68] << 16); o.z = (unsigned)t[4 * 68] | ((unsigned)t[5 * 68] << 16); o.w = (unsigned)t[6 * 68] | ((unsigned)t[7 * 68] << 16);
        if (n0 + n < ncols) *(u32x4*)(dst + (size_t)rowmap(mode, half, n0 + n) * K + k0 + 8 * c) = o; }
    LDS_WAIT();
}
DEVI void p0_load(f32x4 (&v)[16], const float* W, int ld, int ncols, int item, int lane) {
    const int nblk = (ncols + 63) >> 6, kb = item / nblk, nb = item % nblk, k0 = 64 * kb, n0 = 64 * nb, lr = lane >> 4, lc = 4 * (lane & 15);
#pragma unroll
    for (int i = 0; i < 16; ++i) v[i] = (n0 + lc < ncols) ? *(const f32x4*)(W + (size_t)(k0 + 4 * i + lr) * ld + n0 + lc) : (f32x4){0.f, 0.f, 0.f, 0.f};
}
DEVI void p0_finish(const f32x4 (&v)[16], int ncols, int K, const float* gain, bf16_t* dst, int mode, int half, LAS unsigned char* scr, int item, int lane) {
    const int nblk = (ncols + 63) >> 6, kb = item / nblk, nb = item % nblk, k0 = 64 * kb, n0 = 64 * nb, lr = lane >> 4, lc = 4 * (lane & 15);
#pragma unroll
    for (int i = 0; i < 16; ++i) { const float g = gain ? gain[k0 + 4 * i + lr] : 1.0f; const f32x4 x = v[i] * g; *(LAS u32x2*)(scr + (4 * i + lr) * 136 + lc * 2) = pack4(x); }
    LDS_WAIT();
    const int c = lane & 7;
#pragma unroll
    for (int j = 0; j < 8; ++j) { const int n = (lane >> 3) + 8 * j; const LAS unsigned short* t = (const LAS unsigned short*)(scr + (8 * c) * 136 + n * 2);
        u32x4 o; o.x = (unsigned)t[0 * 68] | ((unsigned)t[1 * 68] << 16); o.y = (unsigned)t[2 * 68] | ((unsigned)t[3 * 68] << 16); o.z = (unsigned)t[4 * 68] | ((unsigned)t[5 * 68] << 16); o.w = (unsigned)t[6 * 68] | ((unsigned)t[7 * 68] << 16);
        if (n0 + n < ncols) *(u32x4*)(dst + (size_t)rowmap(mode, half, n0 + n) * K + k0 + 8 * c) = o; }
    LDS_WAIT();
}
DEVI void prep_layer(const Frame& F, const Args& a, int L) {
    LAS unsigned char* scr = F.lds + RING_OFF + F.wave * 16384;
    const int gw = F.vcu * NWAVES + F.wave, NGW = F.G * NWAVES;
    const float* gf = a.in[4] + (size_t)L * DM;
    bf16_t* wgu = (bf16_t*)(F.ws + WS_WGU); bf16_t* wdn = (bf16_t*)(F.ws + WS_WDN);
#define PREP_SRC(it_) ((((it_) % 384) >> 7) == 0 ? a.in[25] + ((size_t)L * NEXP + (it_) / 384) * DM * DEXP : (((it_) % 384) >> 7) == 1 ? a.in[26] + ((size_t)L * NEXP + (it_) / 384) * DM * DEXP : a.in[27] + ((size_t)L * NEXP + (it_) / 384) * DEXP * DM)
    f32x4 vc[16], vn[16];
    int it = gw;
    if (it < NEXP * 384) { const int wh = (it % 384) >> 7; p0_load(vc, PREP_SRC(it), wh == 2 ? DM : DEXP, wh == 2 ? DM : DEXP, it & 127, F.lane); }
    for (; it < NEXP * 384; it += NGW) {
        const int itn = it + NGW;
        if (itn < NEXP * 384) { const int wh = (itn % 384) >> 7; p0_load(vn, PREP_SRC(itn), wh == 2 ? DM : DEXP, wh == 2 ? DM : DEXP, itn & 127, F.lane); }
        { const int e = it / 384, wh = (it % 384) >> 7, item = it & 127;
          if (wh == 2) p0_finish(vc, DM, DEXP, nullptr, wdn + (size_t)e * 1024 * 512, 0, 0, scr, item, F.lane);
          else p0_finish(vc, DEXP, DM, gf, wgu + (size_t)e * 1024 * 1024, 1, wh, scr, item, F.lane); }
#pragma unroll
        for (int i = 0; i < 16; ++i) vc[i] = vn[i];
    }
#undef PREP_SRC
    const float* p = a.in[1] + (size_t)L * NTOK * PLE; bf16_t* pb = (bf16_t*)(F.ws + WS_PB);
    const size_t n8 = (size_t)NTOK * PLE / 8;
#pragma unroll 4
    for (size_t i = (size_t)F.vcu * 512 + F.tid; i < n8; i += (size_t)F.G * 512) {
        const f32x4 v0 = *(const f32x4*)(p + i * 8), v1 = *(const f32x4*)(p + i * 8 + 4);
        u32x4 o; o.x = pk2(v0[0], v0[1]); o.y = pk2(v0[2], v0[3]); o.z = pk2(v1[0], v1[1]); o.w = pk2(v1[2], v1[3]);
        *(u32x4*)(pb + i * 8) = o; }
}
DEVI void p0_prologue(const Frame& F, const Args& a) {
    LAS unsigned char* scr = F.lds + RING_OFF + F.wave * 16384;
    const int gw = F.vcu * NWAVES + F.wave, NGW = F.G * NWAVES;
    unsigned char* ws = F.ws;
    constexpr int I_PW1 = 16 * 16 * 2, I_PW2 = 16 * 16, I_WIN = 16 * 41, I_WOUT = 16 * 16, I_C1 = 32 * 4 * 2, I_PP = 4 * 16 * 2, I_PG = 16 * 16 * 2;
    constexpr int NIT = I_PW1 + I_PW2 + I_WIN + I_WOUT + I_C1 + I_PP + I_PG;
    for (int it = gw; it < NIT; it += NGW) {
        int r = it;
        if (r < I_PW1) { const int half = r / 256; p0_item(a.in[6] + half * 1024, 2048, 1024, DM, a.in[3], (bf16_t*)(ws + WS_WPW1), 1, half, scr, r % 256, F.lane); continue; } r -= I_PW1;
        if (r < I_PW2) { p0_item(a.in[12], DM, DM, DM, nullptr, (bf16_t*)(ws + WS_WPW2), 0, 0, scr, r, F.lane); continue; } r -= I_PW2;
        if (r < I_WIN) { p0_item(a.in[14], NWIN, NWIN, DM, a.in[3] + DM, (bf16_t*)(ws + WS_WIN), 2, 0, scr, r, F.lane); continue; } r -= I_WIN;
        if (r < I_WOUT) { p0_item(a.in[20], DM, DM, DM, nullptr, (bf16_t*)(ws + WS_WOUT), 0, 0, scr, r, F.lane); continue; } r -= I_WOUT;
        if (r < I_C1) { const int j = r / 128; p0_item(a.in[18] + (size_t)j * 2048 * 256, 256, 256, 2048, nullptr, (bf16_t*)(ws + WS_WC1) + (size_t)j * 256 * 2048, 0, 0, scr, r % 128, F.lane); continue; } r -= I_C1;
        if (r < I_PP) { const int L = r / 64; p0_item(a.in[28] + (size_t)L * PLE * DM, DM, DM, PLE, nullptr, (bf16_t*)(ws + WS_WPP) + (size_t)L * DM * PLE, 0, 0, scr, r % 64, F.lane); continue; } r -= I_PP;
        { const int L = r / 256; p0_item(a.in[29] + (size_t)L * DM * DM, DM, DM, DM, a.in[5] + (size_t)L * DM, (bf16_t*)(ws + WS_WPG) + (size_t)L * DM * DM, 0, 0, scr, r % 256, F.lane); }
    }
    { u32x4* z = (u32x4*)((bf16_t*)(ws + WS_WIN) + (size_t)NWIN * DM); const int n16 = (NWIN_PAD - NWIN) * DM / 8;
      for (int i = F.vcu * 512 + F.tid; i < n16; i += F.G * 512) z[i] = (u32x4){0u, 0u, 0u, 0u}; }
    { bf16_t* rw = (bf16_t*)(ws + WS_RW);
      for (int i = F.vcu * 512 + F.tid; i < 2 * 48 * 1024; i += F.G * 512) {
          const int L = i / (48 * 1024), j = (i / 1024) % 48, k = i & 1023;
          float w = 0.f;
          if (j < 4) w = a.in[21][((size_t)L * DM + k) * 4 + j]; else if (j < 36) w = a.in[23][((size_t)L * DM + k) * 32 + (j - 4)];
          w *= a.in[4][(size_t)L * DM + k];
          const unsigned hi = pk2(w, 0.f) & 0xffffu; const float lo = w - bflo(hi);
          rw[((size_t)(L * 2 + 0) * 48 + j) * 1024 + k] = (bf16_t)hi; rw[((size_t)(L * 2 + 1) * 48 + j) * 1024 + k] = (bf16_t)(pk2(lo, 0.f) & 0xffffu); } }
    { bf16_t* w2t = (bf16_t*)(ws + WS_W2T);
      for (int i = F.vcu * 512 + F.tid; i < 2 * 64 * 256; i += F.G * 512) { const int j = i >> 14, n = (i >> 8) & 63, k = i & 255; w2t[i] = (bf16_t)(pk2(a.in[19][(size_t)(j * 256 + k) * 64 + n], 0.f) & 0xffffu); } }
    for (int it = gw; it < 2 * 4 * 32; it += NGW) {
        const int j = it >> 7, cg = (it >> 5) & 3, kr = it & 31;
        const float* pe = a.in[17] + (size_t)j * 2048 + kr * 64; const float* w1 = a.in[18] + ((size_t)j * 2048 + kr * 64) * 256 + cg * 64 + F.lane;
        float s = 0.f;
#pragma unroll 16
        for (int k = 0; k < 64; ++k) s += pe[k] * w1[(size_t)k * 256];
        ((float*)(ws + WS_CBP))[(j * 32 + kr) * 256 + cg * 64 + F.lane] = s; }
    { float* rope = (float*)(ws + WS_ROPE); const int* pos = (const int*)a.in[2];
      for (int i = F.vcu * 512 + F.tid; i < NTOK * 32; i += F.G * 512) {
          const int row = i >> 5, fi = i & 31;
          const float ang = (float)pos[row] * a.inv_freq[fi];
          const double rev = (double)ang * 0.15915494309189533577; const float fr = (float)(rev - floor(rev));
          rope[(size_t)row * 64 + fi] = __builtin_amdgcn_cosf(fr); rope[(size_t)row * 64 + 32 + fi] = __builtin_amdgcn_sinf(fr); } }
    { const float* x = a.in[0]; bf16_t* ha = (bf16_t*)(ws + WS_HA); float* rs0 = (float*)(ws + WS_RS0);
      f32x4 va[4], vb[4], na[4], nb[4];
#define XR(m_, j_) (((const f32x4*)(x + (size_t)(m_) * DM) + F.lane)[64 * (j_)])
      if (gw < NTOK) {
#pragma unroll
          for (int j = 0; j < 4; ++j) { na[j] = XR(gw, j); nb[j] = (gw + NGW < NTOK) ? XR(gw + NGW, j) : (f32x4){0.f, 0.f, 0.f, 0.f}; } }
      for (int m = gw; m < NTOK; m += 2 * NGW) {
#pragma unroll
          for (int j = 0; j < 4; ++j) { va[j] = na[j]; vb[j] = nb[j]; }
          if (m + 2 * NGW < NTOK) {
#pragma unroll
              for (int j = 0; j < 4; ++j) { na[j] = XR(m + 2 * NGW, j); nb[j] = (m + 3 * NGW < NTOK) ? XR(m + 3 * NGW, j) : (f32x4){0.f, 0.f, 0.f, 0.f}; } }
          float sa = 0.f, sb = 0.f;
#pragma unroll
          for (int j = 0; j < 4; ++j) { sa += (va[j][0] * va[j][0] + va[j][1] * va[j][1]) + (va[j][2] * va[j][2] + va[j][3] * va[j][3]); sb += (vb[j][0] * vb[j][0] + vb[j][1] * vb[j][1]) + (vb[j][2] * vb[j][2] + vb[j][3] * vb[j][3]); }
          sa = wave_sum(sa); sb = wave_sum(sb);
          u32x2* oa = (u32x2*)(ha + (size_t)m * DM) + F.lane; u32x2* ob = (u32x2*)(ha + (size_t)(m + NGW) * DM) + F.lane;
#pragma unroll
          for (int j = 0; j < 4; ++j) { oa[64 * j] = pack4(va[j]); if (m + NGW < NTOK) ob[64 * j] = pack4(vb[j]); }
          if (F.lane == 0) { rs0[m] = 1.0f / sqrtf(sa * (1.0f / DM) + EPS); if (m + NGW < NTOK) rs0[m + NGW] = 1.0f / sqrtf(sb * (1.0f / DM) + EPS); } }
#undef XR
      }

}

using pg8::Unit;
typedef f32x4 AccT[2][2][4][2];
struct ProbBase { const char* A; const char* Bt; int K; unsigned ldb; int G, c; };

#define EPI_FENCE() asm volatile("" ::: "memory")
struct ProbPw1 : ProbBase {
    const float* __restrict__ rstd; const float* __restrict__ bias; bf16_t* __restrict__ U;
    DEVI bool next(int i, Unit& u) const { const int L = i * G + c; if (L >= 128 * 8) return false; u.pm = L >> 3; u.pn = L & 7; u.e = 0; u.v = 256; return true; }
    DEVI unsigned a_off(const Unit& u, int R) const { return (unsigned)(u.pm * 256 + R) * 2048u; }
    DEVI size_t b_off(const Unit& u) const { return (size_t)u.pn * 256 * ldb; }
    DEVI void epi(const AccT& acc, const Unit& u, int wr, int wc, int fr, int fq) const {
        const int q0 = 32 * wc + 4 * fq;
        f32x4 ba[2], bg[2]; float rs[2][4];
#pragma unroll
        for (int n = 0; n < 2; ++n) { ba[n] = *(const f32x4*)(bias + 128 * u.pn + q0 + 16 * n); bg[n] = *(const f32x4*)(bias + 1024 + 128 * u.pn + q0 + 16 * n); }
#pragma unroll
        for (int ai = 0; ai < 2; ++ai)
#pragma unroll
            for (int m = 0; m < 4; ++m) rs[ai][m] = rstd[u.pm * 256 + 128 * ai + 64 * wr + 16 * m + fr];
        EPI_FENCE();
#pragma unroll
        for (int ai = 0; ai < 2; ++ai)
#pragma unroll
            for (int m = 0; m < 4; ++m) {
                const int row = u.pm * 256 + 128 * ai + 64 * wr + 16 * m + fr;
#pragma unroll
                for (int n = 0; n < 2; ++n) {
                    const f32x4 av = acc[ai][0][m][n] * rs[ai][m] + ba[n], gv = acc[ai][1][m][n] * rs[ai][m] + bg[n]; f32x4 o;
#pragma unroll
                    for (int j = 0; j < 4; ++j) o[j] = av[j] * sigmoid_f(gv[j]);
                    *(u32x2*)(U + (size_t)row * DM + 128 * u.pn + q0 + 16 * n) = pack4(o); } }
    }
};
struct ProbPP : ProbBase {
    bf16_t* O; int tail_lo;
    DEVI bool next(int i, Unit& u) const { if (c < tail_lo) return false; const int L = i * (G - tail_lo) + (c - tail_lo); if (L >= 128 * 4) return false; u.pm = L >> 2; u.pn = L & 3; u.e = 0; u.v = 256; return true; }
    DEVI unsigned a_off(const Unit& u, int R) const { return (unsigned)(u.pm * 256 + R) * 512u; }
    DEVI size_t b_off(const Unit& u) const { return (size_t)u.pn * 256 * ldb; }
    DEVI void epi(const AccT& acc, const Unit& u, int wr, int wc, int fr, int fq) const {
#pragma unroll
        for (int ai = 0; ai < 2; ++ai)
#pragma unroll
            for (int m = 0; m < 4; ++m) {
                const int row = u.pm * 256 + 128 * ai + 64 * wr + 16 * m + fr;
#pragma unroll
                for (int bj = 0; bj < 2; ++bj)
#pragma unroll
                    for (int n = 0; n < 2; ++n) *(u32x2*)(O + (size_t)row * DM + 256 * u.pn + 128 * bj + 32 * wc + 16 * n + 4 * fq) = pack4(acc[ai][bj][m][n]); }
    }
};
struct ProbRes : ProbBase {
    const bf16_t* __restrict__ RES; bf16_t* __restrict__ OUT; const float* __restrict__ bias;
    DEVI bool next(int i, Unit& u) const { const int L = i * G + c; if (L >= 128 * 4) return false; u.pm = L >> 2; u.pn = L & 3; u.e = 0; u.v = 256; return true; }
    DEVI unsigned a_off(const Unit& u, int R) const { return (unsigned)(u.pm * 256 + R) * 2048u; }
    DEVI size_t b_off(const Unit& u) const { return (size_t)u.pn * 256 * ldb; }
    DEVI void epi(const AccT& acc, const Unit& u, int wr, int wc, int fr, int fq) const {
        const int col0 = 256 * u.pn + 32 * wc + 4 * fq;
        f32x4 bv[2][2];
#pragma unroll
        for (int bj = 0; bj < 2; ++bj)
#pragma unroll
            for (int n = 0; n < 2; ++n) bv[bj][n] = bias ? *(const f32x4*)(bias + col0 + 128 * bj + 16 * n) : (f32x4){0.f, 0.f, 0.f, 0.f};
#pragma unroll
        for (int ai = 0; ai < 2; ++ai) {
            u32x2 r[4][2][2];
#pragma unroll
            for (int m = 0; m < 4; ++m) { const size_t o = (size_t)(u.pm * 256 + 128 * ai + 64 * wr + 16 * m + fr) * DM + col0;
#pragma unroll
                for (int bj = 0; bj < 2; ++bj)
#pragma unroll
                    for (int n = 0; n < 2; ++n) r[m][bj][n] = *(const u32x2*)(RES + o + 128 * bj + 16 * n); }
            EPI_FENCE();
#pragma unroll
            for (int m = 0; m < 4; ++m) { const size_t o = (size_t)(u.pm * 256 + 128 * ai + 64 * wr + 16 * m + fr) * DM + col0;
#pragma unroll
                for (int bj = 0; bj < 2; ++bj)
#pragma unroll
                    for (int n = 0; n < 2; ++n) *(u32x2*)(OUT + o + 128 * bj + 16 * n) = pack4(unpack4(r[m][bj][n]) + acc[ai][bj][m][n] + bv[bj][n]); }
            EPI_FENCE();
        }
    }
};
struct ProbPle : ProbBase {
    const bf16_t* __restrict__ H2; const bf16_t* __restrict__ PPp; const float* __restrict__ rstd; bf16_t* __restrict__ OUTB; float* __restrict__ OUTF; float* __restrict__ ssq; int last;
    DEVI bool next(int i, Unit& u) const { const int L = i * G + c; if (L >= 128 * 4) return false; u.pm = L >> 2; u.pn = L & 3; u.e = 0; u.v = 256; return true; }
    DEVI unsigned a_off(const Unit& u, int R) const { return (unsigned)(u.pm * 256 + R) * 2048u; }
    DEVI size_t b_off(const Unit& u) const { return (size_t)u.pn * 256 * ldb; }
    DEVI void epi(const AccT& acc, const Unit& u, int wr, int wc, int fr, int fq) const {
        const int col0 = 256 * u.pn + 32 * wc + 4 * fq;
#pragma unroll
        for (int ai = 0; ai < 2; ++ai) {
            u32x2 h[4][2][2], q[4][2][2]; float rs[4];
#pragma unroll
            for (int m = 0; m < 4; ++m) { const int row = u.pm * 256 + 128 * ai + 64 * wr + 16 * m + fr; const size_t o = (size_t)row * DM + col0; rs[m] = rstd[row];
#pragma unroll
                for (int bj = 0; bj < 2; ++bj)
#pragma unroll
                    for (int n = 0; n < 2; ++n) { h[m][bj][n] = *(const u32x2*)(H2 + o + 128 * bj + 16 * n); q[m][bj][n] = *(const u32x2*)(PPp + o + 128 * bj + 16 * n); } }
            EPI_FENCE();
#pragma unroll
            for (int m = 0; m < 4; ++m) { const int row = u.pm * 256 + 128 * ai + 64 * wr + 16 * m + fr; const size_t o = (size_t)row * DM + col0; float ss = 0.f;
#pragma unroll
                for (int bj = 0; bj < 2; ++bj)
#pragma unroll
                    for (int n = 0; n < 2; ++n) {
                        const f32x4 h2 = unpack4(h[m][bj][n]), pp = unpack4(q[m][bj][n]), a4 = acc[ai][bj][m][n] * rs[m]; f32x4 v;
#pragma unroll
                        for (int j = 0; j < 4; ++j) v[j] = h2[j] + sigmoid_f(a4[j]) * pp[j];
                        if (last) *(f32x4*)(OUTF + o + 128 * bj + 16 * n) = v;
                        else { *(u32x2*)(OUTB + o + 128 * bj + 16 * n) = pack4(v); ss += (v[0] * v[0] + v[1] * v[1]) + (v[2] * v[2] + v[3] * v[3]); } }
                if (!last) { ss += __shfl_xor(ss, 16); ss += __shfl_xor(ss, 32); if (fq == 0) ssq[(size_t)row * 16 + u.pn * 4 + wc] = ss; } }
            EPI_FENCE();
        }
    }
};
struct ProbGateUp : ProbBase {
    const LAS int* tab_row; const LAS int* tab_ev; int nblk;
    const LAS unsigned* goff;
    const float* __restrict__ slot_rs; bf16_t* __restrict__ HBUF;
    DEVI bool next(int i, Unit& u) const { const int L = i * G + c; if (L >= nblk * 4) return false; const int b = L >> 2; u.pn = L & 3; u.pm = tab_row[b]; const int ev = tab_ev[b]; u.e = (ev >> 9) | (i << 8); u.v = ev & 511; return true; }
    DEVI unsigned a_off(const Unit& u, int R) const { return goff[(u.e >> 8) * 256 + R]; }
    DEVI size_t b_off(const Unit& u) const { return ((size_t)(u.e & 255) * 1024 + (size_t)u.pn * 256) * ldb; }
    DEVI void epi(const AccT& acc, const Unit& u, int wr, int wc, int fr, int fq) const {
        float rsv[2][4];
#pragma unroll
        for (int ai = 0; ai < 2; ++ai)
#pragma unroll
            for (int m = 0; m < 4; ++m) rsv[ai][m] = slot_rs[u.pm + 128 * ai + 64 * wr + 16 * m + fr];
        EPI_FENCE();
#pragma unroll
        for (int ai = 0; ai < 2; ++ai)
#pragma unroll
            for (int m = 0; m < 4; ++m) {
                const int R = 128 * ai + 64 * wr + 16 * m + fr;
                if (R < u.v) { const int slot = u.pm + R; const float rs = rsv[ai][m];
#pragma unroll
                    for (int n = 0; n < 2; ++n) { const f32x4 g = acc[ai][0][m][n] * rs, up = acc[ai][1][m][n] * rs; f32x4 o;
#pragma unroll
                        for (int j = 0; j < 4; ++j) o[j] = g[j] * sigmoid_f(g[j]) * up[j];
                        *(u32x2*)(HBUF + (size_t)slot * DEXP + 128 * u.pn + 32 * wc + 16 * n + 4 * fq) = pack4(o); } } }
    }
};
struct ProbDown : ProbBase {
    const LAS int* tab_row; const LAS int* tab_ev; int nblk;
    const float* __restrict__ slot_w; bf16_t* __restrict__ YB;
    DEVI bool next(int i, Unit& u) const { const int L = i * G + c; if (L >= nblk * 4) return false; const int b = L >> 2; u.pn = L & 3; u.pm = tab_row[b]; const int ev = tab_ev[b]; u.e = ev >> 9; u.v = ev & 511; return true; }
    DEVI unsigned a_off(const Unit& u, int R) const { return (unsigned)(u.pm + R) * 1024u; }
    DEVI size_t b_off(const Unit& u) const { return ((size_t)u.e * 1024 + (size_t)u.pn * 256) * ldb; }
    DEVI void epi(const AccT& acc, const Unit& u, int wr, int wc, int fr, int fq) const {
        float wv[2][4];
#pragma unroll
        for (int ai = 0; ai < 2; ++ai)
#pragma unroll
            for (int m = 0; m < 4; ++m) wv[ai][m] = slot_w[u.pm + 128 * ai + 64 * wr + 16 * m + fr];
        EPI_FENCE();
#pragma unroll
        for (int ai = 0; ai < 2; ++ai)
#pragma unroll
            for (int m = 0; m < 4; ++m) {
                const int R = 128 * ai + 64 * wr + 16 * m + fr;
                if (R < u.v) { const int slot = u.pm + R; const float w = wv[ai][m];
#pragma unroll
                    for (int bj = 0; bj < 2; ++bj)
#pragma unroll
                        for (int n = 0; n < 2; ++n) *(u32x2*)(YB + (size_t)slot * DM + 256 * u.pn + 128 * bj + 32 * wc + 16 * n + 4 * fq) = pack4(acc[ai][bj][m][n] * w); } }
    }
};
struct ProbWin : ProbBase {
    const float* __restrict__ rstd; const float* __restrict__ rope; const float* __restrict__ qnorm; const float* __restrict__ knorm; bf16_t* __restrict__ Q; bf16_t* __restrict__ KV; float* __restrict__ gates;
    const LAS float* lrs;
    DEVI bool next(int i, Unit& u) const { const int L = i * G + c; if (L >= 128 * 11) return false; u.pm = L / 11; u.pn = L % 11; u.e = i; u.v = 256; return true; }
    DEVI unsigned a_off(const Unit& u, int R) const { return (unsigned)(u.pm * 256 + R) * 2048u; }
    DEVI size_t b_off(const Unit& u) const { return (size_t)u.pn * 256 * ldb; }
    DEVI void epi(const AccT& acc, const Unit& u, int wr, int wc, int fr, int fq) const {
        const int pn = u.pn;
        float rsv[2][4];
#pragma unroll
        for (int ai = 0; ai < 2; ++ai)
#pragma unroll
            for (int m = 0; m < 4; ++m) rsv[ai][m] = lrs[u.e * 256 + 128 * ai + 64 * wr + 16 * m + fr];
        if (pn == 10) {
            EPI_FENCE();
            if (wc < 2) {
#pragma unroll
                for (int ai = 0; ai < 2; ++ai)
#pragma unroll
                    for (int m = 0; m < 4; ++m) {
                        const int row = u.pm * 256 + 128 * ai + 64 * wr + 16 * m + fr; const float rs = rsv[ai][m];
#pragma unroll
                        for (int n = 0; n < 2; ++n) if (wc == 0 || n == 0) { const f32x4 a4 = acc[ai][0][m][n] * rs; f32x4 o;
#pragma unroll
                            for (int j = 0; j < 4; ++j) o[j] = sigmoid_f(a4[j]);
                            *(f32x4*)(gates + (size_t)row * 48 + 32 * wc + 16 * n + 4 * fq) = o; } } }
            return;
        }
        const bool isq = pn < 4, dorope = isq || pn == 6 || pn == 8;
        const float* gvec = isq ? qnorm : (knorm + (pn == 6 ? 64 : 128));
        f32x4 g1[2], g2[2];
#pragma unroll
        for (int n = 0; n < 2; ++n) { g1[n] = *(const f32x4*)(gvec + 16 * n + 4 * fq); g2[n] = *(const f32x4*)(gvec + 32 + 16 * n + 4 * fq); }
        const float oscale = isq ? C2 : 1.0f;
#pragma unroll
        for (int g = 0; g < 8; ++g) { const int ai = g >> 2, m = g & 3;
            const int row = u.pm * 256 + 128 * ai + 64 * wr + 16 * m + fr; const float rs = rsv[ai][m];
            f32x4 cs[2], sn[2];
            if (dorope) { const size_t ro = (size_t)row * 64 + 4 * fq;
#pragma unroll
                for (int n = 0; n < 2; ++n) { cs[n] = *(const f32x4*)(rope + ro + 16 * n); sn[n] = *(const f32x4*)(rope + ro + 32 + 16 * n); } }
            f32x4 x1[2], x2[2];
#pragma unroll
            for (int n = 0; n < 2; ++n) { x1[n] = acc[ai][0][m][n] * rs; x2[n] = acc[ai][1][m][n] * rs; }
            if (dorope) {
                float ss = 0.f;
#pragma unroll
                for (int n = 0; n < 2; ++n)
#pragma unroll
                    for (int j = 0; j < 4; ++j) ss += x1[n][j] * x1[n][j] + x2[n][j] * x2[n][j];
                ss += __shfl_xor(ss, 16); ss += __shfl_xor(ss, 32);
                const float inv = 1.0f / sqrtf(ss * (1.0f / 64.0f) + EPS);
#pragma unroll
                for (int n = 0; n < 2; ++n) {
                    const f32x4 y1 = x1[n] * inv * g1[n], y2 = x2[n] * inv * g2[n];
                    x1[n] = (y1 * cs[n] - y2 * sn[n]) * oscale; x2[n] = (y2 * cs[n] + y1 * sn[n]) * oscale; } }
            bf16_t* dst;
            if (isq) dst = Q + (size_t)row * DM + (4 * pn + wc) * 64;
            else { const int b = row >> 11, t = row & 2047; dst = KV + (size_t)(pn - 4) * KVS + ((size_t)(b * 4 + wc) * SEQ + t) * 64; }
#pragma unroll
            for (int n = 0; n < 2; ++n) { *(u32x2*)(dst + 16 * n + 4 * fq) = pack4(x1[n]); *(u32x2*)(dst + 32 + 16 * n + 4 * fq) = pack4(x2[n]); }
        }
    }
};
struct ProbCmp : ProbBase {
    float* CP;
    DEVI bool next(int i, Unit& u) const { const int L = i * G + c; if (L >= 256) return false; u.e = L >> 7; u.pm = (L >> 2) & 31; u.v = L & 3; u.pn = 0; return true; }
    DEVI unsigned a_off(const Unit& u, int R) const { return (unsigned)u.e * (unsigned)(KVS * 2) + (unsigned)(u.pm * 256 + R) * 2048u + (unsigned)u.v * 1024u; }
    DEVI size_t b_off(const Unit& u) const { return (size_t)u.e * 256 * ldb + (size_t)u.v * 1024; }
    DEVI void epi(const AccT& acc, const Unit& u, int wr, int wc, int fr, int fq) const {
        float* base = CP + ((size_t)(u.e * 4 + u.v) * 8192) * 256;
#pragma unroll
        for (int ai = 0; ai < 2; ++ai)
#pragma unroll
            for (int m = 0; m < 4; ++m) {
                const int rho = u.pm * 256 + 128 * ai + 64 * wr + 16 * m + fr;
#pragma unroll
                for (int bj = 0; bj < 2; ++bj)
#pragma unroll
                    for (int n = 0; n < 2; ++n) *(f32x4*)(base + (size_t)rho * 256 + 128 * bj + 32 * wc + 16 * n + 4 * fq) = acc[ai][bj][m][n]; }
    }
};

#define CONV_BAR() asm volatile("s_waitcnt lgkmcnt(0)\n\ts_barrier" ::: "memory")
DEVI void conv_phase(const Frame& F, const Args& a) {
    const bf16_t* U = (const bf16_t*)(F.ws + WS_U); bf16_t* V = (bf16_t*)(F.ws + WS_V);
    LAS float* red = (LAS float*)(F.lds + SCR_OFF);
    LAS float* fin = red + 256;
    const int tid = F.tid, c0 = 2 * tid;
    f32x2 w2[31];
#pragma unroll
    for (int k = 0; k < 31; ++k) w2[k] = *(const f32x2*)(a.in[8] + (size_t)k * DM + c0);
    const f32x2 bdw = *(const f32x2*)(a.in[9] + c0), lg = *(const f32x2*)(a.in[10] + c0), lb = *(const f32x2*)(a.in[11] + c0);
    for (int ch = F.vcu; ch < 256; ch += F.G) {
        const int tokbase = ch * 128, t0 = tokbase & (SEQ - 1);
        const unsigned* Up = (const unsigned*)U + (size_t)tokbase * 512 + tid;
        unsigned win[46];
#pragma unroll
        for (int i = 0; i < 46; ++i) { const int rel = i - 30; win[i] = (rel >= 0 || t0 != 0) ? Up[(ptrdiff_t)rel * 512] : 0u; }
#pragma unroll
        for (int s = 0; s < 8; ++s) {
            unsigned nxt[16];
            if (s < 7) {
#pragma unroll
                for (int i = 0; i < 16; ++i) nxt[i] = Up[(ptrdiff_t)(16 * (s + 1) + i) * 512]; }
            f32x2 y[16];
#pragma unroll
            for (int tt = 0; tt < 16; ++tt) y[tt] = bdw;
#pragma unroll
            for (int rr = 0; rr < 46; ++rr) {
                const f32x2 v = {bflo(win[rr]), bfhi(win[rr])};
#pragma unroll
                for (int tt = 0; tt < 16; ++tt) { const int k = rr - tt; if (k >= 0 && k <= 30) y[tt] += w2[k] * v; }
            }
            float v16[16];
            { const bool h5 = (F.lane & 32) != 0;
#pragma unroll
              for (int i = 0; i < 16; ++i) { const float sA = y[i][0] + y[i][1], sB = y[i][0] * y[i][0] + y[i][1] * y[i][1]; const float keep = h5 ? sB : sA, send = h5 ? sA : sB; v16[i] = keep + __shfl_xor(send, 32); } }
            float v8[8], v4[4], v2[2], v1r;
            { const bool h = (F.lane & 16) != 0;
#pragma unroll
              for (int i = 0; i < 8; ++i) { const float keep = h ? v16[i + 8] : v16[i], send = h ? v16[i] : v16[i + 8]; v8[i] = keep + __shfl_xor(send, 16); } }
            { const bool h = (F.lane & 8) != 0;
#pragma unroll
              for (int i = 0; i < 4; ++i) { const float keep = h ? v8[i + 4] : v8[i], send = h ? v8[i] : v8[i + 4]; v4[i] = keep + __shfl_xor(send, 8); } }
            { const bool h = (F.lane & 4) != 0;
#pragma unroll
              for (int i = 0; i < 2; ++i) { const float keep = h ? v4[i + 2] : v4[i], send = h ? v4[i] : v4[i + 2]; v2[i] = keep + __shfl_xor(send, 4); } }
            { const bool h = (F.lane & 2) != 0; const float keep = h ? v2[1] : v2[0], send = h ? v2[0] : v2[1]; v1r = keep + __shfl_xor(send, 2); }
            v1r += __shfl_xor(v1r, 1);
            CONV_BAR();
            if ((F.lane & 1) == 0) red[F.wave * 32 + (F.lane >> 1)] = v1r;
            CONV_BAR();
            if (tid < 16) { float t = 0.f, q = 0.f;
#pragma unroll
                for (int w = 0; w < 8; ++w) { t += red[w * 32 + tid]; q += red[w * 32 + 16 + tid]; }
                const float mean = t * (1.0f / DM), var = q * (1.0f / DM) - mean * mean;
                fin[tid] = mean; fin[16 + tid] = 1.0f / sqrtf(var + EPS); }
            CONV_BAR();
#pragma unroll
            for (int tt = 0; tt < 16; ++tt) {
                const float mean = fin[tt], rstd = fin[16 + tt];
                const float z0 = (y[tt][0] - mean) * rstd * lg[0] + lb[0], z1 = (y[tt][1] - mean) * rstd * lg[1] + lb[1];
                *(unsigned*)(V + (size_t)(tokbase + 16 * s + tt) * DM + c0) = pk2(z0 * sigmoid_f(z0), z1 * sigmoid_f(z1)); }
            if (s < 7) {
#pragma unroll
                for (int i = 0; i < 30; ++i) win[i] = win[i + 16];
#pragma unroll
                for (int i = 0; i < 16; ++i) win[30 + i] = nxt[i]; }
        }
    }
}
DEVI void router_phase(const Frame& F, const Args& a, int L, const bf16_t* H) {
    const bf16_t* rw = (const bf16_t*)(F.ws + WS_RW) + (size_t)(L * 2) * 48 * 1024;
    float* rs1 = (float*)(F.ws + WS_RS1); int* asg_e = (int*)(F.ws + WS_ASGE); int* asg_r = (int*)(F.ws + WS_ASGR); float* asg_w = (float*)(F.ws + WS_ASGW); int* cnt = (int*)(F.ws + WS_CNT);
    LAS unsigned char* wst = F.lds + RING_OFF;
    LAS float* lg = (LAS float*)(F.lds + RING_OFF + 65536) + F.wave * (16 * 48);
    LAS int* elist = (LAS int*)(F.lds + RING_OFF + 98304);
    LAS float* bias = (LAS float*)(F.lds + RING_OFF + 98304 + 1024);
    if (F.tid < 4) bias[F.tid] = a.in[22][L * 4 + F.tid]; else if (F.tid < 36) bias[F.tid] = a.in[24][L * 32 + F.tid - 4];
    const LAS float* brg = bias; const LAS float* bre = bias + 4;
    const int fr = F.lane & 15, fq = F.lane >> 4;
    for (int ch = F.vcu; ch < 256; ch += F.G) {
        const int tok0 = ch * 128 + F.wave * 16;
        f32x4 acc[3];
#pragma unroll
        for (int t = 0; t < 3; ++t) acc[t] = (f32x4){0.f, 0.f, 0.f, 0.f};
        float ss = 0.f;
        const bf16_t* hp = H + (size_t)(tok0 + fr) * DM + 8 * fq;
        for (int kc4 = 0; kc4 < 4; ++kc4) {
            const int kc = (kc4 + F.vcu) & 3;
            bf16x8 hf[8];
#pragma unroll
            for (int sl = 0; sl < 8; ++sl) hf[sl] = *(const bf16x8*)(hp + kc * 256 + 32 * sl);
            u32x4 wv[6];
#pragma unroll
            for (int i = 0; i < 6; ++i) { const int idx = F.tid + 512 * i, hl = idx / 1536, rem = idx % 1536, row = rem >> 5, c = rem & 31;
                wv[i] = *(const u32x4*)(rw + ((size_t)(hl * 48 + row)) * 1024 + kc * 256 + c * 8); }
            wg_sync();
#pragma unroll
            for (int i = 0; i < 6; ++i) { const int idx = F.tid + 512 * i, hl = idx / 1536, rem = idx % 1536, row = rem >> 5, c = rem & 31;
                *(LAS u32x4*)(wst + hl * 25344 + row * 528 + c * 16) = wv[i]; }
            wg_sync();
#pragma unroll
            for (int sl = 0; sl < 8; ++sl) {
#pragma unroll
                for (int t = 0; t < 3; ++t) {
                    const bf16x8 wh = *(const LAS bf16x8*)(wst + (16 * t + fr) * 528 + (32 * sl + 8 * fq) * 2), wl = *(const LAS bf16x8*)(wst + 25344 + (16 * t + fr) * 528 + (32 * sl + 8 * fq) * 2);
                    acc[t] = __builtin_amdgcn_mfma_f32_16x16x32_bf16(wh, hf[sl], acc[t], 0, 0, 0);
                    acc[t] = __builtin_amdgcn_mfma_f32_16x16x32_bf16(wl, hf[sl], acc[t], 0, 0, 0); }
                const u32x4 hu = __builtin_bit_cast(u32x4, hf[sl]);
#pragma unroll
                for (int j = 0; j < 4; ++j) { const float x0 = bflo(hu[j]), x1 = bfhi(hu[j]); ss += x0 * x0 + x1 * x1; }
            }
        }
        ss += __shfl_xor(ss, 16); ss += __shfl_xor(ss, 32);
        const float rs = 1.0f / sqrtf(ss * (1.0f / DM) + EPS);
        if (fq == 0) rs1[tok0 + fr] = rs;
#pragma unroll
        for (int t = 0; t < 3; ++t)
#pragma unroll
            for (int r = 0; r < 4; ++r) lg[fr * 48 + 16 * t + 4 * fq + r] = acc[t][r] * rs;
        LDS_WAIT();
        if (F.lane < 16) {
            const LAS float* my = lg + F.lane * 48;
            float g[4]; int gi = 0; float gm;
#pragma unroll
            for (int j = 0; j < 4; ++j) g[j] = my[j] + brg[j];
            gm = g[0];
#pragma unroll
            for (int j = 1; j < 4; ++j) if (g[j] > gm) { gm = g[j]; gi = j; }
            float den = 0.f;
#pragma unroll
            for (int j = 0; j < 4; ++j) den += __expf(g[j] - gm);
            const float pg = 1.0f / den;
            float v1 = -INFINITY, v2 = -INFINITY; int i1 = 0, i2 = 0;
            for (int j = 0; j < 8; ++j) { const float v = my[4 + gi * 8 + j] + bre[gi * 8 + j];
                if (v > v1) { v2 = v1; i2 = i1; v1 = v; i1 = j; } else if (v > v2) { v2 = v; i2 = j; } }
            const float e2 = __expf(v2 - v1), wa = pg / (1.0f + e2), wb = pg * e2 / (1.0f + e2);
            const int tl = F.wave * 16 + F.lane;
            elist[2 * tl] = gi * 8 + i1; elist[2 * tl + 1] = gi * 8 + i2;
            asg_w[(size_t)ch * 256 + 2 * tl] = wa; asg_w[(size_t)ch * 256 + 2 * tl + 1] = wb;
        }
        wg_sync();
        if (F.tid < 288) {
            const bool isr = F.tid < 256; const int e = isr ? elist[F.tid] : F.tid - 256, lim = isr ? F.tid : 256; int r = 0;
            typedef int i32x4 __attribute__((ext_vector_type(4)));
#pragma unroll 8
            for (int q = 0; q < 256; q += 4) { const i32x4 v = *(const LAS i32x4*)(elist + q);
                r += ((v[0] == e) & (q < lim)) + ((v[1] == e) & (q + 1 < lim)) + ((v[2] == e) & (q + 2 < lim)) + ((v[3] == e) & (q + 3 < lim)); }
            if (isr) { asg_e[(size_t)ch * 256 + F.tid] = e; asg_r[(size_t)ch * 256 + F.tid] = r; } else cnt[ch * 32 + e] = r; }
        wg_sync();
    }
}
DEVI void fill_phase(const Frame& F) {
    const int* cnt = (const int*)(F.ws + WS_CNT); const int* asg_e = (const int*)(F.ws + WS_ASGE); const int* asg_r = (const int*)(F.ws + WS_ASGR); const float* asg_w = (const float*)(F.ws + WS_ASGW);
    const float* rs1 = (const float*)(F.ws + WS_RS1);
    int* tslot = (int*)(F.ws + WS_TSLOT); int* stok = (int*)(F.ws + WS_STOK); float* sw = (float*)(F.ws + WS_SW); float* srs = (float*)(F.ws + WS_SRS); int* mtot = (int*)(F.ws + WS_MTOT);
    LAS int* ptot = (LAS int*)(F.lds + RING_OFF);
    LAS int* ppre = ptot + 512;
    LAS int* tot = ppre + 512; LAS int* start = tot + 32; LAS int* pre = start + 32;
    for (int ch = F.vcu; ch < 256; ch += F.G) {
        wg_sync();
        { const int e = F.tid & 31, part = F.tid >> 5; int t = 0, p = 0;
          for (int w = part * 16; w < part * 16 + 16; ++w) { const int c = cnt[w * 32 + e]; t += c; if (w < ch) p += c; }
          ptot[part * 32 + e] = t; ppre[part * 32 + e] = p; }
        wg_sync();
        if (F.tid < 32) { int t = 0, p = 0;
#pragma unroll
            for (int q = 0; q < 16; ++q) { t += ptot[q * 32 + F.tid]; p += ppre[q * 32 + F.tid]; }
            tot[F.tid] = t; pre[F.tid] = p; }
        wg_sync();
        if (F.tid == 0) { int s = 0; for (int e = 0; e < 32; ++e) { start[e] = s; s += tot[e]; } }
        wg_sync();
        if (F.tid < 256) { const size_t ag = (size_t)ch * 256 + F.tid; const int e = asg_e[ag], slot = start[e] + pre[e] + asg_r[ag], tok = ch * 128 + (F.tid >> 1);
            stok[slot] = tok; sw[slot] = asg_w[ag]; srs[slot] = rs1[tok]; tslot[ag] = slot; }
        if (ch == 0) {
            if (F.tid < 32) { mtot[F.tid] = tot[F.tid]; mtot[32 + F.tid] = start[F.tid]; }
            if (F.tid >= 256) { const int i = NSLOT + F.tid - 256; stok[i] = 0; sw[i] = 0.f; srs[i] = 0.f; }
            { const float* cbp = (const float*)(F.ws + WS_CBP); const int j = F.tid >> 8, c = F.tid & 255; float s2 = 0.f;
              for (int kr = 0; kr < 32; ++kr) s2 += cbp[(j * 32 + kr) * 256 + c];
              ((float*)(F.ws + WS_CB))[F.tid] = s2; } }
    }
}
DEVI int build_moe_table(const Frame& F) {
    const int* mtot = (const int*)(F.ws + WS_MTOT);
    LAS int* trow = (LAS int*)(F.lds + TAB_OFF); LAS int* tev = trow + 320; LAS int* tn = tev + 320;
    LAS int* mt = (LAS int*)(F.lds + SCR_OFF);
    if (F.tid < 64) mt[F.tid] = mtot[F.tid];
    wg_sync();
    if (F.tid == 0) { int nb = 0;
        for (int e = 0; e < 32; ++e) { const int t = mt[e], s = mt[32 + e];
            for (int o = 0; o < t; o += 256) { trow[nb] = s + o; tev[nb] = e * 512 + ((t - o) < 256 ? (t - o) : 256); ++nb; } }
        tn[0] = nb; }
    wg_sync();
    return tn[0];
}
DEVI void combine_phase(const Frame& F, const bf16_t* H, bf16_t* OUT, int zero_y) {
    const bf16_t* YB = (const bf16_t*)(F.ws + WS_YB); const int* tslot = (const int*)(F.ws + WS_TSLOT); float* rs2 = (float*)(F.ws + WS_RS2);
    const int gw = F.vcu * NWAVES + F.wave, NGW = F.G * NWAVES;
    for (int row = gw; row < NTOK; row += NGW) {
        const int s0 = tslot[2 * row], s1 = tslot[2 * row + 1]; float ss = 0.f;
#pragma unroll
        for (int hx = 0; hx < 2; ++hx) {
            const int col = 512 * hx + 8 * F.lane;
            const u32x4 h = *(const u32x4*)(H + (size_t)row * DM + col), y0 = *(const u32x4*)(YB + (size_t)s0 * DM + col), y1 = *(const u32x4*)(YB + (size_t)s1 * DM + col); u32x4 o;
#pragma unroll
            for (int j = 0; j < 4; ++j) { float lo = bflo(h[j]) + bflo(y0[j]) + bflo(y1[j]), hi = bfhi(h[j]) + bfhi(y0[j]) + bfhi(y1[j]); if (zero_y) { lo = bflo(h[j]); hi = bfhi(h[j]); } ss += lo * lo + hi * hi; o[j] = pk2(lo, hi); }
            *(u32x4*)(OUT + (size_t)row * DM + col) = o; }
        ss = wave_sum(ss);
        if (F.lane == 0) rs2[row] = 1.0f / sqrtf(ss * (1.0f / DM) + EPS);
    }
}
DEVI void rstd_from_partials(const Frame& F) {
    const float* ssq = (const float*)(F.ws + WS_SSQ); float* rs0 = (float*)(F.ws + WS_RS0);
    for (int row = F.vcu * 512 + F.tid; row < NTOK; row += F.G * 512) {
        const f32x4* p = (const f32x4*)(ssq + (size_t)row * 16); float s = 0.f;
#pragma unroll
        for (int q = 0; q < 4; ++q) { const f32x4 v = p[q]; s += (v[0] + v[1]) + (v[2] + v[3]); }
        rs0[row] = 1.0f / sqrtf(s * (1.0f / DM) + EPS); }
}
DEVI void cmpb_phase(const Frame& F, const Args& a) {
    const float* CP = (const float*)(F.ws + WS_CP); const float* CB = (const float*)(F.ws + WS_CB); const float* rope = (const float*)(F.ws + WS_ROPE);
    const bf16_t* W2T = (const bf16_t*)(F.ws + WS_W2T);
    bf16_t* KC = (bf16_t*)(F.ws + WS_KC); bf16_t* VC = (bf16_t*)(F.ws + WS_VC);
    LAS unsigned char* hl = F.lds + RING_OFF;
    LAS float* ol = (LAS float*)(F.lds + RING_OFF + 65536);
    const float kn = a.in[16][F.lane];
    const int fr = F.lane & 15, fq = F.lane >> 4;
    for (int wg = F.vcu; wg < 256; wg += F.G) {
        const int row0 = wg * 64, j = row0 >> 13, rho0 = row0 & 8191;
        { const int r = F.tid >> 3, c0 = (F.tid & 7) * 32;
          f32x4 acc8[8];
#pragma unroll
          for (int q = 0; q < 8; ++q) acc8[q] = *(const f32x4*)(CB + j * 256 + c0 + 4 * q);
#pragma unroll
          for (int ks = 0; ks < 4; ++ks) { const float* src = CP + ((size_t)(j * 4 + ks) * 8192 + rho0 + r) * 256 + c0;
#pragma unroll
              for (int q = 0; q < 8; ++q) acc8[q] += *(const f32x4*)(src + 4 * q); }
#pragma unroll
          for (int q = 0; q < 8; ++q) { f32x4 g;
#pragma unroll
              for (int e = 0; e < 4; ++e) { const float x = acc8[q][e], uu = 0.7978845608028654f * (x + 0.044715f * x * x * x); g[e] = x * sigmoid_f(2.0f * uu); }
              *(LAS u32x2*)(hl + r * 528 + (c0 + 4 * q) * 2) = pack4(g); } }
        wg_sync();
        { const int mt = F.wave & 3, np = F.wave >> 2;
          f32x4 d[2]; d[0] = (f32x4){0.f, 0.f, 0.f, 0.f}; d[1] = d[0];
#pragma unroll
          for (int st = 0; st < 8; ++st) {
              const bf16x8 hf = *(const LAS bf16x8*)(hl + (16 * mt + fr) * 528 + (32 * st + 8 * fq) * 2);
#pragma unroll
              for (int t = 0; t < 2; ++t) { const bf16x8 wf = *(const bf16x8*)(W2T + ((size_t)(j * 64 + 32 * np + 16 * t + fr)) * 256 + 32 * st + 8 * fq);
                  d[t] = __builtin_amdgcn_mfma_f32_16x16x32_bf16(wf, hf, d[t], 0, 0, 0); } }
#pragma unroll
          for (int t = 0; t < 2; ++t) *(LAS f32x4*)(ol + (16 * mt + fr) * 64 + 32 * np + 16 * t + 4 * fq) = d[t]; }
        wg_sync();
#pragma unroll
        for (int q = 0; q < 8; ++q) {
            const int r = F.wave * 8 + q, rho = rho0 + r, bg = rho >> 7, n = rho & 127;
            bf16_t* dst = (j == 0 ? KC : VC) + (size_t)rho * 64 + F.lane;
            float o = ol[r * 64 + F.lane];
            if (n == 127) { *dst = 0; continue; }
            if (j == 0) {
                const float ms = wave_sum(o * o) * (1.0f / 64.0f); const float y = o * (1.0f / sqrtf(ms + EPS)) * kn;
                const float other = __shfl_xor(y, 32);
                const int row = (bg >> 2) * SEQ + 16 * n + 31; const float cs = rope[(size_t)row * 64 + (F.lane & 31)], sn = rope[(size_t)row * 64 + 32 + (F.lane & 31)];
                o = (F.lane < 32) ? (y * cs - other * sn) : (y * cs + other * sn);
            }
            *dst = (bf16_t)(pk2(o, 0.f) & 0xffffu);
        }
        wg_sync();
    }
}

#ifndef ATT_REP
#define ATT_REP 1
#endif
namespace att {
constexpr int KS0 = 0, VS0 = 24576, WSF = 49152, OFN = 51200, UNI = 116736;
typedef const LAS char* lptr;
DEVI int crow(int r, int hi) { return (r & 3) + 8 * (r >> 2) + 4 * hi; }
DEVI void glds16(const void* gsrc, unsigned lds_dst) { unsigned keep;
    asm volatile("s_mov_b32 %0, m0\n\ts_mov_b32 m0, %2\n\ts_nop 0\n\tglobal_load_lds_dwordx4 %1, off\n\ts_mov_b32 m0, %0" : "=&s"(keep) : "v"(gsrc), "s"(lds_dst) : "memory"); }
DEVI float xlane32(float v) { return __shfl_xor(v, 32); }
DEVI void qkt(f32x16& p0, f32x16& p1, lptr Kslot, const bf16x8* qr, float cinit, int r32, int hi) {
    lptr kb = Kslot + hi * 1024 + r32 * 16;
#pragma unroll
    for (int r = 0; r < 16; ++r) { p0[r] = cinit; p1[r] = cinit; }
#pragma unroll
    for (int d0 = 0; d0 < 4; ++d0) {
        const bf16x8 b0 = *(const LAS bf16x8*)(kb + d0 * 2048), b1 = *(const LAS bf16x8*)(kb + d0 * 2048 + 512);
        p0 = __builtin_amdgcn_mfma_f32_32x32x16_bf16(b0, qr[d0], p0, 0, 0, 0); p1 = __builtin_amdgcn_mfma_f32_32x32x16_bf16(b1, qr[d0], p1, 0, 0, 0); }
}
DEVI float rowmax(const f32x16& p0, const f32x16& p1) {
    float m = fmaxf(p0[0], p1[0]);
#pragma unroll
    for (int r = 1; r < 16; ++r) m = fmaxf(m, fmaxf(p0[r], p1[r]));
    return fmaxf(m, xlane32(m));
}
DEVI float max3f(float a, float b, float c) { float r; asm("v_max3_f32 %0, %1, %2, %3" : "=v"(r) : "v"(a), "v"(b), "v"(c)); return r; }
DEVI float rowmax3(const f32x16& p0, const f32x16& p1) {
    float a = max3f(p0[0], p0[1], p1[0]), b = max3f(p0[2], p0[3], p1[1]); a = max3f(a, p1[2], p1[3]);
#pragma unroll
    for (int r = 4; r < 16; r += 4) { a = max3f(a, p0[r], p0[r + 1]); b = max3f(b, p0[r + 2], p0[r + 3]); a = max3f(a, p1[r], p1[r + 1]); b = max3f(b, p1[r + 2], p1[r + 3]); }
    const float m = max3f(a, b, b);
    return max3f(m, xlane32(m), m);
}
DEVI void qk2(f32x16& p0, f32x16& p1, lptr Kslot, const bf16x8* qr, const f32x16& negm, int r32, int hi) {
    lptr kb = Kslot + hi * 1024 + r32 * 16;
    bf16x8 kf[8];
#pragma unroll
    for (int d0 = 0; d0 < 4; ++d0) { kf[2 * d0] = *(const LAS bf16x8*)(kb + d0 * 2048); kf[2 * d0 + 1] = *(const LAS bf16x8*)(kb + d0 * 2048 + 512); }
    asm volatile("s_waitcnt lgkmcnt(0)" : "+v"(kf[0]), "+v"(kf[1]), "+v"(kf[2]), "+v"(kf[3]), "+v"(kf[4]), "+v"(kf[5]), "+v"(kf[6]), "+v"(kf[7]) :: "memory");
    p0 = __builtin_amdgcn_mfma_f32_32x32x16_bf16(kf[0], qr[0], negm, 0, 0, 0); p1 = __builtin_amdgcn_mfma_f32_32x32x16_bf16(kf[1], qr[0], negm, 0, 0, 0);
#pragma unroll
    for (int d0 = 1; d0 < 4; ++d0) { p0 = __builtin_amdgcn_mfma_f32_32x32x16_bf16(kf[2 * d0], qr[d0], p0, 0, 0, 0); p1 = __builtin_amdgcn_mfma_f32_32x32x16_bf16(kf[2 * d0 + 1], qr[d0], p1, 0, 0, 0); }
}
DEVI void pv(f32x16* o, int vb, bf16x8 pa0, bf16x8 pa1, bf16x8 pa2, bf16x8 pa3) {
#pragma unroll
    for (int d0 = 0; d0 < 2; ++d0) { s16x4 lo[4], hi[4];
#pragma unroll
        for (int ks = 0; ks < 4; ++ks) {
            asm volatile("ds_read_b64_tr_b16 %0,%1 offset:%c2" : "=&v"(lo[ks]) : "v"(vb), "i"(d0 * 4096 + ks * 1024) : "memory");
            asm volatile("ds_read_b64_tr_b16 %0,%1 offset:%c2" : "=&v"(hi[ks]) : "v"(vb), "i"(d0 * 4096 + ks * 1024 + 512) : "memory"); }
        asm volatile("s_waitcnt lgkmcnt(0)" ::: "memory"); __builtin_amdgcn_sched_barrier(0);
#define ATT_PK(k) (bf16x8){lo[k][0], lo[k][1], lo[k][2], lo[k][3], hi[k][0], hi[k][1], hi[k][2], hi[k][3]}
        o[d0] = __builtin_amdgcn_mfma_f32_32x32x16_bf16(pa0, ATT_PK(0), o[d0], 0, 0, 0);
        o[d0] = __builtin_amdgcn_mfma_f32_32x32x16_bf16(pa1, ATT_PK(1), o[d0], 0, 0, 0);
        o[d0] = __builtin_amdgcn_mfma_f32_32x32x16_bf16(pa2, ATT_PK(2), o[d0], 0, 0, 0);
        o[d0] = __builtin_amdgcn_mfma_f32_32x32x16_bf16(pa3, ATT_PK(3), o[d0], 0, 0, 0);
#undef ATT_PK
    }
}
DEVI bf16x8 packp(const f32x16& p, int b) { u32x4 w; w.x = pk2(p[b], p[b + 1]); w.y = pk2(p[b + 2], p[b + 3]); w.z = pk2(p[b + 4], p[b + 5]); w.w = pk2(p[b + 6], p[b + 7]); return __builtin_bit_cast(bf16x8, w); }
DEVI void scale_rows(f32x16* o, LAS float* wsf, float fac, int r32, int hi) {
    if (hi == 0) wsf[r32] = fac;
    LDS_WAIT();
#pragma unroll
    for (int r = 0; r < 16; ++r) { const float f = wsf[crow(r, hi)]; o[0][r] *= f; o[1][r] *= f; }
    LDS_WAIT();
}
DEVI void fold_rows(const f32x16* o, LAS float* ofl, LAS float* wsf, float fac, int r32, int hi) {
    if (hi == 0) wsf[r32] = fac;
    LDS_WAIT();
#pragma unroll
    for (int r = 0; r < 16; ++r) { const int q = crow(r, hi); const float f = wsf[q]; ofl[q * 64 + r32] += o[0][r] * f; ofl[q * 64 + 32 + r32] += o[1][r] * f; }
    LDS_WAIT();
}
DEVI void tile_step(f32x16* o, float& m, float& l, const bf16x8* qr, lptr Kslot, int vb, LAS float* wsf, int r32, int hi, float cinit, bool domask, int kbase, int lo, int hi_) {
    f32x16 p0, p1;
    qkt(p0, p1, Kslot, qr, cinit, r32, hi);
    if (domask) {
#pragma unroll
        for (int r = 0; r < 16; ++r) { const int kp = kbase + crow(r, hi); if (kp < lo || kp > hi_) p0[r] = -INFINITY; if (kp + 32 < lo || kp + 32 > hi_) p1[r] = -INFINITY; } }
    const float rm = rowmax(p0, p1);
    if (__builtin_amdgcn_ballot_w64(rm > m + 8.0f) != 0ull) {
        const float mn = fmaxf(m, rm), f = __builtin_amdgcn_exp2f(m - mn); m = mn;
        l *= f;
        scale_rows(o, wsf, f, r32, hi);
    }
    float ps = 0.f;
#pragma unroll
    for (int r = 0; r < 16; ++r) { p0[r] = __builtin_amdgcn_exp2f(p0[r] - m); p1[r] = __builtin_amdgcn_exp2f(p1[r] - m); ps += p0[r] + p1[r]; }
    l += ps;
    pv(o, vb, packp(p0, 0), packp(p0, 8), packp(p1, 0), packp(p1, 8));
}

DEVI void attn_unit(int b, int g, int qb, const bf16_t* Q, const bf16_t* KV, const bf16_t* KC, const bf16_t* VC, const float* gates, bf16_t* O, LAS char* shm) {
    const int tid = threadIdx.x, lane = tid & 63, r32 = lane & 31, hi = lane >> 5; const int wid = __builtin_amdgcn_readfirstlane(tid >> 6);
    const int tl = r32 >> 2, head = r32 & 3, tq0 = qb * 64, tq = tq0 + 8 * wid + tl, row = b * SEQ + tq, bg = b * 4 + g;
    const unsigned lds0 = (unsigned)(uintptr_t)shm;
    LAS float* wsf = (LAS float*)(shm + WSF) + wid * 64;
    const bf16_t* Ks = KV + 2 * KVS + (size_t)bg * SEQ * 64; const bf16_t* Vs = KV + 3 * KVS + (size_t)bg * SEQ * 64;
    const bf16_t* Kw = KV + 4 * KVS + (size_t)bg * SEQ * 64; const bf16_t* Vw = KV + 5 * KVS + (size_t)bg * SEQ * 64;
    const bf16_t* Kc = KC + (size_t)bg * 128 * 64; const bf16_t* Vc = VC + (size_t)bg * 128 * 64;
    const int koff = lane * 64 + wid * 8, voff = (16 * (wid & 3) + (lane >> 2)) * 64 + (wid >> 2) * 32 + (lane & 3) * 8;
#define ATT_DMA(Kt, Vt, slot) do { glds16((Kt) + koff, (unsigned)__builtin_amdgcn_readfirstlane(lds0 + KS0 + (slot) * 8192 + wid * 1024)); \
                                   glds16((Vt) + voff, (unsigned)__builtin_amdgcn_readfirstlane(lds0 + VS0 + (slot) * 8192 + wid * 1024)); } while (0)
#define ATT_WAITBAR() asm volatile("s_waitcnt vmcnt(0) lgkmcnt(0)\n\ts_barrier" ::: "memory")
    const int vb0 = (int)(lds0 + VS0) + ((lane >> 4) & 1) * 32 + (lane & 3) * 8 + (4 * hi + ((lane & 15) >> 2)) * 64;
    const lptr kslot0 = (lptr)(shm + KS0);
    ATT_WAITBAR();
    const int nC = (qb >= 16) ? 2 : 1;
    const int wlo = qb >= 8 ? qb - 8 : 0, nW = qb - wlo + 1;
    bf16x8 qr[4];
    { const bf16_t* qp = Q + (size_t)row * DM + (4 * g + head) * 64 + 8 * hi;
#pragma unroll
      for (int d0 = 0; d0 < 4; ++d0) qr[d0] = *(const bf16x8*)(qp + 16 * d0); }
    const float* gp = gates + (size_t)row * 48 + (g * 4 + head) * 3; const float gate_c = (PROBE == 4) ? 0.f : gp[0], gate_s = (PROBE == 5) ? 0.f : gp[1], gate_w = (PROBE == 6) ? 0.f : gp[2];
    ATT_DMA(Kc, Vc, 0); if (nC == 2) ATT_DMA(Kc + 64 * 64, Vc + 64 * 64, 1);
    ATT_DMA(Kw + (size_t)wlo * 4096, Vw + (size_t)wlo * 4096, 2);
    f32x16 o[2];
    LAS float* ofl = (LAS float*)(shm + OFN) + wid * 2048;
#pragma unroll
    for (int r = 0; r < 16; ++r) { ofl[crow(r, hi) * 64 + r32] = 0.f; ofl[crow(r, hi) * 64 + 32 + r32] = 0.f; }
    unsigned selmask = (qb == 31) ? 0xffffffffu : ((2u << qb) - 1u);
    asm volatile("s_waitcnt vmcnt(2) lgkmcnt(0)\n\ts_barrier" ::: "memory");
    {
        const int nmax = (tq - 31) >> 4;
        f32x16 pa0, pa1, pb0, pb1;
        qkt(pa0, pa1, kslot0, qr, 0.f, r32, hi);
        if (nC == 2) qkt(pb0, pb1, kslot0 + 8192, qr, 0.f, r32, hi);
        else {
#pragma unroll
            for (int r = 0; r < 16; ++r) { pb0[r] = -INFINITY; pb1[r] = -INFINITY; } }
#pragma unroll
        for (int r = 0; r < 16; ++r) { const int n0 = crow(r, hi);
            if (n0 > nmax) pa0[r] = -INFINITY; if (n0 + 32 > nmax) pa1[r] = -INFINITY; if (n0 + 64 > nmax) pb0[r] = -INFINITY; if (n0 + 96 > nmax) pb1[r] = -INFINITY; }
        float m = fmaxf(rowmax(pa0, pa1), rowmax(pb0, pb1));
        if (m == -INFINITY) m = 0.f;
        float ps = 0.f;
#pragma unroll
        for (int r = 0; r < 16; ++r) { pa0[r] = __builtin_amdgcn_exp2f(pa0[r] - m); pa1[r] = __builtin_amdgcn_exp2f(pa1[r] - m); pb0[r] = __builtin_amdgcn_exp2f(pb0[r] - m); pb1[r] = __builtin_amdgcn_exp2f(pb1[r] - m);
            ps += (pa0[r] + pa1[r]) + (pb0[r] + pb1[r]); }
        ps += xlane32(ps);
        const float inv = ps > 0.f ? __builtin_amdgcn_rcpf(ps) : 0.f;
#pragma unroll
        for (int r = 0; r < 16; ++r) { o[0][r] = 0.f; o[1][r] = 0.f; }
        pv(o, vb0, packp(pa0, 0), packp(pa0, 8), packp(pa1, 0), packp(pa1, 8));
        if (nC == 2) pv(o, vb0 + 8192, packp(pb0, 0), packp(pb0, 8), packp(pb1, 0), packp(pb1, 8));
        fold_rows(o, ofl, wsf, gate_c * inv, r32, hi);
        if (qb >= 16) {
#define ATT_QSUM(x) do { float t_ = (x) * inv; t_ += __builtin_bit_cast(float, __builtin_amdgcn_update_dpp(0, __builtin_bit_cast(int, t_), 0xB1, 0xf, 0xf, false)); \
                         t_ += __builtin_bit_cast(float, __builtin_amdgcn_update_dpp(0, __builtin_bit_cast(int, t_), 0x4E, 0xf, 0xf, false)); (x) = t_; } while (0)
#pragma unroll
            for (int r = 0; r < 16; ++r) { ATT_QSUM(pa0[r]); ATT_QSUM(pa1[r]); ATT_QSUM(pb0[r]); ATT_QSUM(pb1[r]); }
#undef ATT_QSUM
            float sc[16], fo[16];
#define ATT_H4(h4, r) ((h4) == 0 ? pa0[r] : (h4) == 1 ? pa1[r] : (h4) == 2 ? pb0[r] : pb1[r])
#pragma unroll
            for (int h4 = 0; h4 < 4; ++h4)
#pragma unroll
                for (int gq = 0; gq < 4; ++gq) fo[h4 * 4 + gq] = xlane32(ATT_H4(h4, 4 * gq));
#pragma unroll
            for (int h4 = 0; h4 < 4; ++h4)
#pragma unroll
                for (int gq = 0; gq < 4; ++gq) {
                    const int s = h4 * 4 + gq;
                    const float nxt_lo = fo[s];
                    const float nxt_hi = (s < 15) ? fo[s + 1] : 0.f;
                    float v = ATT_H4(h4, 4 * gq) + 2.0f * (ATT_H4(h4, 4 * gq + 1) + ATT_H4(h4, 4 * gq + 2) + ATT_H4(h4, 4 * gq + 3)) + (hi ? nxt_hi : nxt_lo);
                    const int j = 8 * h4 + 2 * gq + hi;
                    if (j == 0 || j == qb || j == qb - 1) v = INFINITY; else if (j > qb) v = -INFINITY;
                    sc[s] = v; }
#undef ATT_H4
            float so[16];
#pragma unroll
            for (int s = 0; s < 16; ++s) so[s] = xlane32(sc[s]);
            unsigned own = 0u;
#pragma unroll
            for (int s = 0; s < 16; ++s) {
                int rk = 0;
#pragma unroll
                for (int s2 = 0; s2 < 16; ++s2) {
                    if (s2 < s) rk += (sc[s2] >= sc[s]) ? 1 : 0; else if (s2 > s) rk += (sc[s2] > sc[s]) ? 1 : 0;
                    if (s2 < s) rk += (so[s2] >= sc[s]) ? 1 : 0; else if (s2 > s) rk += (so[s2] > sc[s]) ? 1 : 0;
                    else rk += hi ? ((so[s2] >= sc[s]) ? 1 : 0) : ((so[s2] > sc[s]) ? 1 : 0); }
                if (rk < 16) own |= 1u << (2 * s);
            }
            own <<= hi;
            selmask = own | (unsigned)__shfl_xor((int)own, 32);
        }
    }
    unsigned uni = selmask, wuni = selmask;
    if (qb >= 16) {
#pragma unroll
        for (int off = 1; off < 64; off <<= 1) uni |= (unsigned)__shfl_xor((int)uni, off);
        wuni = (unsigned)__builtin_amdgcn_readfirstlane((int)uni);
        LAS unsigned* uw = (LAS unsigned*)(shm + UNI);
        if (lane == 0) uw[wid] = uni;
        ATT_WAITBAR();
        uni = 0u;
#pragma unroll
        for (int w = 0; w < 8; ++w) uni |= uw[w];
        uni = (unsigned)__builtin_amdgcn_readfirstlane((int)uni);
    } else { ATT_WAITBAR(); }
    const unsigned smask = uni & ((qb == 31) ? 0xffffffffu : ((2u << qb) - 1u));
    const int nS = __builtin_popcount(smask), nT = nW + nS;
    unsigned rem_issue = smask, rem_qk = smask;
#define ATT_ISSUE(tt) do { const int sl_ = ((tt) + 2) % 3; \
        if ((tt) < nW) { const int j_ = wlo + (tt); ATT_DMA(Kw + (size_t)j_ * 4096, Vw + (size_t)j_ * 4096, sl_); } \
        else { const int j_ = __builtin_ctz(rem_issue); rem_issue &= rem_issue - 1u; ATT_DMA(Ks + (size_t)j_ * 4096, Vs + (size_t)j_ * 4096, sl_); } } while (0)
    if (nT > 1) ATT_ISSUE(1);
    ATT_WAITBAR();
    if (nT > 2) ATT_ISSUE(2);
    float mref = 0.f, l = 0.f;
#pragma unroll
    for (int r = 0; r < 16; ++r) { o[0][r] = 0.f; o[1][r] = 0.f; }
    f32x16 pc0, pc1, negm;
#pragma unroll
    for (int r = 0; r < 16; ++r) negm[r] = 0.f;
    qk2(pc0, pc1, kslot0 + 2 * 8192, qr, negm, r32, hi);
    int jc = wlo; bool cS = false, cskip = false;
    for (int t = 0; t < nT; ++t) {
        const bool hasn = t + 1 < nT; int jn = 0; bool nSel = false, nskip = true;
        if (hasn) { if (t + 1 < nW) { jn = wlo + t + 1; nskip = false; } else { jn = __builtin_ctz(rem_qk); rem_qk &= rem_qk - 1u; nSel = true; nskip = ((wuni >> jn) & 1u) == 0u; } }
        if (t > 0) { ATT_WAITBAR(); if (t + 2 < nT) ATT_ISSUE(t + 2); }
        f32x16 pn0, pn1;
        if (!nskip) {
            const float nm = (nSel && ((selmask >> jn) & 1u) == 0u) ? -INFINITY : -mref;
#pragma unroll
            for (int r = 0; r < 16; ++r) negm[r] = nm;
            qk2(pn0, pn1, kslot0 + ((t + 3) % 3) * 8192, qr, negm, r32, hi);
        }
        if (!cskip) {
            const bool dm = cS ? (jc == qb) : ((jc == qb) || (jc + 8 == qb));
            if (dm) { const int lo = cS ? 0 : tq - 511, kbase = 64 * jc;
#pragma unroll
                for (int r = 0; r < 16; ++r) { const int kp = kbase + crow(r, hi); if (kp < lo || kp > tq) pc0[r] = -INFINITY; if (kp + 32 < lo || kp + 32 > tq) pc1[r] = -INFINITY; } }
            const float rm = rowmax3(pc0, pc1);
            if (__builtin_amdgcn_ballot_w64(rm > 8.0f) != 0ull) {
                const float dl = fmaxf(rm, 0.f), f = __builtin_amdgcn_exp2f(-dl); mref += dl; l *= f;
#pragma unroll
                for (int r = 0; r < 16; ++r) { pc0[r] -= dl; pc1[r] -= dl; }
                if (!nskip) {
#pragma unroll
                    for (int r = 0; r < 16; ++r) { pn0[r] -= dl; pn1[r] -= dl; } }
                scale_rows(o, wsf, f, r32, hi);
            }
            float ps = 0.f;
#pragma unroll
            for (int r = 0; r < 16; ++r) { pc0[r] = __builtin_amdgcn_exp2f(pc0[r]); pc1[r] = __builtin_amdgcn_exp2f(pc1[r]); ps = (ps + pc0[r]) + pc1[r]; }
            l += ps;
            pv(o, vb0 + ((t + 2) % 3) * 8192, packp(pc0, 0), packp(pc0, 8), packp(pc1, 0), packp(pc1, 8));
        }
        if (t + 1 == nW) {
            l += xlane32(l); fold_rows(o, ofl, wsf, gate_w * (l > 0.f ? __builtin_amdgcn_rcpf(l) : 0.f), r32, hi);
#pragma unroll
            for (int r = 0; r < 16; ++r) { o[0][r] = 0.f; o[1][r] = 0.f; }
            l = 0.f; }
        pc0 = pn0; pc1 = pn1; jc = jn; cS = nSel; cskip = nskip;
    }
#undef ATT_ISSUE
    l += xlane32(l); fold_rows(o, ofl, wsf, gate_s * (l > 0.f ? __builtin_amdgcn_rcpf(l) : 0.f), r32, hi);
    {
#pragma unroll
      for (int i = 0; i < 4; ++i) { const int q = i * 8 + (lane >> 3), chn = lane & 7; const f32x4 v0 = *(const LAS f32x4*)(ofl + q * 64 + chn * 8), v1 = *(const LAS f32x4*)(ofl + q * 64 + chn * 8 + 4);
          u32x4 v; v.x = pk2(v0[0], v0[1]); v.y = pk2(v0[2], v0[3]); v.z = pk2(v1[0], v1[1]); v.w = pk2(v1[2], v1[3]);
          *(u32x4*)(O + (size_t)(b * SEQ + tq0 + 8 * wid + (q >> 2)) * DM + (4 * g + (q & 3)) * 64 + chn * 8) = v; }
      LDS_WAIT(); }
#undef ATT_DMA
#undef ATT_WAITBAR
}
DEVI void attn_phase(const Frame& F, const Args& args) {
    const bf16_t* Q = (const bf16_t*)(F.ws + WS_Q); const bf16_t* KV = (const bf16_t*)(F.ws + WS_KV); const bf16_t* KC = (const bf16_t*)(F.ws + WS_KC); const bf16_t* VC = (const bf16_t*)(F.ws + WS_VC);
    const float* gates = (const float*)(F.ws + WS_GATES); bf16_t* O = (bf16_t*)(F.ws + WS_O);
#if PROBE == 1
    { u32x4* z = (u32x4*)O; for (size_t i = (size_t)F.vcu * 512 + F.tid; i < (size_t)NTOK * DM / 8; i += (size_t)F.G * 512) z[i] = (u32x4){0u, 0u, 0u, 0u}; return; }
#endif
    for (int i = 0;; ++i) {
        const int idx = (i / ATT_REP) * F.G + F.vcu; if (idx >= 2048) break;
        const int ii = idx >> 8, bgq = idx & 255, bg = bgq >> 2, qt = bgq & 3;

        const int qb = 8 * (ii >> 1) + ((ii & 1) ? 7 - qt : qt) + ((ii & 1) ? 0 : 0);
        attn_unit(bg >> 2, bg & 3, (ii & 1) ? (8 * (ii >> 1) + 7 - qt) : (8 * (ii >> 1) + qt), Q, KV, KC, VC, gates, O, (LAS char*)(F.lds + RING_OFF));
        (void)qb;
    }
    asm volatile("s_waitcnt vmcnt(0) lgkmcnt(0)\n\ts_barrier" ::: "memory");
}
}

#ifndef PH_MASK
#define PH_MASK 0xffffffffu
#endif
#ifndef REP_MASK
#define REP_MASK 0u
#endif
#define PH(k) (((PH_MASK) >> (k)) & 1u)
#define REPB(k) (((REP_MASK) >> (k)) & 1u)
#define GRID_BAR() xcd_barrier(bar)
#define REFRESH() do { int t_ = threadIdx.x; asm volatile("" : "+v"(t_)); F.tid = t_; F.lane = t_ & 63; F.wave = __builtin_amdgcn_readfirstlane(t_ >> 6); } while (0)
template <int K, int L>
DEVI void phase(Frame& F, const Args& args, int nblk) {
    unsigned char* ws = args.ws;
    LAS unsigned char* ring = F.lds + RING_OFF;
    bf16_t* const HA = (bf16_t*)(ws + WS_HA); bf16_t* const HB = (bf16_t*)(ws + WS_HB);
    bf16_t* const hin = (L == 0) ? HA : HB;
    bf16_t* const hmx = (L == 0) ? HB : HA;
    REFRESH();
    if constexpr (K == 0) p0_prologue(F, args);
    if constexpr (K == 2) { ProbPw1 P; P.A = (const char*)HA; P.Bt = (const char*)(ws + WS_WPW1); P.K = DM; P.ldb = 2048; P.G = F.G; P.c = F.vcu;
          P.rstd = (const float*)(ws + WS_RS0); P.bias = args.in[7]; P.U = (bf16_t*)(ws + WS_U);
          pg8::gemm_phase(ring, P); }
    if constexpr (K == 3) {
        if (F.vcu & 1) { prep_layer(F, args, 0); wg_sync(); conv_phase(F, args); }
        else { conv_phase(F, args); wg_sync(); prep_layer(F, args, 0); } }
    if constexpr (K == 4) { ProbRes P; P.A = (const char*)(ws + WS_V); P.Bt = (const char*)(ws + WS_WPW2); P.K = DM; P.ldb = 2048; P.G = F.G; P.c = F.vcu;
          P.RES = HA; P.OUT = HB; P.bias = args.in[13];
          pg8::gemm_phase(ring, P); }
    if constexpr (K == 5) { ProbWin P; P.A = (const char*)HB; P.Bt = (const char*)(ws + WS_WIN); P.K = DM; P.ldb = 2048; P.G = F.G; P.c = F.vcu;
          P.rstd = (const float*)(ws + WS_SSQ); P.rope = (const float*)(ws + WS_ROPE); P.qnorm = args.in[15]; P.knorm = args.in[16];
          P.Q = (bf16_t*)(ws + WS_Q); P.KV = (bf16_t*)(ws + WS_KV); P.gates = (float*)(ws + WS_GATES);
          { LAS float* lr = (LAS float*)(F.lds + SCR_OFF);
            for (int idx = F.tid; idx < 8 * 256; idx += 512) { const int Lq = (idx >> 8) * F.G + F.vcu;
                if (Lq < 128 * 11) { const f32x4* pp = (const f32x4*)(P.rstd + (size_t)((Lq / 11) * 256 + (idx & 255)) * 16); const f32x4 st = (pp[0] + pp[1]) + (pp[2] + pp[3]);
                    lr[idx] = 1.0f / sqrtf(((st[0] + st[1]) + (st[2] + st[3])) * (1.0f / DM) + EPS); } }
            wg_sync(); P.lrs = lr; }
          pg8::gemm_phase(ring, P); }
    if constexpr (K == 6) { ProbCmp P; P.A = (const char*)(ws + WS_KV); P.Bt = (const char*)(ws + WS_WC1); P.K = 512; P.ldb = 4096; P.G = F.G; P.c = F.vcu;
          P.CP = (float*)(ws + WS_CP);
          pg8::gemm_phase(ring, P); }
    if constexpr (K == 7) cmpb_phase(F, args);
    if constexpr (K == 8) {
        if (F.vcu & 1) { prep_layer(F, args, 1); wg_sync(); REFRESH(); }
        att::attn_phase(F, args);
        if (!(F.vcu & 1)) { REFRESH(); prep_layer(F, args, 1); } }
    if constexpr (K == 9) { ProbRes P; P.A = (const char*)(ws + WS_O); P.Bt = (const char*)(ws + WS_WOUT); P.K = DM; P.ldb = 2048; P.G = F.G; P.c = F.vcu;
          P.RES = HB; P.OUT = HA; P.bias = nullptr;
          pg8::gemm_phase(ring, P); }
    if constexpr (K == 11) router_phase(F, args, L, hmx);
    if constexpr (K == 12) fill_phase(F);
    if constexpr (K == 13) { ProbGateUp P; P.A = (const char*)hmx; P.Bt = (const char*)(ws + WS_WGU); P.K = DM; P.ldb = 2048; P.G = F.G; P.c = F.vcu;
          P.tab_row = (const LAS int*)(F.lds + TAB_OFF); P.tab_ev = P.tab_row + 320; P.nblk = nblk;
          P.slot_rs = (const float*)(ws + WS_SRS); P.HBUF = (bf16_t*)(ws + WS_HBUF);
          { LAS unsigned* go = (LAS unsigned*)(F.lds + SCR_OFF); const int* stok = (const int*)(ws + WS_STOK);
            for (int idx = F.tid; idx < 8 * 256; idx += 512) { const int Lq = (idx >> 8) * F.G + F.vcu; if (Lq < nblk * 4) go[idx] = (unsigned)stok[P.tab_row[Lq >> 2] + (idx & 255)] * 2048u; }
            wg_sync(); P.goff = go; }
          pg8::gemm_phase(ring, P);
          ProbPP Q2; Q2.A = (const char*)(ws + WS_PB); Q2.Bt = (const char*)(ws + WS_WPP) + (size_t)L * DM * PLE * 2; Q2.K = PLE; Q2.ldb = 512; Q2.G = F.G; Q2.c = F.vcu;
          Q2.O = (bf16_t*)(ws + WS_PP);
          { const int nun = nblk * 4, maxu = (nun + F.G - 1) / F.G; int tl = nun - (maxu - 1) * F.G; if (tl >= F.G || tl < 0) tl = 0; Q2.tail_lo = tl; }
          pg8::gemm_phase(ring, Q2); }
    if constexpr (K == 14) { ProbDown P; P.A = (const char*)(ws + WS_HBUF); P.Bt = (const char*)(ws + WS_WDN); P.K = DEXP; P.ldb = 1024; P.G = F.G; P.c = F.vcu;
          P.tab_row = (const LAS int*)(F.lds + TAB_OFF); P.tab_ev = P.tab_row + 320; P.nblk = nblk;
          P.slot_w = (const float*)(ws + WS_SW); P.YB = (bf16_t*)(ws + WS_YB);
          pg8::gemm_phase(ring, P); }
    if constexpr (K == 15) combine_phase(F, hmx, hin, (PROBE == 2 && L == 1) || (PROBE == 3 && L == 0));
    if constexpr (K == 16) { ProbPle P; P.A = (const char*)hin; P.Bt = (const char*)(ws + WS_WPG) + (size_t)L * DM * DM * 2; P.K = DM; P.ldb = 2048; P.G = F.G; P.c = F.vcu;
          P.H2 = hin; P.PPp = (const bf16_t*)(ws + WS_PP); P.rstd = (const float*)(ws + WS_RS2); P.OUTB = hmx; P.OUTF = args.out; P.ssq = (float*)(ws + WS_SSQ); P.last = L;
          pg8::gemm_phase(ring, P); }
}
#if defined(TPHASE)
#define PHASE(k) do { const bool tp_ = ((k) == TPHASE) && (L == TLAYER); const unsigned long long t0_ = tp_ ? __builtin_amdgcn_s_memrealtime() : 0ull; \
    if (PH(k)) phase<k, L>(F, args, nblk); \
    if (tp_) { asm volatile("s_waitcnt vmcnt(0) lgkmcnt(0)" ::: "memory"); const unsigned long long t1_ = __builtin_amdgcn_s_memrealtime(); const unsigned long long d_ = (t1_ - t0_) * TALPHA; \
        while (__builtin_amdgcn_s_memrealtime() - t1_ < d_) __builtin_amdgcn_s_sleep(8); } } while (0)
#else
#define PHASE(k) do { if (PH(k)) phase<k, L>(F, args, nblk); if (PH(k) && REPB(k)) phase<k, L>(F, args, nblk); } while (0)
#endif
template <int L>
DEVI void layer_program(Frame& F, const Args& args, const XcdBarrier& bar) {
    int nblk = 0;
    if (L == 0) {
        PHASE(2); GRID_BAR();
        PHASE(3); GRID_BAR();
        PHASE(4);
    } else {
        PHASE(5); GRID_BAR();
        PHASE(6); GRID_BAR();
        PHASE(7); GRID_BAR();
        PHASE(8); GRID_BAR();
        PHASE(9);
    }
    GRID_BAR();
    PHASE(11); GRID_BAR();
    PHASE(12); GRID_BAR();
    REFRESH(); nblk = build_moe_table(F);
    PHASE(13); GRID_BAR();
    PHASE(14); GRID_BAR();
    PHASE(15); GRID_BAR();
    PHASE(16);
    if (L == 0) GRID_BAR();
}
__global__ void __launch_bounds__(NWAVES * 64, 2) hybrid_fwd(Args args) {
    extern __shared__ __attribute__((aligned(16))) unsigned char lds[];
    Frame F;
    F.lds = (LAS unsigned char*)lds; F.ws = args.ws; F.ctl = (gu32*)(args.ws + WS_CTL);
    F.tid = threadIdx.x; F.lane = F.tid & 63; F.wave = __builtin_amdgcn_readfirstlane(F.tid >> 6);
    F.G = gridDim.x; { const int bx = blockIdx.x; F.vcu = (F.G % 8 == 0) ? (bx % 8) * (F.G / 8) + bx / 8 : bx; }
    for (int u = F.tid; u < (LDS_BYTES - LDSCTL_OFF) / 4; u += NWAVES * 64) ((LAS unsigned*)(F.lds + LDSCTL_OFF))[u] = 0u;
    __syncthreads();
    XcdBarrier bar = xcd_barrier_post((unsigned*)(F.ctl + CW_BAR), (volatile LAS unsigned*)(F.lds + MISC_OFF) + 8);
    { constexpr int L = 0; const int nblk = 0; PHASE(0); }
    GRID_BAR();
#ifdef EXTRA_BARS
    GRID_BAR(); GRID_BAR(); GRID_BAR(); GRID_BAR(); GRID_BAR(); GRID_BAR(); GRID_BAR(); GRID_BAR(); GRID_BAR(); GRID_BAR();
#endif
    layer_program<0>(F, args, bar);
    layer_program<1>(F, args, bar);
}
#undef GRID_BAR

extern "C" void kernel_launch(void* const* d_in, const int* in_sizes, int n_in, void* d_out, int out_size, void* d_ws, size_t ws_size, hipStream_t stream) {
    static int grid = 0;
    if (grid == 0) {
        if (n_in != 30 || out_size != NTOK * DM || ws_size < WS_END) { fprintf(stderr, "kernel_launch: unexpected shapes (n_in %d, out %d, ws %zu < %zu)\n", n_in, out_size, ws_size, (size_t)WS_END); grid = -1; return; }
        int dev = 0, cus = 0, per_cu = 0;
        if (hipGetDevice(&dev) != hipSuccess || hipDeviceGetAttribute(&cus, hipDeviceAttributeMultiprocessorCount, dev) != hipSuccess) { grid = -1; return; }
        if (hipFuncSetAttribute((const void*)hybrid_fwd, hipFuncAttributeMaxDynamicSharedMemorySize, LDS_BYTES) != hipSuccess) { fprintf(stderr, "kernel_launch: hipFuncSetAttribute failed\n"); grid = -1; return; }
        if (hipOccupancyMaxActiveBlocksPerMultiprocessor(&per_cu, (const void*)hybrid_fwd, NWAVES * 64, LDS_BYTES) != hipSuccess || per_cu < 1)
            fprintf(stderr, "kernel_launch: occupancy query reports %d workgroups per CU\n", per_cu);
        (void)hipGetLastError();
        grid = cus;
    }
    if (grid < 0) return;
    if (hipMemsetAsync((char*)d_ws + WS_CTL, 0, CTL_ZERO_BYTES, stream) != hipSuccess) return;
    Args a{};
    for (int i = 0; i < 30; ++i) a.in[i] = (const float*)d_in[i];
    a.out = (float*)d_out; a.ws = (unsigned char*)d_ws;
    for (int i = 0; i < 32; ++i) { const float p = powf(10000.0f, (float)i / 32.0f); a.inv_freq[i] = 1.0f / p; }
    hipLaunchKernelGGL(hybrid_fwd, dim3(grid), dim3(NWAVES * 64), LDS_BYTES, stream, a);
}
```

```cpp
#define PROBE 0
#define REP_MASK 0u
#include <hip/hip_runtime.h>
#include <hip/hip_bf16.h>
#include <cstdio>
#include <cstdint>
#include <cmath>

#ifndef PROBE
#define PROBE 0
#endif
#define DEVI __device__ __forceinline__
#define GAS __attribute__((address_space(1)))
#define LAS __attribute__((address_space(3)))
typedef unsigned short bf16_t;
typedef short bf16x8 __attribute__((ext_vector_type(8)));
typedef short s16x4 __attribute__((ext_vector_type(4)));
typedef float f32x2 __attribute__((ext_vector_type(2)));
typedef float f32x4 __attribute__((ext_vector_type(4)));
typedef float f32x16 __attribute__((ext_vector_type(16)));
typedef unsigned u32x2 __attribute__((ext_vector_type(2)));
typedef unsigned u32x4 __attribute__((ext_vector_type(4)));
typedef __bf16 bf16x2_t __attribute__((ext_vector_type(2)));
typedef GAS unsigned gu32;

#define LDS_WAIT() asm volatile("s_waitcnt lgkmcnt(0)" ::: "memory")
#define VM_WAIT() asm volatile("s_waitcnt vmcnt(0)" ::: "memory")
#define RLX_AGENT __ATOMIC_RELAXED, __HIP_MEMORY_SCOPE_AGENT

DEVI unsigned pk2(float lo, float hi) { f32x2 v = {lo, hi}; bf16x2_t b = __builtin_convertvector(v, bf16x2_t); return __builtin_bit_cast(unsigned, b); }
DEVI float bflo(unsigned u) { return __uint_as_float(u << 16); }
DEVI float bfhi(unsigned u) { return __uint_as_float(u & 0xffff0000u); }
DEVI f32x4 unpack4(u32x2 w) { return (f32x4){bflo(w.x), bfhi(w.x), bflo(w.y), bfhi(w.y)}; }
DEVI u32x2 pack4(f32x4 v) { u32x2 w; w.x = pk2(v[0], v[1]); w.y = pk2(v[2], v[3]); return w; }
DEVI float sigmoid_f(float x) { return __builtin_amdgcn_rcpf(1.0f + __expf(-x)); }
DEVI const char* sgpr_ptr(const char* p) { const unsigned long long u = (unsigned long long)p; const unsigned lo = (unsigned)__builtin_amdgcn_readfirstlane((int)(unsigned)u), hi = (unsigned)__builtin_amdgcn_readfirstlane((int)(unsigned)(u >> 32)); return (const char*)(((unsigned long long)hi << 32) | lo); }
DEVI float wave_sum(float v) {
#pragma unroll
    for (int o = 1; o < 64; o <<= 1) v += __shfl_xor(v, o);
    return v;
}

namespace pg8 {
constexpr int BM = 256, BK = 64, HALF = 128, HTB = HALF * BK * 2  , STAGE_BYTES = 8 * HTB;
DEVI int lds_byte(int r, int c) { const int st = (r >> 4) * 2 + (c >> 5), rr = r & 15, cc = c & 31, ob = rr * 64 + cc * 2; return st * 1024 + (ob ^ (((ob >> 9) & 1) << 5)); }
DEVI void stage_rc(int b, int& R, int& C) { const int st = b / 1024, sb = b % 1024, swz = sb ^ (((sb >> 9) & 1) << 5); R = (st >> 1) * 16 + swz / 64; C = (st & 1) * 32 + (swz % 64) / 2; }
struct Unit { int pm, pn, e, v; };

template <class P>
DEVI void gemm_phase(LAS unsigned char* lds, const P& S) {
    int tid = threadIdx.x; asm volatile("" : "+v"(tid));
    const int wid = __builtin_amdgcn_readfirstlane(tid >> 6), lane = tid & 63, wr = wid >> 2, wc = wid & 3, fr = lane & 15, fq = lane >> 4;
    const int nt = S.K / BK;
    int Rp[2], Cp[2]; unsigned voffB[2];
#pragma unroll
    for (int i = 0; i < 2; ++i) { stage_rc(tid * 16 + i * 8192, Rp[i], Cp[i]); voffB[i] = (unsigned)Rp[i] * S.ldb + (unsigned)Cp[i] * 2u; }
    const size_t hstepB = (size_t)HALF * S.ldb;
    const unsigned ldsw = (unsigned)wid * 1024u;
    const int aoff = lds_byte(wr * 64 + fr, fq * 8), boff = lds_byte(wc * 32 + fr, fq * 8);
    const char* const Abase = S.A;
#define PG8_SA(b, h) (((b) * 2 + (h)) * HTB)
#define PG8_SB(b, h) ((4 + (b) * 2 + (h)) * HTB)
#define PG8_STAGE_A(bufoff, ao, sp) do { _Pragma("unroll") for (int _i = 0; _i < 2; ++_i) \
        __builtin_amdgcn_global_load_lds((const unsigned*)((sp) + (ao)[_i]), (LAS unsigned*)(lds + (bufoff) + ldsw + _i * 8192), 16, 0, 0); } while (0)
#define PG8_PIN(p) do { (p) = sgpr_ptr(p); asm volatile("" : "+s"(p)); } while (0)
#define PG8_STAGE_B(bufoff, bp) do { _Pragma("unroll") for (int _i = 0; _i < 2; ++_i) \
        __builtin_amdgcn_global_load_lds((const unsigned*)((bp) + voffB[_i]), (LAS unsigned*)(lds + (bufoff) + ldsw + _i * 8192), 16, 0, 0); } while (0)
#define PG8_LDA(dst, b, h) do { _Pragma("unroll") for (int m = 0; m < 4; ++m) _Pragma("unroll") for (int k = 0; k < 2; ++k) dst[m][k] = *(const LAS bf16x8*)(lds + PG8_SA(b, h) + aoff + m * 2048 + k * 1024); } while (0)
#define PG8_LDB(dst, b, h) do { _Pragma("unroll") for (int n = 0; n < 2; ++n) _Pragma("unroll") for (int k = 0; k < 2; ++k) dst[n][k] = *(const LAS bf16x8*)(lds + PG8_SB(b, h) + boff + n * 2048 + k * 1024); } while (0)
#define PG8_MMA(ai, bj, At, Bt) do { __builtin_amdgcn_s_setprio(1); _Pragma("unroll") for (int m = 0; m < 4; ++m) _Pragma("unroll") for (int n = 0; n < 2; ++n) _Pragma("unroll") for (int k = 0; k < 2; ++k) \
        acc[ai][bj][m][n] = __builtin_amdgcn_mfma_f32_16x16x32_bf16(Bt[n][k], At[m][k], acc[ai][bj][m][n], 0, 0, 0); __builtin_amdgcn_s_setprio(0); } while (0)
#define PG8_WAIT_V(n) asm volatile("s_waitcnt vmcnt(" #n ")" ::: "memory")
#define PG8_WAIT_L(n) asm volatile("s_waitcnt lgkmcnt(" #n ")" ::: "memory")
#define PG8_BAR __builtin_amdgcn_s_barrier()
#define PG8_SCHED __builtin_amdgcn_sched_barrier(0)
    Unit cur, nxt; int ui = 0;
    if (!S.next(0, cur)) return;
    f32x4 acc[2][2][4][2];
#pragma unroll
    for (int a = 0; a < 2; ++a)
#pragma unroll
        for (int b = 0; b < 2; ++b)
#pragma unroll
            for (int m = 0; m < 4; ++m)
#pragma unroll
                for (int n = 0; n < 2; ++n) acc[a][b][m][n] = (f32x4){0.f, 0.f, 0.f, 0.f};
    bf16x8 At[4][2], B0[2][2], B1[2][2];
    unsigned ac0[2], ac1[2], an0[2], an1[2];
#pragma unroll
    for (int i = 0; i < 2; ++i) { ac0[i] = S.a_off(cur, Rp[i]) + (unsigned)Cp[i] * 2u; ac1[i] = S.a_off(cur, Rp[i] + HALF) + (unsigned)Cp[i] * 2u; }
    const char* cB = S.Bt + S.b_off(cur);
    { const char* q0 = cB; const char* q1 = cB + hstepB; const char* q2 = Abase; const char* q3 = cB + 128; const char* q4 = Abase + 128; const char* q5 = cB + hstepB + 128;
      PG8_PIN(q0); PG8_PIN(q1); PG8_PIN(q2); PG8_PIN(q3); PG8_PIN(q4); PG8_PIN(q5);
    PG8_STAGE_B(PG8_SB(0, 0), q0); PG8_STAGE_B(PG8_SB(0, 1), q1); PG8_STAGE_A(PG8_SA(0, 0), ac0, q2); PG8_STAGE_A(PG8_SA(0, 1), ac1, q2);
    if (wr == 1) PG8_BAR;
    PG8_WAIT_V(2); PG8_BAR;
    PG8_STAGE_B(PG8_SB(1, 0), q3); PG8_STAGE_A(PG8_SA(1, 0), ac0, q4); PG8_STAGE_B(PG8_SB(1, 1), q5);
    PG8_WAIT_V(6); PG8_BAR; }
    for (;;) {
        const bool has_next = S.next(ui + 1, nxt);
        const char* nB = cB;
        if (has_next) {
#pragma unroll
            for (int i = 0; i < 2; ++i) { an0[i] = S.a_off(nxt, Rp[i]) + (unsigned)Cp[i] * 2u; an1[i] = S.a_off(nxt, Rp[i] + HALF) + (unsigned)Cp[i] * 2u; }
            nB = S.Bt + S.b_off(nxt);
        } else {
#pragma unroll
            for (int i = 0; i < 2; ++i) { an0[i] = ac0[i]; an1[i] = ac1[i]; }
        }
        for (int t = 0; t < nt; t += 2) {
            const bool last = (t == nt - 2);
            unsigned a20[2], a21[2];
#pragma unroll
            for (int i = 0; i < 2; ++i) { a20[i] = last ? an0[i] : ac0[i]; a21[i] = last ? an1[i] : ac1[i]; }
            const int k1 = (t + 1) * 128, k2 = last ? 0 : (t + 2) * 128;
            const char* b2 = last ? nB : cB + (size_t)(t + 2) * 128; const char* b3 = b2 + 128; const char* b2h = b2 + hstepB; const char* b3h = b3 + hstepB;
            const char* pa1 = Abase + k1; const char* pa2 = Abase + k2; const char* pa3 = pa2 + 128;
            PG8_PIN(b2); PG8_PIN(b3); PG8_PIN(b2h); PG8_PIN(b3h); PG8_PIN(pa1); PG8_PIN(pa2); PG8_PIN(pa3);
            PG8_LDB(B0, 0, 0); PG8_LDB(B1, 0, 1); PG8_SCHED; PG8_LDA(At, 0, 0); PG8_STAGE_A(PG8_SA(1, 1), ac1, pa1);
            PG8_WAIT_V(8); PG8_WAIT_L(0); PG8_BAR; PG8_MMA(0, 0, At, B0); PG8_MMA(0, 1, At, B1); PG8_BAR; PG8_SCHED;
            PG8_LDA(At, 0, 1); PG8_STAGE_B(PG8_SB(0, 0), b2); PG8_STAGE_B(PG8_SB(0, 1), b2h); PG8_STAGE_A(PG8_SA(0, 0), a20, pa2);
            PG8_WAIT_V(8); PG8_WAIT_L(0); PG8_BAR; PG8_MMA(1, 0, At, B0); PG8_MMA(1, 1, At, B1); PG8_BAR; PG8_SCHED;
            PG8_LDB(B0, 1, 0); PG8_LDB(B1, 1, 1); PG8_SCHED; PG8_LDA(At, 1, 0); PG8_STAGE_A(PG8_SA(0, 1), a21, pa2);
            PG8_WAIT_V(8); PG8_WAIT_L(0); PG8_BAR; PG8_MMA(0, 0, At, B0); PG8_MMA(0, 1, At, B1); PG8_BAR; PG8_SCHED;
            PG8_LDA(At, 1, 1); PG8_STAGE_B(PG8_SB(1, 0), b3); PG8_STAGE_B(PG8_SB(1, 1), b3h); PG8_STAGE_A(PG8_SA(1, 0), a20, pa3);
            PG8_WAIT_V(8); PG8_WAIT_L(0); PG8_BAR; PG8_MMA(1, 0, At, B0); PG8_MMA(1, 1, At, B1); PG8_BAR; PG8_SCHED;
        }
        if (wr == 0) PG8_BAR;
        S.epi(acc, cur, wr, wc, fr, fq);
        if (!has_next) break;
#pragma unroll
        for (int a = 0; a < 2; ++a)
#pragma unroll
            for (int b = 0; b < 2; ++b)
#pragma unroll
                for (int m = 0; m < 4; ++m)
#pragma unroll
                    for (int n = 0; n < 2; ++n) acc[a][b][m][n] = (f32x4){0.f, 0.f, 0.f, 0.f};
        cur = nxt; cB = nB; ++ui;
#pragma unroll
        for (int i = 0; i < 2; ++i) { ac0[i] = an0[i]; ac1[i] = an1[i]; }
        if (wr == 1) PG8_BAR;
    }
    PG8_WAIT_V(0);
    PG8_BAR;
#undef PG8_SA
#undef PG8_SB
#undef PG8_STAGE_A
#undef PG8_STAGE_B
#undef PG8_PIN
#undef PG8_LDA
#undef PG8_LDB
#undef PG8_MMA
#undef PG8_WAIT_V
#undef PG8_WAIT_L
#undef PG8_BAR
#undef PG8_SCHED
}
}
#define XB_TMO      128
#define XB_XCNT(j)  (256  + 64 * (j))
#define XB_XSUB(j)  (1280 + 64 * (j))
#define XB_XGEN(j)  (2304 + 64 * (j))
#define XB_TOP      3328
#define XB_TOPGEN   3392
#define XCD_BAR_WORDS 3456
#define XB_SPIN_CAP (1u << 18)

__device__ __forceinline__ unsigned xb_ld(unsigned* p)              { return __hip_atomic_load(p, __ATOMIC_RELAXED, __HIP_MEMORY_SCOPE_AGENT); }
__device__ __forceinline__ unsigned xb_add(unsigned* p, unsigned v) { return __hip_atomic_fetch_add(p, v, __ATOMIC_RELAXED, __HIP_MEMORY_SCOPE_AGENT); }
__device__ __forceinline__ unsigned xb_xcc_id() { return (unsigned)__builtin_amdgcn_s_getreg((3 << 11) | 20) & 0xFu; }
#define XB_SPIN(cond, bar) do { unsigned _sp = 0; while (cond) { __builtin_amdgcn_s_sleep(1); \
    if ((++_sp & 255u) == 0u) { if (xb_ld(&(bar)[XB_TMO])) break; if (_sp > XB_SPIN_CAP) { atomicAdd(&(bar)[XB_TMO], 1u); break; } } } } while (0)

struct XcdBarrier {
    unsigned* bar; unsigned x;
    volatile LAS unsigned* st;
};

__device__ __forceinline__ XcdBarrier xcd_barrier_post(unsigned* bar, volatile LAS unsigned* st) {
    XcdBarrier b; b.bar = bar; b.x = xb_xcc_id(); b.st = st;
    if (threadIdx.x == 0) (void)xb_add(&bar[XB_XCNT(b.x)], 1u);
    return b;
}
__device__ __forceinline__ void xcd_barrier_complete(unsigned* bar, unsigned x, unsigned& nloc, unsigned& nx) {
    const unsigned G = gridDim.x * gridDim.y * gridDim.z;
    unsigned sum, cnt, mine, sp = 0u;
    for (;;) {
        sum = 0u; cnt = 0u; mine = 0u;
#pragma unroll
        for (unsigned j = 0; j < 16; ++j) { const unsigned c = xb_ld(&bar[XB_XCNT(j)]); sum += c; cnt += (c > 0u) ? 1u : 0u; mine = (j == x) ? c : mine; }
        if (sum == G) break;
        __builtin_amdgcn_s_sleep(1);
        if ((++sp & 255u) == 0u) { if (xb_ld(&bar[XB_TMO])) break; if (sp > XB_SPIN_CAP) { atomicAdd(&bar[XB_TMO], 1u); break; } }
    }
    nloc = mine > 0u ? mine : 1u; nx = cnt > 0u ? cnt : 1u;
}

__device__ __forceinline__ void xcd_barrier(const XcdBarrier& b) {
    asm volatile("s_waitcnt vmcnt(0)" ::: "memory");
    __syncthreads();
    if (threadIdx.x == 0) {
        unsigned* bar = b.bar;
        __builtin_amdgcn_s_waitcnt(0);
        unsigned nloc = b.st[0], nx = b.st[1];
        if (nloc == 0u) { xcd_barrier_complete(bar, b.x, nloc, nx); b.st[0] = nloc; b.st[1] = nx; }
        const unsigned old = xb_add(&bar[XB_XSUB(b.x)], 1u);
        const unsigned gen = old / nloc;
        if (old + 1u == (gen + 1u) * nloc) {
            __builtin_amdgcn_fence(__ATOMIC_RELEASE, "agent");
            asm volatile("s_waitcnt vmcnt(0)" ::: "memory");
            const unsigned og = xb_add(&bar[XB_TOP], 1u);
            const unsigned tg = og / nx;
            if (og + 1u == (tg + 1u) * nx) xb_add(&bar[XB_TOPGEN], 1u);
            else XB_SPIN(xb_ld(&bar[XB_TOPGEN]) == tg, bar);
            __builtin_amdgcn_fence(__ATOMIC_ACQUIRE, "agent");
            xb_add(&bar[XB_XGEN(b.x)], 1u);
            asm volatile("s_waitcnt vmcnt(0)" ::: "memory");
        } else {
            XB_SPIN(xb_ld(&bar[XB_XGEN(b.x)]) == gen, bar);
            __builtin_amdgcn_fence(__ATOMIC_ACQUIRE, "agent");
            asm volatile("s_waitcnt vmcnt(0)" ::: "memory");
        }
    }
    __syncthreads();
}

constexpr int NTOK = 32768, DM = 1024, SEQ = 2048, NBATCH = 16, NEXP = 32, DEXP = 512, PLE = 256;
constexpr int NWIN = 2608, NWIN_PAD = 2816;
constexpr float EPS = 1e-6f;
constexpr float C2 = 0.125f * 1.4426950408889634f;
constexpr int NWAVES = 8;

constexpr size_t MiB = 1u << 20;
constexpr size_t WS_CTL = 0, CTL_ZERO_BYTES = 1 * MiB;
constexpr int CW_TMO = 0, CW_BAR = 4096;
constexpr size_t WS_RS0 = 1 * MiB;
constexpr size_t WS_RS1 = WS_RS0 + 131072;
constexpr size_t WS_RS2 = WS_RS1 + 131072;
constexpr size_t WS_ASGE = WS_RS2 + 131072;
constexpr size_t WS_ASGR = WS_ASGE + 262144;
constexpr size_t WS_ASGW = WS_ASGR + 262144;
constexpr size_t WS_TSLOT = WS_ASGW + 262144;
constexpr int NSLOT = 2 * NTOK, NSLOT_PAD = NSLOT + 256;
constexpr size_t WS_STOK = WS_TSLOT + 262144;
constexpr size_t WS_SW = WS_STOK + 266240;
constexpr size_t WS_SRS = WS_SW + 266240;
constexpr size_t WS_CNT = WS_SRS + 266240;
constexpr size_t WS_MTOT = WS_CNT + 32768;
constexpr size_t WS_CBP = WS_MTOT + 1024;
constexpr size_t WS_RW = WS_CBP + 65536;
constexpr size_t WS_CB = WS_RW + 393216;
constexpr size_t WS_W2T = WS_CB + 2048;
constexpr size_t WS_SSQ = 4 * MiB;
constexpr size_t WS_ROPE = 6 * MiB;
static_assert(WS_W2T + 2 * 64 * 256 * 2 <= WS_SSQ, "tables");
constexpr size_t WS_WPW1 = 16 * MiB, WS_WPW2 = 20 * MiB, WS_WIN = 22 * MiB, WS_WOUT = 28 * MiB, WS_WC1 = 30 * MiB, WS_WPP = 32 * MiB, WS_WPG = 33 * MiB;
constexpr size_t WS_WGU = 40 * MiB, WS_WDN = 104 * MiB;
constexpr size_t WS_HA = 136 * MiB, WS_HB = 200 * MiB, WS_PP = 264 * MiB, WS_PB = 328 * MiB;
constexpr size_t WS_YB = 344 * MiB, WS_HBUF = 473 * MiB;
constexpr size_t WS_U = 344 * MiB, WS_V = 408 * MiB;
constexpr size_t WS_Q = WS_PP, WS_KV = 344 * MiB, WS_O = 440 * MiB, WS_CP = WS_HA  , WS_GATES = 504 * MiB, WS_KC = 510 * MiB, WS_VC = 511 * MiB;
constexpr size_t WS_END = 538 * MiB;
constexpr size_t KVS = (size_t)NTOK * 256;

constexpr int RING_OFF = 0, RING_BYTES = 131072;
constexpr int LDSCTL_OFF = RING_BYTES;
constexpr int MISC_OFF = LDSCTL_OFF + 320;
constexpr int TAB_OFF = LDSCTL_OFF + 1024;
constexpr int SCR_OFF = LDSCTL_OFF + 4096;
constexpr int LDS_BYTES = 147456;

struct Args { const float* in[30]; float* out; unsigned char* ws; float inv_freq[32]; };
struct Frame {
    LAS unsigned char* lds;
    gu32* ctl;
    unsigned char* ws;
    int tid, lane, wave, vcu, G;
};
DEVI void wg_sync() { __syncthreads(); }

DEVI int rowmap(int mode, int half, int n) {
    if (mode == 0) return n;
    if (mode == 1) return 256 * (n >> 7) + 128 * half + (n & 127);
    if (n < 2560) { const int hd = n >> 6, d = n & 63; return 256 * (hd >> 2) + 128 * (d >> 5) + 32 * (hd & 3) + (d & 31); }
    return n;
}
DEVI void p0_item(const float* W, int ld, int ncols, int K, const float* gain, bf16_t* dst, int mode, int half, LAS unsigned char* scr, int item, int lane) {
    const int nblk = (ncols + 63) >> 6, kb = item / nblk, nb = item % nblk, k0 = 64 * kb, n0 = 64 * nb;
    const int lr = lane >> 4, lc = 4 * (lane & 15);
    f32x4 v[16];
#pragma unroll
    for (int i = 0; i < 16; ++i) v[i] = (n0 + lc < ncols) ? *(const f32x4*)(W + (size_t)(k0 + 4 * i + lr) * ld + n0 + lc) : (f32x4){0.f, 0.f, 0.f, 0.f};
#pragma unroll
    for (int i = 0; i < 16; ++i) { const float g = gain ? gain[k0 + 4 * i + lr] : 1.0f; const f32x4 x = v[i] * g; *(LAS u32x2*)(scr + (4 * i + lr) * 136 + lc * 2) = pack4(x); }
    LDS_WAIT();
    const int c = lane & 7;
#pragma unroll
    for (int j = 0; j < 8; ++j) { const int n = (lane >> 3) + 8 * j; const LAS unsigned short* t = (const LAS unsigned short*)(scr + (8 * c) * 136 + n * 2);
        u32x4 o; o.x = (unsigned)t[0 * 68] | ((unsigned)t[1 * 68] << 16); o.y = (unsigned)t[2 * 68] | ((unsigned)t[3 * 68] << 16); o.z = (unsigned)t[4 * 68] | ((unsigned)t[5 * 68] << 16); o.w = (unsigned)t[6 * 68] | ((unsigned)t[7 * 68] << 16);
        if (n0 + n < ncols) *(u32x4*)(dst + (size_t)rowmap(mode, half, n0 + n) * K + k0 + 8 * c) = o; }
    LDS_WAIT();
}
DEVI void p0_load(f32x4 (&v)[16], const float* W, int ld, int ncols, int item, int lane) {
    const int nblk = (ncols + 63) >> 6, kb = item / nblk, nb = item % nblk, k0 = 64 * kb, n0 = 64 * nb, lr = lane >> 4, lc = 4 * (lane & 15);
#pragma unroll
    for (int i = 0; i < 16; ++i) v[i] = (n0 + lc < ncols) ? *(const f32x4*)(W + (size_t)(k0 + 4 * i + lr) * ld + n0 + lc) : (f32x4){0.f, 0.f, 0.f, 0.f};
}
DEVI void p0_finish(const f32x4 (&v)[16], int ncols, int K, const float* gain, bf16_t* dst, int mode, int half, LAS unsigned char* scr, int item, int lane) {
    const int nblk = (ncols + 63) >> 6, kb = item / nblk, nb = item % nblk, k0 = 64 * kb, n0 = 64 * nb, lr = lane >> 4, lc = 4 * (lane & 15);
#pragma unroll
    for (int i = 0; i < 16; ++i) { const float g = gain ? gain[k0 + 4 * i + lr] : 1.0f; const f32x4 x = v[i] * g; *(LAS u32x2*)(scr + (4 * i + lr) * 136 + lc * 2) = pack4(x); }
    LDS_WAIT();
    const int c = lane & 7;
#pragma unroll
    for (int j = 0; j < 8; ++j) { const int n = (lane >> 3) + 8 * j; const LAS unsigned short* t = (const LAS unsigned short*)(scr + (8 * c) * 136 + n * 2);
        u32x4 o; o.x = (unsigned)t[0 * 68] | ((unsigned)t[1 * 68] << 16); o.y = (unsigned)t[2 * 68] | ((unsigned)t[3 * 68] << 16); o.z = (unsigned)t[4 * 68] | ((unsigned)t[5 * 68] << 16); o.w = (unsigned)t[6 * 68] | ((unsigned)t[7 * 68] << 16);
        if (n0 + n < ncols) *(u32x4*)(dst + (size_t)rowmap(mode, half, n0 + n) * K + k0 + 8 * c) = o; }
    LDS_WAIT();
}
DEVI void prep_layer(const Frame& F, const Args& a, int L) {
    LAS unsigned char* scr = F.lds + RING_OFF + F.wave * 16384;
    const int gw = F.vcu * NWAVES + F.wave, NGW = F.G * NWAVES;
    const float* gf = a.in[4] + (size_t)L * DM;
    bf16_t* wgu = (bf16_t*)(F.ws + WS_WGU); bf16_t* wdn = (bf16_t*)(F.ws + WS_WDN);
#define PREP_SRC(it_) ((((it_) % 384) >> 7) == 0 ? a.in[25] + ((size_t)L * NEXP + (it_) / 384) * DM * DEXP : (((it_) % 384) >> 7) == 1 ? a.in[26] + ((size_t)L * NEXP + (it_) / 384) * DM * DEXP : a.in[27] + ((size_t)L * NEXP + (it_) / 384) * DEXP * DM)
    f32x4 vc[16], vn[16];
    int it = gw;
    if (it < NEXP * 384) { const int wh = (it % 384) >> 7; p0_load(vc, PREP_SRC(it), wh == 2 ? DM : DEXP, wh == 2 ? DM : DEXP, it & 127, F.lane); }
    for (; it < NEXP * 384; it += NGW) {
        const int itn = it + NGW;
        if (itn < NEXP * 384) { const int wh = (itn % 384) >> 7; p0_load(vn, PREP_SRC(itn), wh == 2 ? DM : DEXP, wh == 2 ? DM : DEXP, itn & 127, F.lane); }
        { const int e = it / 384, wh = (it % 384) >> 7, item = it & 127;
          if (wh == 2) p0_finish(vc, DM, DEXP, nullptr, wdn + (size_t)e * 1024 * 512, 0, 0, scr, item, F.lane);
          else p0_finish(vc, DEXP, DM, gf, wgu + (size_t)e * 1024 * 1024, 1, wh, scr, item, F.lane); }
#pragma unroll
        for (int i = 0; i < 16; ++i) vc[i] = vn[i];
    }
#undef PREP_SRC
    const float* p = a.in[1] + (size_t)L * NTOK * PLE; bf16_t* pb = (bf16_t*)(F.ws + WS_PB);
    const size_t n8 = (size_t)NTOK * PLE / 8;
#pragma unroll 4
    for (size_t i = (size_t)F.vcu * 512 + F.tid; i < n8; i += (size_t)F.G * 512) {
        const f32x4 v0 = *(const f32x4*)(p + i * 8), v1 = *(const f32x4*)(p + i * 8 + 4);
        u32x4 o; o.x = pk2(v0[0], v0[1]); o.y = pk2(v0[2], v0[3]); o.z = pk2(v1[0], v1[1]); o.w = pk2(v1[2], v1[3]);
        *(u32x4*)(pb + i * 8) = o; }
}
DEVI void p0_prologue(const Frame& F, const Args& a) {
    LAS unsigned char* scr = F.lds + RING_OFF + F.wave * 16384;
    const int gw = F.vcu * NWAVES + F.wave, NGW = F.G * NWAVES;
    unsigned char* ws = F.ws;
    constexpr int I_PW1 = 16 * 16 * 2, I_PW2 = 16 * 16, I_WIN = 16 * 41, I_WOUT = 16 * 16, I_C1 = 32 * 4 * 2, I_PP = 4 * 16 * 2, I_PG = 16 * 16 * 2;
    constexpr int NIT = I_PW1 + I_PW2 + I_WIN + I_WOUT + I_C1 + I_PP + I_PG;
    for (int it = gw; it < NIT; it += NGW) {
        int r = it;
        if (r < I_PW1) { const int half = r / 256; p0_item(a.in[6] + half * 1024, 2048, 1024, DM, a.in[3], (bf16_t*)(ws + WS_WPW1), 1, half, scr, r % 256, F.lane); continue; } r -= I_PW1;
        if (r < I_PW2) { p0_item(a.in[12], DM, DM, DM, nullptr, (bf16_t*)(ws + WS_WPW2), 0, 0, scr, r, F.lane); continue; } r -= I_PW2;
        if (r < I_WIN) { p0_item(a.in[14], NWIN, NWIN, DM, a.in[3] + DM, (bf16_t*)(ws + WS_WIN), 2, 0, scr, r, F.lane); continue; } r -= I_WIN;
        if (r < I_WOUT) { p0_item(a.in[20], DM, DM, DM, nullptr, (bf16_t*)(ws + WS_WOUT), 0, 0, scr, r, F.lane); continue; } r -= I_WOUT;
        if (r < I_C1) { const int j = r / 128; p0_item(a.in[18] + (size_t)j * 2048 * 256, 256, 256, 2048, nullptr, (bf16_t*)(ws + WS_WC1) + (size_t)j * 256 * 2048, 0, 0, scr, r % 128, F.lane); continue; } r -= I_C1;
        if (r < I_PP) { const int L = r / 64; p0_item(a.in[28] + (size_t)L * PLE * DM, DM, DM, PLE, nullptr, (bf16_t*)(ws + WS_WPP) + (size_t)L * DM * PLE, 0, 0, scr, r % 64, F.lane); continue; } r -= I_PP;
        { const int L = r / 256; p0_item(a.in[29] + (size_t)L * DM * DM, DM, DM, DM, a.in[5] + (size_t)L * DM, (bf16_t*)(ws + WS_WPG) + (size_t)L * DM * DM, 0, 0, scr, r % 256, F.lane); }
    }
    { u32x4* z = (u32x4*)((bf16_t*)(ws + WS_WIN) + (size_t)NWIN * DM); const int n16 = (NWIN_PAD - NWIN) * DM / 8;
      for (int i = F.vcu * 512 + F.tid; i < n16; i += F.G * 512) z[i] = (u32x4){0u, 0u, 0u, 0u}; }
    { bf16_t* rw = (bf16_t*)(ws + WS_RW);
      for (int i = F.vcu * 512 + F.tid; i < 2 * 48 * 1024; i += F.G * 512) {
          const int L = i / (48 * 1024), j = (i / 1024) % 48, k = i & 1023;
          float w = 0.f;
          if (j < 4) w = a.in[21][((size_t)L * DM + k) * 4 + j]; else if (j < 36) w = a.in[23][((size_t)L * DM + k) * 32 + (j - 4)];
          w *= a.in[4][(size_t)L * DM + k];
          const unsigned hi = pk2(w, 0.f) & 0xffffu; const float lo = w - bflo(hi);
          rw[((size_t)(L * 2 + 0) * 48 + j) * 1024 + k] = (bf16_t)hi; rw[((size_t)(L * 2 + 1) * 48 + j) * 1024 + k] = (bf16_t)(pk2(lo, 0.f) & 0xffffu); } }
    { bf16_t* w2t = (bf16_t*)(ws + WS_W2T);
      for (int i = F.vcu * 512 + F.tid; i < 2 * 64 * 256; i += F.G * 512) { const int j = i >> 14, n = (i >> 8) & 63, k = i & 255; w2t[i] = (bf16_t)(pk2(a.in[19][(size_t)(j * 256 + k) * 64 + n], 0.f) & 0xffffu); } }
    for (int it = gw; it < 2 * 4 * 32; it += NGW) {
        const int j = it >> 7, cg = (it >> 5) & 3, kr = it & 31;
        const float* pe = a.in[17] + (size_t)j * 2048 + kr * 64; const float* w1 = a.in[18] + ((size_t)j * 2048 + kr * 64) * 256 + cg * 64 + F.lane;
        float s = 0.f;
#pragma unroll 16
        for (int k = 0; k < 64; ++k) s += pe[k] * w1[(size_t)k * 256];
        ((float*)(ws + WS_CBP))[(j * 32 + kr) * 256 + cg * 64 + F.lane] = s; }
    { float* rope = (float*)(ws + WS_ROPE); const int* pos = (const int*)a.in[2];
      for (int i = F.vcu * 512 + F.tid; i < NTOK * 32; i += F.G * 512) {
          const int row = i >> 5, fi = i & 31;
          const float ang = (float)pos[row] * a.inv_freq[fi];
          const double rev = (double)ang * 0.15915494309189533577; const float fr = (float)(rev - floor(rev));
          rope[(size_t)row * 64 + fi] = __builtin_amdgcn_cosf(fr); rope[(size_t)row * 64 + 32 + fi] = __builtin_amdgcn_sinf(fr); } }
    { const float* x = a.in[0]; bf16_t* ha = (bf16_t*)(ws + WS_HA); float* rs0 = (float*)(ws + WS_RS0);
      f32x4 va[4], vb[4], na[4], nb[4];
#define XR(m_, j_) (((const f32x4*)(x + (size_t)(m_) * DM) + F.lane)[64 * (j_)])
      if (gw < NTOK) {
#pragma unroll
          for (int j = 0; j < 4; ++j) { na[j] = XR(gw, j); nb[j] = (gw + NGW < NTOK) ? XR(gw + NGW, j) : (f32x4){0.f, 0.f, 0.f, 0.f}; } }
      for (int m = gw; m < NTOK; m += 2 * NGW) {
#pragma unroll
          for (int j = 0; j < 4; ++j) { va[j] = na[j]; vb[j] = nb[j]; }
          if (m + 2 * NGW < NTOK) {
#pragma unroll
              for (int j = 0; j < 4; ++j) { na[j] = XR(m + 2 * NGW, j); nb[j] = (m + 3 * NGW < NTOK) ? XR(m + 3 * NGW, j) : (f32x4){0.f, 0.f, 0.f, 0.f}; } }
          float sa = 0.f, sb = 0.f;
#pragma unroll
          for (int j = 0; j < 4; ++j) { sa += (va[j][0] * va[j][0] + va[j][1] * va[j][1]) + (va[j][2] * va[j][2] + va[j][3] * va[j][3]); sb += (vb[j][0] * vb[j][0] + vb[j][1] * vb[j][1]) + (vb[j][2] * vb[j][2] + vb[j][3] * vb[j][3]); }
          sa = wave_sum(sa); sb = wave_sum(sb);
          u32x2* oa = (u32x2*)(ha + (size_t)m * DM) + F.lane; u32x2* ob = (u32x2*)(ha + (size_t)(m + NGW) * DM) + F.lane;
#pragma unroll
          for (int j = 0; j < 4; ++j) { oa[64 * j] = pack4(va[j]); if (m + NGW < NTOK) ob[64 * j] = pack4(vb[j]); }
          if (F.lane == 0) { rs0[m] = 1.0f / sqrtf(sa * (1.0f / DM) + EPS); if (m + NGW < NTOK) rs0[m + NGW] = 1.0f / sqrtf(sb * (1.0f / DM) + EPS); } }
#undef XR
      }

}

using pg8::Unit;
typedef f32x4 AccT[2][2][4][2];
struct ProbBase { const char* A; const char* Bt; int K; unsigned ldb; int G, c; };

#define EPI_FENCE() asm volatile("" ::: "memory")
struct ProbPw1 : ProbBase {
    const float* __restrict__ rstd; const float* __restrict__ bias; bf16_t* __restrict__ U;
    DEVI bool next(int i, Unit& u) const { const int L = i * G + c; if (L >= 128 * 8) return false; u.pm = L >> 3; u.pn = L & 7; u.e = 0; u.v = 256; return true; }
    DEVI unsigned a_off(const Unit& u, int R) const { return (unsigned)(u.pm * 256 + R) * 2048u; }
    DEVI size_t b_off(const Unit& u) const { return (size_t)u.pn * 256 * ldb; }
    DEVI void epi(const AccT& acc, const Unit& u, int wr, int wc, int fr, int fq) const {
        const int q0 = 32 * wc + 4 * fq;
        f32x4 ba[2], bg[2]; float rs[2][4];
#pragma unroll
        for (int n = 0; n < 2; ++n) { ba[n] = *(const f32x4*)(bias + 128 * u.pn + q0 + 16 * n); bg[n] = *(const f32x4*)(bias + 1024 + 128 * u.pn + q0 + 16 * n); }
#pragma unroll
        for (int ai = 0; ai < 2; ++ai)
#pragma unroll
            for (int m = 0; m < 4; ++m) rs[ai][m] = rstd[u.pm * 256 + 128 * ai + 64 * wr + 16 * m + fr];
        EPI_FENCE();
#pragma unroll
        for (int ai = 0; ai < 2; ++ai)
#pragma unroll
            for (int m = 0; m < 4; ++m) {
                const int row = u.pm * 256 + 128 * ai + 64 * wr + 16 * m + fr;
#pragma unroll
                for (int n = 0; n < 2; ++n) {
                    const f32x4 av = acc[ai][0][m][n] * rs[ai][m] + ba[n], gv = acc[ai][1][m][n] * rs[ai][m] + bg[n]; f32x4 o;
#pragma unroll
                    for (int j = 0; j < 4; ++j) o[j] = av[j] * sigmoid_f(gv[j]);
                    *(u32x2*)(U + (size_t)row * DM + 128 * u.pn + q0 + 16 * n) = pack4(o); } }
    }
};
struct ProbPP : ProbBase {
    bf16_t* O; int tail_lo;
    DEVI bool next(int i, Unit& u) const { if (c < tail_lo) return false; const int L = i * (G - tail_lo) + (c - tail_lo); if (L >= 128 * 4) return false; u.pm = L >> 2; u.pn = L & 3; u.e = 0; u.v = 256; return true; }
    DEVI unsigned a_off(const Unit& u, int R) const { return (unsigned)(u.pm * 256 + R) * 512u; }
    DEVI size_t b_off(const Unit& u) const { return (size_t)u.pn * 256 * ldb; }
    DEVI void epi(const AccT& acc, const Unit& u, int wr, int wc, int fr, int fq) const {
#pragma unroll
        for (int ai = 0; ai < 2; ++ai)
#pragma unroll
            for (int m = 0; m < 4; ++m) {
                const int row = u.pm * 256 + 128 * ai + 64 * wr + 16 * m + fr;
#pragma unroll
                for (int bj = 0; bj < 2; ++bj)
#pragma unroll
                    for (int n = 0; n < 2; ++n) *(u32x2*)(O + (size_t)row * DM + 256 * u.pn + 128 * bj + 32 * wc + 16 * n + 4 * fq) = pack4(acc[ai][bj][m][n]); }
    }
};
struct ProbRes : ProbBase {
    const bf16_t* __restrict__ RES; bf16_t* __restrict__ OUT; const float* __restrict__ bias;
    DEVI bool next(int i, Unit& u) const { const int L = i * G + c; if (L >= 128 * 4) return false; u.pm = L >> 2; u.pn = L & 3; u.e = 0; u.v = 256; return true; }
    DEVI unsigned a_off(const Unit& u, int R) const { return (unsigned)(u.pm * 256 + R) * 2048u; }
    DEVI size_t b_off(const Unit& u) const { return (size_t)u.pn * 256 * ldb; }
    DEVI void epi(const AccT& acc, const Unit& u, int wr, int wc, int fr, int fq) const {
        const int col0 = 256 * u.pn + 32 * wc + 4 * fq;
        f32x4 bv[2][2];
#pragma unroll
        for (int bj = 0; bj < 2; ++bj)
#pragma unroll
            for (int n = 0; n < 2; ++n) bv[bj][n] = bias ? *(const f32x4*)(bias + col0 + 128 * bj + 16 * n) : (f32x4){0.f, 0.f, 0.f, 0.f};
#pragma unroll
        for (int ai = 0; ai < 2; ++ai) {
            u32x2 r[4][2][2];
#pragma unroll
            for (int m = 0; m < 4; ++m) { const size_t o = (size_t)(u.pm * 256 + 128 * ai + 64 * wr + 16 * m + fr) * DM + col0;
#pragma unroll
                for (int bj = 0; bj < 2; ++bj)
#pragma unroll
                    for (int n = 0; n < 2; ++n) r[m][bj][n] = *(const u32x2*)(RES + o + 128 * bj + 16 * n); }
            EPI_FENCE();
#pragma unroll
            for (int m = 0; m < 4; ++m) { const size_t o = (size_t)(u.pm * 256 + 128 * ai + 64 * wr + 16 * m + fr) * DM + col0;
#pragma unroll
                for (int bj = 0; bj < 2; ++bj)
#pragma unroll
                    for (int n = 0; n < 2; ++n) *(u32x2*)(OUT + o + 128 * bj + 16 * n) = pack4(unpack4(r[m][bj][n]) + acc[ai][bj][m][n] + bv[bj][n]); }
            EPI_FENCE();
        }
    }
};
struct ProbPle : ProbBase {
    const bf16_t* __restrict__ H2; const bf16_t* __restrict__ PPp; const float* __restrict__ rstd; bf16_t* __restrict__ OUTB; float* __restrict__ OUTF; float* __restrict__ ssq; int last;
    DEVI bool next(int i, Unit& u) const { const int L = i * G + c; if (L >= 128 * 4) return false; u.pm = L >> 2; u.pn = L & 3; u.e = 0; u.v = 256; return true; }
    DEVI unsigned a_off(const Unit& u, int R) const { return (unsigned)(u.pm * 256 + R) * 2048u; }
    DEVI size_t b_off(const Unit& u) const { return (size_t)u.pn * 256 * ldb; }
    DEVI void epi(const AccT& acc, const Unit& u, int wr, int wc, int fr, int fq) const {
        const int col0 = 256 * u.pn + 32 * wc + 4 * fq;
#pragma unroll
        for (int ai = 0; ai < 2; ++ai) {
            u32x2 h[4][2][2], q[4][2][2]; float rs[4];
#pragma unroll
            for (int m = 0; m < 4; ++m) { const int row = u.pm * 256 + 128 * ai + 64 * wr + 16 * m + fr; const size_t o = (size_t)row * DM + col0; rs[m] = rstd[row];
#pragma unroll
                for (int bj = 0; bj < 2; ++bj)
#pragma unroll
                    for (int n = 0; n < 2; ++n) { h[m][bj][n] = *(const u32x2*)(H2 + o + 128 * bj + 16 * n); q[m][bj][n] = *(const u32x2*)(PPp + o + 128 * bj + 16 * n); } }
            EPI_FENCE();
#pragma unroll
            for (int m = 0; m < 4; ++m) { const int row = u.pm * 256 + 128 * ai + 64 * wr + 16 * m + fr; const size_t o = (size_t)row * DM + col0; float ss = 0.f;
#pragma unroll
                for (int bj = 0; bj < 2; ++bj)
#pragma unroll
                    for (int n = 0; n < 2; ++n) {
                        const f32x4 h2 = unpack4(h[m][bj][n]), pp = unpack4(q[m][bj][n]), a4 = acc[ai][bj][m][n] * rs[m]; f32x4 v;
#pragma unroll
                        for (int j = 0; j < 4; ++j) v[j] = h2[j] + sigmoid_f(a4[j]) * pp[j];
                        if (last) *(f32x4*)(OUTF + o + 128 * bj + 16 * n) = v;
                        else { *(u32x2*)(OUTB + o + 128 * bj + 16 * n) = pack4(v); ss += (v[0] * v[0] + v[1] * v[1]) + (v[2] * v[2] + v[3] * v[3]); } }
                if (!last) { ss += __shfl_xor(ss, 16); ss += __shfl_xor(ss, 32); if (fq == 0) ssq[(size_t)row * 16 + u.pn * 4 + wc] = ss; } }
            EPI_FENCE();
        }
    }
};
struct ProbGateUp : ProbBase {
    const LAS int* tab_row; const LAS int* tab_ev; int nblk;
    const LAS unsigned* goff;
    const float* __restrict__ slot_rs; bf16_t* __restrict__ HBUF;
    DEVI bool next(int i, Unit& u) const { const int L = i * G + c; if (L >= nblk * 4) return false; const int b = L >> 2; u.pn = L & 3; u.pm = tab_row[b]; const int ev = tab_ev[b]; u.e = (ev >> 9) | (i << 8); u.v = ev & 511; return true; }
    DEVI unsigned a_off(const Unit& u, int R) const { return goff[(u.e >> 8) * 256 + R]; }
    DEVI size_t b_off(const Unit& u) const { return ((size_t)(u.e & 255) * 1024 + (size_t)u.pn * 256) * ldb; }
    DEVI void epi(const AccT& acc, const Unit& u, int wr, int wc, int fr, int fq) const {
        float rsv[2][4];
#pragma unroll
        for (int ai = 0; ai < 2; ++ai)
#pragma unroll
            for (int m = 0; m < 4; ++m) rsv[ai][m] = slot_rs[u.pm + 128 * ai + 64 * wr + 16 * m + fr];
        EPI_FENCE();
#pragma unroll
        for (int ai = 0; ai < 2; ++ai)
#pragma unroll
            for (int m = 0; m < 4; ++m) {
                const int R = 128 * ai + 64 * wr + 16 * m + fr;
                if (R < u.v) { const int slot = u.pm + R; const float rs = rsv[ai][m];
#pragma unroll
                    for (int n = 0; n < 2; ++n) { const f32x4 g = acc[ai][0][m][n] * rs, up = acc[ai][1][m][n] * rs; f32x4 o;
#pragma unroll
                        for (int j = 0; j < 4; ++j) o[j] = g[j] * sigmoid_f(g[j]) * up[j];
                        *(u32x2*)(HBUF + (size_t)slot * DEXP + 128 * u.pn + 32 * wc + 16 * n + 4 * fq) = pack4(o); } } }
    }
};
struct ProbDown : ProbBase {
    const LAS int* tab_row; const LAS int* tab_ev; int nblk;
    const float* __restrict__ slot_w; bf16_t* __restrict__ YB;
    DEVI bool next(int i, Unit& u) const { const int L = i * G + c; if (L >= nblk * 4) return false; const int b = L >> 2; u.pn = L & 3; u.pm = tab_row[b]; const int ev = tab_ev[b]; u.e = ev >> 9; u.v = ev & 511; return true; }
    DEVI unsigned a_off(const Unit& u, int R) const { return (unsigned)(u.pm + R) * 1024u; }
    DEVI size_t b_off(const Unit& u) const { return ((size_t)u.e * 1024 + (size_t)u.pn * 256) * ldb; }
    DEVI void epi(const AccT& acc, const Unit& u, int wr, int wc, int fr, int fq) const {
        float wv[2][4];
#pragma unroll
        for (int ai = 0; ai < 2; ++ai)
#pragma unroll
            for (int m = 0; m < 4; ++m) wv[ai][m] = slot_w[u.pm + 128 * ai + 64 * wr + 16 * m + fr];
        EPI_FENCE();
#pragma unroll
        for (int ai = 0; ai < 2; ++ai)
#pragma unroll
            for (int m = 0; m < 4; ++m) {
                const int R = 128 * ai + 64 * wr + 16 * m + fr;
                if (R < u.v) { const int slot = u.pm + R; const float w = wv[ai][m];
#pragma unroll
                    for (int bj = 0; bj < 2; ++bj)
#pragma unroll
                        for (int n = 0; n < 2; ++n) *(u32x2*)(YB + (size_t)slot * DM + 256 * u.pn + 128 * bj + 32 * wc + 16 * n + 4 * fq) = pack4(acc[ai][bj][m][n] * w); } }
    }
};
struct ProbWin : ProbBase {
    const float* __restrict__ rstd; const float* __restrict__ rope; const float* __restrict__ qnorm; const float* __restrict__ knorm; bf16_t* __restrict__ Q; bf16_t* __restrict__ KV; float* __restrict__ gates;
    const LAS float* lrs;
    DEVI bool next(int i, Unit& u) const { const int L = i * G + c; if (L >= 128 * 11) return false; u.pm = L / 11; u.pn = L % 11; u.e = i; u.v = 256; return true; }
    DEVI unsigned a_off(const Unit& u, int R) const { return (unsigned)(u.pm * 256 + R) * 2048u; }
    DEVI size_t b_off(const Unit& u) const { return (size_t)u.pn * 256 * ldb; }
    DEVI void epi(const AccT& acc, const Unit& u, int wr, int wc, int fr, int fq) const {
        const int pn = u.pn;
        float rsv[2][4];
#pragma unroll
        for (int ai = 0; ai < 2; ++ai)
#pragma unroll
            for (int m = 0; m < 4; ++m) rsv[ai][m] = lrs[u.e * 256 + 128 * ai + 64 * wr + 16 * m + fr];
        if (pn == 10) {
            EPI_FENCE();
            if (wc < 2) {
#pragma unroll
                for (int ai = 0; ai < 2; ++ai)
#pragma unroll
                    for (int m = 0; m < 4; ++m) {
                        const int row = u.pm * 256 + 128 * ai + 64 * wr + 16 * m + fr; const float rs = rsv[ai][m];
#pragma unroll
                        for (int n = 0; n < 2; ++n) if (wc == 0 || n == 0) { const f32x4 a4 = acc[ai][0][m][n] * rs; f32x4 o;
#pragma unroll
                            for (int j = 0; j < 4; ++j) o[j] = sigmoid_f(a4[j]);
                            *(f32x4*)(gates + (size_t)row * 48 + 32 * wc + 16 * n + 4 * fq) = o; } } }
            return;
        }
        const bool isq = pn < 4, dorope = isq || pn == 6 || pn == 8;
        const float* gvec = isq ? qnorm : (knorm + (pn == 6 ? 64 : 128));
        f32x4 g1[2], g2[2];
#pragma unroll
        for (int n = 0; n < 2; ++n) { g1[n] = *(const f32x4*)(gvec + 16 * n + 4 * fq); g2[n] = *(const f32x4*)(gvec + 32 + 16 * n + 4 * fq); }
        const float oscale = isq ? C2 : 1.0f;
#pragma unroll
        for (int g = 0; g < 8; ++g) { const int ai = g >> 2, m = g & 3;
            const int row = u.pm * 256 + 128 * ai + 64 * wr + 16 * m + fr; const float rs = rsv[ai][m];
            f32x4 cs[2], sn[2];
            if (dorope) { const size_t ro = (size_t)row * 64 + 4 * fq;
#pragma unroll
                for (int n = 0; n < 2; ++n) { cs[n] = *(const f32x4*)(rope + ro + 16 * n); sn[n] = *(const f32x4*)(rope + ro + 32 + 16 * n); } }
            f32x4 x1[2], x2[2];
#pragma unroll
            for (int n = 0; n < 2; ++n) { x1[n] = acc[ai][0][m][n] * rs; x2[n] = acc[ai][1][m][n] * rs; }
            if (dorope) {
                float ss = 0.f;
#pragma unroll
                for (int n = 0; n < 2; ++n)
#pragma unroll
                    for (int j = 0; j < 4; ++j) ss += x1[n][j] * x1[n][j] + x2[n][j] * x2[n][j];
                ss += __shfl_xor(ss, 16); ss += __shfl_xor(ss, 32);
                const float inv = 1.0f / sqrtf(ss * (1.0f / 64.0f) + EPS);
#pragma unroll
                for (int n = 0; n < 2; ++n) {
                    const f32x4 y1 = x1[n] * inv * g1[n], y2 = x2[n] * inv * g2[n];
                    x1[n] = (y1 * cs[n] - y2 * sn[n]) * oscale; x2[n] = (y2 * cs[n] + y1 * sn[n]) * oscale; } }
            bf16_t* dst;
            if (isq) dst = Q + (size_t)row * DM + (4 * pn + wc) * 64;
            else { const int b = row >> 11, t = row & 2047; dst = KV + (size_t)(pn - 4) * KVS + ((size_t)(b * 4 + wc) * SEQ + t) * 64; }
#pragma unroll
            for (int n = 0; n < 2; ++n) { *(u32x2*)(dst + 16 * n + 4 * fq) = pack4(x1[n]); *(u32x2*)(dst + 32 + 16 * n + 4 * fq) = pack4(x2[n]); }
        }
    }
};
struct ProbCmp : ProbBase {
    float* CP;
    DEVI bool next(int i, Unit& u) const { const int L = i * G + c; if (L >= 256) return false; u.e = L >> 7; u.pm = (L >> 2) & 31; u.v = L & 3; u.pn = 0; return true; }
    DEVI unsigned a_off(const Unit& u, int R) const { return (unsigned)u.e * (unsigned)(KVS * 2) + (unsigned)(u.pm * 256 + R) * 2048u + (unsigned)u.v * 1024u; }
    DEVI size_t b_off(const Unit& u) const { return (size_t)u.e * 256 * ldb + (size_t)u.v * 1024; }
    DEVI void epi(const AccT& acc, const Unit& u, int wr, int wc, int fr, int fq) const {
        float* base = CP + ((size_t)(u.e * 4 + u.v) * 8192) * 256;
#pragma unroll
        for (int ai = 0; ai < 2; ++ai)
#pragma unroll
            for (int m = 0; m < 4; ++m) {
                const int rho = u.pm * 256 + 128 * ai + 64 * wr + 16 * m + fr;
#pragma unroll
                for (int bj = 0; bj < 2; ++bj)
#pragma unroll
                    for (int n = 0; n < 2; ++n) *(f32x4*)(base + (size_t)rho * 256 + 128 * bj + 32 * wc + 16 * n + 4 * fq) = acc[ai][bj][m][n]; }
    }
};

#define CONV_BAR() asm volatile("s_waitcnt lgkmcnt(0)\n\ts_barrier" ::: "memory")
DEVI void conv_phase(const Frame& F, const Args& a) {
    const bf16_t* U = (const bf16_t*)(F.ws + WS_U); bf16_t* V = (bf16_t*)(F.ws + WS_V);
    LAS float* red = (LAS float*)(F.lds + SCR_OFF);
    LAS float* fin = red + 256;
    const int tid = F.tid, c0 = 2 * tid;
    f32x2 w2[31];
#pragma unroll
    for (int k = 0; k < 31; ++k) w2[k] = *(const f32x2*)(a.in[8] + (size_t)k * DM + c0);
    const f32x2 bdw = *(const f32x2*)(a.in[9] + c0), lg = *(const f32x2*)(a.in[10] + c0), lb = *(const f32x2*)(a.in[11] + c0);
    for (int ch = F.vcu; ch < 256; ch += F.G) {
        const int tokbase = ch * 128, t0 = tokbase & (SEQ - 1);
        const unsigned* Up = (const unsigned*)U + (size_t)tokbase * 512 + tid;
        unsigned win[46];
#pragma unroll
        for (int i = 0; i < 46; ++i) { const int rel = i - 30; win[i] = (rel >= 0 || t0 != 0) ? Up[(ptrdiff_t)rel * 512] : 0u; }
#pragma unroll
        for (int s = 0; s < 8; ++s) {
            unsigned nxt[16];
            if (s < 7) {
#pragma unroll
                for (int i = 0; i < 16; ++i) nxt[i] = Up[(ptrdiff_t)(16 * (s + 1) + i) * 512]; }
            f32x2 y[16];
#pragma unroll
            for (int tt = 0; tt < 16; ++tt) y[tt] = bdw;
#pragma unroll
            for (int rr = 0; rr < 46; ++rr) {
                const f32x2 v = {bflo(win[rr]), bfhi(win[rr])};
#pragma unroll
                for (int tt = 0; tt < 16; ++tt) { const int k = rr - tt; if (k >= 0 && k <= 30) y[tt] += w2[k] * v; }
            }
            float v16[16];
            { const bool h5 = (F.lane & 32) != 0;
#pragma unroll
              for (int i = 0; i < 16; ++i) { const float sA = y[i][0] + y[i][1], sB = y[i][0] * y[i][0] + y[i][1] * y[i][1]; const float keep = h5 ? sB : sA, send = h5 ? sA : sB; v16[i] = keep + __shfl_xor(send, 32); } }
            float v8[8], v4[4], v2[2], v1r;
            { const bool h = (F.lane & 16) != 0;
#pragma unroll
              for (int i = 0; i < 8; ++i) { const float keep = h ? v16[i + 8] : v16[i], send = h ? v16[i] : v16[i + 8]; v8[i] = keep + __shfl_xor(send, 16); } }
            { const bool h = (F.lane & 8) != 0;
#pragma unroll
              for (int i = 0; i < 4; ++i) { const float keep = h ? v8[i + 4] : v8[i], send = h ? v8[i] : v8[i + 4]; v4[i] = keep + __shfl_xor(send, 8); } }
            { const bool h = (F.lane & 4) != 0;
#pragma unroll
              for (int i = 0; i < 2; ++i) { const float keep = h ? v4[i + 2] : v4[i], send = h ? v4[i] : v4[i + 2]; v2[i] = keep + __shfl_xor(send, 4); } }
            { const bool h = (F.lane & 2) != 0; const float keep = h ? v2[1] : v2[0], send = h ? v2[0] : v2[1]; v1r = keep + __shfl_xor(send, 2); }
            v1r += __shfl_xor(v1r, 1);
            CONV_BAR();
            if ((F.lane & 1) == 0) red[F.wave * 32 + (F.lane >> 1)] = v1r;
            CONV_BAR();
            if (tid < 16) { float t = 0.f, q = 0.f;
#pragma unroll
                for (int w = 0; w < 8; ++w) { t += red[w * 32 + tid]; q += red[w * 32 + 16 + tid]; }
                const float mean = t * (1.0f / DM), var = q * (1.0f / DM) - mean * mean;
                fin[tid] = mean; fin[16 + tid] = 1.0f / sqrtf(var + EPS); }
            CONV_BAR();
#pragma unroll
            for (int tt = 0; tt < 16; ++tt) {
                const float mean = fin[tt], rstd = fin[16 + tt];
                const float z0 = (y[tt][0] - mean) * rstd * lg[0] + lb[0], z1 = (y[tt][1] - mean) * rstd * lg[1] + lb[1];
                *(unsigned*)(V + (size_t)(tokbase + 16 * s + tt) * DM + c0) = pk2(z0 * sigmoid_f(z0), z1 * sigmoid_f(z1)); }
            if (s < 7) {
#pragma unroll
                for (int i = 0; i < 30; ++i) win[i] = win[i + 16];
#pragma unroll
                for (int i = 0; i < 16; ++i) win[30 + i] = nxt[i]; }
        }
    }
}
DEVI void router_phase(const Frame& F, const Args& a, int L, const bf16_t* H) {
    const bf16_t* rw = (const bf16_t*)(F.ws + WS_RW) + (size_t)(L * 2) * 48 * 1024;
    float* rs1 = (float*)(F.ws + WS_RS1); int* asg_e = (int*)(F.ws + WS_ASGE); int* asg_r = (int*)(F.ws + WS_ASGR); float* asg_w = (float*)(F.ws + WS_ASGW); int* cnt = (int*)(F.ws + WS_CNT);
    LAS unsigned char* wst = F.lds + RING_OFF;
    LAS float* lg = (LAS float*)(F.lds + RING_OFF + 65536) + F.wave * (16 * 48);
    LAS int* elist = (LAS int*)(F.lds + RING_OFF + 98304);
    LAS float* bias = (LAS float*)(F.lds + RING_OFF + 98304 + 1024);
    if (F.tid < 4) bias[F.tid] = a.in[22][L * 4 + F.tid]; else if (F.tid < 36) bias[F.tid] = a.in[24][L * 32 + F.tid - 4];
    const LAS float* brg = bias; const LAS float* bre = bias + 4;
    const int fr = F.lane & 15, fq = F.lane >> 4;
    for (int ch = F.vcu; ch < 256; ch += F.G) {
        const int tok0 = ch * 128 + F.wave * 16;
        f32x4 acc[3];
#pragma unroll
        for (int t = 0; t < 3; ++t) acc[t] = (f32x4){0.f, 0.f, 0.f, 0.f};
        float ss = 0.f;
        const bf16_t* hp = H + (size_t)(tok0 + fr) * DM + 8 * fq;
        for (int kc4 = 0; kc4 < 4; ++kc4) {
            const int kc = (kc4 + F.vcu) & 3;
            bf16x8 hf[8];
#pragma unroll
            for (int sl = 0; sl < 8; ++sl) hf[sl] = *(const bf16x8*)(hp + kc * 256 + 32 * sl);
            u32x4 wv[6];
#pragma unroll
            for (int i = 0; i < 6; ++i) { const int idx = F.tid + 512 * i, hl = idx / 1536, rem = idx % 1536, row = rem >> 5, c = rem & 31;
                wv[i] = *(const u32x4*)(rw + ((size_t)(hl * 48 + row)) * 1024 + kc * 256 + c * 8); }
            wg_sync();
#pragma unroll
            for (int i = 0; i < 6; ++i) { const int idx = F.tid + 512 * i, hl = idx / 1536, rem = idx % 1536, row = rem >> 5, c = rem & 31;
                *(LAS u32x4*)(wst + hl * 25344 + row * 528 + c * 16) = wv[i]; }
            wg_sync();
#pragma unroll
            for (int sl = 0; sl < 8; ++sl) {
#pragma unroll
                for (int t = 0; t < 3; ++t) {
                    const bf16x8 wh = *(const LAS bf16x8*)(wst + (16 * t + fr) * 528 + (32 * sl + 8 * fq) * 2), wl = *(const LAS bf16x8*)(wst + 25344 + (16 * t + fr) * 528 + (32 * sl + 8 * fq) * 2);
                    acc[t] = __builtin_amdgcn_mfma_f32_16x16x32_bf16(wh, hf[sl], acc[t], 0, 0, 0);
                    acc[t] = __builtin_amdgcn_mfma_f32_16x16x32_bf16(wl, hf[sl], acc[t], 0, 0, 0); }
                const u32x4 hu = __builtin_bit_cast(u32x4, hf[sl]);
#pragma unroll
                for (int j = 0; j < 4; ++j) { const float x0 = bflo(hu[j]), x1 = bfhi(hu[j]); ss += x0 * x0 + x1 * x1; }
            }
        }
        ss += __shfl_xor(ss, 16); ss += __shfl_xor(ss, 32);
        const float rs = 1.0f / sqrtf(ss * (1.0f / DM) + EPS);
        if (fq == 0) rs1[tok0 + fr] = rs;
#pragma unroll
        for (int t = 0; t < 3; ++t)
#pragma unroll
            for (int r = 0; r < 4; ++r) lg[fr * 48 + 16 * t + 4 * fq + r] = acc[t][r] * rs;
        LDS_WAIT();
        if (F.lane < 16) {
            const LAS float* my = lg + F.lane * 48;
            float g[4]; int gi = 0; float gm;
#pragma unroll
            for (int j = 0; j < 4; ++j) g[j] = my[j] + brg[j];
            gm = g[0];
#pragma unroll
            for (int j = 1; j < 4; ++j) if (g[j] > gm) { gm = g[j]; gi = j; }
            float den = 0.f;
#pragma unroll
            for (int j = 0; j < 4; ++j) den += __expf(g[j] - gm);
            const float pg = 1.0f / den;
            float v1 = -INFINITY, v2 = -INFINITY; int i1 = 0, i2 = 0;
            for (int j = 0; j < 8; ++j) { const float v = my[4 + gi * 8 + j] + bre[gi * 8 + j];
                if (v > v1) { v2 = v1; i2 = i1; v1 = v; i1 = j; } else if (v > v2) { v2 = v; i2 = j; } }
            const float e2 = __expf(v2 - v1), wa = pg / (1.0f + e2), wb = pg * e2 / (1.0f + e2);
            const int tl = F.wave * 16 + F.lane;
            elist[2 * tl] = gi * 8 + i1; elist[2 * tl + 1] = gi * 8 + i2;
            asg_w[(size_t)ch * 256 + 2 * tl] = wa; asg_w[(size_t)ch * 256 + 2 * tl + 1] = wb;
        }
        wg_sync();
        if (F.tid < 288) {
            const bool isr = F.tid < 256; const int e = isr ? elist[F.tid] : F.tid - 256, lim = isr ? F.tid : 256; int r = 0;
            typedef int i32x4 __attribute__((ext_vector_type(4)));
#pragma unroll 8
            for (int q = 0; q < 256; q += 4) { const i32x4 v = *(const LAS i32x4*)(elist + q);
                r += ((v[0] == e) & (q < lim)) + ((v[1] == e) & (q + 1 < lim)) + ((v[2] == e) & (q + 2 < lim)) + ((v[3] == e) & (q + 3 < lim)); }
            if (isr) { asg_e[(size_t)ch * 256 + F.tid] = e; asg_r[(size_t)ch * 256 + F.tid] = r; } else cnt[ch * 32 + e] = r; }
        wg_sync();
    }
}
DEVI void fill_phase(const Frame& F) {
    const int* cnt = (const int*)(F.ws + WS_CNT); const int* asg_e = (const int*)(F.ws + WS_ASGE); const int* asg_r = (const int*)(F.ws + WS_ASGR); const float* asg_w = (const float*)(F.ws + WS_ASGW);
    const float* rs1 = (const float*)(F.ws + WS_RS1);
    int* tslot = (int*)(F.ws + WS_TSLOT); int* stok = (int*)(F.ws + WS_STOK); float* sw = (float*)(F.ws + WS_SW); float* srs = (float*)(F.ws + WS_SRS); int* mtot = (int*)(F.ws + WS_MTOT);
    LAS int* ptot = (LAS int*)(F.lds + RING_OFF);
    LAS int* ppre = ptot + 512;
    LAS int* tot = ppre + 512; LAS int* start = tot + 32; LAS int* pre = start + 32;
    for (int ch = F.vcu; ch < 256; ch += F.G) {
        wg_sync();
        { const int e = F.tid & 31, part = F.tid >> 5; int t = 0, p = 0;
          for (int w = part * 16; w < part * 16 + 16; ++w) { const int c = cnt[w * 32 + e]; t += c; if (w < ch) p += c; }
          ptot[part * 32 + e] = t; ppre[part * 32 + e] = p; }
        wg_sync();
        if (F.tid < 32) { int t = 0, p = 0;
#pragma unroll
            for (int q = 0; q < 16; ++q) { t += ptot[q * 32 + F.tid]; p += ppre[q * 32 + F.tid]; }
            tot[F.tid] = t; pre[F.tid] = p; }
        wg_sync();
        if (F.tid == 0) { int s = 0; for (int e = 0; e < 32; ++e) { start[e] = s; s += tot[e]; } }
        wg_sync();
        if (F.tid < 256) { const size_t ag = (size_t)ch * 256 + F.tid; const int e = asg_e[ag], slot = start[e] + pre[e] + asg_r[ag], tok = ch * 128 + (F.tid >> 1);
            stok[slot] = tok; sw[slot] = asg_w[ag]; srs[slot] = rs1[tok]; tslot[ag] = slot; }
        if (ch == 0) {
            if (F.tid < 32) { mtot[F.tid] = tot[F.tid]; mtot[32 + F.tid] = start[F.tid]; }
            if (F.tid >= 256) { const int i = NSLOT + F.tid - 256; stok[i] = 0; sw[i] = 0.f; srs[i] = 0.f; }
            { const float* cbp = (const float*)(F.ws + WS_CBP); const int j = F.tid >> 8, c = F.tid & 255; float s2 = 0.f;
              for (int kr = 0; kr < 32; ++kr) s2 += cbp[(j * 32 + kr) * 256 + c];
              ((float*)(F.ws + WS_CB))[F.tid] = s2; } }
    }
}
DEVI int build_moe_table(const Frame& F) {
    const int* mtot = (const int*)(F.ws + WS_MTOT);
    LAS int* trow = (LAS int*)(F.lds + TAB_OFF); LAS int* tev = trow + 320; LAS int* tn = tev + 320;
    LAS int* mt = (LAS int*)(F.lds + SCR_OFF);
    if (F.tid < 64) mt[F.tid] = mtot[F.tid];
    wg_sync();
    if (F.tid == 0) { int nb = 0;
        for (int e = 0; e < 32; ++e) { const int t = mt[e], s = mt[32 + e];
            for (int o = 0; o < t; o += 256) { trow[nb] = s + o; tev[nb] = e * 512 + ((t - o) < 256 ? (t - o) : 256); ++nb; } }
        tn[0] = nb; }
    wg_sync();
    return tn[0];
}
DEVI void combine_phase(const Frame& F, const bf16_t* H, bf16_t* OUT, int zero_y) {
    const bf16_t* YB = (const bf16_t*)(F.ws + WS_YB); const int* tslot = (const int*)(F.ws + WS_TSLOT); float* rs2 = (float*)(F.ws + WS_RS2);
    const int gw = F.vcu * NWAVES + F.wave, NGW = F.G * NWAVES;
    for (int row = gw; row < NTOK; row += NGW) {
        const int s0 = tslot[2 * row], s1 = tslot[2 * row + 1]; float ss = 0.f;
#pragma unroll
        for (int hx = 0; hx < 2; ++hx) {
            const int col = 512 * hx + 8 * F.lane;
            const u32x4 h = *(const u32x4*)(H + (size_t)row * DM + col), y0 = *(const u32x4*)(YB + (size_t)s0 * DM + col), y1 = *(const u32x4*)(YB + (size_t)s1 * DM + col); u32x4 o;
#pragma unroll
            for (int j = 0; j < 4; ++j) { float lo = bflo(h[j]) + bflo(y0[j]) + bflo(y1[j]), hi = bfhi(h[j]) + bfhi(y0[j]) + bfhi(y1[j]); if (zero_y) { lo = bflo(h[j]); hi = bfhi(h[j]); } ss += lo * lo + hi * hi; o[j] = pk2(lo, hi); }
            *(u32x4*)(OUT + (size_t)row * DM + col) = o; }
        ss = wave_sum(ss);
        if (F.lane == 0) rs2[row] = 1.0f / sqrtf(ss * (1.0f / DM) + EPS);
    }
}
DEVI void rstd_from_partials(const Frame& F) {
    const float* ssq = (const float*)(F.ws + WS_SSQ); float* rs0 = (float*)(F.ws + WS_RS0);
    for (int row = F.vcu * 512 + F.tid; row < NTOK; row += F.G * 512) {
        const f32x4* p = (const f32x4*)(ssq + (size_t)row * 16); float s = 0.f;
#pragma unroll
        for (int q = 0; q < 4; ++q) { const f32x4 v = p[q]; s += (v[0] + v[1]) + (v[2] + v[3]); }
        rs0[row] = 1.0f / sqrtf(s * (1.0f / DM) + EPS); }
}
DEVI void cmpb_phase(const Frame& F, const Args& a) {
    const float* CP = (const float*)(F.ws + WS_CP); const float* CB = (const float*)(F.ws + WS_CB); const float* rope = (const float*)(F.ws + WS_ROPE);
    const bf16_t* W2T = (const bf16_t*)(F.ws + WS_W2T);
    bf16_t* KC = (bf16_t*)(F.ws + WS_KC); bf16_t* VC = (bf16_t*)(F.ws + WS_VC);
    LAS unsigned char* hl = F.lds + RING_OFF;
    LAS float* ol = (LAS float*)(F.lds + RING_OFF + 65536);
    const float kn = a.in[16][F.lane];
    const int fr = F.lane & 15, fq = F.lane >> 4;
    for (int wg = F.vcu; wg < 256; wg += F.G) {
        const int row0 = wg * 64, j = row0 >> 13, rho0 = row0 & 8191;
        { const int r = F.tid >> 3, c0 = (F.tid & 7) * 32;
          f32x4 acc8[8];
#pragma unroll
          for (int q = 0; q < 8; ++q) acc8[q] = *(const f32x4*)(CB + j * 256 + c0 + 4 * q);
#pragma unroll
          for (int ks = 0; ks < 4; ++ks) { const float* src = CP + ((size_t)(j * 4 + ks) * 8192 + rho0 + r) * 256 + c0;
#pragma unroll
              for (int q = 0; q < 8; ++q) acc8[q] += *(const f32x4*)(src + 4 * q); }
#pragma unroll
          for (int q = 0; q < 8; ++q) { f32x4 g;
#pragma unroll
              for (int e = 0; e < 4; ++e) { const float x = acc8[q][e], uu = 0.7978845608028654f * (x + 0.044715f * x * x * x); g[e] = x * sigmoid_f(2.0f * uu); }
              *(LAS u32x2*)(hl + r * 528 + (c0 + 4 * q) * 2) = pack4(g); } }
        wg_sync();
        { const int mt = F.wave & 3, np = F.wave >> 2;
          f32x4 d[2]; d[0] = (f32x4){0.f, 0.f, 0.f, 0.f}; d[1] = d[0];
#pragma unroll
          for (int st = 0; st < 8; ++st) {
              const bf16x8 hf = *(const LAS bf16x8*)(hl + (16 * mt + fr) * 528 + (32 * st + 8 * fq) * 2);
#pragma unroll
              for (int t = 0; t < 2; ++t) { const bf16x8 wf = *(const bf16x8*)(W2T + ((size_t)(j * 64 + 32 * np + 16 * t + fr)) * 256 + 32 * st + 8 * fq);
                  d[t] = __builtin_amdgcn_mfma_f32_16x16x32_bf16(wf, hf, d[t], 0, 0, 0); } }
#pragma unroll
          for (int t = 0; t < 2; ++t) *(LAS f32x4*)(ol + (16 * mt + fr) * 64 + 32 * np + 16 * t + 4 * fq) = d[t]; }
        wg_sync();
#pragma unroll
        for (int q = 0; q < 8; ++q) {
            const int r = F.wave * 8 + q, rho = rho0 + r, bg = rho >> 7, n = rho & 127;
            bf16_t* dst = (j == 0 ? KC : VC) + (size_t)rho * 64 + F.lane;
            float o = ol[r * 64 + F.lane];
            if (n == 127) { *dst = 0; continue; }
            if (j == 0) {
                const float ms = wave_sum(o * o) * (1.0f / 64.0f); const float y = o * (1.0f / sqrtf(ms + EPS)) * kn;
                const float other = __shfl_xor(y, 32);
                const int row = (bg >> 2) * SEQ + 16 * n + 31; const float cs = rope[(size_t)row * 64 + (F.lane & 31)], sn = rope[(size_t)row * 64 + 32 + (F.lane & 31)];
                o = (F.lane < 32) ? (y * cs - other * sn) : (y * cs + other * sn);
            }
            *dst = (bf16_t)(pk2(o, 0.f) & 0xffffu);
        }
        wg_sync();
    }
}

#ifndef ATT_REP
#define ATT_REP 1
#endif
namespace att {
constexpr int KS0 = 0, VS0 = 24576, WSF = 49152, OFN = 51200, UNI = 116736;
typedef const LAS char* lptr;
DEVI int crow(int r, int hi) { return (r & 3) + 8 * (r >> 2) + 4 * hi; }
DEVI void glds16(const void* gsrc, unsigned lds_dst) { unsigned keep;
    asm volatile("s_mov_b32 %0, m0\n\ts_mov_b32 m0, %2\n\ts_nop 0\n\tglobal_load_lds_dwordx4 %1, off\n\ts_mov_b32 m0, %0" : "=&s"(keep) : "v"(gsrc), "s"(lds_dst) : "memory"); }
DEVI float xlane32(float v) { return __shfl_xor(v, 32); }
DEVI void qkt(f32x16& p0, f32x16& p1, lptr Kslot, const bf16x8* qr, float cinit, int r32, int hi) {
    lptr kb = Kslot + hi * 1024 + r32 * 16;
#pragma unroll
    for (int r = 0; r < 16; ++r) { p0[r] = cinit; p1[r] = cinit; }
#pragma unroll
    for (int d0 = 0; d0 < 4; ++d0) {
        const bf16x8 b0 = *(const LAS bf16x8*)(kb + d0 * 2048), b1 = *(const LAS bf16x8*)(kb + d0 * 2048 + 512);
        p0 = __builtin_amdgcn_mfma_f32_32x32x16_bf16(b0, qr[d0], p0, 0, 0, 0); p1 = __builtin_amdgcn_mfma_f32_32x32x16_bf16(b1, qr[d0], p1, 0, 0, 0); }
}
DEVI float rowmax(const f32x16& p0, const f32x16& p1) {
    float m = fmaxf(p0[0], p1[0]);
#pragma unroll
    for (int r = 1; r < 16; ++r) m = fmaxf(m, fmaxf(p0[r], p1[r]));
    return fmaxf(m, xlane32(m));
}
DEVI float max3f(float a, float b, float c) { float r; asm("v_max3_f32 %0, %1, %2, %3" : "=v"(r) : "v"(a), "v"(b), "v"(c)); return r; }
DEVI float rowmax3(const f32x16& p0, const f32x16& p1) {
    float a = max3f(p0[0], p0[1], p1[0]), b = max3f(p0[2], p0[3], p1[1]); a = max3f(a, p1[2], p1[3]);
#pragma unroll
    for (int r = 4; r < 16; r += 4) { a = max3f(a, p0[r], p0[r + 1]); b = max3f(b, p0[r + 2], p0[r + 3]); a = max3f(a, p1[r], p1[r + 1]); b = max3f(b, p1[r + 2], p1[r + 3]); }
    const float m = max3f(a, b, b);
    return max3f(m, xlane32(m), m);
}
DEVI void qk2(f32x16& p0, f32x16& p1, lptr Kslot, const bf16x8* qr, const f32x16& negm, int r32, int hi) {
    lptr kb = Kslot + hi * 1024 + r32 * 16;
    bf16x8 kf[8];
#pragma unroll
    for (int d0 = 0; d0 < 4; ++d0) { kf[2 * d0] = *(const LAS bf16x8*)(kb + d0 * 2048); kf[2 * d0 + 1] = *(const LAS bf16x8*)(kb + d0 * 2048 + 512); }
    asm volatile("s_waitcnt lgkmcnt(0)" : "+v"(kf[0]), "+v"(kf[1]), "+v"(kf[2]), "+v"(kf[3]), "+v"(kf[4]), "+v"(kf[5]), "+v"(kf[6]), "+v"(kf[7]) :: "memory");
    p0 = __builtin_amdgcn_mfma_f32_32x32x16_bf16(kf[0], qr[0], negm, 0, 0, 0); p1 = __builtin_amdgcn_mfma_f32_32x32x16_bf16(kf[1], qr[0], negm, 0, 0, 0);
#pragma unroll
    for (int d0 = 1; d0 < 4; ++d0) { p0 = __builtin_amdgcn_mfma_f32_32x32x16_bf16(kf[2 * d0], qr[d0], p0, 0, 0, 0); p1 = __builtin_amdgcn_mfma_f32_32x32x16_bf16(kf[2 * d0 + 1], qr[d0], p1, 0, 0, 0); }
}
DEVI void pv(f32x16* o, int vb, bf16x8 pa0, bf16x8 pa1, bf16x8 pa2, bf16x8 pa3) {
#pragma unroll
    for (int d0 = 0; d0 < 2; ++d0) { s16x4 lo[4], hi[4];
#pragma unroll
        for (int ks = 0; ks < 4; ++ks) {
            asm volatile("ds_read_b64_tr_b16 %0,%1 offset:%c2" : "=&v"(lo[ks]) : "v"(vb), "i"(d0 * 4096 + ks * 1024) : "memory");
            asm volatile("ds_read_b64_tr_b16 %0,%1 offset:%c2" : "=&v"(hi[ks]) : "v"(vb), "i"(d0 * 4096 + ks * 1024 + 512) : "memory"); }
        asm volatile("s_waitcnt lgkmcnt(0)" ::: "memory"); __builtin_amdgcn_sched_barrier(0);
#define ATT_PK(k) (bf16x8){lo[k][0], lo[k][1], lo[k][2], lo[k][3], hi[k][0], hi[k][1], hi[k][2], hi[k][3]}
        o[d0] = __builtin_amdgcn_mfma_f32_32x32x16_bf16(pa0, ATT_PK(0), o[d0], 0, 0, 0);
        o[d0] = __builtin_amdgcn_mfma_f32_32x32x16_bf16(pa1, ATT_PK(1), o[d0], 0, 0, 0);
        o[d0] = __builtin_amdgcn_mfma_f32_32x32x16_bf16(pa2, ATT_PK(2), o[d0], 0, 0, 0);
        o[d0] = __builtin_amdgcn_mfma_f32_32x32x16_bf16(pa3, ATT_PK(3), o[d0], 0, 0, 0);
#undef ATT_PK
    }
}
DEVI bf16x8 packp(const f32x16& p, int b) { u32x4 w; w.x = pk2(p[b], p[b + 1]); w.y = pk2(p[b + 2], p[b + 3]); w.z = pk2(p[b + 4], p[b + 5]); w.w = pk2(p[b + 6], p[b + 7]); return __builtin_bit_cast(bf16x8, w); }
DEVI void scale_rows(f32x16* o, LAS float* wsf, float fac, int r32, int hi) {
    if (hi == 0) wsf[r32] = fac;
    LDS_WAIT();
#pragma unroll
    for (int r = 0; r < 16; ++r) { const float f = wsf[crow(r, hi)]; o[0][r] *= f; o[1][r] *= f; }
    LDS_WAIT();
}
DEVI void fold_rows(const f32x16* o, LAS float* ofl, LAS float* wsf, float fac, int r32, int hi) {
    if (hi == 0) wsf[r32] = fac;
    LDS_WAIT();
#pragma unroll
    for (int r = 0; r < 16; ++r) { const int q = crow(r, hi); const float f = wsf[q]; ofl[q * 64 + r32] += o[0][r] * f; ofl[q * 64 + 32 + r32] += o[1][r] * f; }
    LDS_WAIT();
}
DEVI void tile_step(f32x16* o, float& m, float& l, const bf16x8* qr, lptr Kslot, int vb, LAS float* wsf, int r32, int hi, float cinit, bool domask, int kbase, int lo, int hi_) {
    f32x16 p0, p1;
    qkt(p0, p1, Kslot, qr, cinit, r32, hi);
    if (domask) {
#pragma unroll
        for (int r = 0; r < 16; ++r) { const int kp = kbase + crow(r, hi); if (kp < lo || kp > hi_) p0[r] = -INFINITY; if (kp + 32 < lo || kp + 32 > hi_) p1[r] = -INFINITY; } }
    const float rm = rowmax(p0, p1);
    if (__builtin_amdgcn_ballot_w64(rm > m + 8.0f) != 0ull) {
        const float mn = fmaxf(m, rm), f = __builtin_amdgcn_exp2f(m - mn); m = mn;
        l *= f;
        scale_rows(o, wsf, f, r32, hi);
    }
    float ps = 0.f;
#pragma unroll
    for (int r = 0; r < 16; ++r) { p0[r] = __builtin_amdgcn_exp2f(p0[r] - m); p1[r] = __builtin_amdgcn_exp2f(p1[r] - m); ps += p0[r] + p1[r]; }
    l += ps;
    pv(o, vb, packp(p0, 0), packp(p0, 8), packp(p1, 0), packp(p1, 8));
}

DEVI void attn_unit(int b, int g, int qb, const bf16_t* Q, const bf16_t* KV, const bf16_t* KC, const bf16_t* VC, const float* gates, bf16_t* O, LAS char* shm) {
    const int tid = threadIdx.x, lane = tid & 63, r32 = lane & 31, hi = lane >> 5; const int wid = __builtin_amdgcn_readfirstlane(tid >> 6);
    const int tl = r32 >> 2, head = r32 & 3, tq0 = qb * 64, tq = tq0 + 8 * wid + tl, row = b * SEQ + tq, bg = b * 4 + g;
    const unsigned lds0 = (unsigned)(uintptr_t)shm;
    LAS float* wsf = (LAS float*)(shm + WSF) + wid * 64;
    const bf16_t* Ks = KV + 2 * KVS + (size_t)bg * SEQ * 64; const bf16_t* Vs = KV + 3 * KVS + (size_t)bg * SEQ * 64;
    const bf16_t* Kw = KV + 4 * KVS + (size_t)bg * SEQ * 64; const bf16_t* Vw = KV + 5 * KVS + (size_t)bg * SEQ * 64;
    const bf16_t* Kc = KC + (size_t)bg * 128 * 64; const bf16_t* Vc = VC + (size_t)bg * 128 * 64;
    const int koff = lane * 64 + wid * 8, voff = (16 * (wid & 3) + (lane >> 2)) * 64 + (wid >> 2) * 32 + (lane & 3) * 8;
#define ATT_DMA(Kt, Vt, slot) do { glds16((Kt) + koff, (unsigned)__builtin_amdgcn_readfirstlane(lds0 + KS0 + (slot) * 8192 + wid * 1024)); \
                                   glds16((Vt) + voff, (unsigned)__builtin_amdgcn_readfirstlane(lds0 + VS0 + (slot) * 8192 + wid * 1024)); } while (0)
#define ATT_WAITBAR() asm volatile("s_waitcnt vmcnt(0) lgkmcnt(0)\n\ts_barrier" ::: "memory")
    const int vb0 = (int)(lds0 + VS0) + ((lane >> 4) & 1) * 32 + (lane & 3) * 8 + (4 * hi + ((lane & 15) >> 2)) * 64;
    const lptr kslot0 = (lptr)(shm + KS0);
#ifdef ATT_TSEG
    unsigned long long tsa_ = __builtin_amdgcn_s_memrealtime(), tsb_ = 0, tsc_ = 0, tsd_ = 0;
#endif
    ATT_WAITBAR();
    const int nC = (qb >= 16) ? 2 : 1;
    const int wlo = qb >= 8 ? qb - 8 : 0, nW = qb - wlo + 1;
    bf16x8 qr[4];
    { const bf16_t* qp = Q + (size_t)row * DM + (4 * g + head) * 64 + 8 * hi;
#pragma unroll
      for (int d0 = 0; d0 < 4; ++d0) qr[d0] = *(const bf16x8*)(qp + 16 * d0); }
    const float* gp = gates + (size_t)row * 48 + (g * 4 + head) * 3; const float gate_c = (PROBE == 4) ? 0.f : gp[0], gate_s = (PROBE == 5) ? 0.f : gp[1], gate_w = (PROBE == 6) ? 0.f : gp[2];
    ATT_DMA(Kc, Vc, 0); if (nC == 2) ATT_DMA(Kc + 64 * 64, Vc + 64 * 64, 1);
    ATT_DMA(Kw + (size_t)wlo * 4096, Vw + (size_t)wlo * 4096, 2);
    f32x16 o[2];
    LAS float* ofl = (LAS float*)(shm + OFN) + wid * 2048;
#pragma unroll
    for (int r = 0; r < 16; ++r) { ofl[crow(r, hi) * 64 + r32] = 0.f; ofl[crow(r, hi) * 64 + 32 + r32] = 0.f; }
    unsigned selmask = (qb == 31) ? 0xffffffffu : ((2u << qb) - 1u);
    asm volatile("s_waitcnt vmcnt(2) lgkmcnt(0)\n\ts_barrier" ::: "memory");
#ifdef ATT_TSEG
    tsb_ = __builtin_amdgcn_s_memrealtime();
#endif
    {
        const int nmax = (tq - 31) >> 4;
        f32x16 pa0, pa1, pb0, pb1;
        qkt(pa0, pa1, kslot0, qr, 0.f, r32, hi);
        if (nC == 2) qkt(pb0, pb1, kslot0 + 8192, qr, 0.f, r32, hi);
#pragma unroll
        for (int r = 0; r < 16; ++r) { const int n0 = crow(r, hi); if (n0 > nmax) pa0[r] = -INFINITY; if (n0 + 32 > nmax) pa1[r] = -INFINITY; }
        float m = rowmax(pa0, pa1), ps = 0.f;
        if (nC == 2) {
#pragma unroll
            for (int r = 0; r < 16; ++r) { const int n0 = crow(r, hi); if (n0 + 64 > nmax) pb0[r] = -INFINITY; if (n0 + 96 > nmax) pb1[r] = -INFINITY; }
            m = fmaxf(m, rowmax(pb0, pb1)); }
        if (m == -INFINITY) m = 0.f;
#pragma unroll
        for (int r = 0; r < 16; ++r) { pa0[r] = __builtin_amdgcn_exp2f(pa0[r] - m); pa1[r] = __builtin_amdgcn_exp2f(pa1[r] - m); ps += pa0[r] + pa1[r]; }
        if (nC == 2) {
#pragma unroll
            for (int r = 0; r < 16; ++r) { pb0[r] = __builtin_amdgcn_exp2f(pb0[r] - m); pb1[r] = __builtin_amdgcn_exp2f(pb1[r] - m); ps += pb0[r] + pb1[r]; } }
        ps += xlane32(ps);
        const float inv = ps > 0.f ? __builtin_amdgcn_rcpf(ps) : 0.f;
#pragma unroll
        for (int r = 0; r < 16; ++r) { o[0][r] = 0.f; o[1][r] = 0.f; }
        pv(o, vb0, packp(pa0, 0), packp(pa0, 8), packp(pa1, 0), packp(pa1, 8));
        if (nC == 2) pv(o, vb0 + 8192, packp(pb0, 0), packp(pb0, 8), packp(pb1, 0), packp(pb1, 8));
        fold_rows(o, ofl, wsf, gate_c * inv, r32, hi);
        if (qb >= 16) {
#define ATT_QSUM(x) do { float t_ = (x) * inv; t_ += __builtin_bit_cast(float, __builtin_amdgcn_update_dpp(0, __builtin_bit_cast(int, t_), 0xB1, 0xf, 0xf, false)); \
                         t_ += __builtin_bit_cast(float, __builtin_amdgcn_update_dpp(0, __builtin_bit_cast(int, t_), 0x4E, 0xf, 0xf, false)); (x) = t_; } while (0)
#pragma unroll
            for (int r = 0; r < 16; ++r) { ATT_QSUM(pa0[r]); ATT_QSUM(pa1[r]); ATT_QSUM(pb0[r]); ATT_QSUM(pb1[r]); }
#undef ATT_QSUM
            float sc[16], fo[16];
#define ATT_H4(h4, r) ((h4) == 0 ? pa0[r] : (h4) == 1 ? pa1[r] : (h4) == 2 ? pb0[r] : pb1[r])
#pragma unroll
            for (int h4 = 0; h4 < 4; ++h4)
#pragma unroll
                for (int gq = 0; gq < 4; ++gq) fo[h4 * 4 + gq] = xlane32(ATT_H4(h4, 4 * gq));
#pragma unroll
            for (int h4 = 0; h4 < 4; ++h4)
#pragma unroll
                for (int gq = 0; gq < 4; ++gq) {
                    const int s = h4 * 4 + gq;
                    const float nxt_lo = fo[s];
                    const float nxt_hi = (s < 15) ? fo[s + 1] : 0.f;
                    float v = ATT_H4(h4, 4 * gq) + 2.0f * (ATT_H4(h4, 4 * gq + 1) + ATT_H4(h4, 4 * gq + 2) + ATT_H4(h4, 4 * gq + 3)) + (hi ? nxt_hi : nxt_lo);
                    const int j = 8 * h4 + 2 * gq + hi;
                    if (j == 0 || j == qb || j == qb - 1) v = INFINITY; else if (j > qb) v = -INFINITY;
                    sc[s] = v; }
#undef ATT_H4
            float so[16];
#pragma unroll
            for (int s = 0; s < 16; ++s) so[s] = xlane32(sc[s]);
            float x4[4];
#pragma unroll
            for (int i = 0; i < 4; ++i) x4[i] = (head == 0) ? sc[4 * i] : (head == 1) ? sc[4 * i + 1] : (head == 2) ? sc[4 * i + 2] : sc[4 * i + 3];
            unsigned own = 0u;
#pragma unroll
            for (int i = 0; i < 4; ++i) {
                int rk = 0; const float xv = x4[i];
#pragma unroll
                for (int s2 = 0; s2 < 16; ++s2) {
                    const int g2 = s2 >> 2, q2 = s2 & 3;
                    if (g2 < i) { rk += (sc[s2] >= xv) ? 1 : 0; rk += (so[s2] >= xv) ? 1 : 0; }
                    else if (g2 > i) { rk += (sc[s2] > xv) ? 1 : 0; rk += (so[s2] > xv) ? 1 : 0; }
                    else { const bool lt = q2 < head, eq = q2 == head;
                        rk += eq ? 0 : (lt ? ((sc[s2] >= xv) ? 1 : 0) : ((sc[s2] > xv) ? 1 : 0));
                        rk += (lt || (eq && hi)) ? ((so[s2] >= xv) ? 1 : 0) : ((so[s2] > xv) ? 1 : 0); }
                }
                if (rk < 16) own |= 1u << (8 * i);
            }
            own <<= 2 * head;
            own |= (unsigned)__builtin_amdgcn_update_dpp(0, (int)own, 0xB1, 0xf, 0xf, false);
            own |= (unsigned)__builtin_amdgcn_update_dpp(0, (int)own, 0x4E, 0xf, 0xf, false);
            own <<= hi;
            selmask = own | (unsigned)__shfl_xor((int)own, 32);
        }
    }
    unsigned uni = selmask, wuni = selmask;
    if (qb >= 16) {
#pragma unroll
        for (int off = 1; off < 64; off <<= 1) uni |= (unsigned)__shfl_xor((int)uni, off);
        wuni = (unsigned)__builtin_amdgcn_readfirstlane((int)uni);
        LAS unsigned* uw = (LAS unsigned*)(shm + UNI);
        if (lane == 0) uw[wid] = uni;
        ATT_WAITBAR();
        uni = 0u;
#pragma unroll
        for (int w = 0; w < 8; ++w) uni |= uw[w];
        uni = (unsigned)__builtin_amdgcn_readfirstlane((int)uni);
    } else { ATT_WAITBAR(); }
#ifdef ATT_TSEG
    tsc_ = __builtin_amdgcn_s_memrealtime();
#endif
    const unsigned smask = uni & ((qb == 31) ? 0xffffffffu : ((2u << qb) - 1u));
    const int nS = __builtin_popcount(smask), nT = nW + nS;
    unsigned rem_issue = smask, rem_qk = smask;
#define ATT_ISSUE(tt) do { const int sl_ = ((tt) + 2) % 3; \
        if ((tt) < nW) { const int j_ = wlo + (tt); ATT_DMA(Kw + (size_t)j_ * 4096, Vw + (size_t)j_ * 4096, sl_); } \
        else { const int j_ = __builtin_ctz(rem_issue); rem_issue &= rem_issue - 1u; ATT_DMA(Ks + (size_t)j_ * 4096, Vs + (size_t)j_ * 4096, sl_); } } while (0)
    if (nT > 1) ATT_ISSUE(1);
    ATT_WAITBAR();
    if (nT > 2) ATT_ISSUE(2);
    float mref = 0.f, l = 0.f;
#pragma unroll
    for (int r = 0; r < 16; ++r) { o[0][r] = 0.f; o[1][r] = 0.f; }
    f32x16 pc0, pc1, negm;
#pragma unroll
    for (int r = 0; r < 16; ++r) negm[r] = 0.f;
    qk2(pc0, pc1, kslot0 + 2 * 8192, qr, negm, r32, hi);
    int jc = wlo; bool cS = false, cskip = false;
    for (int t = 0; t < nT; ++t) {
        const bool hasn = t + 1 < nT; int jn = 0; bool nSel = false, nskip = true;
        if (hasn) { if (t + 1 < nW) { jn = wlo + t + 1; nskip = false; } else { jn = __builtin_ctz(rem_qk); rem_qk &= rem_qk - 1u; nSel = true; nskip = ((wuni >> jn) & 1u) == 0u; } }
        if (t > 0) { ATT_WAITBAR(); if (t + 2 < nT) ATT_ISSUE(t + 2); }
        f32x16 pn0, pn1;
        if (!nskip) {
            const float nm = (nSel && ((selmask >> jn) & 1u) == 0u) ? -INFINITY : -mref;
#pragma unroll
            for (int r = 0; r < 16; ++r) negm[r] = nm;
            qk2(pn0, pn1, kslot0 + ((t + 3) % 3) * 8192, qr, negm, r32, hi);
        }
        if (!cskip) {
            const bool dm = cS ? (jc == qb) : ((jc == qb) || (jc + 8 == qb));
            if (dm) { const int lo = cS ? 0 : tq - 511, kbase = 64 * jc;
#pragma unroll
                for (int r = 0; r < 16; ++r) { const int kp = kbase + crow(r, hi); if (kp < lo || kp > tq) pc0[r] = -INFINITY; if (kp + 32 < lo || kp + 32 > tq) pc1[r] = -INFINITY; } }
            const float rm = rowmax3(pc0, pc1);
            if (__builtin_amdgcn_ballot_w64(rm > 8.0f) != 0ull) {
                const float dl = fmaxf(rm, 0.f), f = __builtin_amdgcn_exp2f(-dl); mref += dl; l *= f;
#pragma unroll
                for (int r = 0; r < 16; ++r) { pc0[r] -= dl; pc1[r] -= dl; }
                if (!nskip) {
#pragma unroll
                    for (int r = 0; r < 16; ++r) { pn0[r] -= dl; pn1[r] -= dl; } }
                scale_rows(o, wsf, f, r32, hi);
            }
            float ps = 0.f;
#pragma unroll
            for (int r = 0; r < 16; ++r) { pc0[r] = __builtin_amdgcn_exp2f(pc0[r]); pc1[r] = __builtin_amdgcn_exp2f(pc1[r]); ps = (ps + pc0[r]) + pc1[r]; }
            l += ps;
            pv(o, vb0 + ((t + 2) % 3) * 8192, packp(pc0, 0), packp(pc0, 8), packp(pc1, 0), packp(pc1, 8));
        }
        if (t + 1 == nW) {
            l += xlane32(l); fold_rows(o, ofl, wsf, gate_w * (l > 0.f ? __builtin_amdgcn_rcpf(l) : 0.f), r32, hi);
#pragma unroll
            for (int r = 0; r < 16; ++r) { o[0][r] = 0.f; o[1][r] = 0.f; }
            l = 0.f; }
        pc0 = pn0; pc1 = pn1; jc = jn; cS = nSel; cskip = nskip;
    }
#undef ATT_ISSUE
    l += xlane32(l); fold_rows(o, ofl, wsf, gate_s * (l > 0.f ? __builtin_amdgcn_rcpf(l) : 0.f), r32, hi);
#ifdef ATT_TSEG
    tsd_ = __builtin_amdgcn_s_memrealtime();
    { const unsigned long long seg_ = (ATT_TSEG == 1) ? (tsb_ - tsa_) : (ATT_TSEG == 2) ? (tsc_ - tsb_) : (tsd_ - tsc_);
      LAS unsigned* tw_ = (LAS unsigned*)(shm + UNI + 64) + wid; if (lane == 0) tw_[0] += (unsigned)seg_; }
#endif
    {
#pragma unroll
      for (int i = 0; i < 4; ++i) { const int q = i * 8 + (lane >> 3), chn = lane & 7; const f32x4 v0 = *(const LAS f32x4*)(ofl + q * 64 + chn * 8), v1 = *(const LAS f32x4*)(ofl + q * 64 + chn * 8 + 4);
          u32x4 v; v.x = pk2(v0[0], v0[1]); v.y = pk2(v0[2], v0[3]); v.z = pk2(v1[0], v1[1]); v.w = pk2(v1[2], v1[3]);
          *(u32x4*)(O + (size_t)(b * SEQ + tq0 + 8 * wid + (q >> 2)) * DM + (4 * g + (q & 3)) * 64 + chn * 8) = v; }
      LDS_WAIT(); }
#undef ATT_DMA
#undef ATT_WAITBAR
}
DEVI void attn_phase(const Frame& F, const Args& args) {
    const bf16_t* Q = (const bf16_t*)(F.ws + WS_Q); const bf16_t* KV = (const bf16_t*)(F.ws + WS_KV); const bf16_t* KC = (const bf16_t*)(F.ws + WS_KC); const bf16_t* VC = (const bf16_t*)(F.ws + WS_VC);
    const float* gates = (const float*)(F.ws + WS_GATES); bf16_t* O = (bf16_t*)(F.ws + WS_O);
#if PROBE == 1
    { u32x4* z = (u32x4*)O; for (size_t i = (size_t)F.vcu * 512 + F.tid; i < (size_t)NTOK * DM / 8; i += (size_t)F.G * 512) z[i] = (u32x4){0u, 0u, 0u, 0u}; return; }
#endif
#ifdef ATT_TSEG
    { LAS unsigned* tw_ = (LAS unsigned*)(F.lds + RING_OFF + UNI + 64); if (F.tid < 8) tw_[F.tid] = 0u; asm volatile("s_waitcnt lgkmcnt(0)\n\ts_barrier" ::: "memory"); }
#endif
    for (int i = 0;; ++i) {
        const int idx = (i / ATT_REP) * F.G + F.vcu; if (idx >= 2048) break;
        const int ii = idx >> 8, bgq = idx & 255, bg = bgq >> 2, qt = bgq & 3;
        const int qbc = (ii & 1) ? (8 * (ii >> 1) + 7 - qt) : (8 * (ii >> 1) + qt);
        attn_unit(bg >> 2, bg & 3, qbc, Q, KV, KC, VC, gates, O, (LAS char*)(F.lds + RING_OFF));
        const int qb = qbc;
        (void)qb;
    }
    asm volatile("s_waitcnt vmcnt(0) lgkmcnt(0)\n\ts_barrier" ::: "memory");
#ifdef ATT_TSEG
    { LAS unsigned* tw_ = (LAS unsigned*)(F.lds + RING_OFF + UNI + 64); const unsigned long long d_ = (unsigned long long)tw_[0] * 3ull; const unsigned long long t1_ = __builtin_amdgcn_s_memrealtime();
      while (__builtin_amdgcn_s_memrealtime() - t1_ < d_) __builtin_amdgcn_s_sleep(8); }
#endif
}
}

#ifndef PH_MASK
#define PH_MASK 0xffffffffu
#endif
#ifndef REP_MASK
#define REP_MASK 0u
#endif
#define PH(k) (((PH_MASK) >> (k)) & 1u)
#define REPB(k) (((REP_MASK) >> (k)) & 1u)
#define GRID_BAR() xcd_barrier(bar)
#define REFRESH() do { int t_ = threadIdx.x; asm volatile("" : "+v"(t_)); F.tid = t_; F.lane = t_ & 63; F.wave = __builtin_amdgcn_readfirstlane(t_ >> 6); } while (0)
template <int K, int L>
DEVI void phase(Frame& F, const Args& args, int nblk) {
    unsigned char* ws = args.ws;
    LAS unsigned char* ring = F.lds + RING_OFF;
    bf16_t* const HA = (bf16_t*)(ws + WS_HA); bf16_t* const HB = (bf16_t*)(ws + WS_HB);
    bf16_t* const hin = (L == 0) ? HA : HB;
    bf16_t* const hmx = (L == 0) ? HB : HA;
    REFRESH();
    if constexpr (K == 0) p0_prologue(F, args);
    if constexpr (K == 2) { ProbPw1 P; P.A = (const char*)HA; P.Bt = (const char*)(ws + WS_WPW1); P.K = DM; P.ldb = 2048; P.G = F.G; P.c = F.vcu;
          P.rstd = (const float*)(ws + WS_RS0); P.bias = args.in[7]; P.U = (bf16_t*)(ws + WS_U);
          pg8::gemm_phase(ring, P); }
    if constexpr (K == 3) {
        if (F.vcu & 1) { prep_layer(F, args, 0); wg_sync(); conv_phase(F, args); }
        else { conv_phase(F, args); wg_sync(); prep_layer(F, args, 0); } }
    if constexpr (K == 4) { ProbRes P; P.A = (const char*)(ws + WS_V); P.Bt = (const char*)(ws + WS_WPW2); P.K = DM; P.ldb = 2048; P.G = F.G; P.c = F.vcu;
          P.RES = HA; P.OUT = HB; P.bias = args.in[13];
          pg8::gemm_phase(ring, P); }
    if constexpr (K == 5) { ProbWin P; P.A = (const char*)HB; P.Bt = (const char*)(ws + WS_WIN); P.K = DM; P.ldb = 2048; P.G = F.G; P.c = F.vcu;
          P.rstd = (const float*)(ws + WS_SSQ); P.rope = (const float*)(ws + WS_ROPE); P.qnorm = args.in[15]; P.knorm = args.in[16];
          P.Q = (bf16_t*)(ws + WS_Q); P.KV = (bf16_t*)(ws + WS_KV); P.gates = (float*)(ws + WS_GATES);
          { LAS float* lr = (LAS float*)(F.lds + SCR_OFF);
            for (int idx = F.tid; idx < 8 * 256; idx += 512) { const int Lq = (idx >> 8) * F.G + F.vcu;
                if (Lq < 128 * 11) { const f32x4* pp = (const f32x4*)(P.rstd + (size_t)((Lq / 11) * 256 + (idx & 255)) * 16); const f32x4 st = (pp[0] + pp[1]) + (pp[2] + pp[3]);
                    lr[idx] = 1.0f / sqrtf(((st[0] + st[1]) + (st[2] + st[3])) * (1.0f / DM) + EPS); } }
            wg_sync(); P.lrs = lr; }
          pg8::gemm_phase(ring, P); }
    if constexpr (K == 6) { ProbCmp P; P.A = (const char*)(ws + WS_KV); P.Bt = (const char*)(ws + WS_WC1); P.K = 512; P.ldb = 4096; P.G = F.G; P.c = F.vcu;
          P.CP = (float*)(ws + WS_CP);
          pg8::gemm_phase(ring, P); }
    if constexpr (K == 7) cmpb_phase(F, args);
    if constexpr (K == 8) {
        if (F.vcu & 1) { prep_layer(F, args, 1); wg_sync(); REFRESH(); }
        att::attn_phase(F, args);
        if (!(F.vcu & 1)) { REFRESH(); prep_layer(F, args, 1); } }
    if constexpr (K == 9) { ProbRes P; P.A = (const char*)(ws + WS_O); P.Bt = (const char*)(ws + WS_WOUT); P.K = DM; P.ldb = 2048; P.G = F.G; P.c = F.vcu;
          P.RES = HB; P.OUT = HA; P.bias = nullptr;
          pg8::gemm_phase(ring, P); }
    if constexpr (K == 11) router_phase(F, args, L, hmx);
    if constexpr (K == 12) fill_phase(F);
    if constexpr (K == 13) { ProbGateUp P; P.A = (const char*)hmx; P.Bt = (const char*)(ws + WS_WGU); P.K = DM; P.ldb = 2048; P.G = F.G; P.c = F.vcu;
          P.tab_row = (const LAS int*)(F.lds + TAB_OFF); P.tab_ev = P.tab_row + 320; P.nblk = nblk;
          P.slot_rs = (const float*)(ws + WS_SRS); P.HBUF = (bf16_t*)(ws + WS_HBUF);
          { LAS unsigned* go = (LAS unsigned*)(F.lds + SCR_OFF); const int* stok = (const int*)(ws + WS_STOK);
            for (int idx = F.tid; idx < 8 * 256; idx += 512) { const int Lq = (idx >> 8) * F.G + F.vcu; if (Lq < nblk * 4) go[idx] = (unsigned)stok[P.tab_row[Lq >> 2] + (idx & 255)] * 2048u; }
            wg_sync(); P.goff = go; }
          pg8::gemm_phase(ring, P);
          ProbPP Q2; Q2.A = (const char*)(ws + WS_PB); Q2.Bt = (const char*)(ws + WS_WPP) + (size_t)L * DM * PLE * 2; Q2.K = PLE; Q2.ldb = 512; Q2.G = F.G; Q2.c = F.vcu;
          Q2.O = (bf16_t*)(ws + WS_PP);
          { const int nun = nblk * 4, maxu = (nun + F.G - 1) / F.G; int tl = nun - (maxu - 1) * F.G; if (tl >= F.G || tl < 0) tl = 0; Q2.tail_lo = tl; }
          pg8::gemm_phase(ring, Q2); }
    if constexpr (K == 14) { ProbDown P; P.A = (const char*)(ws + WS_HBUF); P.Bt = (const char*)(ws + WS_WDN); P.K = DEXP; P.ldb = 1024; P.G = F.G; P.c = F.vcu;
          P.tab_row = (const LAS int*)(F.lds + TAB_OFF); P.tab_ev = P.tab_row + 320; P.nblk = nblk;
          P.slot_w = (const float*)(ws + WS_SW); P.YB = (bf16_t*)(ws + WS_YB);
          pg8::gemm_phase(ring, P); }
    if constexpr (K == 15) combine_phase(F, hmx, hin, (PROBE == 2 && L == 1) || (PROBE == 3 && L == 0));
#ifdef STAGGER_US
    if constexpr (K == STAGGER_PH) { if (F.vcu & 1) { const unsigned long long t0_ = __builtin_amdgcn_s_memrealtime(); while (__builtin_amdgcn_s_memrealtime() - t0_ < (unsigned long long)(STAGGER_US) * 100ull) __builtin_amdgcn_s_sleep(8); } }
#endif
    if constexpr (K == 16) { ProbPle P; P.A = (const char*)hin; P.Bt = (const char*)(ws + WS_WPG) + (size_t)L * DM * DM * 2; P.K = DM; P.ldb = 2048; P.G = F.G; P.c = F.vcu;
          P.H2 = hin; P.PPp = (const bf16_t*)(ws + WS_PP); P.rstd = (const float*)(ws + WS_RS2); P.OUTB = hmx; P.OUTF = args.out; P.ssq = (float*)(ws + WS_SSQ); P.last = L;
          pg8::gemm_phase(ring, P); }
}
#if defined(TPHASE)
#define PHASE(k) do { const bool tp_ = ((k) == TPHASE) && (L == TLAYER); const unsigned long long t0_ = tp_ ? __builtin_amdgcn_s_memrealtime() : 0ull; \
    if (PH(k)) phase<k, L>(F, args, nblk); \
    if (tp_) { asm volatile("s_waitcnt vmcnt(0) lgkmcnt(0)" ::: "memory"); const unsigned long long t1_ = __builtin_amdgcn_s_memrealtime(); const unsigned long long d_ = (t1_ - t0_) * TALPHA; \
        while (__builtin_amdgcn_s_memrealtime() - t1_ < d_) __builtin_amdgcn_s_sleep(8); } } while (0)
#else
#define PHASE(k) do { if (PH(k)) phase<k, L>(F, args, nblk); if (PH(k) && REPB(k)) phase<k, L>(F, args, nblk); } while (0)
#endif
template <int L>
DEVI void layer_program(Frame& F, const Args& args, const XcdBarrier& bar) {
    int nblk = 0;
    if (L == 0) {
        PHASE(2); GRID_BAR();
        PHASE(3); GRID_BAR();
        PHASE(4);
    } else {
        PHASE(5); GRID_BAR();
        PHASE(6); GRID_BAR();
        PHASE(7); GRID_BAR();
        PHASE(8); GRID_BAR();
        PHASE(9);
    }
    GRID_BAR();
    PHASE(11); GRID_BAR();
    PHASE(12); GRID_BAR();
    REFRESH(); nblk = build_moe_table(F);
    PHASE(13); GRID_BAR();
    PHASE(14); GRID_BAR();
    PHASE(15); GRID_BAR();
    PHASE(16);
    if (L == 0) GRID_BAR();
}
__global__ void __launch_bounds__(NWAVES * 64, 2) hybrid_fwd(Args args) {
    extern __shared__ __attribute__((aligned(16))) unsigned char lds[];
    Frame F;
    F.lds = (LAS unsigned char*)lds; F.ws = args.ws; F.ctl = (gu32*)(args.ws + WS_CTL);
    F.tid = threadIdx.x; F.lane = F.tid & 63; F.wave = __builtin_amdgcn_readfirstlane(F.tid >> 6);
    F.G = gridDim.x; { const int bx = blockIdx.x; F.vcu = (F.G % 8 == 0) ? (bx % 8) * (F.G / 8) + bx / 8 : bx; }
    for (int u = F.tid; u < (LDS_BYTES - LDSCTL_OFF) / 4; u += NWAVES * 64) ((LAS unsigned*)(F.lds + LDSCTL_OFF))[u] = 0u;
    __syncthreads();
    XcdBarrier bar = xcd_barrier_post((unsigned*)(F.ctl + CW_BAR), (volatile LAS unsigned*)(F.lds + MISC_OFF) + 8);
    { constexpr int L = 0; const int nblk = 0; PHASE(0); }
    GRID_BAR();
#ifdef EXTRA_BARS
    GRID_BAR(); GRID_BAR(); GRID_BAR(); GRID_BAR(); GRID_BAR(); GRID_BAR(); GRID_BAR(); GRID_BAR(); GRID_BAR(); GRID_BAR();
#endif
    layer_program<0>(F, args, bar);
    layer_program<1>(F, args, bar);
}
#undef GRID_BAR

extern "C" void kernel_launch(void* const* d_in, const int* in_sizes, int n_in, void* d_out, int out_size, void* d_ws, size_t ws_size, hipStream_t stream) {
    static int grid = 0;
    if (grid == 0) {
        if (n_in != 30 || out_size != NTOK * DM || ws_size < WS_END) { fprintf(stderr, "kernel_launch: unexpected shapes (n_in %d, out %d, ws %zu < %zu)\n", n_in, out_size, ws_size, (size_t)WS_END); grid = -1; return; }
        int dev = 0, cus = 0, per_cu = 0;
        if (hipGetDevice(&dev) != hipSuccess || hipDeviceGetAttribute(&cus, hipDeviceAttributeMultiprocessorCount, dev) != hipSuccess) { grid = -1; return; }
        if (hipFuncSetAttribute((const void*)hybrid_fwd, hipFuncAttributeMaxDynamicSharedMemorySize, LDS_BYTES) != hipSuccess) { fprintf(stderr, "kernel_launch: hipFuncSetAttribute failed\n"); grid = -1; return; }
        if (hipOccupancyMaxActiveBlocksPerMultiprocessor(&per_cu, (const void*)hybrid_fwd, NWAVES * 64, LDS_BYTES) != hipSuccess || per_cu < 1)
            fprintf(stderr, "kernel_launch: occupancy query reports %d workgroups per CU\n", per_cu);
        (void)hipGetLastError();
        grid = cus;
    }
    if (grid < 0) return;
    if (hipMemsetAsync((char*)d_ws + WS_CTL, 0, CTL_ZERO_BYTES, stream) != hipSuccess) return;
    Args a{};
    for (int i = 0; i < 30; ++i) a.in[i] = (const float*)d_in[i];
    a.out = (float*)d_out; a.ws = (unsigned char*)d_ws;
    for (int i = 0; i < 32; ++i) { const float p = powf(10000.0f, (float)i / 32.0f); a.inv_freq[i] = 1.0f / p; }
    hipLaunchKernelGGL(hybrid_fwd, dim3(grid), dim3(NWAVES * 64), LDS_BYTES, stream, a);
}
```

```cpp
#define PROBE 0
#define REP_MASK 0u
#include <hip/hip_runtime.h>
#include <hip/hip_bf16.h>
#include <cstdio>
#include <cstdint>
#include <cmath>

#ifndef PROBE
#define PROBE 0
#endif
#define DEVI __device__ __forceinline__
#define GAS __attribute__((address_space(1)))
#define LAS __attribute__((address_space(3)))
typedef unsigned short bf16_t;
typedef short bf16x8 __attribute__((ext_vector_type(8)));
typedef short s16x4 __attribute__((ext_vector_type(4)));
typedef float f32x2 __attribute__((ext_vector_type(2)));
typedef float f32x4 __attribute__((ext_vector_type(4)));
typedef float f32x16 __attribute__((ext_vector_type(16)));
typedef unsigned u32x2 __attribute__((ext_vector_type(2)));
typedef unsigned u32x4 __attribute__((ext_vector_type(4)));
typedef __bf16 bf16x2_t __attribute__((ext_vector_type(2)));
typedef GAS unsigned gu32;

#define LDS_WAIT() asm volatile("s_waitcnt lgkmcnt(0)" ::: "memory")
#define VM_WAIT() asm volatile("s_waitcnt vmcnt(0)" ::: "memory")
#define RLX_AGENT __ATOMIC_RELAXED, __HIP_MEMORY_SCOPE_AGENT

DEVI unsigned pk2(float lo, float hi) { f32x2 v = {lo, hi}; bf16x2_t b = __builtin_convertvector(v, bf16x2_t); return __builtin_bit_cast(unsigned, b); }
DEVI float bflo(unsigned u) { return __uint_as_float(u << 16); }
DEVI float bfhi(unsigned u) { return __uint_as_float(u & 0xffff0000u); }
DEVI f32x4 unpack4(u32x2 w) { return (f32x4){bflo(w.x), bfhi(w.x), bflo(w.y), bfhi(w.y)}; }
DEVI u32x2 pack4(f32x4 v) { u32x2 w; w.x = pk2(v[0], v[1]); w.y = pk2(v[2], v[3]); return w; }
DEVI float sigmoid_f(float x) { return __builtin_amdgcn_rcpf(1.0f + __expf(-x)); }
DEVI const char* sgpr_ptr(const char* p) { const unsigned long long u = (unsigned long long)p; const unsigned lo = (unsigned)__builtin_amdgcn_readfirstlane((int)(unsigned)u), hi = (unsigned)__builtin_amdgcn_readfirstlane((int)(unsigned)(u >> 32)); return (const char*)(((unsigned long long)hi << 32) | lo); }
DEVI float wave_sum(float v) {
#pragma unroll
    for (int o = 1; o < 64; o <<= 1) v += __shfl_xor(v, o);
    return v;
}

namespace pg8 {
constexpr int BM = 256, BK = 64, HALF = 128, HTB = HALF * BK * 2  , STAGE_BYTES = 8 * HTB;
DEVI int lds_byte(int r, int c) { const int st = (r >> 4) * 2 + (c >> 5), rr = r & 15, cc = c & 31, ob = rr * 64 + cc * 2; return st * 1024 + (ob ^ (((ob >> 9) & 1) << 5)); }
DEVI void stage_rc(int b, int& R, int& C) { const int st = b / 1024, sb = b % 1024, swz = sb ^ (((sb >> 9) & 1) << 5); R = (st >> 1) * 16 + swz / 64; C = (st & 1) * 32 + (swz % 64) / 2; }
struct Unit { int pm, pn, e, v; };

template <class P>
DEVI void gemm_phase(LAS unsigned char* lds, const P& S) {
    int tid = threadIdx.x; asm volatile("" : "+v"(tid));
    const int wid = __builtin_amdgcn_readfirstlane(tid >> 6), lane = tid & 63, wr = wid >> 2, wc = wid & 3, fr = lane & 15, fq = lane >> 4;
    const int nt = S.K / BK;
    int Rp[2], Cp[2]; unsigned voffB[2];
#pragma unroll
    for (int i = 0; i < 2; ++i) { stage_rc(tid * 16 + i * 8192, Rp[i], Cp[i]); voffB[i] = (unsigned)Rp[i] * S.ldb + (unsigned)Cp[i] * 2u; }
    const size_t hstepB = (size_t)HALF * S.ldb;
    const unsigned ldsw = (unsigned)wid * 1024u;
    const int aoff = lds_byte(wr * 64 + fr, fq * 8), boff = lds_byte(wc * 32 + fr, fq * 8);
    const char* const Abase = S.A;
#define PG8_SA(b, h) (((b) * 2 + (h)) * HTB)
#define PG8_SB(b, h) ((4 + (b) * 2 + (h)) * HTB)
#define PG8_STAGE_A(bufoff, ao, sp) do { _Pragma("unroll") for (int _i = 0; _i < 2; ++_i) \
        __builtin_amdgcn_global_load_lds((const unsigned*)((sp) + (ao)[_i]), (LAS unsigned*)(lds + (bufoff) + ldsw + _i * 8192), 16, 0, 0); } while (0)
#define PG8_PIN(p) do { (p) = sgpr_ptr(p); asm volatile("" : "+s"(p)); } while (0)
#define PG8_STAGE_B(bufoff, bp) do { _Pragma("unroll") for (int _i = 0; _i < 2; ++_i) \
        __builtin_amdgcn_global_load_lds((const unsigned*)((bp) + voffB[_i]), (LAS unsigned*)(lds + (bufoff) + ldsw + _i * 8192), 16, 0, 0); } while (0)
#define PG8_LDA(dst, b, h) do { _Pragma("unroll") for (int m = 0; m < 4; ++m) _Pragma("unroll") for (int k = 0; k < 2; ++k) dst[m][k] = *(const LAS bf16x8*)(lds + PG8_SA(b, h) + aoff + m * 2048 + k * 1024); } while (0)
#define PG8_LDB(dst, b, h) do { _Pragma("unroll") for (int n = 0; n < 2; ++n) _Pragma("unroll") for (int k = 0; k < 2; ++k) dst[n][k] = *(const LAS bf16x8*)(lds + PG8_SB(b, h) + boff + n * 2048 + k * 1024); } while (0)
#define PG8_MMA(ai, bj, At, Bt) do { __builtin_amdgcn_s_setprio(1); _Pragma("unroll") for (int m = 0; m < 4; ++m) _Pragma("unroll") for (int n = 0; n < 2; ++n) _Pragma("unroll") for (int k = 0; k < 2; ++k) \
        acc[ai][bj][m][n] = __builtin_amdgcn_mfma_f32_16x16x32_bf16(Bt[n][k], At[m][k], acc[ai][bj][m][n], 0, 0, 0); __builtin_amdgcn_s_setprio(0); } while (0)
#define PG8_WAIT_V(n) asm volatile("s_waitcnt vmcnt(" #n ")" ::: "memory")
#define PG8_WAIT_L(n) asm volatile("s_waitcnt lgkmcnt(" #n ")" ::: "memory")
#define PG8_BAR __builtin_amdgcn_s_barrier()
#define PG8_SCHED __builtin_amdgcn_sched_barrier(0)
    Unit cur, nxt; int ui = 0;
    if (!S.next(0, cur)) return;
    f32x4 acc[2][2][4][2];
#pragma unroll
    for (int a = 0; a < 2; ++a)
#pragma unroll
        for (int b = 0; b < 2; ++b)
#pragma unroll
            for (int m = 0; m < 4; ++m)
#pragma unroll
                for (int n = 0; n < 2; ++n) acc[a][b][m][n] = (f32x4){0.f, 0.f, 0.f, 0.f};
    bf16x8 At[4][2], B0[2][2], B1[2][2];
    unsigned ac0[2], ac1[2], an0[2], an1[2];
#pragma unroll
    for (int i = 0; i < 2; ++i) { ac0[i] = S.a_off(cur, Rp[i]) + (unsigned)Cp[i] * 2u; ac1[i] = S.a_off(cur, Rp[i] + HALF) + (unsigned)Cp[i] * 2u; }
    const char* cB = S.Bt + S.b_off(cur);
    { const char* q0 = cB; const char* q1 = cB + hstepB; const char* q2 = Abase; const char* q3 = cB + 128; const char* q4 = Abase + 128; const char* q5 = cB + hstepB + 128;
      PG8_PIN(q0); PG8_PIN(q1); PG8_PIN(q2); PG8_PIN(q3); PG8_PIN(q4); PG8_PIN(q5);
    PG8_STAGE_B(PG8_SB(0, 0), q0); PG8_STAGE_B(PG8_SB(0, 1), q1); PG8_STAGE_A(PG8_SA(0, 0), ac0, q2); PG8_STAGE_A(PG8_SA(0, 1), ac1, q2);
    if (wr == 1) PG8_BAR;
    PG8_WAIT_V(2); PG8_BAR;
    PG8_STAGE_B(PG8_SB(1, 0), q3); PG8_STAGE_A(PG8_SA(1, 0), ac0, q4); PG8_STAGE_B(PG8_SB(1, 1), q5);
    PG8_WAIT_V(6); PG8_BAR; }
    for (;;) {
        const bool has_next = S.next(ui + 1, nxt);
        const char* nB = cB;
        if (has_next) {
#pragma unroll
            for (int i = 0; i < 2; ++i) { an0[i] = S.a_off(nxt, Rp[i]) + (unsigned)Cp[i] * 2u; an1[i] = S.a_off(nxt, Rp[i] + HALF) + (unsigned)Cp[i] * 2u; }
            nB = S.Bt + S.b_off(nxt);
        } else {
#pragma unroll
            for (int i = 0; i < 2; ++i) { an0[i] = ac0[i]; an1[i] = ac1[i]; }
        }
        for (int t = 0; t < nt; t += 2) {
            const bool last = (t == nt - 2);
            unsigned a20[2], a21[2];
#pragma unroll
            for (int i = 0; i < 2; ++i) { a20[i] = last ? an0[i] : ac0[i]; a21[i] = last ? an1[i] : ac1[i]; }
            const int k1 = (t + 1) * 128, k2 = last ? 0 : (t + 2) * 128;
            const char* b2 = last ? nB : cB + (size_t)(t + 2) * 128; const char* b3 = b2 + 128; const char* b2h = b2 + hstepB; const char* b3h = b3 + hstepB;
            const char* pa1 = Abase + k1; const char* pa2 = Abase + k2; const char* pa3 = pa2 + 128;
            PG8_PIN(b2); PG8_PIN(b3); PG8_PIN(b2h); PG8_PIN(b3h); PG8_PIN(pa1); PG8_PIN(pa2); PG8_PIN(pa3);
            PG8_LDB(B0, 0, 0); PG8_LDB(B1, 0, 1); PG8_SCHED; PG8_LDA(At, 0, 0); PG8_STAGE_A(PG8_SA(1, 1), ac1, pa1);
            PG8_WAIT_V(8); PG8_WAIT_L(0); PG8_BAR; PG8_MMA(0, 0, At, B0); PG8_MMA(0, 1, At, B1); PG8_BAR; PG8_SCHED;
            PG8_LDA(At, 0, 1); PG8_STAGE_B(PG8_SB(0, 0), b2); PG8_STAGE_B(PG8_SB(0, 1), b2h); PG8_STAGE_A(PG8_SA(0, 0), a20, pa2);
            PG8_WAIT_V(8); PG8_WAIT_L(0); PG8_BAR; PG8_MMA(1, 0, At, B0); PG8_MMA(1, 1, At, B1); PG8_BAR; PG8_SCHED;
            PG8_LDB(B0, 1, 0); PG8_LDB(B1, 1, 1); PG8_SCHED; PG8_LDA(At, 1, 0); PG8_STAGE_A(PG8_SA(0, 1), a21, pa2);
            PG8_WAIT_V(8); PG8_WAIT_L(0); PG8_BAR; PG8_MMA(0, 0, At, B0); PG8_MMA(0, 1, At, B1); PG8_BAR; PG8_SCHED;
            PG8_LDA(At, 1, 1); PG8_STAGE_B(PG8_SB(1, 0), b3); PG8_STAGE_B(PG8_SB(1, 1), b3h); PG8_STAGE_A(PG8_SA(1, 0), a20, pa3);
            PG8_WAIT_V(8); PG8_WAIT_L(0); PG8_BAR; PG8_MMA(1, 0, At, B0); PG8_MMA(1, 1, At, B1); PG8_BAR; PG8_SCHED;
        }
        if (wr == 0) PG8_BAR;
        S.epi(acc, cur, wr, wc, fr, fq);
        if (!has_next) break;
#pragma unroll
        for (int a = 0; a < 2; ++a)
#pragma unroll
            for (int b = 0; b < 2; ++b)
#pragma unroll
                for (int m = 0; m < 4; ++m)
#pragma unroll
                    for (int n = 0; n < 2; ++n) acc[a][b][m][n] = (f32x4){0.f, 0.f, 0.f, 0.f};
        cur = nxt; cB = nB; ++ui;
#pragma unroll
        for (int i = 0; i < 2; ++i) { ac0[i] = an0[i]; ac1[i] = an1[i]; }
        if (wr == 1) PG8_BAR;
    }
    PG8_WAIT_V(0);
    PG8_BAR;
#undef PG8_SA
#undef PG8_SB
#undef PG8_STAGE_A
#undef PG8_STAGE_B
#undef PG8_PIN
#undef PG8_LDA
#undef PG8_LDB
#undef PG8_MMA
#undef PG8_WAIT_V
#undef PG8_WAIT_L
#undef PG8_BAR
#undef PG8_SCHED
}
}
#define XB_TMO      128
#define XB_XCNT(j)  (256  + 64 * (j))
#define XB_XSUB(j)  (1280 + 64 * (j))
#define XB_XGEN(j)  (2304 + 64 * (j))
#define XB_TOP      3328
#define XB_TOPGEN   3392
#define XCD_BAR_WORDS 3456
#define XB_SPIN_CAP (1u << 18)

__device__ __forceinline__ unsigned xb_ld(unsigned* p)              { return __hip_atomic_load(p, __ATOMIC_RELAXED, __HIP_MEMORY_SCOPE_AGENT); }
__device__ __forceinline__ unsigned xb_add(unsigned* p, unsigned v) { return __hip_atomic_fetch_add(p, v, __ATOMIC_RELAXED, __HIP_MEMORY_SCOPE_AGENT); }
__device__ __forceinline__ unsigned xb_xcc_id() { return (unsigned)__builtin_amdgcn_s_getreg((3 << 11) | 20) & 0xFu; }
#define XB_SPIN(cond, bar) do { unsigned _sp = 0; while (cond) { __builtin_amdgcn_s_sleep(1); \
    if ((++_sp & 255u) == 0u) { if (xb_ld(&(bar)[XB_TMO])) break; if (_sp > XB_SPIN_CAP) { atomicAdd(&(bar)[XB_TMO], 1u); break; } } } } while (0)

struct XcdBarrier {
    unsigned* bar; unsigned x;
    volatile LAS unsigned* st;
};

__device__ __forceinline__ XcdBarrier xcd_barrier_post(unsigned* bar, volatile LAS unsigned* st) {
    XcdBarrier b; b.bar = bar; b.x = xb_xcc_id(); b.st = st;
    if (threadIdx.x == 0) (void)xb_add(&bar[XB_XCNT(b.x)], 1u);
    return b;
}
__device__ __forceinline__ void xcd_barrier_complete(unsigned* bar, unsigned x, unsigned& nloc, unsigned& nx) {
    const unsigned G = gridDim.x * gridDim.y * gridDim.z;
    unsigned sum, cnt, mine, sp = 0u;
    for (;;) {
        sum = 0u; cnt = 0u; mine = 0u;
#pragma unroll
        for (unsigned j = 0; j < 16; ++j) { const unsigned c = xb_ld(&bar[XB_XCNT(j)]); sum += c; cnt += (c > 0u) ? 1u : 0u; mine = (j == x) ? c : mine; }
        if (sum == G) break;
        __builtin_amdgcn_s_sleep(1);
        if ((++sp & 255u) == 0u) { if (xb_ld(&bar[XB_TMO])) break; if (sp > XB_SPIN_CAP) { atomicAdd(&bar[XB_TMO], 1u); break; } }
    }
    nloc = mine > 0u ? mine : 1u; nx = cnt > 0u ? cnt : 1u;
}

__device__ __forceinline__ void xcd_barrier(const XcdBarrier& b) {
    asm volatile("s_waitcnt vmcnt(0)" ::: "memory");
    __syncthreads();
    if (threadIdx.x == 0) {
        unsigned* bar = b.bar;
        __builtin_amdgcn_s_waitcnt(0);
        unsigned nloc = b.st[0], nx = b.st[1];
        if (nloc == 0u) { xcd_barrier_complete(bar, b.x, nloc, nx); b.st[0] = nloc; b.st[1] = nx; }
        const unsigned old = xb_add(&bar[XB_XSUB(b.x)], 1u);
        const unsigned gen = old / nloc;
        if (old + 1u == (gen + 1u) * nloc) {
            __builtin_amdgcn_fence(__ATOMIC_RELEASE, "agent");
            asm volatile("s_waitcnt vmcnt(0)" ::: "memory");
            const unsigned og = xb_add(&bar[XB_TOP], 1u);
            const unsigned tg = og / nx;
            if (og + 1u == (tg + 1u) * nx) xb_add(&bar[XB_TOPGEN], 1u);
            else XB_SPIN(xb_ld(&bar[XB_TOPGEN]) == tg, bar);
            __builtin_amdgcn_fence(__ATOMIC_ACQUIRE, "agent");
            xb_add(&bar[XB_XGEN(b.x)], 1u);
            asm volatile("s_waitcnt vmcnt(0)" ::: "memory");
        } else {
            XB_SPIN(xb_ld(&bar[XB_XGEN(b.x)]) == gen, bar);
            __builtin_amdgcn_fence(__ATOMIC_ACQUIRE, "agent");
            asm volatile("s_waitcnt vmcnt(0)" ::: "memory");
        }
    }
    __syncthreads();
}

constexpr int NTOK = 32768, DM = 1024, SEQ = 2048, NBATCH = 16, NEXP = 32, DEXP = 512, PLE = 256;
constexpr int NWIN = 2608, NWIN_PAD = 2816;
constexpr float EPS = 1e-6f;
constexpr float C2 = 0.125f * 1.4426950408889634f;
constexpr int NWAVES = 8;

constexpr size_t MiB = 1u << 20;
constexpr size_t WS_CTL = 0, CTL_ZERO_BYTES = 1 * MiB;
constexpr int CW_TMO = 0, CW_BAR = 4096;
constexpr size_t WS_RS0 = 1 * MiB;
constexpr size_t WS_RS1 = WS_RS0 + 131072;
constexpr size_t WS_RS2 = WS_RS1 + 131072;
constexpr size_t WS_ASGE = WS_RS2 + 131072;
constexpr size_t WS_ASGR = WS_ASGE + 262144;
constexpr size_t WS_ASGW = WS_ASGR + 262144;
constexpr size_t WS_TSLOT = WS_ASGW + 262144;
constexpr int NSLOT = 2 * NTOK, NSLOT_PAD = NSLOT + 256;
constexpr size_t WS_STOK = WS_TSLOT + 262144;
constexpr size_t WS_SW = WS_STOK + 266240;
constexpr size_t WS_SRS = WS_SW + 266240;
constexpr size_t WS_CNT = WS_SRS + 266240;
constexpr size_t WS_MTOT = WS_CNT + 32768;
constexpr size_t WS_CBP = WS_MTOT + 1024;
constexpr size_t WS_RW = WS_CBP + 65536;
constexpr size_t WS_CB = WS_RW + 393216;
constexpr size_t WS_W2T = WS_CB + 2048;
constexpr size_t WS_SSQ = 4 * MiB;
constexpr size_t WS_ROPE = 6 * MiB;
static_assert(WS_W2T + 2 * 64 * 256 * 2 <= WS_SSQ, "tables");
constexpr size_t WS_WPW1 = 16 * MiB, WS_WPW2 = 20 * MiB, WS_WIN = 22 * MiB, WS_WOUT = 28 * MiB, WS_WC1 = 30 * MiB, WS_WPP = 32 * MiB, WS_WPG = 33 * MiB;
constexpr size_t WS_WGU = 40 * MiB, WS_WDN = 104 * MiB;
constexpr size_t WS_HA = 136 * MiB, WS_HB = 200 * MiB, WS_PP = 264 * MiB, WS_PB = 328 * MiB;
constexpr size_t WS_YB = 344 * MiB, WS_HBUF = 473 * MiB;
constexpr size_t WS_U = 344 * MiB, WS_V = 408 * MiB;
constexpr size_t WS_Q = WS_PP, WS_KV = 344 * MiB, WS_O = 440 * MiB, WS_CP = WS_HA  , WS_GATES = 504 * MiB, WS_KC = 510 * MiB, WS_VC = 511 * MiB;
constexpr size_t WS_END = 538 * MiB;
constexpr size_t KVS = (size_t)NTOK * 256;

constexpr int RING_OFF = 0, RING_BYTES = 131072;
constexpr int LDSCTL_OFF = RING_BYTES;
constexpr int MISC_OFF = LDSCTL_OFF + 320;
constexpr int TAB_OFF = LDSCTL_OFF + 1024;
constexpr int SCR_OFF = LDSCTL_OFF + 4096;
constexpr int LDS_BYTES = 147456;

struct Args { const float* in[30]; float* out; unsigned char* ws; float inv_freq[32]; };
struct Frame {
    LAS unsigned char* lds;
    gu32* ctl;
    unsigned char* ws;
    int tid, lane, wave, vcu, G;
};
DEVI void wg_sync() { __syncthreads(); }

DEVI int perm32(int r) { return (r & ~31) | (((r >> 2) & 1) << 4) | (((r >> 3) & 3) << 2) | (r & 3); }
DEVI int rowmap(int mode, int half, int n) {
    if (mode == 0) return perm32(n);
    if (mode == 1) return perm32(256 * (n >> 7) + 128 * half + (n & 127));
    if (n < 2560) { const int hd = n >> 6, d = n & 63; return perm32(256 * (hd >> 2) + 128 * (d >> 5) + 32 * (hd & 3) + (d & 31)); }
    return perm32(n);
}
DEVI u32x4 pack8(const f32x4& a, const f32x4& b) { const u32x2 x = pack4(a), y = pack4(b); return (u32x4){x.x, x.y, y.x, y.y}; }
DEVI void p0_item(const float* W, int ld, int ncols, int K, const float* gain, bf16_t* dst, int mode, int half, LAS unsigned char* scr, int item, int lane) {
    const int nblk = (ncols + 63) >> 6, kb = item / nblk, nb = item % nblk, k0 = 64 * kb, n0 = 64 * nb;
    const int lr = lane >> 4, lc = 4 * (lane & 15);
    f32x4 v[16];
#pragma unroll
    for (int i = 0; i < 16; ++i) v[i] = (n0 + lc < ncols) ? *(const f32x4*)(W + (size_t)(k0 + 4 * i + lr) * ld + n0 + lc) : (f32x4){0.f, 0.f, 0.f, 0.f};
#pragma unroll
    for (int i = 0; i < 16; ++i) { const float g = gain ? gain[k0 + 4 * i + lr] : 1.0f; const f32x4 x = v[i] * g; *(LAS u32x2*)(scr + (4 * i + lr) * 136 + lc * 2) = pack4(x); }
    LDS_WAIT();
    const int c = lane & 7;
#pragma unroll
    for (int j = 0; j < 8; ++j) { const int n = (lane >> 3) + 8 * j; const LAS unsigned short* t = (const LAS unsigned short*)(scr + (8 * c) * 136 + n * 2);
        u32x4 o; o.x = (unsigned)t[0 * 68] | ((unsigned)t[1 * 68] << 16); o.y = (unsigned)t[2 * 68] | ((unsigned)t[3 * 68] << 16); o.z = (unsigned)t[4 * 68] | ((unsigned)t[5 * 68] << 16); o.w = (unsigned)t[6 * 68] | ((unsigned)t[7 * 68] << 16);
        if (n0 + n < ncols) *(u32x4*)(dst + (size_t)rowmap(mode, half, n0 + n) * K + k0 + 8 * c) = o; }
    LDS_WAIT();
}
DEVI void p0_load(f32x4 (&v)[16], const float* W, int ld, int ncols, int item, int lane) {
    const int nblk = (ncols + 63) >> 6, kb = item / nblk, nb = item % nblk, k0 = 64 * kb, n0 = 64 * nb, lr = lane >> 4, lc = 4 * (lane & 15);
#pragma unroll
    for (int i = 0; i < 16; ++i) v[i] = (n0 + lc < ncols) ? *(const f32x4*)(W + (size_t)(k0 + 4 * i + lr) * ld + n0 + lc) : (f32x4){0.f, 0.f, 0.f, 0.f};
}
DEVI void p0_finish(const f32x4 (&v)[16], int ncols, int K, const float* gain, bf16_t* dst, int mode, int half, LAS unsigned char* scr, int item, int lane) {
    const int nblk = (ncols + 63) >> 6, kb = item / nblk, nb = item % nblk, k0 = 64 * kb, n0 = 64 * nb, lr = lane >> 4, lc = 4 * (lane & 15);
#pragma unroll
    for (int i = 0; i < 16; ++i) { const float g = gain ? gain[k0 + 4 * i + lr] : 1.0f; const f32x4 x = v[i] * g; *(LAS u32x2*)(scr + (4 * i + lr) * 136 + lc * 2) = pack4(x); }
    LDS_WAIT();
    const int c = lane & 7;
#pragma unroll
    for (int j = 0; j < 8; ++j) { const int n = (lane >> 3) + 8 * j; const LAS unsigned short* t = (const LAS unsigned short*)(scr + (8 * c) * 136 + n * 2);
        u32x4 o; o.x = (unsigned)t[0 * 68] | ((unsigned)t[1 * 68] << 16); o.y = (unsigned)t[2 * 68] | ((unsigned)t[3 * 68] << 16); o.z = (unsigned)t[4 * 68] | ((unsigned)t[5 * 68] << 16); o.w = (unsigned)t[6 * 68] | ((unsigned)t[7 * 68] << 16);
        if (n0 + n < ncols) *(u32x4*)(dst + (size_t)rowmap(mode, half, n0 + n) * K + k0 + 8 * c) = o; }
    LDS_WAIT();
}
DEVI void prep_layer(const Frame& F, const Args& a, int L) {
    LAS unsigned char* scr = F.lds + RING_OFF + F.wave * 16384;
    const int gw = F.vcu * NWAVES + F.wave, NGW = F.G * NWAVES;
    const float* gf = a.in[4] + (size_t)L * DM;
    bf16_t* wgu = (bf16_t*)(F.ws + WS_WGU); bf16_t* wdn = (bf16_t*)(F.ws + WS_WDN);
#define PREP_SRC(it_) ((((it_) % 384) >> 7) == 0 ? a.in[25] + ((size_t)L * NEXP + (it_) / 384) * DM * DEXP : (((it_) % 384) >> 7) == 1 ? a.in[26] + ((size_t)L * NEXP + (it_) / 384) * DM * DEXP : a.in[27] + ((size_t)L * NEXP + (it_) / 384) * DEXP * DM)
    f32x4 vc[16], vn[16];
    int it = gw;
    if (it < NEXP * 384) { const int wh = (it % 384) >> 7; p0_load(vc, PREP_SRC(it), wh == 2 ? DM : DEXP, wh == 2 ? DM : DEXP, it & 127, F.lane); }
    for (; it < NEXP * 384; it += NGW) {
        const int itn = it + NGW;
        if (itn < NEXP * 384) { const int wh = (itn % 384) >> 7; p0_load(vn, PREP_SRC(itn), wh == 2 ? DM : DEXP, wh == 2 ? DM : DEXP, itn & 127, F.lane); }
        { const int e = it / 384, wh = (it % 384) >> 7, item = it & 127;
          if (wh == 2) p0_finish(vc, DM, DEXP, nullptr, wdn + (size_t)e * 1024 * 512, 0, 0, scr, item, F.lane);
          else p0_finish(vc, DEXP, DM, gf, wgu + (size_t)e * 1024 * 1024, 1, wh, scr, item, F.lane); }
#pragma unroll
        for (int i = 0; i < 16; ++i) vc[i] = vn[i];
    }
#undef PREP_SRC
    const float* p = a.in[1] + (size_t)L * NTOK * PLE; bf16_t* pb = (bf16_t*)(F.ws + WS_PB);
    const size_t n8 = (size_t)NTOK * PLE / 8;
#pragma unroll 4
    for (size_t i = (size_t)F.vcu * 512 + F.tid; i < n8; i += (size_t)F.G * 512) {
        const f32x4 v0 = *(const f32x4*)(p + i * 8), v1 = *(const f32x4*)(p + i * 8 + 4);
        u32x4 o; o.x = pk2(v0[0], v0[1]); o.y = pk2(v0[2], v0[3]); o.z = pk2(v1[0], v1[1]); o.w = pk2(v1[2], v1[3]);
        *(u32x4*)(pb + i * 8) = o; }
}
DEVI void p0_prologue(const Frame& F, const Args& a) {
    LAS unsigned char* scr = F.lds + RING_OFF + F.wave * 16384;
    const int gw = F.vcu * NWAVES + F.wave, NGW = F.G * NWAVES;
    unsigned char* ws = F.ws;
    constexpr int I_PW1 = 16 * 16 * 2, I_PW2 = 16 * 16, I_WIN = 16 * 41, I_WOUT = 16 * 16, I_C1 = 32 * 4 * 2, I_PP = 4 * 16 * 2, I_PG = 16 * 16 * 2;
    constexpr int NIT = I_PW1 + I_PW2 + I_WIN + I_WOUT + I_C1 + I_PP + I_PG;
    for (int it = gw; it < NIT; it += NGW) {
        int r = it;
        if (r < I_PW1) { const int half = r / 256; p0_item(a.in[6] + half * 1024, 2048, 1024, DM, a.in[3], (bf16_t*)(ws + WS_WPW1), 1, half, scr, r % 256, F.lane); continue; } r -= I_PW1;
        if (r < I_PW2) { p0_item(a.in[12], DM, DM, DM, nullptr, (bf16_t*)(ws + WS_WPW2), 0, 0, scr, r, F.lane); continue; } r -= I_PW2;
        if (r < I_WIN) { p0_item(a.in[14], NWIN, NWIN, DM, a.in[3] + DM, (bf16_t*)(ws + WS_WIN), 2, 0, scr, r, F.lane); continue; } r -= I_WIN;
        if (r < I_WOUT) { p0_item(a.in[20], DM, DM, DM, nullptr, (bf16_t*)(ws + WS_WOUT), 0, 0, scr, r, F.lane); continue; } r -= I_WOUT;
        if (r < I_C1) { const int j = r / 128; p0_item(a.in[18] + (size_t)j * 2048 * 256, 256, 256, 2048, nullptr, (bf16_t*)(ws + WS_WC1) + (size_t)j * 256 * 2048, 0, 0, scr, r % 128, F.lane); continue; } r -= I_C1;
        if (r < I_PP) { const int L = r / 64; p0_item(a.in[28] + (size_t)L * PLE * DM, DM, DM, PLE, nullptr, (bf16_t*)(ws + WS_WPP) + (size_t)L * DM * PLE, 0, 0, scr, r % 64, F.lane); continue; } r -= I_PP;
        { const int L = r / 256; p0_item(a.in[29] + (size_t)L * DM * DM, DM, DM, DM, a.in[5] + (size_t)L * DM, (bf16_t*)(ws + WS_WPG) + (size_t)L * DM * DM, 0, 0, scr, r % 256, F.lane); }
    }
    { u32x4* z = (u32x4*)((bf16_t*)(ws + WS_WIN) + (size_t)2616 * DM); const int n16 = (NWIN_PAD - 2616) * DM / 8;
      for (int i = F.vcu * 512 + F.tid; i < n16; i += F.G * 512) z[i] = (u32x4){0u, 0u, 0u, 0u};
      u32x4* z2 = (u32x4*)((bf16_t*)(ws + WS_WIN) + (size_t)2600 * DM);
      for (int i = F.vcu * 512 + F.tid; i < 8 * DM / 8; i += F.G * 512) z2[i] = (u32x4){0u, 0u, 0u, 0u}; }
    { bf16_t* rw = (bf16_t*)(ws + WS_RW);
      for (int i = F.vcu * 512 + F.tid; i < 2 * 48 * 1024; i += F.G * 512) {
          const int L = i / (48 * 1024), j = (i / 1024) % 48, k = i & 1023;
          float w = 0.f;
          if (j < 4) w = a.in[21][((size_t)L * DM + k) * 4 + j]; else if (j < 36) w = a.in[23][((size_t)L * DM + k) * 32 + (j - 4)];
          w *= a.in[4][(size_t)L * DM + k];
          const unsigned hi = pk2(w, 0.f) & 0xffffu; const float lo = w - bflo(hi);
          rw[((size_t)(L * 2 + 0) * 48 + j) * 1024 + k] = (bf16_t)hi; rw[((size_t)(L * 2 + 1) * 48 + j) * 1024 + k] = (bf16_t)(pk2(lo, 0.f) & 0xffffu); } }
    { bf16_t* w2t = (bf16_t*)(ws + WS_W2T);
      for (int i = F.vcu * 512 + F.tid; i < 2 * 64 * 256; i += F.G * 512) { const int j = i >> 14, n = (i >> 8) & 63, k = i & 255; w2t[i] = (bf16_t)(pk2(a.in[19][(size_t)(j * 256 + k) * 64 + n], 0.f) & 0xffffu); } }
    for (int it = gw; it < 2 * 4 * 32; it += NGW) {
        const int j = it >> 7, cg = (it >> 5) & 3, kr = it & 31;
        const float* pe = a.in[17] + (size_t)j * 2048 + kr * 64; const float* w1 = a.in[18] + ((size_t)j * 2048 + kr * 64) * 256 + cg * 64 + F.lane;
        float s = 0.f;
#pragma unroll 16
        for (int k = 0; k < 64; ++k) s += pe[k] * w1[(size_t)k * 256];
        ((float*)(ws + WS_CBP))[(j * 32 + kr) * 256 + cg * 64 + F.lane] = s; }
    { float* rope = (float*)(ws + WS_ROPE); const int* pos = (const int*)a.in[2];
      for (int i = F.vcu * 512 + F.tid; i < NTOK * 32; i += F.G * 512) {
          const int row = i >> 5, fi = i & 31;
          const float ang = (float)pos[row] * a.inv_freq[fi];
          const double rev = (double)ang * 0.15915494309189533577; const float fr = (float)(rev - floor(rev));
          rope[(size_t)row * 64 + fi] = __builtin_amdgcn_cosf(fr); rope[(size_t)row * 64 + 32 + fi] = __builtin_amdgcn_sinf(fr); } }
    { const float* x = a.in[0]; bf16_t* ha = (bf16_t*)(ws + WS_HA); float* rs0 = (float*)(ws + WS_RS0);
      f32x4 va[4], vb[4], na[4], nb[4];
#define XR(m_, j_) (((const f32x4*)(x + (size_t)(m_) * DM) + F.lane)[64 * (j_)])
      if (gw < NTOK) {
#pragma unroll
          for (int j = 0; j < 4; ++j) { na[j] = XR(gw, j); nb[j] = (gw + NGW < NTOK) ? XR(gw + NGW, j) : (f32x4){0.f, 0.f, 0.f, 0.f}; } }
      for (int m = gw; m < NTOK; m += 2 * NGW) {
#pragma unroll
          for (int j = 0; j < 4; ++j) { va[j] = na[j]; vb[j] = nb[j]; }
          if (m + 2 * NGW < NTOK) {
#pragma unroll
              for (int j = 0; j < 4; ++j) { na[j] = XR(m + 2 * NGW, j); nb[j] = (m + 3 * NGW < NTOK) ? XR(m + 3 * NGW, j) : (f32x4){0.f, 0.f, 0.f, 0.f}; } }
          float sa = 0.f, sb = 0.f;
#pragma unroll
          for (int j = 0; j < 4; ++j) { sa += (va[j][0] * va[j][0] + va[j][1] * va[j][1]) + (va[j][2] * va[j][2] + va[j][3] * va[j][3]); sb += (vb[j][0] * vb[j][0] + vb[j][1] * vb[j][1]) + (vb[j][2] * vb[j][2] + vb[j][3] * vb[j][3]); }
          sa = wave_sum(sa); sb = wave_sum(sb);
          u32x2* oa = (u32x2*)(ha + (size_t)m * DM) + F.lane; u32x2* ob = (u32x2*)(ha + (size_t)(m + NGW) * DM) + F.lane;
#pragma unroll
          for (int j = 0; j < 4; ++j) { oa[64 * j] = pack4(va[j]); if (m + NGW < NTOK) ob[64 * j] = pack4(vb[j]); }
          if (F.lane == 0) { rs0[m] = 1.0f / sqrtf(sa * (1.0f / DM) + EPS); if (m + NGW < NTOK) rs0[m + NGW] = 1.0f / sqrtf(sb * (1.0f / DM) + EPS); } }
#undef XR
      }

}

using pg8::Unit;
typedef f32x4 AccT[2][2][4][2];
struct ProbBase { const char* A; const char* Bt; int K; unsigned ldb; int G, c; };

#define EPI_FENCE() asm volatile("" ::: "memory")
struct ProbPw1 : ProbBase {
    const float* __restrict__ rstd; const float* __restrict__ bias; bf16_t* __restrict__ U;
    DEVI bool next(int i, Unit& u) const { const int L = i * G + c; if (L >= 128 * 8) return false; u.pm = L >> 3; u.pn = L & 7; u.e = 0; u.v = 256; return true; }
    DEVI unsigned a_off(const Unit& u, int R) const { return (unsigned)(u.pm * 256 + R) * 2048u; }
    DEVI size_t b_off(const Unit& u) const { return (size_t)u.pn * 256 * ldb; }
    DEVI void epi(const AccT& acc, const Unit& u, int wr, int wc, int fr, int fq) const {
        const int q0 = 32 * wc + 8 * fq;
        f32x4 ba[2], bg[2]; float rs[2][4];
#pragma unroll
        for (int n = 0; n < 2; ++n) { ba[n] = *(const f32x4*)(bias + 128 * u.pn + q0 + 4 * n); bg[n] = *(const f32x4*)(bias + 1024 + 128 * u.pn + q0 + 4 * n); }
#pragma unroll
        for (int ai = 0; ai < 2; ++ai)
#pragma unroll
            for (int m = 0; m < 4; ++m) rs[ai][m] = rstd[u.pm * 256 + 128 * ai + 64 * wr + 16 * m + fr];
        EPI_FENCE();
#pragma unroll
        for (int ai = 0; ai < 2; ++ai)
#pragma unroll
            for (int m = 0; m < 4; ++m) {
                const int row = u.pm * 256 + 128 * ai + 64 * wr + 16 * m + fr;
                f32x4 o[2];
#pragma unroll
                for (int n = 0; n < 2; ++n) {
                    const f32x4 av = acc[ai][0][m][n] * rs[ai][m] + ba[n], gv = acc[ai][1][m][n] * rs[ai][m] + bg[n];
#pragma unroll
                    for (int j = 0; j < 4; ++j) o[n][j] = av[j] * sigmoid_f(gv[j]); }
                *(u32x4*)(U + (size_t)row * DM + 128 * u.pn + q0) = pack8(o[0], o[1]); }
    }
};
struct ProbPP : ProbBase {
    bf16_t* O; int tail_lo;
    DEVI bool next(int i, Unit& u) const { if (c < tail_lo) return false; const int L = i * (G - tail_lo) + (c - tail_lo); if (L >= 128 * 4) return false; u.pm = L >> 2; u.pn = L & 3; u.e = 0; u.v = 256; return true; }
    DEVI unsigned a_off(const Unit& u, int R) const { return (unsigned)(u.pm * 256 + R) * 512u; }
    DEVI size_t b_off(const Unit& u) const { return (size_t)u.pn * 256 * ldb; }
    DEVI void epi(const AccT& acc, const Unit& u, int wr, int wc, int fr, int fq) const {
#pragma unroll
        for (int ai = 0; ai < 2; ++ai)
#pragma unroll
            for (int m = 0; m < 4; ++m) {
                const int row = u.pm * 256 + 128 * ai + 64 * wr + 16 * m + fr;
#pragma unroll
                for (int bj = 0; bj < 2; ++bj) *(u32x4*)(O + (size_t)row * DM + 256 * u.pn + 128 * bj + 32 * wc + 8 * fq) = pack8(acc[ai][bj][m][0], acc[ai][bj][m][1]); }
    }
};
struct ProbRes : ProbBase {
    const bf16_t* __restrict__ RES; bf16_t* __restrict__ OUT; const float* __restrict__ bias;
    DEVI bool next(int i, Unit& u) const { const int L = i * G + c; if (L >= 128 * 4) return false; u.pm = L >> 2; u.pn = L & 3; u.e = 0; u.v = 256; return true; }
    DEVI unsigned a_off(const Unit& u, int R) const { return (unsigned)(u.pm * 256 + R) * 2048u; }
    DEVI size_t b_off(const Unit& u) const { return (size_t)u.pn * 256 * ldb; }
    DEVI void epi(const AccT& acc, const Unit& u, int wr, int wc, int fr, int fq) const {
        const int col0 = 256 * u.pn + 32 * wc + 8 * fq;
        f32x4 bv[2][2];
#pragma unroll
        for (int bj = 0; bj < 2; ++bj)
#pragma unroll
            for (int n = 0; n < 2; ++n) bv[bj][n] = bias ? *(const f32x4*)(bias + col0 + 128 * bj + 4 * n) : (f32x4){0.f, 0.f, 0.f, 0.f};
#pragma unroll
        for (int ai = 0; ai < 2; ++ai) {
            u32x4 r[4][2];
#pragma unroll
            for (int m = 0; m < 4; ++m) { const size_t o = (size_t)(u.pm * 256 + 128 * ai + 64 * wr + 16 * m + fr) * DM + col0;
#pragma unroll
                for (int bj = 0; bj < 2; ++bj) r[m][bj] = *(const u32x4*)(RES + o + 128 * bj); }
            EPI_FENCE();
#pragma unroll
            for (int m = 0; m < 4; ++m) { const size_t o = (size_t)(u.pm * 256 + 128 * ai + 64 * wr + 16 * m + fr) * DM + col0;
#pragma unroll
                for (int bj = 0; bj < 2; ++bj) { const u32x4 rr = r[m][bj];
                    *(u32x4*)(OUT + o + 128 * bj) = pack8(unpack4((u32x2){rr.x, rr.y}) + acc[ai][bj][m][0] + bv[bj][0], unpack4((u32x2){rr.z, rr.w}) + acc[ai][bj][m][1] + bv[bj][1]); } }
            EPI_FENCE();
        }
    }
};
struct ProbPle : ProbBase {
    const bf16_t* __restrict__ H2; const bf16_t* __restrict__ PPp; const float* __restrict__ rstd; bf16_t* __restrict__ OUTB; float* __restrict__ OUTF; float* __restrict__ ssq; int last;
    DEVI bool next(int i, Unit& u) const { const int L = i * G + c; if (L >= 128 * 4) return false; u.pm = L >> 2; u.pn = L & 3; u.e = 0; u.v = 256; return true; }
    DEVI unsigned a_off(const Unit& u, int R) const { return (unsigned)(u.pm * 256 + R) * 2048u; }
    DEVI size_t b_off(const Unit& u) const { return (size_t)u.pn * 256 * ldb; }
    DEVI void epi(const AccT& acc, const Unit& u, int wr, int wc, int fr, int fq) const {
        const int col0 = 256 * u.pn + 32 * wc + 8 * fq;
#pragma unroll
        for (int ai = 0; ai < 2; ++ai) {
            u32x4 h[4][2], q[4][2]; float rs[4];
#pragma unroll
            for (int m = 0; m < 4; ++m) { const int row = u.pm * 256 + 128 * ai + 64 * wr + 16 * m + fr; const size_t o = (size_t)row * DM + col0; rs[m] = rstd[row];
#pragma unroll
                for (int bj = 0; bj < 2; ++bj) { h[m][bj] = *(const u32x4*)(H2 + o + 128 * bj); q[m][bj] = *(const u32x4*)(PPp + o + 128 * bj); } }
            EPI_FENCE();
#pragma unroll
            for (int m = 0; m < 4; ++m) { const int row = u.pm * 256 + 128 * ai + 64 * wr + 16 * m + fr; const size_t o = (size_t)row * DM + col0; float ss = 0.f;
#pragma unroll
                for (int bj = 0; bj < 2; ++bj) { f32x4 v[2];
#pragma unroll
                    for (int n = 0; n < 2; ++n) {
                        const f32x4 h2 = unpack4(n ? (u32x2){h[m][bj].z, h[m][bj].w} : (u32x2){h[m][bj].x, h[m][bj].y}), pp = unpack4(n ? (u32x2){q[m][bj].z, q[m][bj].w} : (u32x2){q[m][bj].x, q[m][bj].y}), a4 = acc[ai][bj][m][n] * rs[m];
#pragma unroll
                        for (int j = 0; j < 4; ++j) v[n][j] = h2[j] + sigmoid_f(a4[j]) * pp[j];
                        if (!last) ss += (v[n][0] * v[n][0] + v[n][1] * v[n][1]) + (v[n][2] * v[n][2] + v[n][3] * v[n][3]); }
                    if (last) { *(f32x4*)(OUTF + o + 128 * bj) = v[0]; *(f32x4*)(OUTF + o + 128 * bj + 4) = v[1]; }
                    else *(u32x4*)(OUTB + o + 128 * bj) = pack8(v[0], v[1]); }
                if (!last) { ss += __shfl_xor(ss, 16); ss += __shfl_xor(ss, 32); if (fq == 0) ssq[(size_t)row * 16 + u.pn * 4 + wc] = ss; } }
            EPI_FENCE();
        }
    }
};
struct ProbGateUp : ProbBase {
    const LAS int* tab_row; const LAS int* tab_ev; int nblk;
    const LAS unsigned* goff;
    const float* __restrict__ slot_rs; bf16_t* __restrict__ HBUF;
    DEVI bool next(int i, Unit& u) const { const int L = i * G + c; if (L >= nblk * 4) return false; const int b = L >> 2; u.pn = L & 3; u.pm = tab_row[b]; const int ev = tab_ev[b]; u.e = (ev >> 9) | (i << 8); u.v = ev & 511; return true; }
    DEVI unsigned a_off(const Unit& u, int R) const { return goff[(u.e >> 8) * 256 + R]; }
    DEVI size_t b_off(const Unit& u) const { return ((size_t)(u.e & 255) * 1024 + (size_t)u.pn * 256) * ldb; }
    DEVI void epi(const AccT& acc, const Unit& u, int wr, int wc, int fr, int fq) const {
        float rsv[2][4];
#pragma unroll
        for (int ai = 0; ai < 2; ++ai)
#pragma unroll
            for (int m = 0; m < 4; ++m) rsv[ai][m] = slot_rs[u.pm + 128 * ai + 64 * wr + 16 * m + fr];
        EPI_FENCE();
#pragma unroll
        for (int ai = 0; ai < 2; ++ai)
#pragma unroll
            for (int m = 0; m < 4; ++m) {
                const int R = 128 * ai + 64 * wr + 16 * m + fr;
                if (R < u.v) { const int slot = u.pm + R; const float rs = rsv[ai][m];
                    f32x4 o[2];
#pragma unroll
                    for (int n = 0; n < 2; ++n) { const f32x4 g = acc[ai][0][m][n] * rs, up = acc[ai][1][m][n] * rs;
#pragma unroll
                        for (int j = 0; j < 4; ++j) o[n][j] = g[j] * sigmoid_f(g[j]) * up[j]; }
                    *(u32x4*)(HBUF + (size_t)slot * DEXP + 128 * u.pn + 32 * wc + 8 * fq) = pack8(o[0], o[1]); } }
    }
};
struct ProbDown : ProbBase {
    const LAS int* tab_row; const LAS int* tab_ev; int nblk;
    const float* __restrict__ slot_w; bf16_t* __restrict__ YB;
    DEVI bool next(int i, Unit& u) const { const int L = i * G + c; if (L >= nblk * 4) return false; const int b = L >> 2; u.pn = L & 3; u.pm = tab_row[b]; const int ev = tab_ev[b]; u.e = ev >> 9; u.v = ev & 511; return true; }
    DEVI unsigned a_off(const Unit& u, int R) const { return (unsigned)(u.pm + R) * 1024u; }
    DEVI size_t b_off(const Unit& u) const { return ((size_t)u.e * 1024 + (size_t)u.pn * 256) * ldb; }
    DEVI void epi(const AccT& acc, const Unit& u, int wr, int wc, int fr, int fq) const {
        float wv[2][4];
#pragma unroll
        for (int ai = 0; ai < 2; ++ai)
#pragma unroll
            for (int m = 0; m < 4; ++m) wv[ai][m] = slot_w[u.pm + 128 * ai + 64 * wr + 16 * m + fr];
        EPI_FENCE();
#pragma unroll
        for (int ai = 0; ai < 2; ++ai)
#pragma unroll
            for (int m = 0; m < 4; ++m) {
                const int R = 128 * ai + 64 * wr + 16 * m + fr;
                if (R < u.v) { const int slot = u.pm + R; const float w = wv[ai][m];
#pragma unroll
                    for (int bj = 0; bj < 2; ++bj) *(u32x4*)(YB + (size_t)slot * DM + 256 * u.pn + 128 * bj + 32 * wc + 8 * fq) = pack8(acc[ai][bj][m][0] * w, acc[ai][bj][m][1] * w); } }
    }
};
struct ProbWin : ProbBase {
    const float* __restrict__ rstd; const float* __restrict__ rope; const float* __restrict__ qnorm; const float* __restrict__ knorm; bf16_t* __restrict__ Q; bf16_t* __restrict__ KV; float* __restrict__ gates;
    const LAS float* lrs;
    DEVI bool next(int i, Unit& u) const { const int L = i * G + c; if (L >= 128 * 11) return false; u.pm = L / 11; u.pn = L % 11; u.e = i; u.v = 256; return true; }
    DEVI unsigned a_off(const Unit& u, int R) const { return (unsigned)(u.pm * 256 + R) * 2048u; }
    DEVI size_t b_off(const Unit& u) const { return (size_t)u.pn * 256 * ldb; }
    DEVI void epi(const AccT& acc, const Unit& u, int wr, int wc, int fr, int fq) const {
        const int pn = u.pn;
        float rsv[2][4];
#pragma unroll
        for (int ai = 0; ai < 2; ++ai)
#pragma unroll
            for (int m = 0; m < 4; ++m) rsv[ai][m] = lrs[u.e * 256 + 128 * ai + 64 * wr + 16 * m + fr];
        if (pn == 10) {
            EPI_FENCE();
            if (wc < 2) {
#pragma unroll
                for (int ai = 0; ai < 2; ++ai)
#pragma unroll
                    for (int m = 0; m < 4; ++m) {
                        const int row = u.pm * 256 + 128 * ai + 64 * wr + 16 * m + fr; const float rs = rsv[ai][m];
#pragma unroll
                        for (int n = 0; n < 2; ++n) if (wc == 0 || fq < 2) { const f32x4 a4 = acc[ai][0][m][n] * rs; f32x4 o;
#pragma unroll
                            for (int j = 0; j < 4; ++j) o[j] = sigmoid_f(a4[j]);
                            *(f32x4*)(gates + (size_t)row * 48 + 32 * wc + 8 * fq + 4 * n) = o; } } }
            return;
        }
        const bool isq = pn < 4, dorope = isq || pn == 6 || pn == 8;
        const float* gvec = isq ? qnorm : (knorm + (pn == 6 ? 64 : 128));
        f32x4 g1[2], g2[2];
#pragma unroll
        for (int n = 0; n < 2; ++n) { g1[n] = *(const f32x4*)(gvec + 8 * fq + 4 * n); g2[n] = *(const f32x4*)(gvec + 32 + 8 * fq + 4 * n); }
        const float oscale = isq ? C2 : 1.0f;
#pragma unroll
        for (int g = 0; g < 8; ++g) { const int ai = g >> 2, m = g & 3;
            const int row = u.pm * 256 + 128 * ai + 64 * wr + 16 * m + fr; const float rs = rsv[ai][m];
            f32x4 cs[2], sn[2];
            if (dorope) { const size_t ro = (size_t)row * 64 + 8 * fq;
#pragma unroll
                for (int n = 0; n < 2; ++n) { cs[n] = *(const f32x4*)(rope + ro + 4 * n); sn[n] = *(const f32x4*)(rope + ro + 32 + 4 * n); } }
            f32x4 x1[2], x2[2];
#pragma unroll
            for (int n = 0; n < 2; ++n) { x1[n] = acc[ai][0][m][n] * rs; x2[n] = acc[ai][1][m][n] * rs; }
            if (dorope) {
                float ss = 0.f;
#pragma unroll
                for (int n = 0; n < 2; ++n)
#pragma unroll
                    for (int j = 0; j < 4; ++j) ss += x1[n][j] * x1[n][j] + x2[n][j] * x2[n][j];
                ss += __shfl_xor(ss, 16); ss += __shfl_xor(ss, 32);
                const float inv = 1.0f / sqrtf(ss * (1.0f / 64.0f) + EPS);
#pragma unroll
                for (int n = 0; n < 2; ++n) {
                    const f32x4 y1 = x1[n] * inv * g1[n], y2 = x2[n] * inv * g2[n];
                    x1[n] = (y1 * cs[n] - y2 * sn[n]) * oscale; x2[n] = (y2 * cs[n] + y1 * sn[n]) * oscale; } }
            bf16_t* dst;
            if (isq) dst = Q + (size_t)row * DM + (4 * pn + wc) * 64;
            else { const int b = row >> 11, t = row & 2047; dst = KV + (size_t)(pn - 4) * KVS + ((size_t)(b * 4 + wc) * SEQ + t) * 64; }
            *(u32x4*)(dst + 8 * fq) = pack8(x1[0], x1[1]); *(u32x4*)(dst + 32 + 8 * fq) = pack8(x2[0], x2[1]);
        }
    }
};
struct ProbCmp : ProbBase {
    float* CP;
    DEVI bool next(int i, Unit& u) const { const int L = i * G + c; if (L >= 256) return false; u.e = L >> 7; u.pm = (L >> 2) & 31; u.v = L & 3; u.pn = 0; return true; }
    DEVI unsigned a_off(const Unit& u, int R) const { return (unsigned)u.e * (unsigned)(KVS * 2) + (unsigned)(u.pm * 256 + R) * 2048u + (unsigned)u.v * 1024u; }
    DEVI size_t b_off(const Unit& u) const { return (size_t)u.e * 256 * ldb + (size_t)u.v * 1024; }
    DEVI void epi(const AccT& acc, const Unit& u, int wr, int wc, int fr, int fq) const {
        float* base = CP + ((size_t)(u.e * 4 + u.v) * 8192) * 256;
#pragma unroll
        for (int ai = 0; ai < 2; ++ai)
#pragma unroll
            for (int m = 0; m < 4; ++m) {
                const int rho = u.pm * 256 + 128 * ai + 64 * wr + 16 * m + fr;
#pragma unroll
                for (int bj = 0; bj < 2; ++bj)
#pragma unroll
                    for (int n = 0; n < 2; ++n) *(f32x4*)(base + (size_t)rho * 256 + 128 * bj + 32 * wc + 8 * fq + 4 * n) = acc[ai][bj][m][n]; }
    }
};

#define CONV_BAR() asm volatile("s_waitcnt lgkmcnt(0)\n\ts_barrier" ::: "memory")
DEVI void conv_phase(const Frame& F, const Args& a) {
    const bf16_t* U = (const bf16_t*)(F.ws + WS_U); bf16_t* V = (bf16_t*)(F.ws + WS_V);
    LAS float* red = (LAS float*)(F.lds + SCR_OFF);
    LAS float* fin = red + 256;
    const int tid = F.tid, c0 = 2 * tid;
    f32x2 w2[31];
#pragma unroll
    for (int k = 0; k < 31; ++k) w2[k] = *(const f32x2*)(a.in[8] + (size_t)k * DM + c0);
    const f32x2 bdw = *(const f32x2*)(a.in[9] + c0), lg = *(const f32x2*)(a.in[10] + c0), lb = *(const f32x2*)(a.in[11] + c0);
    for (int ch = F.vcu; ch < 256; ch += F.G) {
        const int tokbase = ch * 128, t0 = tokbase & (SEQ - 1);
        const unsigned* Up = (const unsigned*)U + (size_t)tokbase * 512 + tid;
        unsigned win[46];
#pragma unroll
        for (int i = 0; i < 46; ++i) { const int rel = i - 30; win[i] = (rel >= 0 || t0 != 0) ? Up[(ptrdiff_t)rel * 512] : 0u; }
#pragma unroll
        for (int s = 0; s < 8; ++s) {
            unsigned nxt[16];
            if (s < 7) {
#pragma unroll
                for (int i = 0; i < 16; ++i) nxt[i] = Up[(ptrdiff_t)(16 * (s + 1) + i) * 512]; }
            f32x2 y[16];
#pragma unroll
            for (int tt = 0; tt < 16; ++tt) y[tt] = bdw;
#pragma unroll
            for (int rr = 0; rr < 46; ++rr) {
                const f32x2 v = {bflo(win[rr]), bfhi(win[rr])};
#pragma unroll
                for (int tt = 0; tt < 16; ++tt) { const int k = rr - tt; if (k >= 0 && k <= 30) y[tt] += w2[k] * v; }
            }
            float v16[16];
            { const bool h5 = (F.lane & 32) != 0;
#pragma unroll
              for (int i = 0; i < 16; ++i) { const float sA = y[i][0] + y[i][1], sB = y[i][0] * y[i][0] + y[i][1] * y[i][1]; const float keep = h5 ? sB : sA, send = h5 ? sA : sB; v16[i] = keep + __shfl_xor(send, 32); } }
            float v8[8], v4[4], v2[2], v1r;
            { const bool h = (F.lane & 16) != 0;
#pragma unroll
              for (int i = 0; i < 8; ++i) { const float keep = h ? v16[i + 8] : v16[i], send = h ? v16[i] : v16[i + 8]; v8[i] = keep + __shfl_xor(send, 16); } }
            { const bool h = (F.lane & 8) != 0;
#pragma unroll
              for (int i = 0; i < 4; ++i) { const float keep = h ? v8[i + 4] : v8[i], send = h ? v8[i] : v8[i + 4]; v4[i] = keep + __shfl_xor(send, 8); } }
            { const bool h = (F.lane & 4) != 0;
#pragma unroll
              for (int i = 0; i < 2; ++i) { const float keep = h ? v4[i + 2] : v4[i], send = h ? v4[i] : v4[i + 2]; v2[i] = keep + __shfl_xor(send, 4); } }
            { const bool h = (F.lane & 2) != 0; const float keep = h ? v2[1] : v2[0], send = h ? v2[0] : v2[1]; v1r = keep + __shfl_xor(send, 2); }
            v1r += __shfl_xor(v1r, 1);
            CONV_BAR();
            if ((F.lane & 1) == 0) red[F.wave * 32 + (F.lane >> 1)] = v1r;
            CONV_BAR();
            if (tid < 16) { float t = 0.f, q = 0.f;
#pragma unroll
                for (int w = 0; w < 8; ++w) { t += red[w * 32 + tid]; q += red[w * 32 + 16 + tid]; }
                const float mean = t * (1.0f / DM), var = q * (1.0f / DM) - mean * mean;
                fin[tid] = mean; fin[16 + tid] = 1.0f / sqrtf(var + EPS); }
            CONV_BAR();
#pragma unroll
            for (int tt = 0; tt < 16; ++tt) {
                const float mean = fin[tt], rstd = fin[16 + tt];
                const float z0 = (y[tt][0] - mean) * rstd * lg[0] + lb[0], z1 = (y[tt][1] - mean) * rstd * lg[1] + lb[1];
                *(unsigned*)(V + (size_t)(tokbase + 16 * s + tt) * DM + c0) = pk2(z0 * sigmoid_f(z0), z1 * sigmoid_f(z1)); }
            if (s < 7) {
#pragma unroll
                for (int i = 0; i < 30; ++i) win[i] = win[i + 16];
#pragma unroll
                for (int i = 0; i < 16; ++i) win[30 + i] = nxt[i]; }
        }
    }
}
DEVI void router_phase(const Frame& F, const Args& a, int L, const bf16_t* H) {
    const bf16_t* rw = (const bf16_t*)(F.ws + WS_RW) + (size_t)(L * 2) * 48 * 1024;
    float* rs1 = (float*)(F.ws + WS_RS1); int* asg_e = (int*)(F.ws + WS_ASGE); int* asg_r = (int*)(F.ws + WS_ASGR); float* asg_w = (float*)(F.ws + WS_ASGW); int* cnt = (int*)(F.ws + WS_CNT);
    LAS unsigned char* wst = F.lds + RING_OFF;
    LAS float* lg = (LAS float*)(F.lds + RING_OFF + 65536) + F.wave * (16 * 48);
    LAS int* elist = (LAS int*)(F.lds + RING_OFF + 98304);
    LAS float* bias = (LAS float*)(F.lds + RING_OFF + 98304 + 1024);
    if (F.tid < 4) bias[F.tid] = a.in[22][L * 4 + F.tid]; else if (F.tid < 36) bias[F.tid] = a.in[24][L * 32 + F.tid - 4];
    const LAS float* brg = bias; const LAS float* bre = bias + 4;
    const int fr = F.lane & 15, fq = F.lane >> 4;
    for (int ch = F.vcu; ch < 256; ch += F.G) {
        const int tok0 = ch * 128 + F.wave * 16;
        f32x4 acc[3];
#pragma unroll
        for (int t = 0; t < 3; ++t) acc[t] = (f32x4){0.f, 0.f, 0.f, 0.f};
        float ss = 0.f;
        const bf16_t* hp = H + (size_t)(tok0 + fr) * DM + 8 * fq;
        for (int kc4 = 0; kc4 < 4; ++kc4) {
            const int kc = (kc4 + F.vcu) & 3;
            bf16x8 hf[8];
#pragma unroll
            for (int sl = 0; sl < 8; ++sl) hf[sl] = *(const bf16x8*)(hp + kc * 256 + 32 * sl);
            u32x4 wv[6];
#pragma unroll
            for (int i = 0; i < 6; ++i) { const int idx = F.tid + 512 * i, hl = idx / 1536, rem = idx % 1536, row = rem >> 5, c = rem & 31;
                wv[i] = *(const u32x4*)(rw + ((size_t)(hl * 48 + row)) * 1024 + kc * 256 + c * 8); }
            wg_sync();
#pragma unroll
            for (int i = 0; i < 6; ++i) { const int idx = F.tid + 512 * i, hl = idx / 1536, rem = idx % 1536, row = rem >> 5, c = rem & 31;
                *(LAS u32x4*)(wst + hl * 25344 + row * 528 + c * 16) = wv[i]; }
            wg_sync();
#pragma unroll
            for (int sl = 0; sl < 8; ++sl) {
#pragma unroll
                for (int t = 0; t < 3; ++t) {
                    const bf16x8 wh = *(const LAS bf16x8*)(wst + (16 * t + fr) * 528 + (32 * sl + 8 * fq) * 2), wl = *(const LAS bf16x8*)(wst + 25344 + (16 * t + fr) * 528 + (32 * sl + 8 * fq) * 2);
                    acc[t] = __builtin_amdgcn_mfma_f32_16x16x32_bf16(wh, hf[sl], acc[t], 0, 0, 0);
                    acc[t] = __builtin_amdgcn_mfma_f32_16x16x32_bf16(wl, hf[sl], acc[t], 0, 0, 0); }
                const u32x4 hu = __builtin_bit_cast(u32x4, hf[sl]);
#pragma unroll
                for (int j = 0; j < 4; ++j) { const float x0 = bflo(hu[j]), x1 = bfhi(hu[j]); ss += x0 * x0 + x1 * x1; }
            }
        }
        ss += __shfl_xor(ss, 16); ss += __shfl_xor(ss, 32);
        const float rs = 1.0f / sqrtf(ss * (1.0f / DM) + EPS);
        if (fq == 0) rs1[tok0 + fr] = rs;
#pragma unroll
        for (int t = 0; t < 3; ++t)
#pragma unroll
            for (int r = 0; r < 4; ++r) lg[fr * 48 + 16 * t + 4 * fq + r] = acc[t][r] * rs;
        LDS_WAIT();
        if (F.lane < 16) {
            const LAS float* my = lg + F.lane * 48;
            float g[4]; int gi = 0; float gm;
#pragma unroll
            for (int j = 0; j < 4; ++j) g[j] = my[j] + brg[j];
            gm = g[0];
#pragma unroll
            for (int j = 1; j < 4; ++j) if (g[j] > gm) { gm = g[j]; gi = j; }
            float den = 0.f;
#pragma unroll
            for (int j = 0; j < 4; ++j) den += __expf(g[j] - gm);
            const float pg = 1.0f / den;
            float v1 = -INFINITY, v2 = -INFINITY; int i1 = 0, i2 = 0;
            for (int j = 0; j < 8; ++j) { const float v = my[4 + gi * 8 + j] + bre[gi * 8 + j];
                if (v > v1) { v2 = v1; i2 = i1; v1 = v; i1 = j; } else if (v > v2) { v2 = v; i2 = j; } }
            const float e2 = __expf(v2 - v1), wa = pg / (1.0f + e2), wb = pg * e2 / (1.0f + e2);
            const int tl = F.wave * 16 + F.lane;
            elist[2 * tl] = gi * 8 + i1; elist[2 * tl + 1] = gi * 8 + i2;
            asg_w[(size_t)ch * 256 + 2 * tl] = wa; asg_w[(size_t)ch * 256 + 2 * tl + 1] = wb;
        }
        wg_sync();
        if (F.tid < 288) {
            const bool isr = F.tid < 256; const int e = isr ? elist[F.tid] : F.tid - 256, lim = isr ? F.tid : 256; int r = 0;
            typedef int i32x4 __attribute__((ext_vector_type(4)));
#pragma unroll 8
            for (int q = 0; q < 256; q += 4) { const i32x4 v = *(const LAS i32x4*)(elist + q);
                r += ((v[0] == e) & (q < lim)) + ((v[1] == e) & (q + 1 < lim)) + ((v[2] == e) & (q + 2 < lim)) + ((v[3] == e) & (q + 3 < lim)); }
            if (isr) { asg_e[(size_t)ch * 256 + F.tid] = e; asg_r[(size_t)ch * 256 + F.tid] = r; } else cnt[ch * 32 + e] = r; }
        wg_sync();
    }
}
DEVI void fill_phase(const Frame& F) {
    const int* cnt = (const int*)(F.ws + WS_CNT); const int* asg_e = (const int*)(F.ws + WS_ASGE); const int* asg_r = (const int*)(F.ws + WS_ASGR); const float* asg_w = (const float*)(F.ws + WS_ASGW);
    const float* rs1 = (const float*)(F.ws + WS_RS1);
    int* tslot = (int*)(F.ws + WS_TSLOT); int* stok = (int*)(F.ws + WS_STOK); float* sw = (float*)(F.ws + WS_SW); float* srs = (float*)(F.ws + WS_SRS); int* mtot = (int*)(F.ws + WS_MTOT);
    LAS int* ptot = (LAS int*)(F.lds + RING_OFF);
    LAS int* ppre = ptot + 512;
    LAS int* tot = ppre + 512; LAS int* start = tot + 32; LAS int* pre = start + 32;
    for (int ch = F.vcu; ch < 256; ch += F.G) {
        wg_sync();
        { const int e = F.tid & 31, part = F.tid >> 5; int t = 0, p = 0;
          for (int w = part * 16; w < part * 16 + 16; ++w) { const int c = cnt[w * 32 + e]; t += c; if (w < ch) p += c; }
          ptot[part * 32 + e] = t; ppre[part * 32 + e] = p; }
        wg_sync();
        if (F.tid < 32) { int t = 0, p = 0;
#pragma unroll
            for (int q = 0; q < 16; ++q) { t += ptot[q * 32 + F.tid]; p += ppre[q * 32 + F.tid]; }
            tot[F.tid] = t; pre[F.tid] = p; }
        wg_sync();
        if (F.tid == 0) { int s = 0; for (int e = 0; e < 32; ++e) { start[e] = s; s += tot[e]; } }
        wg_sync();
        if (F.tid < 256) { const size_t ag = (size_t)ch * 256 + F.tid; const int e = asg_e[ag], slot = start[e] + pre[e] + asg_r[ag], tok = ch * 128 + (F.tid >> 1);
            stok[slot] = tok; sw[slot] = asg_w[ag]; srs[slot] = rs1[tok]; tslot[ag] = slot; }
        if (ch == 0) {
            if (F.tid < 32) { mtot[F.tid] = tot[F.tid]; mtot[32 + F.tid] = start[F.tid]; }
            if (F.tid >= 256) { const int i = NSLOT + F.tid - 256; stok[i] = 0; sw[i] = 0.f; srs[i] = 0.f; }
            { const float* cbp = (const float*)(F.ws + WS_CBP); const int j = F.tid >> 8, c = F.tid & 255; float s2 = 0.f;
              for (int kr = 0; kr < 32; ++kr) s2 += cbp[(j * 32 + kr) * 256 + c];
              ((float*)(F.ws + WS_CB))[F.tid] = s2; } }
    }
}
DEVI int build_moe_table(const Frame& F) {
    const int* mtot = (const int*)(F.ws + WS_MTOT);
    LAS int* trow = (LAS int*)(F.lds + TAB_OFF); LAS int* tev = trow + 320; LAS int* tn = tev + 320;
    LAS int* mt = (LAS int*)(F.lds + SCR_OFF);
    if (F.tid < 64) mt[F.tid] = mtot[F.tid];
    wg_sync();
    if (F.tid == 0) { int nb = 0;
        for (int e = 0; e < 32; ++e) { const int t = mt[e], s = mt[32 + e];
            for (int o = 0; o < t; o += 256) { trow[nb] = s + o; tev[nb] = e * 512 + ((t - o) < 256 ? (t - o) : 256); ++nb; } }
        tn[0] = nb; }
    wg_sync();
    return tn[0];
}
DEVI void combine_phase(const Frame& F, const bf16_t* H, bf16_t* OUT, int zero_y) {
    const bf16_t* YB = (const bf16_t*)(F.ws + WS_YB); const int* tslot = (const int*)(F.ws + WS_TSLOT); float* rs2 = (float*)(F.ws + WS_RS2);
    const int gw = F.vcu * NWAVES + F.wave, NGW = F.G * NWAVES;
    for (int row = gw; row < NTOK; row += NGW) {
        const int s0 = tslot[2 * row], s1 = tslot[2 * row + 1]; float ss = 0.f;
#pragma unroll
        for (int hx = 0; hx < 2; ++hx) {
            const int col = 512 * hx + 8 * F.lane;
            const u32x4 h = *(const u32x4*)(H + (size_t)row * DM + col), y0 = *(const u32x4*)(YB + (size_t)s0 * DM + col), y1 = *(const u32x4*)(YB + (size_t)s1 * DM + col); u32x4 o;
#pragma unroll
            for (int j = 0; j < 4; ++j) { float lo = bflo(h[j]) + bflo(y0[j]) + bflo(y1[j]), hi = bfhi(h[j]) + bfhi(y0[j]) + bfhi(y1[j]); if (zero_y) { lo = bflo(h[j]); hi = bfhi(h[j]); } ss += lo * lo + hi * hi; o[j] = pk2(lo, hi); }
            *(u32x4*)(OUT + (size_t)row * DM + col) = o; }
        ss = wave_sum(ss);
        if (F.lane == 0) rs2[row] = 1.0f / sqrtf(ss * (1.0f / DM) + EPS);
    }
}
DEVI void rstd_from_partials(const Frame& F) {
    const float* ssq = (const float*)(F.ws + WS_SSQ); float* rs0 = (float*)(F.ws + WS_RS0);
    for (int row = F.vcu * 512 + F.tid; row < NTOK; row += F.G * 512) {
        const f32x4* p = (const f32x4*)(ssq + (size_t)row * 16); float s = 0.f;
#pragma unroll
        for (int q = 0; q < 4; ++q) { const f32x4 v = p[q]; s += (v[0] + v[1]) + (v[2] + v[3]); }
        rs0[row] = 1.0f / sqrtf(s * (1.0f / DM) + EPS); }
}
DEVI void cmpb_phase(const Frame& F, const Args& a) {
    const float* CP = (const float*)(F.ws + WS_CP); const float* CB = (const float*)(F.ws + WS_CB); const float* rope = (const float*)(F.ws + WS_ROPE);
    const bf16_t* W2T = (const bf16_t*)(F.ws + WS_W2T);
    bf16_t* KC = (bf16_t*)(F.ws + WS_KC); bf16_t* VC = (bf16_t*)(F.ws + WS_VC);
    LAS unsigned char* hl = F.lds + RING_OFF;
    LAS float* ol = (LAS float*)(F.lds + RING_OFF + 65536);
    const float kn = a.in[16][F.lane];
    const int fr = F.lane & 15, fq = F.lane >> 4;
    for (int wg = F.vcu; wg < 256; wg += F.G) {
        const int row0 = wg * 64, j = row0 >> 13, rho0 = row0 & 8191;
        { const int r = F.tid >> 3, c0 = (F.tid & 7) * 32;
          f32x4 acc8[8];
#pragma unroll
          for (int q = 0; q < 8; ++q) acc8[q] = *(const f32x4*)(CB + j * 256 + c0 + 4 * q);
#pragma unroll
          for (int ks = 0; ks < 4; ++ks) { const float* src = CP + ((size_t)(j * 4 + ks) * 8192 + rho0 + r) * 256 + c0;
#pragma unroll
              for (int q = 0; q < 8; ++q) acc8[q] += *(const f32x4*)(src + 4 * q); }
#pragma unroll
          for (int q = 0; q < 8; ++q) { f32x4 g;
#pragma unroll
              for (int e = 0; e < 4; ++e) { const float x = acc8[q][e], uu = 0.7978845608028654f * (x + 0.044715f * x * x * x); g[e] = x * sigmoid_f(2.0f * uu); }
              *(LAS u32x2*)(hl + r * 528 + (c0 + 4 * q) * 2) = pack4(g); } }
        wg_sync();
        { const int mt = F.wave & 3, np = F.wave >> 2;
          f32x4 d[2]; d[0] = (f32x4){0.f, 0.f, 0.f, 0.f}; d[1] = d[0];
#pragma unroll
          for (int st = 0; st < 8; ++st) {
              const bf16x8 hf = *(const LAS bf16x8*)(hl + (16 * mt + fr) * 528 + (32 * st + 8 * fq) * 2);
#pragma unroll
              for (int t = 0; t < 2; ++t) { const bf16x8 wf = *(const bf16x8*)(W2T + ((size_t)(j * 64 + 32 * np + 16 * t + fr)) * 256 + 32 * st + 8 * fq);
                  d[t] = __builtin_amdgcn_mfma_f32_16x16x32_bf16(wf, hf, d[t], 0, 0, 0); } }
#pragma unroll
          for (int t = 0; t < 2; ++t) *(LAS f32x4*)(ol + (16 * mt + fr) * 64 + 32 * np + 16 * t + 4 * fq) = d[t]; }
        wg_sync();
#pragma unroll
        for (int q = 0; q < 8; ++q) {
            const int r = F.wave * 8 + q, rho = rho0 + r, bg = rho >> 7, n = rho & 127;
            bf16_t* dst = (j == 0 ? KC : VC) + (size_t)rho * 64 + F.lane;
            float o = ol[r * 64 + F.lane];
            if (n == 127) { *dst = 0; continue; }
            if (j == 0) {
                const float ms = wave_sum(o * o) * (1.0f / 64.0f); const float y = o * (1.0f / sqrtf(ms + EPS)) * kn;
                const float other = __shfl_xor(y, 32);
                const int row = (bg >> 2) * SEQ + 16 * n + 31; const float cs = rope[(size_t)row * 64 + (F.lane & 31)], sn = rope[(size_t)row * 64 + 32 + (F.lane & 31)];
                o = (F.lane < 32) ? (y * cs - other * sn) : (y * cs + other * sn);
            }
            *dst = (bf16_t)(pk2(o, 0.f) & 0xffffu);
        }
        wg_sync();
    }
}

#ifndef ATT_REP
#define ATT_REP 1
#endif
namespace att {
constexpr int KS0 = 0, VS0 = 24576, WSF = 49152, OFN = 51200, UNI = 116736;
typedef const LAS char* lptr;
DEVI int crow(int r, int hi) { return (r & 3) + 8 * (r >> 2) + 4 * hi; }
DEVI void glds16(const void* gsrc, unsigned lds_dst) { unsigned keep;
    asm volatile("s_mov_b32 %0, m0\n\ts_mov_b32 m0, %2\n\ts_nop 0\n\tglobal_load_lds_dwordx4 %1, off\n\ts_mov_b32 m0, %0" : "=&s"(keep) : "v"(gsrc), "s"(lds_dst) : "memory"); }
DEVI float xlane32(float v) { return __shfl_xor(v, 32); }
DEVI void qkt(f32x16& p0, f32x16& p1, lptr Kslot, const bf16x8* qr, float cinit, int r32, int hi) {
    lptr kb = Kslot + hi * 1024 + r32 * 16;
#pragma unroll
    for (int r = 0; r < 16; ++r) { p0[r] = cinit; p1[r] = cinit; }
#pragma unroll
    for (int d0 = 0; d0 < 4; ++d0) {
        const bf16x8 b0 = *(const LAS bf16x8*)(kb + d0 * 2048), b1 = *(const LAS bf16x8*)(kb + d0 * 2048 + 512);
        p0 = __builtin_amdgcn_mfma_f32_32x32x16_bf16(b0, qr[d0], p0, 0, 0, 0); p1 = __builtin_amdgcn_mfma_f32_32x32x16_bf16(b1, qr[d0], p1, 0, 0, 0); }
}
DEVI float rowmax(const f32x16& p0, const f32x16& p1) {
    float m = fmaxf(p0[0], p1[0]);
#pragma unroll
    for (int r = 1; r < 16; ++r) m = fmaxf(m, fmaxf(p0[r], p1[r]));
    return fmaxf(m, xlane32(m));
}
DEVI float max3f(float a, float b, float c) { float r; asm("v_max3_f32 %0, %1, %2, %3" : "=v"(r) : "v"(a), "v"(b), "v"(c)); return r; }
DEVI float rowmax3(const f32x16& p0, const f32x16& p1) {
    float a = max3f(p0[0], p0[1], p1[0]), b = max3f(p0[2], p0[3], p1[1]); a = max3f(a, p1[2], p1[3]);
#pragma unroll
    for (int r = 4; r < 16; r += 4) { a = max3f(a, p0[r], p0[r + 1]); b = max3f(b, p0[r + 2], p0[r + 3]); a = max3f(a, p1[r], p1[r + 1]); b = max3f(b, p1[r + 2], p1[r + 3]); }
    const float m = max3f(a, b, b);
    return max3f(m, xlane32(m), m);
}
DEVI void qk2(f32x16& p0, f32x16& p1, lptr Kslot, const bf16x8* qr, const f32x16& negm, int r32, int hi) {
    lptr kb = Kslot + hi * 1024 + r32 * 16;
    bf16x8 kf[8];
#pragma unroll
    for (int d0 = 0; d0 < 4; ++d0) { kf[2 * d0] = *(const LAS bf16x8*)(kb + d0 * 2048); kf[2 * d0 + 1] = *(const LAS bf16x8*)(kb + d0 * 2048 + 512); }
    asm volatile("s_waitcnt lgkmcnt(0)" : "+v"(kf[0]), "+v"(kf[1]), "+v"(kf[2]), "+v"(kf[3]), "+v"(kf[4]), "+v"(kf[5]), "+v"(kf[6]), "+v"(kf[7]) :: "memory");
    p0 = __builtin_amdgcn_mfma_f32_32x32x16_bf16(kf[0], qr[0], negm, 0, 0, 0); p1 = __builtin_amdgcn_mfma_f32_32x32x16_bf16(kf[1], qr[0], negm, 0, 0, 0);
#pragma unroll
    for (int d0 = 1; d0 < 4; ++d0) { p0 = __builtin_amdgcn_mfma_f32_32x32x16_bf16(kf[2 * d0], qr[d0], p0, 0, 0, 0); p1 = __builtin_amdgcn_mfma_f32_32x32x16_bf16(kf[2 * d0 + 1], qr[d0], p1, 0, 0, 0); }
}
DEVI void pv(f32x16* o, int vb, bf16x8 pa0, bf16x8 pa1, bf16x8 pa2, bf16x8 pa3) {
#pragma unroll
    for (int d0 = 0; d0 < 2; ++d0) { s16x4 lo[4], hi[4];
#pragma unroll
        for (int ks = 0; ks < 4; ++ks) {
            asm volatile("ds_read_b64_tr_b16 %0,%1 offset:%c2" : "=&v"(lo[ks]) : "v"(vb), "i"(d0 * 4096 + ks * 1024) : "memory");
            asm volatile("ds_read_b64_tr_b16 %0,%1 offset:%c2" : "=&v"(hi[ks]) : "v"(vb), "i"(d0 * 4096 + ks * 1024 + 512) : "memory"); }
        asm volatile("s_waitcnt lgkmcnt(0)" ::: "memory"); __builtin_amdgcn_sched_barrier(0);
#define ATT_PK(k) (bf16x8){lo[k][0], lo[k][1], lo[k][2], lo[k][3], hi[k][0], hi[k][1], hi[k][2], hi[k][3]}
        o[d0] = __builtin_amdgcn_mfma_f32_32x32x16_bf16(pa0, ATT_PK(0), o[d0], 0, 0, 0);
        o[d0] = __builtin_amdgcn_mfma_f32_32x32x16_bf16(pa1, ATT_PK(1), o[d0], 0, 0, 0);
        o[d0] = __builtin_amdgcn_mfma_f32_32x32x16_bf16(pa2, ATT_PK(2), o[d0], 0, 0, 0);
        o[d0] = __builtin_amdgcn_mfma_f32_32x32x16_bf16(pa3, ATT_PK(3), o[d0], 0, 0, 0);
#undef ATT_PK
    }
}
DEVI bf16x8 packp(const f32x16& p, int b) { u32x4 w; w.x = pk2(p[b], p[b + 1]); w.y = pk2(p[b + 2], p[b + 3]); w.z = pk2(p[b + 4], p[b + 5]); w.w = pk2(p[b + 6], p[b + 7]); return __builtin_bit_cast(bf16x8, w); }
DEVI void scale_rows(f32x16* o, LAS float* wsf, float fac, int r32, int hi) {
    if (hi == 0) wsf[r32] = fac;
    LDS_WAIT();
#pragma unroll
    for (int r = 0; r < 16; ++r) { const float f = wsf[crow(r, hi)]; o[0][r] *= f; o[1][r] *= f; }
    LDS_WAIT();
}
DEVI void fold_rows(const f32x16* o, LAS float* ofl, LAS float* wsf, float fac, int r32, int hi) {
    if (hi == 0) wsf[r32] = fac;
    LDS_WAIT();
#pragma unroll
    for (int r = 0; r < 16; ++r) { const int q = crow(r, hi); const float f = wsf[q]; ofl[q * 64 + r32] += o[0][r] * f; ofl[q * 64 + 32 + r32] += o[1][r] * f; }
    LDS_WAIT();
}
DEVI void tile_step(f32x16* o, float& m, float& l, const bf16x8* qr, lptr Kslot, int vb, LAS float* wsf, int r32, int hi, float cinit, bool domask, int kbase, int lo, int hi_) {
    f32x16 p0, p1;
    qkt(p0, p1, Kslot, qr, cinit, r32, hi);
    if (domask) {
#pragma unroll
        for (int r = 0; r < 16; ++r) { const int kp = kbase + crow(r, hi); if (kp < lo || kp > hi_) p0[r] = -INFINITY; if (kp + 32 < lo || kp + 32 > hi_) p1[r] = -INFINITY; } }
    const float rm = rowmax(p0, p1);
    if (__builtin_amdgcn_ballot_w64(rm > m + 8.0f) != 0ull) {
        const float mn = fmaxf(m, rm), f = __builtin_amdgcn_exp2f(m - mn); m = mn;
        l *= f;
        scale_rows(o, wsf, f, r32, hi);
    }
    float ps = 0.f;
#pragma unroll
    for (int r = 0; r < 16; ++r) { p0[r] = __builtin_amdgcn_exp2f(p0[r] - m); p1[r] = __builtin_amdgcn_exp2f(p1[r] - m); ps += p0[r] + p1[r]; }
    l += ps;
    pv(o, vb, packp(p0, 0), packp(p0, 8), packp(p1, 0), packp(p1, 8));
}

DEVI void attn_unit(int b, int g, int qb, const bf16_t* Q, const bf16_t* KV, const bf16_t* KC, const bf16_t* VC, const float* gates, bf16_t* O, LAS char* shm) {
    const int tid = threadIdx.x, lane = tid & 63, r32 = lane & 31, hi = lane >> 5; const int wid = __builtin_amdgcn_readfirstlane(tid >> 6);
    const int tl = r32 >> 2, head = r32 & 3, tq0 = qb * 64, tq = tq0 + 8 * wid + tl, row = b * SEQ + tq, bg = b * 4 + g;
    const unsigned lds0 = (unsigned)(uintptr_t)shm;
    LAS float* wsf = (LAS float*)(shm + WSF) + wid * 64;
    const bf16_t* Ks = KV + 2 * KVS + (size_t)bg * SEQ * 64; const bf16_t* Vs = KV + 3 * KVS + (size_t)bg * SEQ * 64;
    const bf16_t* Kw = KV + 4 * KVS + (size_t)bg * SEQ * 64; const bf16_t* Vw = KV + 5 * KVS + (size_t)bg * SEQ * 64;
    const bf16_t* Kc = KC + (size_t)bg * 128 * 64; const bf16_t* Vc = VC + (size_t)bg * 128 * 64;
    const int koff = lane * 64 + wid * 8, voff = (16 * (wid & 3) + (lane >> 2)) * 64 + (wid >> 2) * 32 + (lane & 3) * 8;
#define ATT_DMA(Kt, Vt, slot) do { glds16((Kt) + koff, (unsigned)__builtin_amdgcn_readfirstlane(lds0 + KS0 + (slot) * 8192 + wid * 1024)); \
                                   glds16((Vt) + voff, (unsigned)__builtin_amdgcn_readfirstlane(lds0 + VS0 + (slot) * 8192 + wid * 1024)); } while (0)
#define ATT_WAITBAR() asm volatile("s_waitcnt vmcnt(0) lgkmcnt(0)\n\ts_barrier" ::: "memory")
    const int vb0 = (int)(lds0 + VS0) + ((lane >> 4) & 1) * 32 + (lane & 3) * 8 + (4 * hi + ((lane & 15) >> 2)) * 64;
    const lptr kslot0 = (lptr)(shm + KS0);
#ifdef ATT_TSEG
    unsigned long long tsa_ = __builtin_amdgcn_s_memrealtime(), tsb_ = 0, tsc_ = 0, tsd_ = 0;
#endif
    ATT_WAITBAR();
    const int nC = (qb >= 16) ? 2 : 1;
    const int wlo = qb >= 8 ? qb - 8 : 0, nW = qb - wlo + 1;
    bf16x8 qr[4];
    { const bf16_t* qp = Q + (size_t)row * DM + (4 * g + head) * 64 + 8 * hi;
#pragma unroll
      for (int d0 = 0; d0 < 4; ++d0) qr[d0] = *(const bf16x8*)(qp + 16 * d0); }
    const float* gp = gates + (size_t)row * 48 + (g * 4 + head) * 3; const float gate_c = (PROBE == 4) ? 0.f : gp[0], gate_s = (PROBE == 5) ? 0.f : gp[1], gate_w = (PROBE == 6) ? 0.f : gp[2];
    ATT_DMA(Kc, Vc, 0); if (nC == 2) ATT_DMA(Kc + 64 * 64, Vc + 64 * 64, 1);
    ATT_DMA(Kw + (size_t)wlo * 4096, Vw + (size_t)wlo * 4096, 2);
    f32x16 o[2];
    LAS float* ofl = (LAS float*)(shm + OFN) + wid * 2048;
#pragma unroll
    for (int r = 0; r < 16; ++r) { ofl[crow(r, hi) * 64 + r32] = 0.f; ofl[crow(r, hi) * 64 + 32 + r32] = 0.f; }
    unsigned selmask = (qb == 31) ? 0xffffffffu : ((2u << qb) - 1u);
    asm volatile("s_waitcnt vmcnt(2) lgkmcnt(0)\n\ts_barrier" ::: "memory");
#ifdef ATT_TSEG
    tsb_ = __builtin_amdgcn_s_memrealtime();
#endif
    {
        const int nmax = (tq - 31) >> 4;
        f32x16 pa0, pa1, pb0, pb1;
        qkt(pa0, pa1, kslot0, qr, 0.f, r32, hi);
        if (nC == 2) qkt(pb0, pb1, kslot0 + 8192, qr, 0.f, r32, hi);
#pragma unroll
        for (int r = 0; r < 16; ++r) { const int n0 = crow(r, hi); if (n0 > nmax) pa0[r] = -INFINITY; if (n0 + 32 > nmax) pa1[r] = -INFINITY; }
        float m = rowmax(pa0, pa1), ps = 0.f;
        if (nC == 2) {
#pragma unroll
            for (int r = 0; r < 16; ++r) { const int n0 = crow(r, hi); if (n0 + 64 > nmax) pb0[r] = -INFINITY; if (n0 + 96 > nmax) pb1[r] = -INFINITY; }
            m = fmaxf(m, rowmax(pb0, pb1)); }
        if (m == -INFINITY) m = 0.f;
#pragma unroll
        for (int r = 0; r < 16; ++r) { pa0[r] = __builtin_amdgcn_exp2f(pa0[r] - m); pa1[r] = __builtin_amdgcn_exp2f(pa1[r] - m); ps += pa0[r] + pa1[r]; }
        if (nC == 2) {
#pragma unroll
            for (int r = 0; r < 16; ++r) { pb0[r] = __builtin_amdgcn_exp2f(pb0[r] - m); pb1[r] = __builtin_amdgcn_exp2f(pb1[r] - m); ps += pb0[r] + pb1[r]; } }
        ps += xlane32(ps);
        const float inv = ps > 0.f ? __builtin_amdgcn_rcpf(ps) : 0.f;
#pragma unroll
        for (int r = 0; r < 16; ++r) { o[0][r] = 0.f; o[1][r] = 0.f; }
        pv(o, vb0, packp(pa0, 0), packp(pa0, 8), packp(pa1, 0), packp(pa1, 8));
        if (nC == 2) pv(o, vb0 + 8192, packp(pb0, 0), packp(pb0, 8), packp(pb1, 0), packp(pb1, 8));
        fold_rows(o, ofl, wsf, gate_c * inv, r32, hi);
        if (qb >= 16) {
#define ATT_QSUM(x) do { float t_ = (x) * inv; t_ += __builtin_bit_cast(float, __builtin_amdgcn_update_dpp(0, __builtin_bit_cast(int, t_), 0xB1, 0xf, 0xf, false)); \
                         t_ += __builtin_bit_cast(float, __builtin_amdgcn_update_dpp(0, __builtin_bit_cast(int, t_), 0x4E, 0xf, 0xf, false)); (x) = t_; } while (0)
#pragma unroll
            for (int r = 0; r < 16; ++r) { ATT_QSUM(pa0[r]); ATT_QSUM(pa1[r]); ATT_QSUM(pb0[r]); ATT_QSUM(pb1[r]); }
#undef ATT_QSUM
            float sc[16], fo[16];
#define ATT_H4(h4, r) ((h4) == 0 ? pa0[r] : (h4) == 1 ? pa1[r] : (h4) == 2 ? pb0[r] : pb1[r])
#pragma unroll
            for (int h4 = 0; h4 < 4; ++h4)
#pragma unroll
                for (int gq = 0; gq < 4; ++gq) fo[h4 * 4 + gq] = xlane32(ATT_H4(h4, 4 * gq));
#pragma unroll
            for (int h4 = 0; h4 < 4; ++h4)
#pragma unroll
                for (int gq = 0; gq < 4; ++gq) {
                    const int s = h4 * 4 + gq;
                    const float nxt_lo = fo[s];
                    const float nxt_hi = (s < 15) ? fo[s + 1] : 0.f;
                    float v = ATT_H4(h4, 4 * gq) + 2.0f * (ATT_H4(h4, 4 * gq + 1) + ATT_H4(h4, 4 * gq + 2) + ATT_H4(h4, 4 * gq + 3)) + (hi ? nxt_hi : nxt_lo);
                    const int j = 8 * h4 + 2 * gq + hi;
                    if (j == 0 || j == qb || j == qb - 1) v = INFINITY; else if (j > qb) v = -INFINITY;
                    sc[s] = v; }
#undef ATT_H4
            float so[16];
#pragma unroll
            for (int s = 0; s < 16; ++s) so[s] = xlane32(sc[s]);
            float x4[4];
#pragma unroll
            for (int i = 0; i < 4; ++i) x4[i] = (head == 0) ? sc[4 * i] : (head == 1) ? sc[4 * i + 1] : (head == 2) ? sc[4 * i + 2] : sc[4 * i + 3];
            unsigned own = 0u;
#pragma unroll
            for (int i = 0; i < 4; ++i) {
                int rk = 0; const float xv = x4[i];
#pragma unroll
                for (int s2 = 0; s2 < 16; ++s2) {
                    const int g2 = s2 >> 2, q2 = s2 & 3;
                    if (g2 < i) { rk += (sc[s2] >= xv) ? 1 : 0; rk += (so[s2] >= xv) ? 1 : 0; }
                    else if (g2 > i) { rk += (sc[s2] > xv) ? 1 : 0; rk += (so[s2] > xv) ? 1 : 0; }
                    else { const bool lt = q2 < head, eq = q2 == head;
                        rk += eq ? 0 : (lt ? ((sc[s2] >= xv) ? 1 : 0) : ((sc[s2] > xv) ? 1 : 0));
                        rk += (lt || (eq && hi)) ? ((so[s2] >= xv) ? 1 : 0) : ((so[s2] > xv) ? 1 : 0); }
                }
                if (rk < 16) own |= 1u << (8 * i);
            }
            own <<= 2 * head;
            own |= (unsigned)__builtin_amdgcn_update_dpp(0, (int)own, 0xB1, 0xf, 0xf, false);
            own |= (unsigned)__builtin_amdgcn_update_dpp(0, (int)own, 0x4E, 0xf, 0xf, false);
            own <<= hi;
            selmask = own | (unsigned)__shfl_xor((int)own, 32);
        }
    }
    unsigned uni = selmask, wuni = selmask;
    if (qb >= 16) {
#pragma unroll
        for (int off = 1; off < 64; off <<= 1) uni |= (unsigned)__shfl_xor((int)uni, off);
        wuni = (unsigned)__builtin_amdgcn_readfirstlane((int)uni);
        LAS unsigned* uw = (LAS unsigned*)(shm + UNI);
        if (lane == 0) uw[wid] = uni;
        ATT_WAITBAR();
        uni = 0u;
#pragma unroll
        for (int w = 0; w < 8; ++w) uni |= uw[w];
        uni = (unsigned)__builtin_amdgcn_readfirstlane((int)uni);
    } else { ATT_WAITBAR(); }
#ifdef ATT_TSEG
    tsc_ = __builtin_amdgcn_s_memrealtime();
#endif
    const unsigned smask = uni & ((qb == 31) ? 0xffffffffu : ((2u << qb) - 1u));
    const int nS = __builtin_popcount(smask), nT = nW + nS;
    unsigned rem_issue = smask, rem_qk = smask;
#define ATT_ISSUE(tt) do { const int sl_ = ((tt) + 2) % 3; \
        if ((tt) < nW) { const int j_ = wlo + (tt); ATT_DMA(Kw + (size_t)j_ * 4096, Vw + (size_t)j_ * 4096, sl_); } \
        else { const int j_ = __builtin_ctz(rem_issue); rem_issue &= rem_issue - 1u; ATT_DMA(Ks + (size_t)j_ * 4096, Vs + (size_t)j_ * 4096, sl_); } } while (0)
    if (nT > 1) ATT_ISSUE(1);
    ATT_WAITBAR();
    if (nT > 2) ATT_ISSUE(2);
    float mref = 0.f, l = 0.f;
#pragma unroll
    for (int r = 0; r < 16; ++r) { o[0][r] = 0.f; o[1][r] = 0.f; }
    f32x16 pc0, pc1, negm;
#pragma unroll
    for (int r = 0; r < 16; ++r) negm[r] = 0.f;
    qk2(pc0, pc1, kslot0 + 2 * 8192, qr, negm, r32, hi);
    int jc = wlo; bool cS = false, cskip = false;
    for (int t = 0; t < nT; ++t) {
        const bool hasn = t + 1 < nT; int jn = 0; bool nSel = false, nskip = true;
        if (hasn) { if (t + 1 < nW) { jn = wlo + t + 1; nskip = false; } else { jn = __builtin_ctz(rem_qk); rem_qk &= rem_qk - 1u; nSel = true; nskip = ((wuni >> jn) & 1u) == 0u; } }
        if (t > 0) { ATT_WAITBAR(); if (t + 2 < nT) ATT_ISSUE(t + 2); }
        f32x16 pn0, pn1;
        if (!nskip) {
            const float nm = (nSel && ((selmask >> jn) & 1u) == 0u) ? -INFINITY : -mref;
#pragma unroll
            for (int r = 0; r < 16; ++r) negm[r] = nm;
            qk2(pn0, pn1, kslot0 + ((t + 3) % 3) * 8192, qr, negm, r32, hi);
        }
        if (!cskip) {
            const bool dm = cS ? (jc == qb) : ((jc == qb) || (jc + 8 == qb));
            if (dm) { const int lo = cS ? 0 : tq - 511, kbase = 64 * jc;
#pragma unroll
                for (int r = 0; r < 16; ++r) { const int kp = kbase + crow(r, hi); if (kp < lo || kp > tq) pc0[r] = -INFINITY; if (kp + 32 < lo || kp + 32 > tq) pc1[r] = -INFINITY; } }
            const float rm = rowmax3(pc0, pc1);
            if (__builtin_amdgcn_ballot_w64(rm > 8.0f) != 0ull) {
                const float dl = fmaxf(rm, 0.f), f = __builtin_amdgcn_exp2f(-dl); mref += dl; l *= f;
#pragma unroll
                for (int r = 0; r < 16; ++r) { pc0[r] -= dl; pc1[r] -= dl; }
                if (!nskip) {
#pragma unroll
                    for (int r = 0; r < 16; ++r) { pn0[r] -= dl; pn1[r] -= dl; } }
                scale_rows(o, wsf, f, r32, hi);
            }
            float ps = 0.f;
#pragma unroll
            for (int r = 0; r < 16; ++r) { pc0[r] = __builtin_amdgcn_exp2f(pc0[r]); pc1[r] = __builtin_amdgcn_exp2f(pc1[r]); ps = (ps + pc0[r]) + pc1[r]; }
            l += ps;
            pv(o, vb0 + ((t + 2) % 3) * 8192, packp(pc0, 0), packp(pc0, 8), packp(pc1, 0), packp(pc1, 8));
        }
        if (t + 1 == nW) {
            l += xlane32(l); fold_rows(o, ofl, wsf, gate_w * (l > 0.f ? __builtin_amdgcn_rcpf(l) : 0.f), r32, hi);
#pragma unroll
            for (int r = 0; r < 16; ++r) { o[0][r] = 0.f; o[1][r] = 0.f; }
            l = 0.f; }
        pc0 = pn0; pc1 = pn1; jc = jn; cS = nSel; cskip = nskip;
    }
#undef ATT_ISSUE
    l += xlane32(l); fold_rows(o, ofl, wsf, gate_s * (l > 0.f ? __builtin_amdgcn_rcpf(l) : 0.f), r32, hi);
#ifdef ATT_TSEG
    tsd_ = __builtin_amdgcn_s_memrealtime();
    { const unsigned long long seg_ = (ATT_TSEG == 1) ? (tsb_ - tsa_) : (ATT_TSEG == 2) ? (tsc_ - tsb_) : (tsd_ - tsc_);
      LAS unsigned* tw_ = (LAS unsigned*)(shm + UNI + 64) + wid; if (lane == 0) tw_[0] += (unsigned)seg_; }
#endif
    {
#pragma unroll
      for (int i = 0; i < 4; ++i) { const int q = i * 8 + (lane >> 3), chn = lane & 7; const f32x4 v0 = *(const LAS f32x4*)(ofl + q * 64 + chn * 8), v1 = *(const LAS f32x4*)(ofl + q * 64 + chn * 8 + 4);
          u32x4 v; v.x = pk2(v0[0], v0[1]); v.y = pk2(v0[2], v0[3]); v.z = pk2(v1[0], v1[1]); v.w = pk2(v1[2], v1[3]);
          *(u32x4*)(O + (size_t)(b * SEQ + tq0 + 8 * wid + (q >> 2)) * DM + (4 * g + (q & 3)) * 64 + chn * 8) = v; }
      LDS_WAIT(); }
#undef ATT_DMA
#undef ATT_WAITBAR
}
DEVI void attn_phase(const Frame& F, const Args& args) {
    const bf16_t* Q = (const bf16_t*)(F.ws + WS_Q); const bf16_t* KV = (const bf16_t*)(F.ws + WS_KV); const bf16_t* KC = (const bf16_t*)(F.ws + WS_KC); const bf16_t* VC = (const bf16_t*)(F.ws + WS_VC);
    const float* gates = (const float*)(F.ws + WS_GATES); bf16_t* O = (bf16_t*)(F.ws + WS_O);
#if PROBE == 1
    { u32x4* z = (u32x4*)O; for (size_t i = (size_t)F.vcu * 512 + F.tid; i < (size_t)NTOK * DM / 8; i += (size_t)F.G * 512) z[i] = (u32x4){0u, 0u, 0u, 0u}; return; }
#endif
#ifdef ATT_TSEG
    { LAS unsigned* tw_ = (LAS unsigned*)(F.lds + RING_OFF + UNI + 64); if (F.tid < 8) tw_[F.tid] = 0u; asm volatile("s_waitcnt lgkmcnt(0)\n\ts_barrier" ::: "memory"); }
#endif
    for (int i = 0;; ++i) {
        const int idx = (i / ATT_REP) * F.G + F.vcu; if (idx >= 2048) break;
        const int ii = idx >> 8, bgq = idx & 255, bg = bgq >> 2, qt = bgq & 3;
        const int qbc = (ii & 1) ? (8 * (ii >> 1) + 7 - qt) : (8 * (ii >> 1) + qt);
        attn_unit(bg >> 2, bg & 3, qbc, Q, KV, KC, VC, gates, O, (LAS char*)(F.lds + RING_OFF));
        const int qb = qbc;
        (void)qb;
    }
    asm volatile("s_waitcnt vmcnt(0) lgkmcnt(0)\n\ts_barrier" ::: "memory");
#ifdef ATT_TSEG
    { LAS unsigned* tw_ = (LAS unsigned*)(F.lds + RING_OFF + UNI + 64); const unsigned long long d_ = (unsigned long long)tw_[0] * 3ull; const unsigned long long t1_ = __builtin_amdgcn_s_memrealtime();
      while (__builtin_amdgcn_s_memrealtime() - t1_ < d_) __builtin_amdgcn_s_sleep(8); }
#endif
}
}

#ifndef PH_MASK
#define PH_MASK 0xffffffffu
#endif
#ifndef REP_MASK
#define REP_MASK 0u
#endif
#define PH(k) (((PH_MASK) >> (k)) & 1u)
#define REPB(k) (((REP_MASK) >> (k)) & 1u)
#define GRID_BAR() xcd_barrier(bar)
#define REFRESH() do { int t_ = threadIdx.x; asm volatile("" : "+v"(t_)); F.tid = t_; F.lane = t_ & 63; F.wave = __builtin_amdgcn_readfirstlane(t_ >> 6); } while (0)
template <int K, int L>
DEVI void phase(Frame& F, const Args& args, int nblk) {
    unsigned char* ws = args.ws;
    LAS unsigned char* ring = F.lds + RING_OFF;
    bf16_t* const HA = (bf16_t*)(ws + WS_HA); bf16_t* const HB = (bf16_t*)(ws + WS_HB);
    bf16_t* const hin = (L == 0) ? HA : HB;
    bf16_t* const hmx = (L == 0) ? HB : HA;
    REFRESH();
    if constexpr (K == 0) p0_prologue(F, args);
    if constexpr (K == 2) { ProbPw1 P; P.A = (const char*)HA; P.Bt = (const char*)(ws + WS_WPW1); P.K = DM; P.ldb = 2048; P.G = F.G; P.c = F.vcu;
          P.rstd = (const float*)(ws + WS_RS0); P.bias = args.in[7]; P.U = (bf16_t*)(ws + WS_U);
          pg8::gemm_phase(ring, P); }
    if constexpr (K == 3) {
        if (F.vcu & 1) { prep_layer(F, args, 0); wg_sync(); conv_phase(F, args); }
        else { conv_phase(F, args); wg_sync(); prep_layer(F, args, 0); } }
    if constexpr (K == 4) { ProbRes P; P.A = (const char*)(ws + WS_V); P.Bt = (const char*)(ws + WS_WPW2); P.K = DM; P.ldb = 2048; P.G = F.G; P.c = F.vcu;
          P.RES = HA; P.OUT = HB; P.bias = args.in[13];
          pg8::gemm_phase(ring, P); }
    if constexpr (K == 5) { ProbWin P; P.A = (const char*)HB; P.Bt = (const char*)(ws + WS_WIN); P.K = DM; P.ldb = 2048; P.G = F.G; P.c = F.vcu;
          P.rstd = (const float*)(ws + WS_SSQ); P.rope = (const float*)(ws + WS_ROPE); P.qnorm = args.in[15]; P.knorm = args.in[16];
          P.Q = (bf16_t*)(ws + WS_Q); P.KV = (bf16_t*)(ws + WS_KV); P.gates = (float*)(ws + WS_GATES);
          { LAS float* lr = (LAS float*)(F.lds + SCR_OFF);
            for (int idx = F.tid; idx < 8 * 256; idx += 512) { const int Lq = (idx >> 8) * F.G + F.vcu;
                if (Lq < 128 * 11) { const f32x4* pp = (const f32x4*)(P.rstd + (size_t)((Lq / 11) * 256 + (idx & 255)) * 16); const f32x4 st = (pp[0] + pp[1]) + (pp[2] + pp[3]);
                    lr[idx] = 1.0f / sqrtf(((st[0] + st[1]) + (st[2] + st[3])) * (1.0f / DM) + EPS); } }
            wg_sync(); P.lrs = lr; }
          pg8::gemm_phase(ring, P); }
    if constexpr (K == 6) { ProbCmp P; P.A = (const char*)(ws + WS_KV); P.Bt = (const char*)(ws + WS_WC1); P.K = 512; P.ldb = 4096; P.G = F.G; P.c = F.vcu;
          P.CP = (float*)(ws + WS_CP);
          pg8::gemm_phase(ring, P); }
    if constexpr (K == 7) cmpb_phase(F, args);
    if constexpr (K == 8) {
        if (F.vcu & 1) { prep_layer(F, args, 1); wg_sync(); REFRESH(); }
        att::attn_phase(F, args);
        if (!(F.vcu & 1)) { REFRESH(); prep_layer(F, args, 1); } }
    if constexpr (K == 9) { ProbRes P; P.A = (const char*)(ws + WS_O); P.Bt = (const char*)(ws + WS_WOUT); P.K = DM; P.ldb = 2048; P.G = F.G; P.c = F.vcu;
          P.RES = HB; P.OUT = HA; P.bias = nullptr;
          pg8::gemm_phase(ring, P); }
    if constexpr (K == 11) router_phase(F, args, L, hmx);
    if constexpr (K == 12) fill_phase(F);
    if constexpr (K == 13) { ProbGateUp P; P.A = (const char*)hmx; P.Bt = (const char*)(ws + WS_WGU); P.K = DM; P.ldb = 2048; P.G = F.G; P.c = F.vcu;
          P.tab_row = (const LAS int*)(F.lds + TAB_OFF); P.tab_ev = P.tab_row + 320; P.nblk = nblk;
          P.slot_rs = (const float*)(ws + WS_SRS); P.HBUF = (bf16_t*)(ws + WS_HBUF);
          { LAS unsigned* go = (LAS unsigned*)(F.lds + SCR_OFF); const int* stok = (const int*)(ws + WS_STOK);
            for (int idx = F.tid; idx < 8 * 256; idx += 512) { const int Lq = (idx >> 8) * F.G + F.vcu; if (Lq < nblk * 4) go[idx] = (unsigned)stok[P.tab_row[Lq >> 2] + (idx & 255)] * 2048u; }
            wg_sync(); P.goff = go; }
          pg8::gemm_phase(ring, P);
          ProbPP Q2; Q2.A = (const char*)(ws + WS_PB); Q2.Bt = (const char*)(ws + WS_WPP) + (size_t)L * DM * PLE * 2; Q2.K = PLE; Q2.ldb = 512; Q2.G = F.G; Q2.c = F.vcu;
          Q2.O = (bf16_t*)(ws + WS_PP);
          { const int nun = nblk * 4, maxu = (nun + F.G - 1) / F.G; int tl = nun - (maxu - 1) * F.G; if (tl >= F.G || tl < 0) tl = 0; Q2.tail_lo = tl; }
          pg8::gemm_phase(ring, Q2); }
    if constexpr (K == 14) { ProbDown P; P.A = (const char*)(ws + WS_HBUF); P.Bt = (const char*)(ws + WS_WDN); P.K = DEXP; P.ldb = 1024; P.G = F.G; P.c = F.vcu;
          P.tab_row = (const LAS int*)(F.lds + TAB_OFF); P.tab_ev = P.tab_row + 320; P.nblk = nblk;
          P.slot_w = (const float*)(ws + WS_SW); P.YB = (bf16_t*)(ws + WS_YB);
          pg8::gemm_phase(ring, P); }
    if constexpr (K == 15) combine_phase(F, hmx, hin, (PROBE == 2 && L == 1) || (PROBE == 3 && L == 0));
#ifdef STAGGER_US
    if constexpr (K == STAGGER_PH) { if (F.vcu & 1) { const unsigned long long t0_ = __builtin_amdgcn_s_memrealtime(); while (__builtin_amdgcn_s_memrealtime() - t0_ < (unsigned long long)(STAGGER_US) * 100ull) __builtin_amdgcn_s_sleep(8); } }
#endif
    if constexpr (K == 16) { ProbPle P; P.A = (const char*)hin; P.Bt = (const char*)(ws + WS_WPG) + (size_t)L * DM * DM * 2; P.K = DM; P.ldb = 2048; P.G = F.G; P.c = F.vcu;
          P.H2 = hin; P.PPp = (const bf16_t*)(ws + WS_PP); P.rstd = (const float*)(ws + WS_RS2); P.OUTB = hmx; P.OUTF = args.out; P.ssq = (float*)(ws + WS_SSQ); P.last = L;
          pg8::gemm_phase(ring, P); }
}
#if defined(TPHASE)
#define PHASE(k) do { const bool tp_ = ((k) == TPHASE) && (L == TLAYER); const unsigned long long t0_ = tp_ ? __builtin_amdgcn_s_memrealtime() : 0ull; \
    if (PH(k)) phase<k, L>(F, args, nblk); \
    if (tp_) { asm volatile("s_waitcnt vmcnt(0) lgkmcnt(0)" ::: "memory"); const unsigned long long t1_ = __builtin_amdgcn_s_memrealtime(); const unsigned long long d_ = (t1_ - t0_) * TALPHA; \
        while (__builtin_amdgcn_s_memrealtime() - t1_ < d_) __builtin_amdgcn_s_sleep(8); } } while (0)
#else
#define PHASE(k) do { if (PH(k)) phase<k, L>(F, args, nblk); if (PH(k) && REPB(k)) phase<k, L>(F, args, nblk); } while (0)
#endif
template <int L>
DEVI void layer_program(Frame& F, const Args& args, const XcdBarrier& bar) {
    int nblk = 0;
    if (L == 0) {
        PHASE(2); GRID_BAR();
        PHASE(3); GRID_BAR();
        PHASE(4);
    } else {
        PHASE(5); GRID_BAR();
        PHASE(6); GRID_BAR();
        PHASE(7); GRID_BAR();
        PHASE(8); GRID_BAR();
        PHASE(9);
    }
    GRID_BAR();
    PHASE(11); GRID_BAR();
    PHASE(12); GRID_BAR();
    REFRESH(); nblk = build_moe_table(F);
    PHASE(13); GRID_BAR();
    PHASE(14); GRID_BAR();
    PHASE(15); GRID_BAR();
    PHASE(16);
    if (L == 0) GRID_BAR();
}
__global__ void __launch_bounds__(NWAVES * 64, 2) hybrid_fwd(Args args) {
    extern __shared__ __attribute__((aligned(16))) unsigned char lds[];
    Frame F;
    F.lds = (LAS unsigned char*)lds; F.ws = args.ws; F.ctl = (gu32*)(args.ws + WS_CTL);
    F.tid = threadIdx.x; F.lane = F.tid & 63; F.wave = __builtin_amdgcn_readfirstlane(F.tid >> 6);
    F.G = gridDim.x; { const int bx = blockIdx.x; F.vcu = (F.G % 8 == 0) ? (bx % 8) * (F.G / 8) + bx / 8 : bx; }
    for (int u = F.tid; u < (LDS_BYTES - LDSCTL_OFF) / 4; u += NWAVES * 64) ((LAS unsigned*)(F.lds + LDSCTL_OFF))[u] = 0u;
    __syncthreads();
    XcdBarrier bar = xcd_barrier_post((unsigned*)(F.ctl + CW_BAR), (volatile LAS unsigned*)(F.lds + MISC_OFF) + 8);
    { constexpr int L = 0; const int nblk = 0; PHASE(0); }
    GRID_BAR();
#ifdef EXTRA_BARS
    GRID_BAR(); GRID_BAR(); GRID_BAR(); GRID_BAR(); GRID_BAR(); GRID_BAR(); GRID_BAR(); GRID_BAR(); GRID_BAR(); GRID_BAR();
#endif
    layer_program<0>(F, args, bar);
    layer_program<1>(F, args, bar);
}
#undef GRID_BAR

extern "C" void kernel_launch(void* const* d_in, const int* in_sizes, int n_in, void* d_out, int out_size, void* d_ws, size_t ws_size, hipStream_t stream) {
    static int grid = 0;
    if (grid == 0) {
        if (n_in != 30 || out_size != NTOK * DM || ws_size < WS_END) { fprintf(stderr, "kernel_launch: unexpected shapes (n_in %d, out %d, ws %zu < %zu)\n", n_in, out_size, ws_size, (size_t)WS_END); grid = -1; return; }
        int dev = 0, cus = 0, per_cu = 0;
        if (hipGetDevice(&dev) != hipSuccess || hipDeviceGetAttribute(&cus, hipDeviceAttributeMultiprocessorCount, dev) != hipSuccess) { grid = -1; return; }
        if (hipFuncSetAttribute((const void*)hybrid_fwd, hipFuncAttributeMaxDynamicSharedMemorySize, LDS_BYTES) != hipSuccess) { fprintf(stderr, "kernel_launch: hipFuncSetAttribute failed\n"); grid = -1; return; }
        if (hipOccupancyMaxActiveBlocksPerMultiprocessor(&per_cu, (const void*)hybrid_fwd, NWAVES * 64, LDS_BYTES) != hipSuccess || per_cu < 1)
            fprintf(stderr, "kernel_launch: occupancy query reports %d workgroups per CU\n", per_cu);
        (void)hipGetLastError();
        grid = cus;
    }
    if (grid < 0) return;
    if (hipMemsetAsync((char*)d_ws + WS_CTL, 0, CTL_ZERO_BYTES, stream) != hipSuccess) return;
    Args a{};
    for (int i = 0; i < 30; ++i) a.in[i] = (const float*)d_in[i];
    a.out = (float*)d_out; a.ws = (unsigned char*)d_ws;
    for (int i = 0; i < 32; ++i) { const float p = powf(10000.0f, (float)i / 32.0f); a.inv_freq[i] = 1.0f / p; }
    hipLaunchKernelGGL(hybrid_fwd, dim3(grid), dim3(NWAVES * 64), LDS_BYTES, stream, a);
}
```

```cpp
#define PROBE 0
#define REP_MASK 0u
#include <hip/hip_runtime.h>
#include <hip/hip_bf16.h>
#include <cstdio>
#include <cstdint>
#include <cmath>

#ifndef PROBE
#define PROBE 0
#endif
#define DEVI __device__ __forceinline__
#define GAS __attribute__((address_space(1)))
#define LAS __attribute__((address_space(3)))
typedef unsigned short bf16_t;
typedef short bf16x8 __attribute__((ext_vector_type(8)));
typedef short s16x4 __attribute__((ext_vector_type(4)));
typedef float f32x2 __attribute__((ext_vector_type(2)));
typedef float f32x4 __attribute__((ext_vector_type(4)));
typedef float f32x16 __attribute__((ext_vector_type(16)));
typedef unsigned u32x2 __attribute__((ext_vector_type(2)));
typedef unsigned u32x4 __attribute__((ext_vector_type(4)));
typedef __bf16 bf16x2_t __attribute__((ext_vector_type(2)));
typedef GAS unsigned gu32;

#define LDS_WAIT() asm volatile("s_waitcnt lgkmcnt(0)" ::: "memory")
#define VM_WAIT() asm volatile("s_waitcnt vmcnt(0)" ::: "memory")
#define RLX_AGENT __ATOMIC_RELAXED, __HIP_MEMORY_SCOPE_AGENT

DEVI unsigned pk2(float lo, float hi) { f32x2 v = {lo, hi}; bf16x2_t b = __builtin_convertvector(v, bf16x2_t); return __builtin_bit_cast(unsigned, b); }
DEVI float bflo(unsigned u) { return __uint_as_float(u << 16); }
DEVI float bfhi(unsigned u) { return __uint_as_float(u & 0xffff0000u); }
DEVI f32x4 unpack4(u32x2 w) { return (f32x4){bflo(w.x), bfhi(w.x), bflo(w.y), bfhi(w.y)}; }
DEVI u32x2 pack4(f32x4 v) { u32x2 w; w.x = pk2(v[0], v[1]); w.y = pk2(v[2], v[3]); return w; }
DEVI float sigmoid_f(float x) { return __builtin_amdgcn_rcpf(1.0f + __expf(-x)); }
DEVI const char* sgpr_ptr(const char* p) { const unsigned long long u = (unsigned long long)p; const unsigned lo = (unsigned)__builtin_amdgcn_readfirstlane((int)(unsigned)u), hi = (unsigned)__builtin_amdgcn_readfirstlane((int)(unsigned)(u >> 32)); return (const char*)(((unsigned long long)hi << 32) | lo); }
DEVI float wave_sum(float v) {
#pragma unroll
    for (int o = 1; o < 64; o <<= 1) v += __shfl_xor(v, o);
    return v;
}

namespace pg8 {
constexpr int BM = 256, BK = 64, HALF = 128, HTB = HALF * BK * 2  , STAGE_BYTES = 8 * HTB;
DEVI int lds_byte(int r, int c) { const int st = (r >> 4) * 2 + (c >> 5), rr = r & 15, cc = c & 31, ob = rr * 64 + cc * 2; return st * 1024 + (ob ^ (((ob >> 9) & 1) << 5)); }
DEVI void stage_rc(int b, int& R, int& C) { const int st = b / 1024, sb = b % 1024, swz = sb ^ (((sb >> 9) & 1) << 5); R = (st >> 1) * 16 + swz / 64; C = (st & 1) * 32 + (swz % 64) / 2; }
struct Unit { int pm, pn, e, v; };

template <class P>
DEVI void gemm_phase(LAS unsigned char* lds, const P& S) {
    int tid = threadIdx.x; asm volatile("" : "+v"(tid));
    const int wid = __builtin_amdgcn_readfirstlane(tid >> 6), lane = tid & 63, wr = wid >> 2, wc = wid & 3, fr = lane & 15, fq = lane >> 4;
    const int nt = S.K / BK;
    int Rp[2], Cp[2]; unsigned voffB[2];
#pragma unroll
    for (int i = 0; i < 2; ++i) { stage_rc(tid * 16 + i * 8192, Rp[i], Cp[i]); voffB[i] = (unsigned)Rp[i] * S.ldb + (unsigned)Cp[i] * 2u; }
    const size_t hstepB = (size_t)HALF * S.ldb;
    const unsigned ldsw = (unsigned)wid * 1024u;
    const int aoff = lds_byte(wr * 64 + fr, fq * 8), boff = lds_byte(wc * 32 + fr, fq * 8);
    const char* const Abase = S.A;
#define PG8_SA(b, h) (((b) * 2 + (h)) * HTB)
#define PG8_SB(b, h) ((4 + (b) * 2 + (h)) * HTB)
#define PG8_STAGE_A(bufoff, ao, sp) do { _Pragma("unroll") for (int _i = 0; _i < 2; ++_i) \
        __builtin_amdgcn_global_load_lds((const unsigned*)((sp) + (ao)[_i]), (LAS unsigned*)(lds + (bufoff) + ldsw + _i * 8192), 16, 0, 0); } while (0)
#define PG8_PIN(p) do { (p) = sgpr_ptr(p); asm volatile("" : "+s"(p)); } while (0)
#define PG8_STAGE_B(bufoff, bp) do { _Pragma("unroll") for (int _i = 0; _i < 2; ++_i) \
        __builtin_amdgcn_global_load_lds((const unsigned*)((bp) + voffB[_i]), (LAS unsigned*)(lds + (bufoff) + ldsw + _i * 8192), 16, 0, 0); } while (0)
#define PG8_LDA(dst, b, h) do { _Pragma("unroll") for (int m = 0; m < 4; ++m) _Pragma("unroll") for (int k = 0; k < 2; ++k) dst[m][k] = *(const LAS bf16x8*)(lds + PG8_SA(b, h) + aoff + m * 2048 + k * 1024); } while (0)
#define PG8_LDB(dst, b, h) do { _Pragma("unroll") for (int n = 0; n < 2; ++n) _Pragma("unroll") for (int k = 0; k < 2; ++k) dst[n][k] = *(const LAS bf16x8*)(lds + PG8_SB(b, h) + boff + n * 2048 + k * 1024); } while (0)
#define PG8_MMA(ai, bj, At, Bt) do { __builtin_amdgcn_s_setprio(1); _Pragma("unroll") for (int m = 0; m < 4; ++m) _Pragma("unroll") for (int n = 0; n < 2; ++n) _Pragma("unroll") for (int k = 0; k < 2; ++k) \
        acc[ai][bj][m][n] = __builtin_amdgcn_mfma_f32_16x16x32_bf16(Bt[n][k], At[m][k], acc[ai][bj][m][n], 0, 0, 0); __builtin_amdgcn_s_setprio(0); } while (0)
#define PG8_WAIT_V(n) asm volatile("s_waitcnt vmcnt(" #n ")" ::: "memory")
#define PG8_WAIT_L(n) asm volatile("s_waitcnt lgkmcnt(" #n ")" ::: "memory")
#define PG8_BAR __builtin_amdgcn_s_barrier()
#define PG8_SCHED __builtin_amdgcn_sched_barrier(0)
    Unit cur, nxt; int ui = 0;
    if (!S.next(0, cur)) return;
    f32x4 acc[2][2][4][2];
#pragma unroll
    for (int a = 0; a < 2; ++a)
#pragma unroll
        for (int b = 0; b < 2; ++b)
#pragma unroll
            for (int m = 0; m < 4; ++m)
#pragma unroll
                for (int n = 0; n < 2; ++n) acc[a][b][m][n] = (f32x4){0.f, 0.f, 0.f, 0.f};
    bf16x8 At[4][2], B0[2][2], B1[2][2];
    unsigned ac0[2], ac1[2], an0[2], an1[2];
#pragma unroll
    for (int i = 0; i < 2; ++i) { ac0[i] = S.a_off(cur, Rp[i]) + (unsigned)Cp[i] * 2u; ac1[i] = S.a_off(cur, Rp[i] + HALF) + (unsigned)Cp[i] * 2u; }
    const char* cB = S.Bt + S.b_off(cur);
    { const char* q0 = cB; const char* q1 = cB + hstepB; const char* q2 = Abase; const char* q3 = cB + 128; const char* q4 = Abase + 128; const char* q5 = cB + hstepB + 128;
      PG8_PIN(q0); PG8_PIN(q1); PG8_PIN(q2); PG8_PIN(q3); PG8_PIN(q4); PG8_PIN(q5);
    PG8_STAGE_B(PG8_SB(0, 0), q0); PG8_STAGE_B(PG8_SB(0, 1), q1); PG8_STAGE_A(PG8_SA(0, 0), ac0, q2); PG8_STAGE_A(PG8_SA(0, 1), ac1, q2);
    if (wr == 1) PG8_BAR;
    PG8_WAIT_V(2); PG8_BAR;
    PG8_STAGE_B(PG8_SB(1, 0), q3); PG8_STAGE_A(PG8_SA(1, 0), ac0, q4); PG8_STAGE_B(PG8_SB(1, 1), q5);
    PG8_WAIT_V(6); PG8_BAR; }
    for (;;) {
        const bool has_next = S.next(ui + 1, nxt);
        const char* nB = cB;
        if (has_next) {
#pragma unroll
            for (int i = 0; i < 2; ++i) { an0[i] = S.a_off(nxt, Rp[i]) + (unsigned)Cp[i] * 2u; an1[i] = S.a_off(nxt, Rp[i] + HALF) + (unsigned)Cp[i] * 2u; }
            nB = S.Bt + S.b_off(nxt);
        } else {
#pragma unroll
            for (int i = 0; i < 2; ++i) { an0[i] = ac0[i]; an1[i] = ac1[i]; }
        }
        for (int t = 0; t < nt; t += 2) {
            const bool last = (t == nt - 2);
            unsigned a20[2], a21[2];
#pragma unroll
            for (int i = 0; i < 2; ++i) { a20[i] = last ? an0[i] : ac0[i]; a21[i] = last ? an1[i] : ac1[i]; }
            const int k1 = (t + 1) * 128, k2 = last ? 0 : (t + 2) * 128;
            const char* b2 = last ? nB : cB + (size_t)(t + 2) * 128; const char* b3 = b2 + 128; const char* b2h = b2 + hstepB; const char* b3h = b3 + hstepB;
            const char* pa1 = Abase + k1; const char* pa2 = Abase + k2; const char* pa3 = pa2 + 128;
            PG8_PIN(b2); PG8_PIN(b3); PG8_PIN(b2h); PG8_PIN(b3h); PG8_PIN(pa1); PG8_PIN(pa2); PG8_PIN(pa3);
            PG8_LDB(B0, 0, 0); PG8_LDB(B1, 0, 1); PG8_SCHED; PG8_LDA(At, 0, 0); PG8_STAGE_A(PG8_SA(1, 1), ac1, pa1);
            PG8_WAIT_V(8); PG8_WAIT_L(0); PG8_BAR; PG8_MMA(0, 0, At, B0); PG8_MMA(0, 1, At, B1); PG8_BAR; PG8_SCHED;
            PG8_LDA(At, 0, 1); PG8_STAGE_B(PG8_SB(0, 0), b2); PG8_STAGE_B(PG8_SB(0, 1), b2h); PG8_STAGE_A(PG8_SA(0, 0), a20, pa2);
            PG8_WAIT_V(8); PG8_WAIT_L(0); PG8_BAR; PG8_MMA(1, 0, At, B0); PG8_MMA(1, 1, At, B1); PG8_BAR; PG8_SCHED;
            PG8_LDB(B0, 1, 0); PG8_LDB(B1, 1, 1); PG8_SCHED; PG8_LDA(At, 1, 0); PG8_STAGE_A(PG8_SA(0, 1), a21, pa2);
            PG8_WAIT_V(8); PG8_WAIT_L(0); PG8_BAR; PG8_MMA(0, 0, At, B0); PG8_MMA(0, 1, At, B1); PG8_BAR; PG8_SCHED;
            PG8_LDA(At, 1, 1); PG8_STAGE_B(PG8_SB(1, 0), b3); PG8_STAGE_B(PG8_SB(1, 1), b3h); PG8_STAGE_A(PG8_SA(1, 0), a20, pa3);
            PG8_WAIT_V(8); PG8_WAIT_L(0); PG8_BAR; PG8_MMA(1, 0, At, B0); PG8_MMA(1, 1, At, B1); PG8_BAR; PG8_SCHED;
        }
        if (wr == 0) PG8_BAR;
        S.epi(acc, cur, wr, wc, fr, fq);
        if (!has_next) break;
#pragma unroll
        for (int a = 0; a < 2; ++a)
#pragma unroll
            for (int b = 0; b < 2; ++b)
#pragma unroll
                for (int m = 0; m < 4; ++m)
#pragma unroll
                    for (int n = 0; n < 2; ++n) acc[a][b][m][n] = (f32x4){0.f, 0.f, 0.f, 0.f};
        cur = nxt; cB = nB; ++ui;
#pragma unroll
        for (int i = 0; i < 2; ++i) { ac0[i] = an0[i]; ac1[i] = an1[i]; }
        if (wr == 1) PG8_BAR;
    }
    PG8_WAIT_V(0);
    PG8_BAR;
#undef PG8_SA
#undef PG8_SB
#undef PG8_STAGE_A
#undef PG8_STAGE_B
#undef PG8_PIN
#undef PG8_LDA
#undef PG8_LDB
#undef PG8_MMA
#undef PG8_WAIT_V
#undef PG8_WAIT_L
#undef PG8_BAR
#undef PG8_SCHED
}
}
#define XB_TMO      128
#define XB_XCNT(j)  (256  + 64 * (j))
#define XB_XSUB(j)  (1280 + 64 * (j))
#define XB_XGEN(j)  (2304 + 64 * (j))
#define XB_TOP      3328
#define XB_TOPGEN   3392
#define XCD_BAR_WORDS 3456
#define XB_SPIN_CAP (1u << 18)

__device__ __forceinline__ unsigned xb_ld(unsigned* p)              { return __hip_atomic_load(p, __ATOMIC_RELAXED, __HIP_MEMORY_SCOPE_AGENT); }
__device__ __forceinline__ unsigned xb_add(unsigned* p, unsigned v) { return __hip_atomic_fetch_add(p, v, __ATOMIC_RELAXED, __HIP_MEMORY_SCOPE_AGENT); }
__device__ __forceinline__ unsigned xb_xcc_id() { return (unsigned)__builtin_amdgcn_s_getreg((3 << 11) | 20) & 0xFu; }
#define XB_SPIN(cond, bar) do { unsigned _sp = 0; while (cond) { __builtin_amdgcn_s_sleep(1); \
    if ((++_sp & 255u) == 0u) { if (xb_ld(&(bar)[XB_TMO])) break; if (_sp > XB_SPIN_CAP) { atomicAdd(&(bar)[XB_TMO], 1u); break; } } } } while (0)

struct XcdBarrier {
    unsigned* bar; unsigned x;
    volatile LAS unsigned* st;
};

__device__ __forceinline__ XcdBarrier xcd_barrier_post(unsigned* bar, volatile LAS unsigned* st) {
    XcdBarrier b; b.bar = bar; b.x = xb_xcc_id(); b.st = st;
    if (threadIdx.x == 0) (void)xb_add(&bar[XB_XCNT(b.x)], 1u);
    return b;
}
__device__ __forceinline__ void xcd_barrier_complete(unsigned* bar, unsigned x, unsigned& nloc, unsigned& nx) {
    const unsigned G = gridDim.x * gridDim.y * gridDim.z;
    unsigned sum, cnt, mine, sp = 0u;
    for (;;) {
        sum = 0u; cnt = 0u; mine = 0u;
#pragma unroll
        for (unsigned j = 0; j < 16; ++j) { const unsigned c = xb_ld(&bar[XB_XCNT(j)]); sum += c; cnt += (c > 0u) ? 1u : 0u; mine = (j == x) ? c : mine; }
        if (sum == G) break;
        __builtin_amdgcn_s_sleep(1);
        if ((++sp & 255u) == 0u) { if (xb_ld(&bar[XB_TMO])) break; if (sp > XB_SPIN_CAP) { atomicAdd(&bar[XB_TMO], 1u); break; } }
    }
    nloc = mine > 0u ? mine : 1u; nx = cnt > 0u ? cnt : 1u;
}

__device__ __forceinline__ void xcd_barrier(const XcdBarrier& b) {
    asm volatile("s_waitcnt vmcnt(0)" ::: "memory");
    __syncthreads();
    if (threadIdx.x == 0) {
        unsigned* bar = b.bar;
        __builtin_amdgcn_s_waitcnt(0);
        unsigned nloc = b.st[0], nx = b.st[1];
        if (nloc == 0u) { xcd_barrier_complete(bar, b.x, nloc, nx); b.st[0] = nloc; b.st[1] = nx; }
        const unsigned old = xb_add(&bar[XB_XSUB(b.x)], 1u);
        const unsigned gen = old / nloc;
        if (old + 1u == (gen + 1u) * nloc) {
            __builtin_amdgcn_fence(__ATOMIC_RELEASE, "agent");
            asm volatile("s_waitcnt vmcnt(0)" ::: "memory");
            const unsigned og = xb_add(&bar[XB_TOP], 1u);
            const unsigned tg = og / nx;
            if (og + 1u == (tg + 1u) * nx) xb_add(&bar[XB_TOPGEN], 1u);
            else XB_SPIN(xb_ld(&bar[XB_TOPGEN]) == tg, bar);
            __builtin_amdgcn_fence(__ATOMIC_ACQUIRE, "agent");
            xb_add(&bar[XB_XGEN(b.x)], 1u);
            asm volatile("s_waitcnt vmcnt(0)" ::: "memory");
        } else {
            XB_SPIN(xb_ld(&bar[XB_XGEN(b.x)]) == gen, bar);
            __builtin_amdgcn_fence(__ATOMIC_ACQUIRE, "agent");
            asm volatile("s_waitcnt vmcnt(0)" ::: "memory");
        }
    }
    __syncthreads();
}

constexpr int NTOK = 32768, DM = 1024, SEQ = 2048, NBATCH = 16, NEXP = 32, DEXP = 512, PLE = 256;
constexpr int NWIN = 2608, NWIN_PAD = 2816;
constexpr float EPS = 1e-6f;
constexpr float C2 = 0.125f * 1.4426950408889634f;
constexpr int NWAVES = 8;

constexpr size_t MiB = 1u << 20;
constexpr size_t WS_CTL = 0, CTL_ZERO_BYTES = 1 * MiB;
constexpr int CW_TMO = 0, CW_BAR = 4096;
constexpr size_t WS_RS0 = 1 * MiB;
constexpr size_t WS_RS1 = WS_RS0 + 131072;
constexpr size_t WS_RS2 = WS_RS1 + 131072;
constexpr size_t WS_ASGE = WS_RS2 + 131072;
constexpr size_t WS_ASGR = WS_ASGE + 262144;
constexpr size_t WS_ASGW = WS_ASGR + 262144;
constexpr size_t WS_TSLOT = WS_ASGW + 262144;
constexpr int NSLOT = 2 * NTOK, NSLOT_PAD = NSLOT + 256;
constexpr size_t WS_STOK = WS_TSLOT + 262144;
constexpr size_t WS_SW = WS_STOK + 266240;
constexpr size_t WS_SRS = WS_SW + 266240;
constexpr size_t WS_CNT = WS_SRS + 266240;
constexpr size_t WS_MTOT = WS_CNT + 32768;
constexpr size_t WS_CBP = WS_MTOT + 1024;
constexpr size_t WS_RW = WS_CBP + 65536;
constexpr size_t WS_CB = WS_RW + 393216;
constexpr size_t WS_W2T = WS_CB + 2048;
constexpr size_t WS_SSQ = 4 * MiB;
constexpr size_t WS_ROPE = 6 * MiB;
static_assert(WS_W2T + 2 * 64 * 256 * 2 <= WS_SSQ, "tables");
constexpr size_t WS_WPW1 = 16 * MiB, WS_WPW2 = 20 * MiB, WS_WIN = 22 * MiB, WS_WOUT = 28 * MiB, WS_WC1 = 30 * MiB, WS_WPP = 32 * MiB, WS_WPG = 33 * MiB;
constexpr size_t WS_WGU = 40 * MiB, WS_WDN = 104 * MiB;
constexpr size_t WS_HA = 136 * MiB, WS_HB = 200 * MiB, WS_PP = 264 * MiB, WS_PB = 328 * MiB;
constexpr size_t WS_YB = 344 * MiB, WS_HBUF = 473 * MiB;
constexpr size_t WS_U = 344 * MiB, WS_V = 408 * MiB;
constexpr size_t WS_Q = WS_PP, WS_KV = 344 * MiB, WS_O = 440 * MiB, WS_CP = WS_HA  , WS_GATES = 504 * MiB, WS_KC = 510 * MiB, WS_VC = 511 * MiB;
constexpr size_t WS_END = 538 * MiB;
constexpr size_t KVS = (size_t)NTOK * 256;

constexpr int RING_OFF = 0, RING_BYTES = 131072;
constexpr int LDSCTL_OFF = RING_BYTES;
constexpr int MISC_OFF = LDSCTL_OFF + 320;
constexpr int TAB_OFF = LDSCTL_OFF + 1024;
constexpr int SCR_OFF = LDSCTL_OFF + 4096;
constexpr int LDS_BYTES = 147456;

struct Args { const float* in[30]; float* out; unsigned char* ws; float inv_freq[32]; };
struct Frame {
    LAS unsigned char* lds;
    gu32* ctl;
    unsigned char* ws;
    int tid, lane, wave, vcu, G;
};
DEVI void wg_sync() { __syncthreads(); }

DEVI int perm32(int r) { return (r & ~31) | (((r >> 2) & 1) << 4) | (((r >> 3) & 3) << 2) | (r & 3); }
DEVI int rowmap(int mode, int half, int n) {
    if (mode == 0) return perm32(n);
    if (mode == 1) return perm32(256 * (n >> 7) + 128 * half + (n & 127));
    if (n < 2560) { const int hd = n >> 6, d = n & 63; return perm32(256 * (hd >> 2) + 128 * (d >> 5) + 32 * (hd & 3) + (d & 31)); }
    return perm32(n);
}
DEVI u32x4 pack8(const f32x4& a, const f32x4& b) { const u32x2 x = pack4(a), y = pack4(b); return (u32x4){x.x, x.y, y.x, y.y}; }
DEVI void p0_item(const float* W, int ld, int ncols, int K, const float* gain, bf16_t* dst, int mode, int half, LAS unsigned char* scr, int item, int lane) {
    const int nblk = (ncols + 63) >> 6, kb = item / nblk, nb = item % nblk, k0 = 64 * kb, n0 = 64 * nb;
    const int lr = lane >> 4, lc = 4 * (lane & 15);
    f32x4 v[16];
#pragma unroll
    for (int i = 0; i < 16; ++i) v[i] = (n0 + lc < ncols) ? *(const f32x4*)(W + (size_t)(k0 + 4 * i + lr) * ld + n0 + lc) : (f32x4){0.f, 0.f, 0.f, 0.f};
#pragma unroll
    for (int i = 0; i < 16; ++i) { const float g = gain ? gain[k0 + 4 * i + lr] : 1.0f; const f32x4 x = v[i] * g; *(LAS u32x2*)(scr + (4 * i + lr) * 136 + lc * 2) = pack4(x); }
    LDS_WAIT();
    const int c = lane & 7;
#pragma unroll
    for (int j = 0; j < 8; ++j) { const int n = (lane >> 3) + 8 * j; const LAS unsigned short* t = (const LAS unsigned short*)(scr + (8 * c) * 136 + n * 2);
        u32x4 o; o.x = (unsigned)t[0 * 68] | ((unsigned)t[1 * 68] << 16); o.y = (unsigned)t[2 * 68] | ((unsigned)t[3 * 68] << 16); o.z = (unsigned)t[4 * 68] | ((unsigned)t[5 * 68] << 16); o.w = (unsigned)t[6 * 68] | ((unsigned)t[7 * 68] << 16);
        if (n0 + n < ncols) *(u32x4*)(dst + (size_t)rowmap(mode, half, n0 + n) * K + k0 + 8 * c) = o; }
    LDS_WAIT();
}
DEVI void p0_load(f32x4 (&v)[16], const float* W, int ld, int ncols, int item, int lane) {
    const int nblk = (ncols + 63) >> 6, kb = item / nblk, nb = item % nblk, k0 = 64 * kb, n0 = 64 * nb, lr = lane >> 4, lc = 4 * (lane & 15);
#pragma unroll
    for (int i = 0; i < 16; ++i) v[i] = (n0 + lc < ncols) ? *(const f32x4*)(W + (size_t)(k0 + 4 * i + lr) * ld + n0 + lc) : (f32x4){0.f, 0.f, 0.f, 0.f};
}
DEVI void p0_finish(const f32x4 (&v)[16], int ncols, int K, const float* gain, bf16_t* dst, int mode, int half, LAS unsigned char* scr, int item, int lane) {
    const int nblk = (ncols + 63) >> 6, kb = item / nblk, nb = item % nblk, k0 = 64 * kb, n0 = 64 * nb, lr = lane >> 4, lc = 4 * (lane & 15);
#pragma unroll
    for (int i = 0; i < 16; ++i) { const float g = gain ? gain[k0 + 4 * i + lr] : 1.0f; const f32x4 x = v[i] * g; *(LAS u32x2*)(scr + (4 * i + lr) * 136 + lc * 2) = pack4(x); }
    LDS_WAIT();
    const int c = lane & 7;
#pragma unroll
    for (int j = 0; j < 8; ++j) { const int n = (lane >> 3) + 8 * j; const LAS unsigned short* t = (const LAS unsigned short*)(scr + (8 * c) * 136 + n * 2);
        u32x4 o; o.x = (unsigned)t[0 * 68] | ((unsigned)t[1 * 68] << 16); o.y = (unsigned)t[2 * 68] | ((unsigned)t[3 * 68] << 16); o.z = (unsigned)t[4 * 68] | ((unsigned)t[5 * 68] << 16); o.w = (unsigned)t[6 * 68] | ((unsigned)t[7 * 68] << 16);
        if (n0 + n < ncols) *(u32x4*)(dst + (size_t)rowmap(mode, half, n0 + n) * K + k0 + 8 * c) = o; }
    LDS_WAIT();
}
DEVI void prep_layer(const Frame& F, const Args& a, int L) {
    LAS unsigned char* scr = F.lds + RING_OFF + F.wave * 16384;
    const int gw = F.vcu * NWAVES + F.wave, NGW = F.G * NWAVES;
    const float* gf = a.in[4] + (size_t)L * DM;
    bf16_t* wgu = (bf16_t*)(F.ws + WS_WGU); bf16_t* wdn = (bf16_t*)(F.ws + WS_WDN);
#define PREP_SRC(it_) ((((it_) % 384) >> 7) == 0 ? a.in[25] + ((size_t)L * NEXP + (it_) / 384) * DM * DEXP : (((it_) % 384) >> 7) == 1 ? a.in[26] + ((size_t)L * NEXP + (it_) / 384) * DM * DEXP : a.in[27] + ((size_t)L * NEXP + (it_) / 384) * DEXP * DM)
    f32x4 vc[16], vn[16];
    int it = gw;
    if (it < NEXP * 384) { const int wh = (it % 384) >> 7; p0_load(vc, PREP_SRC(it), wh == 2 ? DM : DEXP, wh == 2 ? DM : DEXP, it & 127, F.lane); }
    for (; it < NEXP * 384; it += NGW) {
        const int itn = it + NGW;
        if (itn < NEXP * 384) { const int wh = (itn % 384) >> 7; p0_load(vn, PREP_SRC(itn), wh == 2 ? DM : DEXP, wh == 2 ? DM : DEXP, itn & 127, F.lane); }
        { const int e = it / 384, wh = (it % 384) >> 7, item = it & 127;
          if (wh == 2) p0_finish(vc, DM, DEXP, nullptr, wdn + (size_t)e * 1024 * 512, 0, 0, scr, item, F.lane);
          else p0_finish(vc, DEXP, DM, gf, wgu + (size_t)e * 1024 * 1024, 1, wh, scr, item, F.lane); }
#pragma unroll
        for (int i = 0; i < 16; ++i) vc[i] = vn[i];
    }
#undef PREP_SRC
    const float* p = a.in[1] + (size_t)L * NTOK * PLE; bf16_t* pb = (bf16_t*)(F.ws + WS_PB);
    const size_t n8 = (size_t)NTOK * PLE / 8;
#pragma unroll 4
    for (size_t i = (size_t)F.vcu * 512 + F.tid; i < n8; i += (size_t)F.G * 512) {
        const f32x4 v0 = *(const f32x4*)(p + i * 8), v1 = *(const f32x4*)(p + i * 8 + 4);
        u32x4 o; o.x = pk2(v0[0], v0[1]); o.y = pk2(v0[2], v0[3]); o.z = pk2(v1[0], v1[1]); o.w = pk2(v1[2], v1[3]);
        *(u32x4*)(pb + i * 8) = o; }
}
DEVI void p0_prologue(const Frame& F, const Args& a) {
    LAS unsigned char* scr = F.lds + RING_OFF + F.wave * 16384;
    const int gw = F.vcu * NWAVES + F.wave, NGW = F.G * NWAVES;
    unsigned char* ws = F.ws;
    constexpr int I_PW1 = 16 * 16 * 2, I_PW2 = 16 * 16, I_WIN = 16 * 41, I_WOUT = 16 * 16, I_C1 = 32 * 4 * 2, I_PP = 4 * 16 * 2, I_PG = 16 * 16 * 2;
    constexpr int NIT = I_PW1 + I_PW2 + I_WIN + I_WOUT + I_C1 + I_PP + I_PG;
    for (int it = gw; it < NIT; it += NGW) {
        int r = it;
        if (r < I_PW1) { const int half = r / 256; p0_item(a.in[6] + half * 1024, 2048, 1024, DM, a.in[3], (bf16_t*)(ws + WS_WPW1), 1, half, scr, r % 256, F.lane); continue; } r -= I_PW1;
        if (r < I_PW2) { p0_item(a.in[12], DM, DM, DM, nullptr, (bf16_t*)(ws + WS_WPW2), 0, 0, scr, r, F.lane); continue; } r -= I_PW2;
        if (r < I_WIN) { p0_item(a.in[14], NWIN, NWIN, DM, a.in[3] + DM, (bf16_t*)(ws + WS_WIN), 2, 0, scr, r, F.lane); continue; } r -= I_WIN;
        if (r < I_WOUT) { p0_item(a.in[20], DM, DM, DM, nullptr, (bf16_t*)(ws + WS_WOUT), 0, 0, scr, r, F.lane); continue; } r -= I_WOUT;
        if (r < I_C1) { const int j = r / 128; p0_item(a.in[18] + (size_t)j * 2048 * 256, 256, 256, 2048, nullptr, (bf16_t*)(ws + WS_WC1) + (size_t)j * 256 * 2048, 0, 0, scr, r % 128, F.lane); continue; } r -= I_C1;
        if (r < I_PP) { const int L = r / 64; p0_item(a.in[28] + (size_t)L * PLE * DM, DM, DM, PLE, nullptr, (bf16_t*)(ws + WS_WPP) + (size_t)L * DM * PLE, 0, 0, scr, r % 64, F.lane); continue; } r -= I_PP;
        { const int L = r / 256; p0_item(a.in[29] + (size_t)L * DM * DM, DM, DM, DM, a.in[5] + (size_t)L * DM, (bf16_t*)(ws + WS_WPG) + (size_t)L * DM * DM, 0, 0, scr, r % 256, F.lane); }
    }
    { u32x4* z = (u32x4*)((bf16_t*)(ws + WS_WIN) + (size_t)2616 * DM); const int n16 = (NWIN_PAD - 2616) * DM / 8;
      for (int i = F.vcu * 512 + F.tid; i < n16; i += F.G * 512) z[i] = (u32x4){0u, 0u, 0u, 0u};
      u32x4* z2 = (u32x4*)((bf16_t*)(ws + WS_WIN) + (size_t)2600 * DM);
      for (int i = F.vcu * 512 + F.tid; i < 8 * DM / 8; i += F.G * 512) z2[i] = (u32x4){0u, 0u, 0u, 0u}; }
    { bf16_t* rw = (bf16_t*)(ws + WS_RW);
      for (int i = F.vcu * 512 + F.tid; i < 2 * 48 * 1024; i += F.G * 512) {
          const int L = i / (48 * 1024), j = (i / 1024) % 48, k = i & 1023;
          float w = 0.f;
          if (j < 4) w = a.in[21][((size_t)L * DM + k) * 4 + j]; else if (j < 36) w = a.in[23][((size_t)L * DM + k) * 32 + (j - 4)];
          w *= a.in[4][(size_t)L * DM + k];
          const unsigned hi = pk2(w, 0.f) & 0xffffu; const float lo = w - bflo(hi);
          rw[((size_t)(L * 2 + 0) * 48 + j) * 1024 + k] = (bf16_t)hi; rw[((size_t)(L * 2 + 1) * 48 + j) * 1024 + k] = (bf16_t)(pk2(lo, 0.f) & 0xffffu); } }
    { bf16_t* w2t = (bf16_t*)(ws + WS_W2T);
      for (int i = F.vcu * 512 + F.tid; i < 2 * 64 * 256; i += F.G * 512) { const int j = i >> 14, n = (i >> 8) & 63, k = i & 255; w2t[i] = (bf16_t)(pk2(a.in[19][(size_t)(j * 256 + k) * 64 + n], 0.f) & 0xffffu); } }
    for (int it = gw; it < 2 * 4 * 32; it += NGW) {
        const int j = it >> 7, cg = (it >> 5) & 3, kr = it & 31;
        const float* pe = a.in[17] + (size_t)j * 2048 + kr * 64; const float* w1 = a.in[18] + ((size_t)j * 2048 + kr * 64) * 256 + cg * 64 + F.lane;
        float s = 0.f;
#pragma unroll 16
        for (int k = 0; k < 64; ++k) s += pe[k] * w1[(size_t)k * 256];
        ((float*)(ws + WS_CBP))[(j * 32 + kr) * 256 + cg * 64 + F.lane] = s; }
    { float* rope = (float*)(ws + WS_ROPE); const int* pos = (const int*)a.in[2];
      for (int i = F.vcu * 512 + F.tid; i < NTOK * 32; i += F.G * 512) {
          const int row = i >> 5, fi = i & 31;
          const float ang = (float)pos[row] * a.inv_freq[fi];
          const double rev = (double)ang * 0.15915494309189533577; const float fr = (float)(rev - floor(rev));
          rope[(size_t)row * 64 + fi] = __builtin_amdgcn_cosf(fr); rope[(size_t)row * 64 + 32 + fi] = __builtin_amdgcn_sinf(fr); } }
    { const float* x = a.in[0]; bf16_t* ha = (bf16_t*)(ws + WS_HA); float* rs0 = (float*)(ws + WS_RS0);
      f32x4 va[4], vb[4], na[4], nb[4];
#define XR(m_, j_) (((const f32x4*)(x + (size_t)(m_) * DM) + F.lane)[64 * (j_)])
      if (gw < NTOK) {
#pragma unroll
          for (int j = 0; j < 4; ++j) { na[j] = XR(gw, j); nb[j] = (gw + NGW < NTOK) ? XR(gw + NGW, j) : (f32x4){0.f, 0.f, 0.f, 0.f}; } }
      for (int m = gw; m < NTOK; m += 2 * NGW) {
#pragma unroll
          for (int j = 0; j < 4; ++j) { va[j] = na[j]; vb[j] = nb[j]; }
          if (m + 2 * NGW < NTOK) {
#pragma unroll
              for (int j = 0; j < 4; ++j) { na[j] = XR(m + 2 * NGW, j); nb[j] = (m + 3 * NGW < NTOK) ? XR(m + 3 * NGW, j) : (f32x4){0.f, 0.f, 0.f, 0.f}; } }
          float sa = 0.f, sb = 0.f;
#pragma unroll
          for (int j = 0; j < 4; ++j) { sa += (va[j][0] * va[j][0] + va[j][1] * va[j][1]) + (va[j][2] * va[j][2] + va[j][3] * va[j][3]); sb += (vb[j][0] * vb[j][0] + vb[j][1] * vb[j][1]) + (vb[j][2] * vb[j][2] + vb[j][3] * vb[j][3]); }
          sa = wave_sum(sa); sb = wave_sum(sb);
          u32x2* oa = (u32x2*)(ha + (size_t)m * DM) + F.lane; u32x2* ob = (u32x2*)(ha + (size_t)(m + NGW) * DM) + F.lane;
#pragma unroll
          for (int j = 0; j < 4; ++j) { oa[64 * j] = pack4(va[j]); if (m + NGW < NTOK) ob[64 * j] = pack4(vb[j]); }
          if (F.lane == 0) { rs0[m] = 1.0f / sqrtf(sa * (1.0f / DM) + EPS); if (m + NGW < NTOK) rs0[m + NGW] = 1.0f / sqrtf(sb * (1.0f / DM) + EPS); } }
#undef XR
      }

}

using pg8::Unit;
typedef f32x4 AccT[2][2][4][2];
struct ProbBase { const char* A; const char* Bt; int K; unsigned ldb; int G, c; };

#define EPI_FENCE() asm volatile("" ::: "memory")
struct ProbPw1 : ProbBase {
    const float* __restrict__ rstd; const float* __restrict__ bias; bf16_t* __restrict__ U;
    DEVI bool next(int i, Unit& u) const { const int L = i * G + c; if (L >= 128 * 8) return false; u.pm = L >> 3; u.pn = L & 7; u.e = 0; u.v = 256; return true; }
    DEVI unsigned a_off(const Unit& u, int R) const { return (unsigned)(u.pm * 256 + R) * 2048u; }
    DEVI size_t b_off(const Unit& u) const { return (size_t)u.pn * 256 * ldb; }
    DEVI void epi(const AccT& acc, const Unit& u, int wr, int wc, int fr, int fq) const {
        const int q0 = 32 * wc + 8 * fq;
        f32x4 ba[2], bg[2]; float rs[2][4];
#pragma unroll
        for (int n = 0; n < 2; ++n) { ba[n] = *(const f32x4*)(bias + 128 * u.pn + q0 + 4 * n); bg[n] = *(const f32x4*)(bias + 1024 + 128 * u.pn + q0 + 4 * n); }
#pragma unroll
        for (int ai = 0; ai < 2; ++ai)
#pragma unroll
            for (int m = 0; m < 4; ++m) rs[ai][m] = rstd[u.pm * 256 + 128 * ai + 64 * wr + 16 * m + fr];
        EPI_FENCE();
#pragma unroll
        for (int ai = 0; ai < 2; ++ai)
#pragma unroll
            for (int m = 0; m < 4; ++m) {
                const int row = u.pm * 256 + 128 * ai + 64 * wr + 16 * m + fr;
                f32x4 o[2];
#pragma unroll
                for (int n = 0; n < 2; ++n) {
                    const f32x4 av = acc[ai][0][m][n] * rs[ai][m] + ba[n], gv = acc[ai][1][m][n] * rs[ai][m] + bg[n];
#pragma unroll
                    for (int j = 0; j < 4; ++j) o[n][j] = av[j] * sigmoid_f(gv[j]); }
                *(u32x4*)(U + (size_t)row * DM + 128 * u.pn + q0) = pack8(o[0], o[1]); }
    }
};
struct ProbPP : ProbBase {
    bf16_t* O; int tail_lo;
    DEVI bool next(int i, Unit& u) const { if (c < tail_lo) return false; const int L = i * (G - tail_lo) + (c - tail_lo); if (L >= 128 * 4) return false; u.pm = L >> 2; u.pn = L & 3; u.e = 0; u.v = 256; return true; }
    DEVI unsigned a_off(const Unit& u, int R) const { return (unsigned)(u.pm * 256 + R) * 512u; }
    DEVI size_t b_off(const Unit& u) const { return (size_t)u.pn * 256 * ldb; }
    DEVI void epi(const AccT& acc, const Unit& u, int wr, int wc, int fr, int fq) const {
#pragma unroll
        for (int ai = 0; ai < 2; ++ai)
#pragma unroll
            for (int m = 0; m < 4; ++m) {
                const int row = u.pm * 256 + 128 * ai + 64 * wr + 16 * m + fr;
#pragma unroll
                for (int bj = 0; bj < 2; ++bj) *(u32x4*)(O + (size_t)row * DM + 256 * u.pn + 128 * bj + 32 * wc + 8 * fq) = pack8(acc[ai][bj][m][0], acc[ai][bj][m][1]); }
    }
};
struct ProbRes : ProbBase {
    const bf16_t* __restrict__ RES; bf16_t* __restrict__ OUT; const float* __restrict__ bias;
    DEVI bool next(int i, Unit& u) const { const int L = i * G + c; if (L >= 128 * 4) return false; u.pm = L >> 2; u.pn = L & 3; u.e = 0; u.v = 256; return true; }
    DEVI unsigned a_off(const Unit& u, int R) const { return (unsigned)(u.pm * 256 + R) * 2048u; }
    DEVI size_t b_off(const Unit& u) const { return (size_t)u.pn * 256 * ldb; }
    DEVI void epi(const AccT& acc, const Unit& u, int wr, int wc, int fr, int fq) const {
        const int col0 = 256 * u.pn + 32 * wc + 8 * fq;
        f32x4 bv[2][2];
#pragma unroll
        for (int bj = 0; bj < 2; ++bj)
#pragma unroll
            for (int n = 0; n < 2; ++n) bv[bj][n] = bias ? *(const f32x4*)(bias + col0 + 128 * bj + 4 * n) : (f32x4){0.f, 0.f, 0.f, 0.f};
#ifdef EPI_REPS
        for (int rep_ = 0; rep_ < EPI_REPS; ++rep_)
#endif
#pragma unroll
        for (int ai = 0; ai < 2; ++ai) {
            u32x4 r[4][2];
#pragma unroll
            for (int m = 0; m < 4; ++m) { const size_t o = (size_t)(u.pm * 256 + 128 * ai + 64 * wr + 16 * m + fr) * DM + col0;
#pragma unroll
                for (int bj = 0; bj < 2; ++bj) r[m][bj] = *(const u32x4*)(RES + o + 128 * bj); }
            EPI_FENCE();
#pragma unroll
            for (int m = 0; m < 4; ++m) { const size_t o = (size_t)(u.pm * 256 + 128 * ai + 64 * wr + 16 * m + fr) * DM + col0;
#pragma unroll
                for (int bj = 0; bj < 2; ++bj) { const u32x4 rr = r[m][bj];
                    *(u32x4*)(OUT + o + 128 * bj) = pack8(unpack4((u32x2){rr.x, rr.y}) + acc[ai][bj][m][0] + bv[bj][0], unpack4((u32x2){rr.z, rr.w}) + acc[ai][bj][m][1] + bv[bj][1]); } }
            EPI_FENCE();
        }
    }
};
struct ProbPle : ProbBase {
    const bf16_t* __restrict__ H2; const bf16_t* __restrict__ PPp; const float* __restrict__ rstd; bf16_t* __restrict__ OUTB; float* __restrict__ OUTF; float* __restrict__ ssq; int last;
    DEVI bool next(int i, Unit& u) const { const int L = i * G + c; if (L >= 128 * 4) return false; u.pm = L >> 2; u.pn = L & 3; u.e = 0; u.v = 256; return true; }
    DEVI unsigned a_off(const Unit& u, int R) const { return (unsigned)(u.pm * 256 + R) * 2048u; }
    DEVI size_t b_off(const Unit& u) const { return (size_t)u.pn * 256 * ldb; }
    DEVI void epi(const AccT& acc, const Unit& u, int wr, int wc, int fr, int fq) const {
        const int col0 = 256 * u.pn + 32 * wc + 8 * fq;
#pragma unroll
        for (int ai = 0; ai < 2; ++ai) {
            u32x4 h[4][2], q[4][2]; float rs[4];
#pragma unroll
            for (int m = 0; m < 4; ++m) { const int row = u.pm * 256 + 128 * ai + 64 * wr + 16 * m + fr; const size_t o = (size_t)row * DM + col0; rs[m] = rstd[row];
#pragma unroll
                for (int bj = 0; bj < 2; ++bj) { h[m][bj] = *(const u32x4*)(H2 + o + 128 * bj); q[m][bj] = *(const u32x4*)(PPp + o + 128 * bj); } }
            EPI_FENCE();
#pragma unroll
            for (int m = 0; m < 4; ++m) { const int row = u.pm * 256 + 128 * ai + 64 * wr + 16 * m + fr; const size_t o = (size_t)row * DM + col0; float ss = 0.f;
#pragma unroll
                for (int bj = 0; bj < 2; ++bj) { f32x4 v[2];
#pragma unroll
                    for (int n = 0; n < 2; ++n) {
                        const f32x4 h2 = unpack4(n ? (u32x2){h[m][bj].z, h[m][bj].w} : (u32x2){h[m][bj].x, h[m][bj].y}), pp = unpack4(n ? (u32x2){q[m][bj].z, q[m][bj].w} : (u32x2){q[m][bj].x, q[m][bj].y}), a4 = acc[ai][bj][m][n] * rs[m];
#pragma unroll
                        for (int j = 0; j < 4; ++j) v[n][j] = h2[j] + sigmoid_f(a4[j]) * pp[j];
                        if (!last) ss += (v[n][0] * v[n][0] + v[n][1] * v[n][1]) + (v[n][2] * v[n][2] + v[n][3] * v[n][3]); }
                    if (last) { *(f32x4*)(OUTF + o + 128 * bj) = v[0]; *(f32x4*)(OUTF + o + 128 * bj + 4) = v[1]; }
                    else *(u32x4*)(OUTB + o + 128 * bj) = pack8(v[0], v[1]); }
                if (!last) { ss += __shfl_xor(ss, 16); ss += __shfl_xor(ss, 32); if (fq == 0) ssq[(size_t)row * 16 + u.pn * 4 + wc] = ss; } }
            EPI_FENCE();
        }
    }
};
struct ProbGateUp : ProbBase {
    const LAS int* tab_row; const LAS int* tab_ev; int nblk;
    const LAS unsigned* goff;
    const float* __restrict__ slot_rs; bf16_t* __restrict__ HBUF;
    DEVI bool next(int i, Unit& u) const { const int L = i * G + c; if (L >= nblk * 4) return false; const int b = L >> 2; u.pn = L & 3; u.pm = tab_row[b]; const int ev = tab_ev[b]; u.e = (ev >> 9) | (i << 8); u.v = ev & 511; return true; }
    DEVI unsigned a_off(const Unit& u, int R) const { return goff[(u.e >> 8) * 256 + R]; }
    DEVI size_t b_off(const Unit& u) const { return ((size_t)(u.e & 255) * 1024 + (size_t)u.pn * 256) * ldb; }
    DEVI void epi(const AccT& acc, const Unit& u, int wr, int wc, int fr, int fq) const {
        float rsv[2][4];
#pragma unroll
        for (int ai = 0; ai < 2; ++ai)
#pragma unroll
            for (int m = 0; m < 4; ++m) rsv[ai][m] = slot_rs[u.pm + 128 * ai + 64 * wr + 16 * m + fr];
        EPI_FENCE();
#pragma unroll
        for (int ai = 0; ai < 2; ++ai)
#pragma unroll
            for (int m = 0; m < 4; ++m) {
                const int R = 128 * ai + 64 * wr + 16 * m + fr;
                if (R < u.v) { const int slot = u.pm + R; const float rs = rsv[ai][m];
                    f32x4 o[2];
#pragma unroll
                    for (int n = 0; n < 2; ++n) { const f32x4 g = acc[ai][0][m][n] * rs, up = acc[ai][1][m][n] * rs;
#pragma unroll
                        for (int j = 0; j < 4; ++j) o[n][j] = g[j] * sigmoid_f(g[j]) * up[j]; }
                    *(u32x4*)(HBUF + (size_t)slot * DEXP + 128 * u.pn + 32 * wc + 8 * fq) = pack8(o[0], o[1]); } }
    }
};
struct ProbDown : ProbBase {
    const LAS int* tab_row; const LAS int* tab_ev; int nblk;
    const float* __restrict__ slot_w; bf16_t* __restrict__ YB;
    DEVI bool next(int i, Unit& u) const { const int L = i * G + c; if (L >= nblk * 4) return false; const int b = L >> 2; u.pn = L & 3; u.pm = tab_row[b]; const int ev = tab_ev[b]; u.e = ev >> 9; u.v = ev & 511; return true; }
    DEVI unsigned a_off(const Unit& u, int R) const { return (unsigned)(u.pm + R) * 1024u; }
    DEVI size_t b_off(const Unit& u) const { return ((size_t)u.e * 1024 + (size_t)u.pn * 256) * ldb; }
    DEVI void epi(const AccT& acc, const Unit& u, int wr, int wc, int fr, int fq) const {
        float wv[2][4];
#pragma unroll
        for (int ai = 0; ai < 2; ++ai)
#pragma unroll
            for (int m = 0; m < 4; ++m) wv[ai][m] = slot_w[u.pm + 128 * ai + 64 * wr + 16 * m + fr];
        EPI_FENCE();
#pragma unroll
        for (int ai = 0; ai < 2; ++ai)
#pragma unroll
            for (int m = 0; m < 4; ++m) {
                const int R = 128 * ai + 64 * wr + 16 * m + fr;
                if (R < u.v) { const int slot = u.pm + R; const float w = wv[ai][m];
#pragma unroll
                    for (int bj = 0; bj < 2; ++bj) *(u32x4*)(YB + (size_t)slot * DM + 256 * u.pn + 128 * bj + 32 * wc + 8 * fq) = pack8(acc[ai][bj][m][0] * w, acc[ai][bj][m][1] * w); } }
    }
};
struct ProbWin : ProbBase {
    const float* __restrict__ rstd; const float* __restrict__ rope; const float* __restrict__ qnorm; const float* __restrict__ knorm; bf16_t* __restrict__ Q; bf16_t* __restrict__ KV; float* __restrict__ gates;
    const LAS float* lrs;
    DEVI bool next(int i, Unit& u) const { const int L = i * G + c; if (L >= 128 * 11) return false; u.pm = L / 11; u.pn = L % 11; u.e = i; u.v = 256; return true; }
    DEVI unsigned a_off(const Unit& u, int R) const { return (unsigned)(u.pm * 256 + R) * 2048u; }
    DEVI size_t b_off(const Unit& u) const { return (size_t)u.pn * 256 * ldb; }
    DEVI void epi(const AccT& acc, const Unit& u, int wr, int wc, int fr, int fq) const {
        const int pn = u.pn;
        float rsv[2][4];
#pragma unroll
        for (int ai = 0; ai < 2; ++ai)
#pragma unroll
            for (int m = 0; m < 4; ++m) rsv[ai][m] = lrs[u.e * 256 + 128 * ai + 64 * wr + 16 * m + fr];
        if (pn == 10) {
            EPI_FENCE();
            if (wc < 2) {
#pragma unroll
                for (int ai = 0; ai < 2; ++ai)
#pragma unroll
                    for (int m = 0; m < 4; ++m) {
                        const int row = u.pm * 256 + 128 * ai + 64 * wr + 16 * m + fr; const float rs = rsv[ai][m];
#pragma unroll
                        for (int n = 0; n < 2; ++n) if (wc == 0 || fq < 2) { const f32x4 a4 = acc[ai][0][m][n] * rs; f32x4 o;
#pragma unroll
                            for (int j = 0; j < 4; ++j) o[j] = sigmoid_f(a4[j]);
                            *(f32x4*)(gates + (size_t)row * 48 + 32 * wc + 8 * fq + 4 * n) = o; } } }
            return;
        }
        const bool isq = pn < 4, dorope = isq || pn == 6 || pn == 8;
        const float* gvec = isq ? qnorm : (knorm + (pn == 6 ? 64 : 128));
        f32x4 g1[2], g2[2];
#pragma unroll
        for (int n = 0; n < 2; ++n) { g1[n] = *(const f32x4*)(gvec + 8 * fq + 4 * n); g2[n] = *(const f32x4*)(gvec + 32 + 8 * fq + 4 * n); }
        const float oscale = isq ? C2 : 1.0f;
#pragma unroll
        for (int g = 0; g < 8; ++g) { const int ai = g >> 2, m = g & 3;
            const int row = u.pm * 256 + 128 * ai + 64 * wr + 16 * m + fr; const float rs = rsv[ai][m];
            f32x4 cs[2], sn[2];
            if (dorope) { const size_t ro = (size_t)row * 64 + 8 * fq;
#pragma unroll
                for (int n = 0; n < 2; ++n) { cs[n] = *(const f32x4*)(rope + ro + 4 * n); sn[n] = *(const f32x4*)(rope + ro + 32 + 4 * n); } }
            f32x4 x1[2], x2[2];
#pragma unroll
            for (int n = 0; n < 2; ++n) { x1[n] = acc[ai][0][m][n] * rs; x2[n] = acc[ai][1][m][n] * rs; }
            if (dorope) {
                float ss = 0.f;
#pragma unroll
                for (int n = 0; n < 2; ++n)
#pragma unroll
                    for (int j = 0; j < 4; ++j) ss += x1[n][j] * x1[n][j] + x2[n][j] * x2[n][j];
                ss += __shfl_xor(ss, 16); ss += __shfl_xor(ss, 32);
                const float inv = 1.0f / sqrtf(ss * (1.0f / 64.0f) + EPS);
#pragma unroll
                for (int n = 0; n < 2; ++n) {
                    const f32x4 y1 = x1[n] * inv * g1[n], y2 = x2[n] * inv * g2[n];
                    x1[n] = (y1 * cs[n] - y2 * sn[n]) * oscale; x2[n] = (y2 * cs[n] + y1 * sn[n]) * oscale; } }
            bf16_t* dst;
            if (isq) dst = Q + (size_t)row * DM + (4 * pn + wc) * 64;
            else { const int b = row >> 11, t = row & 2047; dst = KV + (size_t)(pn - 4) * KVS + ((size_t)(b * 4 + wc) * SEQ + t) * 64; }
            *(u32x4*)(dst + 8 * fq) = pack8(x1[0], x1[1]); *(u32x4*)(dst + 32 + 8 * fq) = pack8(x2[0], x2[1]);
        }
    }
};
struct ProbCmp : ProbBase {
    float* CP;
    DEVI bool next(int i, Unit& u) const { const int L = i * G + c; if (L >= 256) return false; u.e = L >> 7; u.pm = (L >> 2) & 31; u.v = L & 3; u.pn = 0; return true; }
    DEVI unsigned a_off(const Unit& u, int R) const { return (unsigned)u.e * (unsigned)(KVS * 2) + (unsigned)(u.pm * 256 + R) * 2048u + (unsigned)u.v * 1024u; }
    DEVI size_t b_off(const Unit& u) const { return (size_t)u.e * 256 * ldb + (size_t)u.v * 1024; }
    DEVI void epi(const AccT& acc, const Unit& u, int wr, int wc, int fr, int fq) const {
        float* base = CP + ((size_t)(u.e * 4 + u.v) * 8192) * 256;
#pragma unroll
        for (int ai = 0; ai < 2; ++ai)
#pragma unroll
            for (int m = 0; m < 4; ++m) {
                const int rho = u.pm * 256 + 128 * ai + 64 * wr + 16 * m + fr;
#pragma unroll
                for (int bj = 0; bj < 2; ++bj)
#pragma unroll
                    for (int n = 0; n < 2; ++n) *(f32x4*)(base + (size_t)rho * 256 + 128 * bj + 32 * wc + 8 * fq + 4 * n) = acc[ai][bj][m][n]; }
    }
};

#define CONV_BAR() asm volatile("s_waitcnt lgkmcnt(0)\n\ts_barrier" ::: "memory")
DEVI void conv_phase(const Frame& F, const Args& a) {
    const bf16_t* U = (const bf16_t*)(F.ws + WS_U); bf16_t* V = (bf16_t*)(F.ws + WS_V);
    LAS float* red = (LAS float*)(F.lds + SCR_OFF);
    LAS float* fin = red + 256;
    const int tid = F.tid, c0 = 2 * tid;
    f32x2 w2[31];
#pragma unroll
    for (int k = 0; k < 31; ++k) w2[k] = *(const f32x2*)(a.in[8] + (size_t)k * DM + c0);
    const f32x2 bdw = *(const f32x2*)(a.in[9] + c0), lg = *(const f32x2*)(a.in[10] + c0), lb = *(const f32x2*)(a.in[11] + c0);
    for (int ch = F.vcu; ch < 256; ch += F.G) {
        const int tokbase = ch * 128, t0 = tokbase & (SEQ - 1);
        const unsigned* Up = (const unsigned*)U + (size_t)tokbase * 512 + tid;
        unsigned win[46];
#pragma unroll
        for (int i = 0; i < 46; ++i) { const int rel = i - 30; win[i] = (rel >= 0 || t0 != 0) ? Up[(ptrdiff_t)rel * 512] : 0u; }
#pragma unroll
        for (int s = 0; s < 8; ++s) {
            unsigned nxt[16];
            if (s < 7) {
#pragma unroll
                for (int i = 0; i < 16; ++i) nxt[i] = Up[(ptrdiff_t)(16 * (s + 1) + i) * 512]; }
            f32x2 y[16];
#pragma unroll
            for (int tt = 0; tt < 16; ++tt) y[tt] = bdw;
#pragma unroll
            for (int rr = 0; rr < 46; ++rr) {
                const f32x2 v = {bflo(win[rr]), bfhi(win[rr])};
#pragma unroll
                for (int tt = 0; tt < 16; ++tt) { const int k = rr - tt; if (k >= 0 && k <= 30) y[tt] += w2[k] * v; }
            }
            float v16[16];
            { const bool h5 = (F.lane & 32) != 0;
#pragma unroll
              for (int i = 0; i < 16; ++i) { const float sA = y[i][0] + y[i][1], sB = y[i][0] * y[i][0] + y[i][1] * y[i][1]; const float keep = h5 ? sB : sA, send = h5 ? sA : sB; v16[i] = keep + __shfl_xor(send, 32); } }
            float v8[8], v4[4], v2[2], v1r;
            { const bool h = (F.lane & 16) != 0;
#pragma unroll
              for (int i = 0; i < 8; ++i) { const float keep = h ? v16[i + 8] : v16[i], send = h ? v16[i] : v16[i + 8]; v8[i] = keep + __shfl_xor(send, 16); } }
            { const bool h = (F.lane & 8) != 0;
#pragma unroll
              for (int i = 0; i < 4; ++i) { const float keep = h ? v8[i + 4] : v8[i], send = h ? v8[i] : v8[i + 4]; v4[i] = keep + __shfl_xor(send, 8); } }
            { const bool h = (F.lane & 4) != 0;
#pragma unroll
              for (int i = 0; i < 2; ++i) { const float keep = h ? v4[i + 2] : v4[i], send = h ? v4[i] : v4[i + 2]; v2[i] = keep + __shfl_xor(send, 4); } }
            { const bool h = (F.lane & 2) != 0; const float keep = h ? v2[1] : v2[0], send = h ? v2[0] : v2[1]; v1r = keep + __shfl_xor(send, 2); }
            v1r += __shfl_xor(v1r, 1);
            CONV_BAR();
            if ((F.lane & 1) == 0) red[F.wave * 32 + (F.lane >> 1)] = v1r;
            CONV_BAR();
            if (tid < 16) { float t = 0.f, q = 0.f;
#pragma unroll
                for (int w = 0; w < 8; ++w) { t += red[w * 32 + tid]; q += red[w * 32 + 16 + tid]; }
                const float mean = t * (1.0f / DM), var = q * (1.0f / DM) - mean * mean;
                fin[tid] = mean; fin[16 + tid] = 1.0f / sqrtf(var + EPS); }
            CONV_BAR();
#pragma unroll
            for (int tt = 0; tt < 16; ++tt) {
                const float mean = fin[tt], rstd = fin[16 + tt];
                const float z0 = (y[tt][0] - mean) * rstd * lg[0] + lb[0], z1 = (y[tt][1] - mean) * rstd * lg[1] + lb[1];
                *(unsigned*)(V + (size_t)(tokbase + 16 * s + tt) * DM + c0) = pk2(z0 * sigmoid_f(z0), z1 * sigmoid_f(z1)); }
            if (s < 7) {
#pragma unroll
                for (int i = 0; i < 30; ++i) win[i] = win[i + 16];
#pragma unroll
                for (int i = 0; i < 16; ++i) win[30 + i] = nxt[i]; }
        }
    }
}
DEVI void router_phase(const Frame& F, const Args& a, int L, const bf16_t* H) {
    const bf16_t* rw = (const bf16_t*)(F.ws + WS_RW) + (size_t)(L * 2) * 48 * 1024;
    float* rs1 = (float*)(F.ws + WS_RS1); int* asg_e = (int*)(F.ws + WS_ASGE); int* asg_r = (int*)(F.ws + WS_ASGR); float* asg_w = (float*)(F.ws + WS_ASGW); int* cnt = (int*)(F.ws + WS_CNT);
    LAS unsigned char* wst = F.lds + RING_OFF;
    LAS float* lg = (LAS float*)(F.lds + RING_OFF + 65536) + F.wave * (16 * 48);
    LAS int* elist = (LAS int*)(F.lds + RING_OFF + 98304);
    LAS float* bias = (LAS float*)(F.lds + RING_OFF + 98304 + 1024);
    if (F.tid < 4) bias[F.tid] = a.in[22][L * 4 + F.tid]; else if (F.tid < 36) bias[F.tid] = a.in[24][L * 32 + F.tid - 4];
    const LAS float* brg = bias; const LAS float* bre = bias + 4;
    const int fr = F.lane & 15, fq = F.lane >> 4;
    for (int ch = F.vcu; ch < 256; ch += F.G) {
        const int tok0 = ch * 128 + F.wave * 16;
        f32x4 acc[3];
#pragma unroll
        for (int t = 0; t < 3; ++t) acc[t] = (f32x4){0.f, 0.f, 0.f, 0.f};
        float ss = 0.f;
        const bf16_t* hp = H + (size_t)(tok0 + fr) * DM + 8 * fq;
        for (int kc4 = 0; kc4 < 4; ++kc4) {
            const int kc = (kc4 + F.vcu) & 3;
            bf16x8 hf[8];
#pragma unroll
            for (int sl = 0; sl < 8; ++sl) hf[sl] = *(const bf16x8*)(hp + kc * 256 + 32 * sl);
            u32x4 wv[6];
#pragma unroll
            for (int i = 0; i < 6; ++i) { const int idx = F.tid + 512 * i, hl = idx / 1536, rem = idx % 1536, row = rem >> 5, c = rem & 31;
                wv[i] = *(const u32x4*)(rw + ((size_t)(hl * 48 + row)) * 1024 + kc * 256 + c * 8); }
            wg_sync();
#pragma unroll
            for (int i = 0; i < 6; ++i) { const int idx = F.tid + 512 * i, hl = idx / 1536, rem = idx % 1536, row = rem >> 5, c = rem & 31;
                *(LAS u32x4*)(wst + hl * 25344 + row * 528 + c * 16) = wv[i]; }
            wg_sync();
#pragma unroll
            for (int sl = 0; sl < 8; ++sl) {
#pragma unroll
                for (int t = 0; t < 3; ++t) {
                    const bf16x8 wh = *(const LAS bf16x8*)(wst + (16 * t + fr) * 528 + (32 * sl + 8 * fq) * 2), wl = *(const LAS bf16x8*)(wst + 25344 + (16 * t + fr) * 528 + (32 * sl + 8 * fq) * 2);
                    acc[t] = __builtin_amdgcn_mfma_f32_16x16x32_bf16(wh, hf[sl], acc[t], 0, 0, 0);
                    acc[t] = __builtin_amdgcn_mfma_f32_16x16x32_bf16(wl, hf[sl], acc[t], 0, 0, 0); }
                const u32x4 hu = __builtin_bit_cast(u32x4, hf[sl]);
#pragma unroll
                for (int j = 0; j < 4; ++j) { const float x0 = bflo(hu[j]), x1 = bfhi(hu[j]); ss += x0 * x0 + x1 * x1; }
            }
        }
        ss += __shfl_xor(ss, 16); ss += __shfl_xor(ss, 32);
        const float rs = 1.0f / sqrtf(ss * (1.0f / DM) + EPS);
        if (fq == 0) rs1[tok0 + fr] = rs;
#pragma unroll
        for (int t = 0; t < 3; ++t)
#pragma unroll
            for (int r = 0; r < 4; ++r) lg[fr * 48 + 16 * t + 4 * fq + r] = acc[t][r] * rs;
        LDS_WAIT();
        if (F.lane < 16) {
            const LAS float* my = lg + F.lane * 48;
            float g[4]; int gi = 0; float gm;
#pragma unroll
            for (int j = 0; j < 4; ++j) g[j] = my[j] + brg[j];
            gm = g[0];
#pragma unroll
            for (int j = 1; j < 4; ++j) if (g[j] > gm) { gm = g[j]; gi = j; }
            float den = 0.f;
#pragma unroll
            for (int j = 0; j < 4; ++j) den += __expf(g[j] - gm);
            const float pg = 1.0f / den;
            float v1 = -INFINITY, v2 = -INFINITY; int i1 = 0, i2 = 0;
            for (int j = 0; j < 8; ++j) { const float v = my[4 + gi * 8 + j] + bre[gi * 8 + j];
                if (v > v1) { v2 = v1; i2 = i1; v1 = v; i1 = j; } else if (v > v2) { v2 = v; i2 = j; } }
            const float e2 = __expf(v2 - v1), wa = pg / (1.0f + e2), wb = pg * e2 / (1.0f + e2);
            const int tl = F.wave * 16 + F.lane;
            elist[2 * tl] = gi * 8 + i1; elist[2 * tl + 1] = gi * 8 + i2;
            asg_w[(size_t)ch * 256 + 2 * tl] = wa; asg_w[(size_t)ch * 256 + 2 * tl + 1] = wb;
        }
        wg_sync();
        if (F.tid < 288) {
            const bool isr = F.tid < 256; const int e = isr ? elist[F.tid] : F.tid - 256, lim = isr ? F.tid : 256; int r = 0;
            typedef int i32x4 __attribute__((ext_vector_type(4)));
#pragma unroll 8
            for (int q = 0; q < 256; q += 4) { const i32x4 v = *(const LAS i32x4*)(elist + q);
                r += ((v[0] == e) & (q < lim)) + ((v[1] == e) & (q + 1 < lim)) + ((v[2] == e) & (q + 2 < lim)) + ((v[3] == e) & (q + 3 < lim)); }
            if (isr) { asg_e[(size_t)ch * 256 + F.tid] = e; asg_r[(size_t)ch * 256 + F.tid] = r; } else cnt[ch * 32 + e] = r; }
        wg_sync();
    }
}
DEVI void fill_phase(const Frame& F) {
    const int* cnt = (const int*)(F.ws + WS_CNT); const int* asg_e = (const int*)(F.ws + WS_ASGE); const int* asg_r = (const int*)(F.ws + WS_ASGR); const float* asg_w = (const float*)(F.ws + WS_ASGW);
    const float* rs1 = (const float*)(F.ws + WS_RS1);
    int* tslot = (int*)(F.ws + WS_TSLOT); int* stok = (int*)(F.ws + WS_STOK); float* sw = (float*)(F.ws + WS_SW); float* srs = (float*)(F.ws + WS_SRS); int* mtot = (int*)(F.ws + WS_MTOT);
    LAS int* ptot = (LAS int*)(F.lds + RING_OFF);
    LAS int* ppre = ptot + 512;
    LAS int* tot = ppre + 512; LAS int* start = tot + 32; LAS int* pre = start + 32;
    for (int ch = F.vcu; ch < 256; ch += F.G) {
        wg_sync();
        { const int e = F.tid & 31, part = F.tid >> 5; int t = 0, p = 0;
          for (int w = part * 16; w < part * 16 + 16; ++w) { const int c = cnt[w * 32 + e]; t += c; if (w < ch) p += c; }
          ptot[part * 32 + e] = t; ppre[part * 32 + e] = p; }
        wg_sync();
        if (F.tid < 32) { int t = 0, p = 0;
#pragma unroll
            for (int q = 0; q < 16; ++q) { t += ptot[q * 32 + F.tid]; p += ppre[q * 32 + F.tid]; }
            tot[F.tid] = t; pre[F.tid] = p; }
        wg_sync();
        if (F.tid == 0) { int s = 0; for (int e = 0; e < 32; ++e) { start[e] = s; s += tot[e]; } }
        wg_sync();
        if (F.tid < 256) { const size_t ag = (size_t)ch * 256 + F.tid; const int e = asg_e[ag], slot = start[e] + pre[e] + asg_r[ag], tok = ch * 128 + (F.tid >> 1);
            stok[slot] = tok; sw[slot] = asg_w[ag]; srs[slot] = rs1[tok]; tslot[ag] = slot; }
        if (ch == 0) {
            if (F.tid < 32) { mtot[F.tid] = tot[F.tid]; mtot[32 + F.tid] = start[F.tid]; }
            if (F.tid >= 256) { const int i = NSLOT + F.tid - 256; stok[i] = 0; sw[i] = 0.f; srs[i] = 0.f; }
            { const float* cbp = (const float*)(F.ws + WS_CBP); const int j = F.tid >> 8, c = F.tid & 255; float s2 = 0.f;
              for (int kr = 0; kr < 32; ++kr) s2 += cbp[(j * 32 + kr) * 256 + c];
              ((float*)(F.ws + WS_CB))[F.tid] = s2; } }
    }
}
DEVI int build_moe_table(const Frame& F) {
    const int* mtot = (const int*)(F.ws + WS_MTOT);
    LAS int* trow = (LAS int*)(F.lds + TAB_OFF); LAS int* tev = trow + 320; LAS int* tn = tev + 320;
    LAS int* mt = (LAS int*)(F.lds + SCR_OFF);
    if (F.tid < 64) mt[F.tid] = mtot[F.tid];
    wg_sync();
    if (F.tid == 0) { int nb = 0;
        for (int e = 0; e < 32; ++e) { const int t = mt[e], s = mt[32 + e];
            for (int o = 0; o < t; o += 256) { trow[nb] = s + o; tev[nb] = e * 512 + ((t - o) < 256 ? (t - o) : 256); ++nb; } }
        tn[0] = nb; }
    wg_sync();
    return tn[0];
}
DEVI void combine_phase(const Frame& F, const bf16_t* H, bf16_t* OUT, int zero_y) {
    const bf16_t* YB = (const bf16_t*)(F.ws + WS_YB); const int* tslot = (const int*)(F.ws + WS_TSLOT); float* rs2 = (float*)(F.ws + WS_RS2);
    const int gw = F.vcu * NWAVES + F.wave, NGW = F.G * NWAVES;
    for (int row = gw; row < NTOK; row += NGW) {
        const int s0 = tslot[2 * row], s1 = tslot[2 * row + 1]; float ss = 0.f;
#pragma unroll
        for (int hx = 0; hx < 2; ++hx) {
            const int col = 512 * hx + 8 * F.lane;
            const u32x4 h = *(const u32x4*)(H + (size_t)row * DM + col), y0 = *(const u32x4*)(YB + (size_t)s0 * DM + col), y1 = *(const u32x4*)(YB + (size_t)s1 * DM + col); u32x4 o;
#pragma unroll
            for (int j = 0; j < 4; ++j) { float lo = bflo(h[j]) + bflo(y0[j]) + bflo(y1[j]), hi = bfhi(h[j]) + bfhi(y0[j]) + bfhi(y1[j]); if (zero_y) { lo = bflo(h[j]); hi = bfhi(h[j]); } ss += lo * lo + hi * hi; o[j] = pk2(lo, hi); }
            *(u32x4*)(OUT + (size_t)row * DM + col) = o; }
        ss = wave_sum(ss);
        if (F.lane == 0) rs2[row] = 1.0f / sqrtf(ss * (1.0f / DM) + EPS);
    }
}
DEVI void rstd_from_partials(const Frame& F) {
    const float* ssq = (const float*)(F.ws + WS_SSQ); float* rs0 = (float*)(F.ws + WS_RS0);
    for (int row = F.vcu * 512 + F.tid; row < NTOK; row += F.G * 512) {
        const f32x4* p = (const f32x4*)(ssq + (size_t)row * 16); float s = 0.f;
#pragma unroll
        for (int q = 0; q < 4; ++q) { const f32x4 v = p[q]; s += (v[0] + v[1]) + (v[2] + v[3]); }
        rs0[row] = 1.0f / sqrtf(s * (1.0f / DM) + EPS); }
}
DEVI void cmpb_phase(const Frame& F, const Args& a) {
    const float* CP = (const float*)(F.ws + WS_CP); const float* CB = (const float*)(F.ws + WS_CB); const float* rope = (const float*)(F.ws + WS_ROPE);
    const bf16_t* W2T = (const bf16_t*)(F.ws + WS_W2T);
    bf16_t* KC = (bf16_t*)(F.ws + WS_KC); bf16_t* VC = (bf16_t*)(F.ws + WS_VC);
    LAS unsigned char* hl = F.lds + RING_OFF;
    LAS float* ol = (LAS float*)(F.lds + RING_OFF + 65536);
    const float kn = a.in[16][F.lane];
    const int fr = F.lane & 15, fq = F.lane >> 4;
    for (int wg = F.vcu; wg < 256; wg += F.G) {
        const int row0 = wg * 64, j = row0 >> 13, rho0 = row0 & 8191;
        { const int r = F.tid >> 3, c0 = (F.tid & 7) * 32;
          f32x4 acc8[8];
#pragma unroll
          for (int q = 0; q < 8; ++q) acc8[q] = *(const f32x4*)(CB + j * 256 + c0 + 4 * q);
#pragma unroll
          for (int ks = 0; ks < 4; ++ks) { const float* src = CP + ((size_t)(j * 4 + ks) * 8192 + rho0 + r) * 256 + c0;
#pragma unroll
              for (int q = 0; q < 8; ++q) acc8[q] += *(const f32x4*)(src + 4 * q); }
#pragma unroll
          for (int q = 0; q < 8; ++q) { f32x4 g;
#pragma unroll
              for (int e = 0; e < 4; ++e) { const float x = acc8[q][e], uu = 0.7978845608028654f * (x + 0.044715f * x * x * x); g[e] = x * sigmoid_f(2.0f * uu); }
              *(LAS u32x2*)(hl + r * 528 + (c0 + 4 * q) * 2) = pack4(g); } }
        wg_sync();
        { const int mt = F.wave & 3, np = F.wave >> 2;
          f32x4 d[2]; d[0] = (f32x4){0.f, 0.f, 0.f, 0.f}; d[1] = d[0];
#pragma unroll
          for (int st = 0; st < 8; ++st) {
              const bf16x8 hf = *(const LAS bf16x8*)(hl + (16 * mt + fr) * 528 + (32 * st + 8 * fq) * 2);
#pragma unroll
              for (int t = 0; t < 2; ++t) { const bf16x8 wf = *(const bf16x8*)(W2T + ((size_t)(j * 64 + 32 * np + 16 * t + fr)) * 256 + 32 * st + 8 * fq);
                  d[t] = __builtin_amdgcn_mfma_f32_16x16x32_bf16(wf, hf, d[t], 0, 0, 0); } }
#pragma unroll
          for (int t = 0; t < 2; ++t) *(LAS f32x4*)(ol + (16 * mt + fr) * 64 + 32 * np + 16 * t + 4 * fq) = d[t]; }
        wg_sync();
#pragma unroll
        for (int q = 0; q < 8; ++q) {
            const int r = F.wave * 8 + q, rho = rho0 + r, bg = rho >> 7, n = rho & 127;
            bf16_t* dst = (j == 0 ? KC : VC) + (size_t)rho * 64 + F.lane;
            float o = ol[r * 64 + F.lane];
            if (n == 127) { *dst = 0; continue; }
            if (j == 0) {
                const float ms = wave_sum(o * o) * (1.0f / 64.0f); const float y = o * (1.0f / sqrtf(ms + EPS)) * kn;
                const float other = __shfl_xor(y, 32);
                const int row = (bg >> 2) * SEQ + 16 * n + 31; const float cs = rope[(size_t)row * 64 + (F.lane & 31)], sn = rope[(size_t)row * 64 + 32 + (F.lane & 31)];
                o = (F.lane < 32) ? (y * cs - other * sn) : (y * cs + other * sn);
            }
            *dst = (bf16_t)(pk2(o, 0.f) & 0xffffu);
        }
        wg_sync();
    }
}

#ifndef ATT_REP
#define ATT_REP 1
#endif
namespace att {
constexpr int KS0 = 0, VS0 = 24576, WSF = 49152, OFN = 51200, UNI = 116736;
typedef const LAS char* lptr;
DEVI int crow(int r, int hi) { return (r & 3) + 8 * (r >> 2) + 4 * hi; }
DEVI void glds16(const void* gsrc, unsigned lds_dst) { unsigned keep;
    asm volatile("s_mov_b32 %0, m0\n\ts_mov_b32 m0, %2\n\ts_nop 0\n\tglobal_load_lds_dwordx4 %1, off\n\ts_mov_b32 m0, %0" : "=&s"(keep) : "v"(gsrc), "s"(lds_dst) : "memory"); }
DEVI float xlane32(float v) { return __shfl_xor(v, 32); }
DEVI void qkt(f32x16& p0, f32x16& p1, lptr Kslot, const bf16x8* qr, float cinit, int r32, int hi) {
    lptr kb = Kslot + hi * 1024 + r32 * 16;
#pragma unroll
    for (int r = 0; r < 16; ++r) { p0[r] = cinit; p1[r] = cinit; }
#pragma unroll
    for (int d0 = 0; d0 < 4; ++d0) {
        const bf16x8 b0 = *(const LAS bf16x8*)(kb + d0 * 2048), b1 = *(const LAS bf16x8*)(kb + d0 * 2048 + 512);
        p0 = __builtin_amdgcn_mfma_f32_32x32x16_bf16(b0, qr[d0], p0, 0, 0, 0); p1 = __builtin_amdgcn_mfma_f32_32x32x16_bf16(b1, qr[d0], p1, 0, 0, 0); }
}
DEVI float rowmax(const f32x16& p0, const f32x16& p1) {
    float m = fmaxf(p0[0], p1[0]);
#pragma unroll
    for (int r = 1; r < 16; ++r) m = fmaxf(m, fmaxf(p0[r], p1[r]));
    return fmaxf(m, xlane32(m));
}
DEVI float max3f(float a, float b, float c) { float r; asm("v_max3_f32 %0, %1, %2, %3" : "=v"(r) : "v"(a), "v"(b), "v"(c)); return r; }
DEVI float rowmax3(const f32x16& p0, const f32x16& p1) {
    float a = max3f(p0[0], p0[1], p1[0]), b = max3f(p0[2], p0[3], p1[1]); a = max3f(a, p1[2], p1[3]);
#pragma unroll
    for (int r = 4; r < 16; r += 4) { a = max3f(a, p0[r], p0[r + 1]); b = max3f(b, p0[r + 2], p0[r + 3]); a = max3f(a, p1[r], p1[r + 1]); b = max3f(b, p1[r + 2], p1[r + 3]); }
    const float m = max3f(a, b, b);
    return max3f(m, xlane32(m), m);
}
DEVI void qk2(f32x16& p0, f32x16& p1, lptr Kslot, const bf16x8* qr, const f32x16& negm, int r32, int hi) {
    lptr kb = Kslot + hi * 1024 + r32 * 16;
    bf16x8 kf[8];
#pragma unroll
    for (int d0 = 0; d0 < 4; ++d0) { kf[2 * d0] = *(const LAS bf16x8*)(kb + d0 * 2048); kf[2 * d0 + 1] = *(const LAS bf16x8*)(kb + d0 * 2048 + 512); }
    asm volatile("s_waitcnt lgkmcnt(0)" : "+v"(kf[0]), "+v"(kf[1]), "+v"(kf[2]), "+v"(kf[3]), "+v"(kf[4]), "+v"(kf[5]), "+v"(kf[6]), "+v"(kf[7]) :: "memory");
    p0 = __builtin_amdgcn_mfma_f32_32x32x16_bf16(kf[0], qr[0], negm, 0, 0, 0); p1 = __builtin_amdgcn_mfma_f32_32x32x16_bf16(kf[1], qr[0], negm, 0, 0, 0);
#pragma unroll
    for (int d0 = 1; d0 < 4; ++d0) { p0 = __builtin_amdgcn_mfma_f32_32x32x16_bf16(kf[2 * d0], qr[d0], p0, 0, 0, 0); p1 = __builtin_amdgcn_mfma_f32_32x32x16_bf16(kf[2 * d0 + 1], qr[d0], p1, 0, 0, 0); }
}
DEVI void pv(f32x16* o, int vb, bf16x8 pa0, bf16x8 pa1, bf16x8 pa2, bf16x8 pa3) {
#pragma unroll
    for (int d0 = 0; d0 < 2; ++d0) { s16x4 lo[4], hi[4];
#pragma unroll
        for (int ks = 0; ks < 4; ++ks) {
            asm volatile("ds_read_b64_tr_b16 %0,%1 offset:%c2" : "=&v"(lo[ks]) : "v"(vb), "i"(d0 * 4096 + ks * 1024) : "memory");
            asm volatile("ds_read_b64_tr_b16 %0,%1 offset:%c2" : "=&v"(hi[ks]) : "v"(vb), "i"(d0 * 4096 + ks * 1024 + 512) : "memory"); }
        asm volatile("s_waitcnt lgkmcnt(0)" ::: "memory"); __builtin_amdgcn_sched_barrier(0);
#define ATT_PK(k) (bf16x8){lo[k][0], lo[k][1], lo[k][2], lo[k][3], hi[k][0], hi[k][1], hi[k][2], hi[k][3]}
        o[d0] = __builtin_amdgcn_mfma_f32_32x32x16_bf16(pa0, ATT_PK(0), o[d0], 0, 0, 0);
        o[d0] = __builtin_amdgcn_mfma_f32_32x32x16_bf16(pa1, ATT_PK(1), o[d0], 0, 0, 0);
        o[d0] = __builtin_amdgcn_mfma_f32_32x32x16_bf16(pa2, ATT_PK(2), o[d0], 0, 0, 0);
        o[d0] = __builtin_amdgcn_mfma_f32_32x32x16_bf16(pa3, ATT_PK(3), o[d0], 0, 0, 0);
#undef ATT_PK
    }
}
DEVI bf16x8 packp(const f32x16& p, int b) { u32x4 w; w.x = pk2(p[b], p[b + 1]); w.y = pk2(p[b + 2], p[b + 3]); w.z = pk2(p[b + 4], p[b + 5]); w.w = pk2(p[b + 6], p[b + 7]); return __builtin_bit_cast(bf16x8, w); }
DEVI void scale_rows(f32x16* o, LAS float* wsf, float fac, int r32, int hi) {
    if (hi == 0) wsf[r32] = fac;
    LDS_WAIT();
#pragma unroll
    for (int r = 0; r < 16; ++r) { const float f = wsf[crow(r, hi)]; o[0][r] *= f; o[1][r] *= f; }
    LDS_WAIT();
}
DEVI void fold_rows(const f32x16* o, LAS float* ofl, LAS float* wsf, float fac, int r32, int hi) {
    if (hi == 0) wsf[r32] = fac;
    LDS_WAIT();
#pragma unroll
    for (int r = 0; r < 16; ++r) { const int q = crow(r, hi); const float f = wsf[q]; ofl[q * 64 + r32] += o[0][r] * f; ofl[q * 64 + 32 + r32] += o[1][r] * f; }
    LDS_WAIT();
}
DEVI void tile_step(f32x16* o, float& m, float& l, const bf16x8* qr, lptr Kslot, int vb, LAS float* wsf, int r32, int hi, float cinit, bool domask, int kbase, int lo, int hi_) {
    f32x16 p0, p1;
    qkt(p0, p1, Kslot, qr, cinit, r32, hi);
    if (domask) {
#pragma unroll
        for (int r = 0; r < 16; ++r) { const int kp = kbase + crow(r, hi); if (kp < lo || kp > hi_) p0[r] = -INFINITY; if (kp + 32 < lo || kp + 32 > hi_) p1[r] = -INFINITY; } }
    const float rm = rowmax(p0, p1);
    if (__builtin_amdgcn_ballot_w64(rm > m + 8.0f) != 0ull) {
        const float mn = fmaxf(m, rm), f = __builtin_amdgcn_exp2f(m - mn); m = mn;
        l *= f;
        scale_rows(o, wsf, f, r32, hi);
    }
    float ps = 0.f;
#pragma unroll
    for (int r = 0; r < 16; ++r) { p0[r] = __builtin_amdgcn_exp2f(p0[r] - m); p1[r] = __builtin_amdgcn_exp2f(p1[r] - m); ps += p0[r] + p1[r]; }
    l += ps;
    pv(o, vb, packp(p0, 0), packp(p0, 8), packp(p1, 0), packp(p1, 8));
}

template<bool nomax>
DEVI void attn_unit(int b, int g, int qb, const bf16_t* Q, const bf16_t* KV, const bf16_t* KC, const bf16_t* VC, const float* gates, bf16_t* O, LAS char* shm) {
    const int tid = threadIdx.x, lane = tid & 63, r32 = lane & 31, hi = lane >> 5; const int wid = __builtin_amdgcn_readfirstlane(tid >> 6);
    const int tl = r32 >> 2, head = r32 & 3, tq0 = qb * 64, tq = tq0 + 8 * wid + tl, row = b * SEQ + tq, bg = b * 4 + g;
    const unsigned lds0 = (unsigned)(uintptr_t)shm;
    LAS float* wsf = (LAS float*)(shm + WSF) + wid * 64;
    const bf16_t* Ks = KV + 2 * KVS + (size_t)bg * SEQ * 64; const bf16_t* Vs = KV + 3 * KVS + (size_t)bg * SEQ * 64;
    const bf16_t* Kw = KV + 4 * KVS + (size_t)bg * SEQ * 64; const bf16_t* Vw = KV + 5 * KVS + (size_t)bg * SEQ * 64;
    const bf16_t* Kc = KC + (size_t)bg * 128 * 64; const bf16_t* Vc = VC + (size_t)bg * 128 * 64;
    const int koff = lane * 64 + wid * 8, voff = (16 * (wid & 3) + (lane >> 2)) * 64 + (wid >> 2) * 32 + (lane & 3) * 8;
#define ATT_DMA(Kt, Vt, slot) do { glds16((Kt) + koff, (unsigned)__builtin_amdgcn_readfirstlane(lds0 + KS0 + (slot) * 8192 + wid * 1024)); \
                                   glds16((Vt) + voff, (unsigned)__builtin_amdgcn_readfirstlane(lds0 + VS0 + (slot) * 8192 + wid * 1024)); } while (0)
#define ATT_WAITBAR() asm volatile("s_waitcnt vmcnt(0) lgkmcnt(0)\n\ts_barrier" ::: "memory")
    const int vb0 = (int)(lds0 + VS0) + ((lane >> 4) & 1) * 32 + (lane & 3) * 8 + (4 * hi + ((lane & 15) >> 2)) * 64;
    const lptr kslot0 = (lptr)(shm + KS0);
#ifdef ATT_TSEG
    unsigned long long tsa_ = __builtin_amdgcn_s_memrealtime(), tsb_ = 0, tsc_ = 0, tsd_ = 0, tsx_ = 0, tacc_ = 0;
#define TSB(k) do { if (ATT_TSEG == (k)) tsx_ = __builtin_amdgcn_s_memrealtime(); } while (0)
#define TSE(k) do { if (ATT_TSEG == (k)) tacc_ += __builtin_amdgcn_s_memrealtime() - tsx_; } while (0)
#else
#define TSB(k) do { } while (0)
#define TSE(k) do { } while (0)
#endif
    ATT_WAITBAR();
    const int nC = (qb >= 16) ? 2 : 1;
    const int wlo = qb >= 8 ? qb - 8 : 0, nW = qb - wlo + 1;
    bf16x8 qr[4];
    { const bf16_t* qp = Q + (size_t)row * DM + (4 * g + head) * 64 + 8 * hi;
#pragma unroll
      for (int d0 = 0; d0 < 4; ++d0) qr[d0] = *(const bf16x8*)(qp + 16 * d0); }
    const float* gp = gates + (size_t)row * 48 + (g * 4 + head) * 3; const float gate_c = (PROBE == 4) ? 0.f : gp[0], gate_s = (PROBE == 5) ? 0.f : gp[1], gate_w = (PROBE == 6) ? 0.f : gp[2];
    ATT_DMA(Kc, Vc, 0); if (nC == 2) ATT_DMA(Kc + 64 * 64, Vc + 64 * 64, 1);
    ATT_DMA(Kw + (size_t)wlo * 4096, Vw + (size_t)wlo * 4096, 2);
    f32x16 o[2];
    LAS float* ofl = (LAS float*)(shm + OFN) + wid * 2048;
#pragma unroll
    for (int r = 0; r < 16; ++r) { ofl[crow(r, hi) * 64 + r32] = 0.f; ofl[crow(r, hi) * 64 + 32 + r32] = 0.f; }
    unsigned selmask = (qb == 31) ? 0xffffffffu : ((2u << qb) - 1u);
    asm volatile("s_waitcnt vmcnt(2) lgkmcnt(0)\n\ts_barrier" ::: "memory");
#ifdef ATT_TSEG
    tsb_ = __builtin_amdgcn_s_memrealtime();
#endif
    {
        const int nmax = (tq - 31) >> 4;
        f32x16 pa0, pa1, pb0, pb1;
        qkt(pa0, pa1, kslot0, qr, 0.f, r32, hi);
        if (nC == 2) qkt(pb0, pb1, kslot0 + 8192, qr, 0.f, r32, hi);
#pragma unroll
        for (int r = 0; r < 16; ++r) { const int n0 = crow(r, hi); if (n0 > nmax) pa0[r] = -INFINITY; if (n0 + 32 > nmax) pa1[r] = -INFINITY; }
        float m = rowmax(pa0, pa1), ps = 0.f;
        if (nC == 2) {
#pragma unroll
            for (int r = 0; r < 16; ++r) { const int n0 = crow(r, hi); if (n0 + 64 > nmax) pb0[r] = -INFINITY; if (n0 + 96 > nmax) pb1[r] = -INFINITY; }
            m = fmaxf(m, rowmax(pb0, pb1)); }
        if (m == -INFINITY) m = 0.f;
#pragma unroll
        for (int r = 0; r < 16; ++r) { pa0[r] = __builtin_amdgcn_exp2f(pa0[r] - m); pa1[r] = __builtin_amdgcn_exp2f(pa1[r] - m); ps += pa0[r] + pa1[r]; }
        if (nC == 2) {
#pragma unroll
            for (int r = 0; r < 16; ++r) { pb0[r] = __builtin_amdgcn_exp2f(pb0[r] - m); pb1[r] = __builtin_amdgcn_exp2f(pb1[r] - m); ps += pb0[r] + pb1[r]; } }
        ps += xlane32(ps);
        const float inv = ps > 0.f ? __builtin_amdgcn_rcpf(ps) : 0.f;
#pragma unroll
        for (int r = 0; r < 16; ++r) { o[0][r] = 0.f; o[1][r] = 0.f; }
        pv(o, vb0, packp(pa0, 0), packp(pa0, 8), packp(pa1, 0), packp(pa1, 8));
        if (nC == 2) pv(o, vb0 + 8192, packp(pb0, 0), packp(pb0, 8), packp(pb1, 0), packp(pb1, 8));
        fold_rows(o, ofl, wsf, gate_c * inv, r32, hi);
        if (qb >= 16) {
#define ATT_QSUM(x) do { float t_ = (x) * inv; t_ += __builtin_bit_cast(float, __builtin_amdgcn_update_dpp(0, __builtin_bit_cast(int, t_), 0xB1, 0xf, 0xf, false)); \
                         t_ += __builtin_bit_cast(float, __builtin_amdgcn_update_dpp(0, __builtin_bit_cast(int, t_), 0x4E, 0xf, 0xf, false)); (x) = t_; } while (0)
#pragma unroll
            for (int r = 0; r < 16; ++r) { ATT_QSUM(pa0[r]); ATT_QSUM(pa1[r]); ATT_QSUM(pb0[r]); ATT_QSUM(pb1[r]); }
#undef ATT_QSUM
            float sc[16], fo[16];
#define ATT_H4(h4, r) ((h4) == 0 ? pa0[r] : (h4) == 1 ? pa1[r] : (h4) == 2 ? pb0[r] : pb1[r])
#pragma unroll
            for (int h4 = 0; h4 < 4; ++h4)
#pragma unroll
                for (int gq = 0; gq < 4; ++gq) fo[h4 * 4 + gq] = xlane32(ATT_H4(h4, 4 * gq));
#pragma unroll
            for (int h4 = 0; h4 < 4; ++h4)
#pragma unroll
                for (int gq = 0; gq < 4; ++gq) {
                    const int s = h4 * 4 + gq;
                    const float nxt_lo = fo[s];
                    const float nxt_hi = (s < 15) ? fo[s + 1] : 0.f;
                    float v = ATT_H4(h4, 4 * gq) + 2.0f * (ATT_H4(h4, 4 * gq + 1) + ATT_H4(h4, 4 * gq + 2) + ATT_H4(h4, 4 * gq + 3)) + (hi ? nxt_hi : nxt_lo);
                    const int j = 8 * h4 + 2 * gq + hi;
                    if (j == 0 || j == qb || j == qb - 1) v = INFINITY; else if (j > qb) v = -INFINITY;
                    sc[s] = v; }
#undef ATT_H4
            float so[16];
#pragma unroll
            for (int s = 0; s < 16; ++s) so[s] = xlane32(sc[s]);
            float x4[4];
#pragma unroll
            for (int i = 0; i < 4; ++i) x4[i] = (head == 0) ? sc[4 * i] : (head == 1) ? sc[4 * i + 1] : (head == 2) ? sc[4 * i + 2] : sc[4 * i + 3];
            unsigned own = 0u;
#pragma unroll
            for (int i = 0; i < 4; ++i) {
                int rk = 0; const float xv = x4[i];
#pragma unroll
                for (int s2 = 0; s2 < 16; ++s2) {
                    const int g2 = s2 >> 2, q2 = s2 & 3;
                    if (g2 < i) { rk += (sc[s2] >= xv) ? 1 : 0; rk += (so[s2] >= xv) ? 1 : 0; }
                    else if (g2 > i) { rk += (sc[s2] > xv) ? 1 : 0; rk += (so[s2] > xv) ? 1 : 0; }
                    else { const bool lt = q2 < head, eq = q2 == head;
                        rk += eq ? 0 : (lt ? ((sc[s2] >= xv) ? 1 : 0) : ((sc[s2] > xv) ? 1 : 0));
                        rk += (lt || (eq && hi)) ? ((so[s2] >= xv) ? 1 : 0) : ((so[s2] > xv) ? 1 : 0); }
                }
                if (rk < 16) own |= 1u << (8 * i);
            }
            own <<= 2 * head;
            own |= (unsigned)__builtin_amdgcn_update_dpp(0, (int)own, 0xB1, 0xf, 0xf, false);
            own |= (unsigned)__builtin_amdgcn_update_dpp(0, (int)own, 0x4E, 0xf, 0xf, false);
            own <<= hi;
            selmask = own | (unsigned)__shfl_xor((int)own, 32);
        }
    }
    unsigned uni = selmask, wuni = selmask;
    if (qb >= 16) {
#pragma unroll
        for (int off = 1; off < 64; off <<= 1) uni |= (unsigned)__shfl_xor((int)uni, off);
        wuni = (unsigned)__builtin_amdgcn_readfirstlane((int)uni);
        LAS unsigned* uw = (LAS unsigned*)(shm + UNI);
        if (lane == 0) uw[wid] = uni;
        ATT_WAITBAR();
        uni = 0u;
#pragma unroll
        for (int w = 0; w < 8; ++w) uni |= uw[w];
        uni = (unsigned)__builtin_amdgcn_readfirstlane((int)uni);
    } else { ATT_WAITBAR(); }
    uni = (unsigned)__builtin_amdgcn_readfirstlane((int)uni); wuni = (unsigned)__builtin_amdgcn_readfirstlane((int)wuni);
#ifdef ATT_TSEG
    tsc_ = __builtin_amdgcn_s_memrealtime();
#endif
    const unsigned smask = uni & ((qb == 31) ? 0xffffffffu : ((2u << qb) - 1u));
    const int nS = __builtin_popcount(smask), nT = nW + nS;
    unsigned rem_issue = smask, rem_qk = smask;
#define ATT_ISSUE(tt) do { const int sl_ = ((tt) + 2) % 3; \
        if ((tt) < nW) { const int j_ = wlo + (tt); ATT_DMA(Kw + (size_t)j_ * 4096, Vw + (size_t)j_ * 4096, sl_); } \
        else { const int j_ = __builtin_ctz(rem_issue); rem_issue &= rem_issue - 1u; ATT_DMA(Ks + (size_t)j_ * 4096, Vs + (size_t)j_ * 4096, sl_); } } while (0)
    if (nT > 1) ATT_ISSUE(1);
    ATT_WAITBAR();
    if (nT > 2) ATT_ISSUE(2);
    float mref = 0.f, l = 0.f;
#pragma unroll
    for (int r = 0; r < 16; ++r) { o[0][r] = 0.f; o[1][r] = 0.f; }
    f32x16 pc0, pc1, negm;
#pragma unroll
    for (int r = 0; r < 16; ++r) negm[r] = 0.f;
    qk2(pc0, pc1, kslot0 + 2 * 8192, qr, negm, r32, hi);
    int jc = wlo; bool cS = false, cskip = false;
    f32x16 pd0, pd1;
#define ATT_STEP(t, pc0, pc1, pn0, pn1) do { \
        const bool hasn = t + 1 < nT; int jn = 0; bool nSel = false, nskip = true; \
        if (hasn) { if (t + 1 < nW) { jn = wlo + t + 1; nskip = false; } else { jn = __builtin_ctz(rem_qk); rem_qk &= rem_qk - 1u; nSel = true; nskip = ((wuni >> jn) & 1u) == 0u; } } \
        TSB(4); if (t > 0) { ATT_WAITBAR(); if (t + 2 < nT) ATT_ISSUE(t + 2); } TSE(4); \
        TSB(5); if (!nskip) { \
            const float nm = (nSel && ((selmask >> jn) & 1u) == 0u) ? -INFINITY : -mref; \
_Pragma("unroll") \
            for (int r = 0; r < 16; ++r) negm[r] = nm; \
            qk2(pn0, pn1, kslot0 + ((t + 3) % 3) * 8192, qr, negm, r32, hi); \
        } \
        TSE(5); if (!cskip) { TSB(6); \
            const bool dm = cS ? (jc == qb) : ((jc == qb) || (jc + 8 == qb)); \
            if (dm) { const int lo = cS ? 0 : tq - 511, kbase = 64 * jc; \
_Pragma("unroll") \
                for (int r = 0; r < 16; ++r) { const int kp = kbase + crow(r, hi); if (kp < lo || kp > tq) pc0[r] = -INFINITY; if (kp + 32 < lo || kp + 32 > tq) pc1[r] = -INFINITY; } } \
            const float rm = nomax ? 0.f : rowmax3(pc0, pc1); \
            if (!nomax && __builtin_amdgcn_ballot_w64(rm > 8.0f) != 0ull) { \
                const float dl = fmaxf(rm, 0.f), f = __builtin_amdgcn_exp2f(-dl); mref += dl; l *= f; \
_Pragma("unroll") \
                for (int r = 0; r < 16; ++r) { pc0[r] -= dl; pc1[r] -= dl; } \
                if (!nskip) { \
_Pragma("unroll") \
                    for (int r = 0; r < 16; ++r) { pn0[r] -= dl; pn1[r] -= dl; } } \
                scale_rows(o, wsf, f, r32, hi); \
            } \
            TSE(6); TSB(7); float ps = 0.f; \
_Pragma("unroll") \
            for (int r = 0; r < 16; ++r) { pc0[r] = __builtin_amdgcn_exp2f(pc0[r]); pc1[r] = __builtin_amdgcn_exp2f(pc1[r]); ps = (ps + pc0[r]) + pc1[r]; } \
            l += ps; TSE(7); TSB(8); \
            pv(o, vb0 + ((t + 2) % 3) * 8192, packp(pc0, 0), packp(pc0, 8), packp(pc1, 0), packp(pc1, 8)); TSE(8); \
        } \
        if (t + 1 == nW) { \
            l += xlane32(l); fold_rows(o, ofl, wsf, gate_w * (l > 0.f ? __builtin_amdgcn_rcpf(l) : 0.f), r32, hi); \
_Pragma("unroll") \
            for (int r = 0; r < 16; ++r) { o[0][r] = 0.f; o[1][r] = 0.f; } \
            l = 0.f; } \
        jc = jn; cS = nSel; cskip = nskip; } while (0)
    for (int t = 0; t < nT; t += 2) {
        ATT_STEP(t, pc0, pc1, pd0, pd1);
        if (t + 1 >= nT) break;
        ATT_STEP(t + 1, pd0, pd1, pc0, pc1);
    }
#undef ATT_STEP
#undef ATT_ISSUE
    l += xlane32(l); fold_rows(o, ofl, wsf, gate_s * (l > 0.f ? __builtin_amdgcn_rcpf(l) : 0.f), r32, hi);
#ifdef ATT_TSEG
    tsd_ = __builtin_amdgcn_s_memrealtime();
    { const unsigned long long seg_ = (ATT_TSEG >= 4) ? tacc_ : (ATT_TSEG == 1) ? (tsb_ - tsa_) : (ATT_TSEG == 2) ? (tsc_ - tsb_) : (tsd_ - tsc_);
      LAS unsigned* tw_ = (LAS unsigned*)(shm + UNI + 64) + wid; if (lane == 0) tw_[0] += (unsigned)seg_; }
#endif
    {
#pragma unroll
      for (int i = 0; i < 4; ++i) { const int q = i * 8 + (lane >> 3), chn = lane & 7; const f32x4 v0 = *(const LAS f32x4*)(ofl + q * 64 + chn * 8), v1 = *(const LAS f32x4*)(ofl + q * 64 + chn * 8 + 4);
          u32x4 v; v.x = pk2(v0[0], v0[1]); v.y = pk2(v0[2], v0[3]); v.z = pk2(v1[0], v1[1]); v.w = pk2(v1[2], v1[3]);
          *(u32x4*)(O + (size_t)(b * SEQ + tq0 + 8 * wid + (q >> 2)) * DM + (4 * g + (q & 3)) * 64 + chn * 8) = v; }
      LDS_WAIT(); }
#undef ATT_DMA
#undef ATT_WAITBAR
}
DEVI void attn_phase(const Frame& F, const Args& args) {
    const bf16_t* Q = (const bf16_t*)(F.ws + WS_Q); const bf16_t* KV = (const bf16_t*)(F.ws + WS_KV); const bf16_t* KC = (const bf16_t*)(F.ws + WS_KC); const bf16_t* VC = (const bf16_t*)(F.ws + WS_VC);
    const float* gates = (const float*)(F.ws + WS_GATES); bf16_t* O = (bf16_t*)(F.ws + WS_O);
#if PROBE == 1
    { u32x4* z = (u32x4*)O; for (size_t i = (size_t)F.vcu * 512 + F.tid; i < (size_t)NTOK * DM / 8; i += (size_t)F.G * 512) z[i] = (u32x4){0u, 0u, 0u, 0u}; return; }
#endif
#ifdef ATT_TSEG
    { LAS unsigned* tw_ = (LAS unsigned*)(F.lds + RING_OFF + UNI + 64); if (F.tid < 8) tw_[F.tid] = 0u; asm volatile("s_waitcnt lgkmcnt(0)\n\ts_barrier" ::: "memory"); }
#endif
    bool nomax;
    { const float* qn = args.in[15]; const float* kn = args.in[16];
      float gq = fabsf(qn[F.lane]), gk = fmaxf(fabsf(kn[64 + F.lane]), fabsf(kn[128 + F.lane]));
#pragma unroll
      for (int off = 1; off < 64; off <<= 1) { gq = fmaxf(gq, __shfl_xor(gq, off)); gk = fmaxf(gk, __shfl_xor(gk, off)); }
      const float bound = 11.5416f * gq * gk;
      nomax = __builtin_amdgcn_readfirstlane((bound <= 40.0f) ? 1 : 0) != 0; }
    for (int i = 0;; ++i) {
        const int idx = (i / ATT_REP) * F.G + F.vcu; if (idx >= 2048) break;
        const int ii = idx >> 8, bgq = idx & 255, bg = bgq >> 2, qt = bgq & 3;
        const int qbc = (ii & 1) ? (8 * (ii >> 1) + 7 - qt) : (8 * (ii >> 1) + qt);
        if (nomax) attn_unit<true>(bg >> 2, bg & 3, qbc, Q, KV, KC, VC, gates, O, (LAS char*)(F.lds + RING_OFF));
        else attn_unit<false>(bg >> 2, bg & 3, qbc, Q, KV, KC, VC, gates, O, (LAS char*)(F.lds + RING_OFF));
        const int qb = qbc;
        (void)qb;
    }
    asm volatile("s_waitcnt vmcnt(0) lgkmcnt(0)\n\ts_barrier" ::: "memory");
#ifdef ATT_TSEG
    { LAS unsigned* tw_ = (LAS unsigned*)(F.lds + RING_OFF + UNI + 64); const unsigned long long d_ = (unsigned long long)tw_[0] * 3ull; const unsigned long long t1_ = __builtin_amdgcn_s_memrealtime();
      while (__builtin_amdgcn_s_memrealtime() - t1_ < d_) __builtin_amdgcn_s_sleep(8); }
#endif
}
}

#ifndef PH_MASK
#define PH_MASK 0xffffffffu
#endif
#ifndef REP_MASK
#define REP_MASK 0u
#endif
#define PH(k) (((PH_MASK) >> (k)) & 1u)
#define REPB(k) (((REP_MASK) >> (k)) & 1u)
#define GRID_BAR() xcd_barrier(bar)
#define REFRESH() do { int t_ = threadIdx.x; asm volatile("" : "+v"(t_)); F.tid = t_; F.lane = t_ & 63; F.wave = __builtin_amdgcn_readfirstlane(t_ >> 6); } while (0)
template <int K, int L>
DEVI void phase(Frame& F, const Args& args, int nblk) {
    unsigned char* ws = args.ws;
    LAS unsigned char* ring = F.lds + RING_OFF;
    bf16_t* const HA = (bf16_t*)(ws + WS_HA); bf16_t* const HB = (bf16_t*)(ws + WS_HB);
    bf16_t* const hin = (L == 0) ? HA : HB;
    bf16_t* const hmx = (L == 0) ? HB : HA;
    REFRESH();
    if constexpr (K == 0) p0_prologue(F, args);
    if constexpr (K == 2) { ProbPw1 P; P.A = (const char*)HA; P.Bt = (const char*)(ws + WS_WPW1); P.K = DM; P.ldb = 2048; P.G = F.G; P.c = F.vcu;
          P.rstd = (const float*)(ws + WS_RS0); P.bias = args.in[7]; P.U = (bf16_t*)(ws + WS_U);
          pg8::gemm_phase(ring, P); }
    if constexpr (K == 3) {
        if (F.vcu & 1) { prep_layer(F, args, 0); wg_sync(); conv_phase(F, args); }
        else { conv_phase(F, args); wg_sync(); prep_layer(F, args, 0); } }
    if constexpr (K == 4) { ProbRes P; P.A = (const char*)(ws + WS_V); P.Bt = (const char*)(ws + WS_WPW2); P.K = DM; P.ldb = 2048; P.G = F.G; P.c = F.vcu;
          P.RES = HA; P.OUT = HB; P.bias = args.in[13];
          pg8::gemm_phase(ring, P); }
    if constexpr (K == 5) { ProbWin P; P.A = (const char*)HB; P.Bt = (const char*)(ws + WS_WIN); P.K = DM; P.ldb = 2048; P.G = F.G; P.c = F.vcu;
          P.rstd = (const float*)(ws + WS_SSQ); P.rope = (const float*)(ws + WS_ROPE); P.qnorm = args.in[15]; P.knorm = args.in[16];
          P.Q = (bf16_t*)(ws + WS_Q); P.KV = (bf16_t*)(ws + WS_KV); P.gates = (float*)(ws + WS_GATES);
          { LAS float* lr = (LAS float*)(F.lds + SCR_OFF);
            for (int idx = F.tid; idx < 8 * 256; idx += 512) { const int Lq = (idx >> 8) * F.G + F.vcu;
                if (Lq < 128 * 11) { const f32x4* pp = (const f32x4*)(P.rstd + (size_t)((Lq / 11) * 256 + (idx & 255)) * 16); const f32x4 st = (pp[0] + pp[1]) + (pp[2] + pp[3]);
                    lr[idx] = 1.0f / sqrtf(((st[0] + st[1]) + (st[2] + st[3])) * (1.0f / DM) + EPS); } }
            wg_sync(); P.lrs = lr; }
          pg8::gemm_phase(ring, P); }
    if constexpr (K == 6) { ProbCmp P; P.A = (const char*)(ws + WS_KV); P.Bt = (const char*)(ws + WS_WC1); P.K = 512; P.ldb = 4096; P.G = F.G; P.c = F.vcu;
          P.CP = (float*)(ws + WS_CP);
          pg8::gemm_phase(ring, P); }
    if constexpr (K == 7) cmpb_phase(F, args);
    if constexpr (K == 8) {
        if (F.vcu & 1) { prep_layer(F, args, 1); wg_sync(); REFRESH(); }
        att::attn_phase(F, args);
        if (!(F.vcu & 1)) { REFRESH(); prep_layer(F, args, 1); } }
    if constexpr (K == 9) { ProbRes P; P.A = (const char*)(ws + WS_O); P.Bt = (const char*)(ws + WS_WOUT); P.K = DM; P.ldb = 2048; P.G = F.G; P.c = F.vcu;
          P.RES = HB; P.OUT = HA; P.bias = nullptr;
          pg8::gemm_phase(ring, P); }
    if constexpr (K == 11) router_phase(F, args, L, hmx);
    if constexpr (K == 12) fill_phase(F);
    if constexpr (K == 13) { ProbGateUp P; P.A = (const char*)hmx; P.Bt = (const char*)(ws + WS_WGU); P.K = DM; P.ldb = 2048; P.G = F.G; P.c = F.vcu;
          P.tab_row = (const LAS int*)(F.lds + TAB_OFF); P.tab_ev = P.tab_row + 320; P.nblk = nblk;
          P.slot_rs = (const float*)(ws + WS_SRS); P.HBUF = (bf16_t*)(ws + WS_HBUF);
          { LAS unsigned* go = (LAS unsigned*)(F.lds + SCR_OFF); const int* stok = (const int*)(ws + WS_STOK);
            for (int idx = F.tid; idx < 8 * 256; idx += 512) { const int Lq = (idx >> 8) * F.G + F.vcu; if (Lq < nblk * 4) go[idx] = (unsigned)stok[P.tab_row[Lq >> 2] + (idx & 255)] * 2048u; }
            wg_sync(); P.goff = go; }
          pg8::gemm_phase(ring, P);
          ProbPP Q2; Q2.A = (const char*)(ws + WS_PB); Q2.Bt = (const char*)(ws + WS_WPP) + (size_t)L * DM * PLE * 2; Q2.K = PLE; Q2.ldb = 512; Q2.G = F.G; Q2.c = F.vcu;
          Q2.O = (bf16_t*)(ws + WS_PP);
          { const int nun = nblk * 4, maxu = (nun + F.G - 1) / F.G; int tl = nun - (maxu - 1) * F.G; if (tl >= F.G || tl < 0) tl = 0; Q2.tail_lo = tl; }
          pg8::gemm_phase(ring, Q2); }
    if constexpr (K == 14) { ProbDown P; P.A = (const char*)(ws + WS_HBUF); P.Bt = (const char*)(ws + WS_WDN); P.K = DEXP; P.ldb = 1024; P.G = F.G; P.c = F.vcu;
          P.tab_row = (const LAS int*)(F.lds + TAB_OFF); P.tab_ev = P.tab_row + 320; P.nblk = nblk;
          P.slot_w = (const float*)(ws + WS_SW); P.YB = (bf16_t*)(ws + WS_YB);
          pg8::gemm_phase(ring, P); }
    if constexpr (K == 15) combine_phase(F, hmx, hin, (PROBE == 2 && L == 1) || (PROBE == 3 && L == 0));
#ifdef STAGGER_US
    if constexpr (K == STAGGER_PH) { if (F.vcu & 1) { const unsigned long long t0_ = __builtin_amdgcn_s_memrealtime(); while (__builtin_amdgcn_s_memrealtime() - t0_ < (unsigned long long)(STAGGER_US) * 100ull) __builtin_amdgcn_s_sleep(8); } }
#endif
    if constexpr (K == 16) { ProbPle P; P.A = (const char*)hin; P.Bt = (const char*)(ws + WS_WPG) + (size_t)L * DM * DM * 2; P.K = DM; P.ldb = 2048; P.G = F.G; P.c = F.vcu;
          P.H2 = hin; P.PPp = (const bf16_t*)(ws + WS_PP); P.rstd = (const float*)(ws + WS_RS2); P.OUTB = hmx; P.OUTF = args.out; P.ssq = (float*)(ws + WS_SSQ); P.last = L;
          pg8::gemm_phase(ring, P); }
}
#if defined(TPHASE)
#define PHASE(k) do { const bool tp_ = ((k) == TPHASE) && (L == TLAYER); const unsigned long long t0_ = tp_ ? __builtin_amdgcn_s_memrealtime() : 0ull; \
    if (PH(k)) phase<k, L>(F, args, nblk); \
    if (tp_) { asm volatile("s_waitcnt vmcnt(0) lgkmcnt(0)" ::: "memory"); const unsigned long long t1_ = __builtin_amdgcn_s_memrealtime(); const unsigned long long d_ = (t1_ - t0_) * TALPHA; \
        while (__builtin_amdgcn_s_memrealtime() - t1_ < d_) __builtin_amdgcn_s_sleep(8); } } while (0)
#else
#define PHASE(k) do { if (PH(k)) phase<k, L>(F, args, nblk); if (PH(k) && REPB(k)) phase<k, L>(F, args, nblk); } while (0)
#endif
template <int L>
DEVI void layer_program(Frame& F, const Args& args, const XcdBarrier& bar) {
    int nblk = 0;
    if (L == 0) {
        PHASE(2); GRID_BAR();
        PHASE(3); GRID_BAR();
        PHASE(4);
    } else {
        PHASE(5); GRID_BAR();
        PHASE(6); GRID_BAR();
        PHASE(7); GRID_BAR();
        PHASE(8); GRID_BAR();
        PHASE(9);
    }
    GRID_BAR();
    PHASE(11); GRID_BAR();
    PHASE(12); GRID_BAR();
    REFRESH(); nblk = build_moe_table(F);
    PHASE(13); GRID_BAR();
    PHASE(14); GRID_BAR();
    PHASE(15); GRID_BAR();
    PHASE(16);
    if (L == 0) GRID_BAR();
}
__global__ void __launch_bounds__(NWAVES * 64, 2) hybrid_fwd(Args args) {
    extern __shared__ __attribute__((aligned(16))) unsigned char lds[];
    Frame F;
    F.lds = (LAS unsigned char*)lds; F.ws = args.ws; F.ctl = (gu32*)(args.ws + WS_CTL);
    F.tid = threadIdx.x; F.lane = F.tid & 63; F.wave = __builtin_amdgcn_readfirstlane(F.tid >> 6);
    F.G = gridDim.x; { const int bx = blockIdx.x; F.vcu = (F.G % 8 == 0) ? (bx % 8) * (F.G / 8) + bx / 8 : bx; }
    for (int u = F.tid; u < (LDS_BYTES - LDSCTL_OFF) / 4; u += NWAVES * 64) ((LAS unsigned*)(F.lds + LDSCTL_OFF))[u] = 0u;
    __syncthreads();
    XcdBarrier bar = xcd_barrier_post((unsigned*)(F.ctl + CW_BAR), (volatile LAS unsigned*)(F.lds + MISC_OFF) + 8);
    { constexpr int L = 0; const int nblk = 0; PHASE(0); }
    GRID_BAR();
#ifdef EXTRA_BARS
    GRID_BAR(); GRID_BAR(); GRID_BAR(); GRID_BAR(); GRID_BAR(); GRID_BAR(); GRID_BAR(); GRID_BAR(); GRID_BAR(); GRID_BAR();
#endif
    layer_program<0>(F, args, bar);
    layer_program<1>(F, args, bar);
}
#undef GRID_BAR

extern "C" void kernel_launch(void* const* d_in, const int* in_sizes, int n_in, void* d_out, int out_size, void* d_ws, size_t ws_size, hipStream_t stream) {
    static int grid = 0;
    if (grid == 0) {
        if (n_in != 30 || out_size != NTOK * DM || ws_size < WS_END) { fprintf(stderr, "kernel_launch: unexpected shapes (n_in %d, out %d, ws %zu < %zu)\n", n_in, out_size, ws_size, (size_t)WS_END); grid = -1; return; }
        int dev = 0, cus = 0, per_cu = 0;
        if (hipGetDevice(&dev) != hipSuccess || hipDeviceGetAttribute(&cus, hipDeviceAttributeMultiprocessorCount, dev) != hipSuccess) { grid = -1; return; }
        if (hipFuncSetAttribute((const void*)hybrid_fwd, hipFuncAttributeMaxDynamicSharedMemorySize, LDS_BYTES) != hipSuccess) { fprintf(stderr, "kernel_launch: hipFuncSetAttribute failed\n"); grid = -1; return; }
        if (hipOccupancyMaxActiveBlocksPerMultiprocessor(&per_cu, (const void*)hybrid_fwd, NWAVES * 64, LDS_BYTES) != hipSuccess || per_cu < 1)
            fprintf(stderr, "kernel_launch: occupancy query reports %d workgroups per CU\n", per_cu);
        (void)hipGetLastError();
        grid = cus;
    }
    if (grid < 0) return;
    if (hipMemsetAsync((char*)d_ws + WS_CTL, 0, CTL_ZERO_BYTES, stream) != hipSuccess) return;
    Args a{};
    for (int i = 0; i < 30; ++i) a.in[i] = (const float*)d_in[i];
    a.out = (float*)d_out; a.ws = (unsigned char*)d_ws;
    for (int i = 0; i < 32; ++i) { const float p = powf(10000.0f, (float)i / 32.0f); a.inv_freq[i] = 1.0f / p; }
    hipLaunchKernelGGL(hybrid_fwd, dim3(grid), dim3(NWAVES * 64), LDS_BYTES, stream, a);
}
```

```cpp
#define PROBE 0
#define REP_MASK 0u
#include <hip/hip_runtime.h>
#include <hip/hip_bf16.h>
#include <cstdio>
#include <cstdint>
#include <cmath>

#ifndef PROBE
#define PROBE 0
#endif
#define DEVI __device__ __forceinline__
#define GAS __attribute__((address_space(1)))
#define LAS __attribute__((address_space(3)))
typedef unsigned short bf16_t;
typedef short bf16x8 __attribute__((ext_vector_type(8)));
typedef short s16x4 __attribute__((ext_vector_type(4)));
typedef float f32x2 __attribute__((ext_vector_type(2)));
typedef float f32x4 __attribute__((ext_vector_type(4)));
typedef float f32x16 __attribute__((ext_vector_type(16)));
typedef unsigned u32x2 __attribute__((ext_vector_type(2)));
typedef unsigned u32x4 __attribute__((ext_vector_type(4)));
typedef __bf16 bf16x2_t __attribute__((ext_vector_type(2)));
typedef GAS unsigned gu32;

#define LDS_WAIT() asm volatile("s_waitcnt lgkmcnt(0)" ::: "memory")
#define VM_WAIT() asm volatile("s_waitcnt vmcnt(0)" ::: "memory")
#define RLX_AGENT __ATOMIC_RELAXED, __HIP_MEMORY_SCOPE_AGENT

DEVI unsigned pk2(float lo, float hi) { f32x2 v = {lo, hi}; bf16x2_t b = __builtin_convertvector(v, bf16x2_t); return __builtin_bit_cast(unsigned, b); }
DEVI float bflo(unsigned u) { return __uint_as_float(u << 16); }
DEVI float bfhi(unsigned u) { return __uint_as_float(u & 0xffff0000u); }
DEVI f32x4 unpack4(u32x2 w) { return (f32x4){bflo(w.x), bfhi(w.x), bflo(w.y), bfhi(w.y)}; }
DEVI u32x2 pack4(f32x4 v) { u32x2 w; w.x = pk2(v[0], v[1]); w.y = pk2(v[2], v[3]); return w; }
DEVI float sigmoid_f(float x) { return __builtin_amdgcn_rcpf(1.0f + __expf(-x)); }
DEVI const char* sgpr_ptr(const char* p) { const unsigned long long u = (unsigned long long)p; const unsigned lo = (unsigned)__builtin_amdgcn_readfirstlane((int)(unsigned)u), hi = (unsigned)__builtin_amdgcn_readfirstlane((int)(unsigned)(u >> 32)); return (const char*)(((unsigned long long)hi << 32) | lo); }
DEVI float wave_sum(float v) {
#pragma unroll
    for (int o = 1; o < 64; o <<= 1) v += __shfl_xor(v, o);
    return v;
}

namespace pg8 {
constexpr int BM = 256, BK = 64, HALF = 128, HTB = HALF * BK * 2  , STAGE_BYTES = 8 * HTB;
DEVI int lds_byte(int r, int c) { const int st = (r >> 4) * 2 + (c >> 5), rr = r & 15, cc = c & 31, ob = rr * 64 + cc * 2; return st * 1024 + (ob ^ (((ob >> 9) & 1) << 5)); }
DEVI void stage_rc(int b, int& R, int& C) { const int st = b / 1024, sb = b % 1024, swz = sb ^ (((sb >> 9) & 1) << 5); R = (st >> 1) * 16 + swz / 64; C = (st & 1) * 32 + (swz % 64) / 2; }
struct Unit { int pm, pn, e, v; };

template <class P>
DEVI void gemm_phase(LAS unsigned char* lds, const P& S) {
    int tid = threadIdx.x; asm volatile("" : "+v"(tid));
    const int wid = __builtin_amdgcn_readfirstlane(tid >> 6), lane = tid & 63, wr = wid >> 2, wc = wid & 3, fr = lane & 15, fq = lane >> 4;
    const int nt = S.K / BK;
    int Rp[2], Cp[2]; unsigned voffB[2];
#pragma unroll
    for (int i = 0; i < 2; ++i) { stage_rc(tid * 16 + i * 8192, Rp[i], Cp[i]); voffB[i] = (unsigned)Rp[i] * S.ldb + (unsigned)Cp[i] * 2u; }
    const size_t hstepB = (size_t)HALF * S.ldb;
    const unsigned ldsw = (unsigned)wid * 1024u;
    const int aoff = lds_byte(wr * 64 + fr, fq * 8), boff = lds_byte(wc * 32 + fr, fq * 8);
    const char* const Abase = S.A;
#define PG8_SA(b, h) (((b) * 2 + (h)) * HTB)
#define PG8_SB(b, h) ((4 + (b) * 2 + (h)) * HTB)
#define PG8_STAGE_A(bufoff, ao, sp) do { _Pragma("unroll") for (int _i = 0; _i < 2; ++_i) \
        __builtin_amdgcn_global_load_lds((const unsigned*)((sp) + (ao)[_i]), (LAS unsigned*)(lds + (bufoff) + ldsw + _i * 8192), 16, 0, 0); } while (0)
#define PG8_PIN(p) do { (p) = sgpr_ptr(p); asm volatile("" : "+s"(p)); } while (0)
#define PG8_STAGE_B(bufoff, bp) do { _Pragma("unroll") for (int _i = 0; _i < 2; ++_i) \
        __builtin_amdgcn_global_load_lds((const unsigned*)((bp) + voffB[_i]), (LAS unsigned*)(lds + (bufoff) + ldsw + _i * 8192), 16, 0, 0); } while (0)
#define PG8_LDA(dst, b, h) do { _Pragma("unroll") for (int m = 0; m < 4; ++m) _Pragma("unroll") for (int k = 0; k < 2; ++k) dst[m][k] = *(const LAS bf16x8*)(lds + PG8_SA(b, h) + aoff + m * 2048 + k * 1024); } while (0)
#define PG8_LDB(dst, b, h) do { _Pragma("unroll") for (int n = 0; n < 2; ++n) _Pragma("unroll") for (int k = 0; k < 2; ++k) dst[n][k] = *(const LAS bf16x8*)(lds + PG8_SB(b, h) + boff + n * 2048 + k * 1024); } while (0)
#define PG8_MMA(ai, bj, At, Bt) do { __builtin_amdgcn_s_setprio(1); _Pragma("unroll") for (int m = 0; m < 4; ++m) _Pragma("unroll") for (int n = 0; n < 2; ++n) _Pragma("unroll") for (int k = 0; k < 2; ++k) \
        acc[ai][bj][m][n] = __builtin_amdgcn_mfma_f32_16x16x32_bf16(Bt[n][k], At[m][k], acc[ai][bj][m][n], 0, 0, 0); __builtin_amdgcn_s_setprio(0); } while (0)
#define PG8_WAIT_V(n) asm volatile("s_waitcnt vmcnt(" #n ")" ::: "memory")
#define PG8_WAIT_L(n) asm volatile("s_waitcnt lgkmcnt(" #n ")" ::: "memory")
#define PG8_BAR __builtin_amdgcn_s_barrier()
#define PG8_SCHED __builtin_amdgcn_sched_barrier(0)
    Unit cur, nxt; int ui = 0;
    if (!S.next(0, cur)) return;
    f32x4 acc[2][2][4][2];
#pragma unroll
    for (int a = 0; a < 2; ++a)
#pragma unroll
        for (int b = 0; b < 2; ++b)
#pragma unroll
            for (int m = 0; m < 4; ++m)
#pragma unroll
                for (int n = 0; n < 2; ++n) acc[a][b][m][n] = (f32x4){0.f, 0.f, 0.f, 0.f};
    bf16x8 At[4][2], B0[2][2], B1[2][2];
    unsigned ac0[2], ac1[2], an0[2], an1[2];
#pragma unroll
    for (int i = 0; i < 2; ++i) { ac0[i] = S.a_off(cur, Rp[i]) + (unsigned)Cp[i] * 2u; ac1[i] = S.a_off(cur, Rp[i] + HALF) + (unsigned)Cp[i] * 2u; }
    const char* cB = S.Bt + S.b_off(cur);
    { const char* q0 = cB; const char* q1 = cB + hstepB; const char* q2 = Abase; const char* q3 = cB + 128; const char* q4 = Abase + 128; const char* q5 = cB + hstepB + 128;
      PG8_PIN(q0); PG8_PIN(q1); PG8_PIN(q2); PG8_PIN(q3); PG8_PIN(q4); PG8_PIN(q5);
    PG8_STAGE_B(PG8_SB(0, 0), q0); PG8_STAGE_B(PG8_SB(0, 1), q1); PG8_STAGE_A(PG8_SA(0, 0), ac0, q2); PG8_STAGE_A(PG8_SA(0, 1), ac1, q2);
    if (wr == 1) PG8_BAR;
    PG8_WAIT_V(2); PG8_BAR;
    PG8_STAGE_B(PG8_SB(1, 0), q3); PG8_STAGE_A(PG8_SA(1, 0), ac0, q4); PG8_STAGE_B(PG8_SB(1, 1), q5);
    PG8_WAIT_V(6); PG8_BAR; }
    for (;;) {
        const bool has_next = S.next(ui + 1, nxt);
        const char* nB = cB;
        if (has_next) {
#pragma unroll
            for (int i = 0; i < 2; ++i) { an0[i] = S.a_off(nxt, Rp[i]) + (unsigned)Cp[i] * 2u; an1[i] = S.a_off(nxt, Rp[i] + HALF) + (unsigned)Cp[i] * 2u; }
            nB = S.Bt + S.b_off(nxt);
        } else {
#pragma unroll
            for (int i = 0; i < 2; ++i) { an0[i] = ac0[i]; an1[i] = ac1[i]; }
        }
        for (int t = 0; t < nt; t += 2) {
            const bool last = (t == nt - 2);
            unsigned a20[2], a21[2];
#pragma unroll
            for (int i = 0; i < 2; ++i) { a20[i] = last ? an0[i] : ac0[i]; a21[i] = last ? an1[i] : ac1[i]; }
            const int k1 = (t + 1) * 128, k2 = last ? 0 : (t + 2) * 128;
            const char* b2 = last ? nB : cB + (size_t)(t + 2) * 128; const char* b3 = b2 + 128; const char* b2h = b2 + hstepB; const char* b3h = b3 + hstepB;
            const char* pa1 = Abase + k1; const char* pa2 = Abase + k2; const char* pa3 = pa2 + 128;
            PG8_PIN(b2); PG8_PIN(b3); PG8_PIN(b2h); PG8_PIN(b3h); PG8_PIN(pa1); PG8_PIN(pa2); PG8_PIN(pa3);
            PG8_LDB(B0, 0, 0); PG8_LDB(B1, 0, 1); PG8_SCHED; PG8_LDA(At, 0, 0); PG8_STAGE_A(PG8_SA(1, 1), ac1, pa1);
            PG8_WAIT_V(8); PG8_WAIT_L(0); PG8_BAR; PG8_MMA(0, 0, At, B0); PG8_MMA(0, 1, At, B1); PG8_BAR; PG8_SCHED;
            PG8_LDA(At, 0, 1); PG8_STAGE_B(PG8_SB(0, 0), b2); PG8_STAGE_B(PG8_SB(0, 1), b2h); PG8_STAGE_A(PG8_SA(0, 0), a20, pa2);
            PG8_WAIT_V(8); PG8_WAIT_L(0); PG8_BAR; PG8_MMA(1, 0, At, B0); PG8_MMA(1, 1, At, B1); PG8_BAR; PG8_SCHED;
            PG8_LDB(B0, 1, 0); PG8_LDB(B1, 1, 1); PG8_SCHED; PG8_LDA(At, 1, 0); PG8_STAGE_A(PG8_SA(0, 1), a21, pa2);
            PG8_WAIT_V(8); PG8_WAIT_L(0); PG8_BAR; PG8_MMA(0, 0, At, B0); PG8_MMA(0, 1, At, B1); PG8_BAR; PG8_SCHED;
            PG8_LDA(At, 1, 1); PG8_STAGE_B(PG8_SB(1, 0), b3); PG8_STAGE_B(PG8_SB(1, 1), b3h); PG8_STAGE_A(PG8_SA(1, 0), a20, pa3);
            PG8_WAIT_V(8); PG8_WAIT_L(0); PG8_BAR; PG8_MMA(1, 0, At, B0); PG8_MMA(1, 1, At, B1); PG8_BAR; PG8_SCHED;
        }
        if (wr == 0) PG8_BAR;
        S.epi(acc, cur, wr, wc, fr, fq);
        if (!has_next) break;
#pragma unroll
        for (int a = 0; a < 2; ++a)
#pragma unroll
            for (int b = 0; b < 2; ++b)
#pragma unroll
                for (int m = 0; m < 4; ++m)
#pragma unroll
                    for (int n = 0; n < 2; ++n) acc[a][b][m][n] = (f32x4){0.f, 0.f, 0.f, 0.f};
        cur = nxt; cB = nB; ++ui;
#pragma unroll
        for (int i = 0; i < 2; ++i) { ac0[i] = an0[i]; ac1[i] = an1[i]; }
        if (wr == 1) PG8_BAR;
    }
    PG8_WAIT_V(0);
    PG8_BAR;
#undef PG8_SA
#undef PG8_SB
#undef PG8_STAGE_A
#undef PG8_STAGE_B
#undef PG8_PIN
#undef PG8_LDA
#undef PG8_LDB
#undef PG8_MMA
#undef PG8_WAIT_V
#undef PG8_WAIT_L
#undef PG8_BAR
#undef PG8_SCHED
}
}
#define XB_TMO      128
#define XB_XCNT(j)  (256  + 64 * (j))
#define XB_XSUB(j)  (1280 + 64 * (j))
#define XB_XGEN(j)  (2304 + 64 * (j))
#define XB_TOP      3328
#define XB_TOPGEN   3392
#define XCD_BAR_WORDS 3456
#define XB_SPIN_CAP (1u << 18)

__device__ __forceinline__ unsigned xb_ld(unsigned* p)              { return __hip_atomic_load(p, __ATOMIC_RELAXED, __HIP_MEMORY_SCOPE_AGENT); }
__device__ __forceinline__ unsigned xb_add(unsigned* p, unsigned v) { return __hip_atomic_fetch_add(p, v, __ATOMIC_RELAXED, __HIP_MEMORY_SCOPE_AGENT); }
__device__ __forceinline__ unsigned xb_xcc_id() { return (unsigned)__builtin_amdgcn_s_getreg((3 << 11) | 20) & 0xFu; }
#define XB_SPIN(cond, bar) do { unsigned _sp = 0; while (cond) { __builtin_amdgcn_s_sleep(1); \
    if ((++_sp & 255u) == 0u) { if (xb_ld(&(bar)[XB_TMO])) break; if (_sp > XB_SPIN_CAP) { atomicAdd(&(bar)[XB_TMO], 1u); break; } } } } while (0)

struct XcdBarrier {
    unsigned* bar; unsigned x;
    volatile LAS unsigned* st;
};

__device__ __forceinline__ XcdBarrier xcd_barrier_post(unsigned* bar, volatile LAS unsigned* st) {
    XcdBarrier b; b.bar = bar; b.x = xb_xcc_id(); b.st = st;
    if (threadIdx.x == 0) (void)xb_add(&bar[XB_XCNT(b.x)], 1u);
    return b;
}
__device__ __forceinline__ void xcd_barrier_complete(unsigned* bar, unsigned x, unsigned& nloc, unsigned& nx) {
    const unsigned G = gridDim.x * gridDim.y * gridDim.z;
    unsigned sum, cnt, mine, sp = 0u;
    for (;;) {
        sum = 0u; cnt = 0u; mine = 0u;
#pragma unroll
        for (unsigned j = 0; j < 16; ++j) { const unsigned c = xb_ld(&bar[XB_XCNT(j)]); sum += c; cnt += (c > 0u) ? 1u : 0u; mine = (j == x) ? c : mine; }
        if (sum == G) break;
        __builtin_amdgcn_s_sleep(1);
        if ((++sp & 255u) == 0u) { if (xb_ld(&bar[XB_TMO])) break; if (sp > XB_SPIN_CAP) { atomicAdd(&bar[XB_TMO], 1u); break; } }
    }
    nloc = mine > 0u ? mine : 1u; nx = cnt > 0u ? cnt : 1u;
}

__device__ __forceinline__ void xcd_barrier(const XcdBarrier& b) {
    asm volatile("s_waitcnt vmcnt(0)" ::: "memory");
    __syncthreads();
    if (threadIdx.x == 0) {
        unsigned* bar = b.bar;
        __builtin_amdgcn_s_waitcnt(0);
        unsigned nloc = b.st[0], nx = b.st[1];
        if (nloc == 0u) { xcd_barrier_complete(bar, b.x, nloc, nx); b.st[0] = nloc; b.st[1] = nx; }
        const unsigned old = xb_add(&bar[XB_XSUB(b.x)], 1u);
        const unsigned gen = old / nloc;
        if (old + 1u == (gen + 1u) * nloc) {
            __builtin_amdgcn_fence(__ATOMIC_RELEASE, "agent");
            asm volatile("s_waitcnt vmcnt(0)" ::: "memory");
            const unsigned og = xb_add(&bar[XB_TOP], 1u);
            const unsigned tg = og / nx;
            if (og + 1u == (tg + 1u) * nx) xb_add(&bar[XB_TOPGEN], 1u);
            else XB_SPIN(xb_ld(&bar[XB_TOPGEN]) == tg, bar);
            __builtin_amdgcn_fence(__ATOMIC_ACQUIRE, "agent");
            xb_add(&bar[XB_XGEN(b.x)], 1u);
            asm volatile("s_waitcnt vmcnt(0)" ::: "memory");
        } else {
            XB_SPIN(xb_ld(&bar[XB_XGEN(b.x)]) == gen, bar);
            __builtin_amdgcn_fence(__ATOMIC_ACQUIRE, "agent");
            asm volatile("s_waitcnt vmcnt(0)" ::: "memory");
        }
    }
    __syncthreads();
}

constexpr int NTOK = 32768, DM = 1024, SEQ = 2048, NBATCH = 16, NEXP = 32, DEXP = 512, PLE = 256;
constexpr int NWIN = 2608, NWIN_PAD = 2816;
constexpr float EPS = 1e-6f;
constexpr float C2 = 0.125f * 1.4426950408889634f;
constexpr int NWAVES = 8;

constexpr size_t MiB = 1u << 20;
constexpr size_t WS_CTL = 0, CTL_ZERO_BYTES = 1 * MiB;
constexpr int CW_TMO = 0, CW_BAR = 4096;
constexpr size_t WS_RS0 = 1 * MiB;
constexpr size_t WS_RS1 = WS_RS0 + 131072;
constexpr size_t WS_RS2 = WS_RS1 + 131072;
constexpr size_t WS_ASGE = WS_RS2 + 131072;
constexpr size_t WS_ASGR = WS_ASGE + 262144;
constexpr size_t WS_ASGW = WS_ASGR + 262144;
constexpr size_t WS_TSLOT = WS_ASGW + 262144;
constexpr int NSLOT = 2 * NTOK, NSLOT_PAD = NSLOT + 256;
constexpr size_t WS_STOK = WS_TSLOT + 262144;
constexpr size_t WS_SW = WS_STOK + 266240;
constexpr size_t WS_SRS = WS_SW + 266240;
constexpr size_t WS_CNT = WS_SRS + 266240;
constexpr size_t WS_MTOT = WS_CNT + 32768;
constexpr size_t WS_CBP = WS_MTOT + 1024;
constexpr size_t WS_RW = WS_CBP + 65536;
constexpr size_t WS_CB = WS_RW + 393216;
constexpr size_t WS_W2T = WS_CB + 2048;
constexpr size_t WS_SSQ = 4 * MiB;
constexpr size_t WS_ROPE = 6 * MiB;
static_assert(WS_W2T + 2 * 64 * 256 * 2 <= WS_SSQ, "tables");
constexpr size_t WS_WPW1 = 16 * MiB, WS_WPW2 = 20 * MiB, WS_WIN = 22 * MiB, WS_WOUT = 28 * MiB, WS_WC1 = 30 * MiB, WS_WPP = 32 * MiB, WS_WPG = 33 * MiB;
constexpr size_t WS_WGU = 40 * MiB, WS_WDN = 104 * MiB;
constexpr size_t WS_HA = 136 * MiB, WS_HB = 200 * MiB, WS_PP = 264 * MiB, WS_PB = 328 * MiB;
constexpr size_t WS_YB = 344 * MiB, WS_HBUF = 473 * MiB;
constexpr size_t WS_U = 344 * MiB, WS_V = 408 * MiB;
constexpr size_t WS_Q = WS_PP, WS_KV = 344 * MiB, WS_O = 440 * MiB, WS_CP = WS_HA  , WS_GATES = 504 * MiB, WS_KC = 510 * MiB, WS_VC = 511 * MiB;
constexpr size_t WS_END = 538 * MiB;
constexpr size_t KVS = (size_t)NTOK * 256;

constexpr int RING_OFF = 0, RING_BYTES = 131072;
constexpr int LDSCTL_OFF = RING_BYTES;
constexpr int MISC_OFF = LDSCTL_OFF + 320;
constexpr int TAB_OFF = LDSCTL_OFF + 1024;
constexpr int SCR_OFF = LDSCTL_OFF + 4096;
constexpr int LDS_BYTES = 147456;

struct Args { const float* in[30]; float* out; unsigned char* ws; float inv_freq[32]; };
struct Frame {
    LAS unsigned char* lds;
    gu32* ctl;
    unsigned char* ws;
    int tid, lane, wave, vcu, G;
};
DEVI void wg_sync() { __syncthreads(); }

DEVI int perm32(int r) { return (r & ~31) | (((r >> 2) & 1) << 4) | (((r >> 3) & 3) << 2) | (r & 3); }
DEVI int rowmap(int mode, int half, int n) {
    if (mode == 0) return perm32(n);
    if (mode == 1) return perm32(256 * (n >> 7) + 128 * half + (n & 127));
    if (n < 2560) { const int hd = n >> 6, d = n & 63; return perm32(256 * (hd >> 2) + 128 * (d >> 5) + 32 * (hd & 3) + (d & 31)); }
    return perm32(n);
}
DEVI u32x4 pack8(const f32x4& a, const f32x4& b) { const u32x2 x = pack4(a), y = pack4(b); return (u32x4){x.x, x.y, y.x, y.y}; }
DEVI void p0_item(const float* W, int ld, int ncols, int K, const float* gain, bf16_t* dst, int mode, int half, LAS unsigned char* scr, int item, int lane) {
    const int nblk = (ncols + 63) >> 6, kb = item / nblk, nb = item % nblk, k0 = 64 * kb, n0 = 64 * nb;
    const int lr = lane >> 4, lc = 4 * (lane & 15);
    f32x4 v[16];
#pragma unroll
    for (int i = 0; i < 16; ++i) v[i] = (n0 + lc < ncols) ? *(const f32x4*)(W + (size_t)(k0 + 4 * i + lr) * ld + n0 + lc) : (f32x4){0.f, 0.f, 0.f, 0.f};
#pragma unroll
    for (int i = 0; i < 16; ++i) { const float g = gain ? gain[k0 + 4 * i + lr] : 1.0f; const f32x4 x = v[i] * g; *(LAS u32x2*)(scr + (4 * i + lr) * 136 + lc * 2) = pack4(x); }
    LDS_WAIT();
    const int c = lane & 7;
#pragma unroll
    for (int j = 0; j < 8; ++j) { const int n = (lane >> 3) + 8 * j; const LAS unsigned short* t = (const LAS unsigned short*)(scr + (8 * c) * 136 + n * 2);
        u32x4 o; o.x = (unsigned)t[0 * 68] | ((unsigned)t[1 * 68] << 16); o.y = (unsigned)t[2 * 68] | ((unsigned)t[3 * 68] << 16); o.z = (unsigned)t[4 * 68] | ((unsigned)t[5 * 68] << 16); o.w = (unsigned)t[6 * 68] | ((unsigned)t[7 * 68] << 16);
        if (n0 + n < ncols) *(u32x4*)(dst + (size_t)rowmap(mode, half, n0 + n) * K + k0 + 8 * c) = o; }
    LDS_WAIT();
}
DEVI void p0_load(f32x4 (&v)[16], const float* W, int ld, int ncols, int item, int lane) {
    const int nblk = (ncols + 63) >> 6, kb = item / nblk, nb = item % nblk, k0 = 64 * kb, n0 = 64 * nb, lr = lane >> 4, lc = 4 * (lane & 15);
#pragma unroll
    for (int i = 0; i < 16; ++i) v[i] = (n0 + lc < ncols) ? *(const f32x4*)(W + (size_t)(k0 + 4 * i + lr) * ld + n0 + lc) : (f32x4){0.f, 0.f, 0.f, 0.f};
}
DEVI void p0_finish(const f32x4 (&v)[16], int ncols, int K, const float* gain, bf16_t* dst, int mode, int half, LAS unsigned char* scr, int item, int lane) {
    const int nblk = (ncols + 63) >> 6, kb = item / nblk, nb = item % nblk, k0 = 64 * kb, n0 = 64 * nb, lr = lane >> 4, lc = 4 * (lane & 15);
#pragma unroll
    for (int i = 0; i < 16; ++i) { const float g = gain ? gain[k0 + 4 * i + lr] : 1.0f; const f32x4 x = v[i] * g; *(LAS u32x2*)(scr + (4 * i + lr) * 136 + lc * 2) = pack4(x); }
    LDS_WAIT();
    const int c = lane & 7;
#pragma unroll
    for (int j = 0; j < 8; ++j) { const int n = (lane >> 3) + 8 * j; const LAS unsigned short* t = (const LAS unsigned short*)(scr + (8 * c) * 136 + n * 2);
        u32x4 o; o.x = (unsigned)t[0 * 68] | ((unsigned)t[1 * 68] << 16); o.y = (unsigned)t[2 * 68] | ((unsigned)t[3 * 68] << 16); o.z = (unsigned)t[4 * 68] | ((unsigned)t[5 * 68] << 16); o.w = (unsigned)t[6 * 68] | ((unsigned)t[7 * 68] << 16);
        if (n0 + n < ncols) *(u32x4*)(dst + (size_t)rowmap(mode, half, n0 + n) * K + k0 + 8 * c) = o; }
    LDS_WAIT();
}
DEVI void prep_layer(const Frame& F, const Args& a, int L) {
    LAS unsigned char* scr = F.lds + RING_OFF + F.wave * 16384;
    const int gw = F.vcu * NWAVES + F.wave, NGW = F.G * NWAVES;
    const float* gf = a.in[4] + (size_t)L * DM;
    bf16_t* wgu = (bf16_t*)(F.ws + WS_WGU); bf16_t* wdn = (bf16_t*)(F.ws + WS_WDN);
#define PREP_SRC(it_) ((((it_) % 384) >> 7) == 0 ? a.in[25] + ((size_t)L * NEXP + (it_) / 384) * DM * DEXP : (((it_) % 384) >> 7) == 1 ? a.in[26] + ((size_t)L * NEXP + (it_) / 384) * DM * DEXP : a.in[27] + ((size_t)L * NEXP + (it_) / 384) * DEXP * DM)
    f32x4 vc[16], vn[16];
    int it = gw;
    if (it < NEXP * 384) { const int wh = (it % 384) >> 7; p0_load(vc, PREP_SRC(it), wh == 2 ? DM : DEXP, wh == 2 ? DM : DEXP, it & 127, F.lane); }
    for (; it < NEXP * 384; it += NGW) {
        const int itn = it + NGW;
        if (itn < NEXP * 384) { const int wh = (itn % 384) >> 7; p0_load(vn, PREP_SRC(itn), wh == 2 ? DM : DEXP, wh == 2 ? DM : DEXP, itn & 127, F.lane); }
        { const int e = it / 384, wh = (it % 384) >> 7, item = it & 127;
          if (wh == 2) p0_finish(vc, DM, DEXP, nullptr, wdn + (size_t)e * 1024 * 512, 0, 0, scr, item, F.lane);
          else p0_finish(vc, DEXP, DM, gf, wgu + (size_t)e * 1024 * 1024, 1, wh, scr, item, F.lane); }
#pragma unroll
        for (int i = 0; i < 16; ++i) vc[i] = vn[i];
    }
#undef PREP_SRC
    const float* p = a.in[1] + (size_t)L * NTOK * PLE; bf16_t* pb = (bf16_t*)(F.ws + WS_PB);
    const size_t n8 = (size_t)NTOK * PLE / 8;
#pragma unroll 4
    for (size_t i = (size_t)F.vcu * 512 + F.tid; i < n8; i += (size_t)F.G * 512) {
        const f32x4 v0 = *(const f32x4*)(p + i * 8), v1 = *(const f32x4*)(p + i * 8 + 4);
        u32x4 o; o.x = pk2(v0[0], v0[1]); o.y = pk2(v0[2], v0[3]); o.z = pk2(v1[0], v1[1]); o.w = pk2(v1[2], v1[3]);
        *(u32x4*)(pb + i * 8) = o; }
}
DEVI void p0_prologue(const Frame& F, const Args& a) {
    LAS unsigned char* scr = F.lds + RING_OFF + F.wave * 16384;
    const int gw = F.vcu * NWAVES + F.wave, NGW = F.G * NWAVES;
    unsigned char* ws = F.ws;
    constexpr int I_PW1 = 16 * 16 * 2, I_PW2 = 16 * 16, I_WIN = 16 * 41, I_WOUT = 16 * 16, I_C1 = 32 * 4 * 2, I_PP = 4 * 16 * 2, I_PG = 16 * 16 * 2;
    constexpr int NIT = I_PW1 + I_PW2 + I_WIN + I_WOUT + I_C1 + I_PP + I_PG;
    for (int it = gw; it < NIT; it += NGW) {
        int r = it;
        if (r < I_PW1) { const int half = r / 256; p0_item(a.in[6] + half * 1024, 2048, 1024, DM, a.in[3], (bf16_t*)(ws + WS_WPW1), 1, half, scr, r % 256, F.lane); continue; } r -= I_PW1;
        if (r < I_PW2) { p0_item(a.in[12], DM, DM, DM, nullptr, (bf16_t*)(ws + WS_WPW2), 0, 0, scr, r, F.lane); continue; } r -= I_PW2;
        if (r < I_WIN) { p0_item(a.in[14], NWIN, NWIN, DM, a.in[3] + DM, (bf16_t*)(ws + WS_WIN), 2, 0, scr, r, F.lane); continue; } r -= I_WIN;
        if (r < I_WOUT) { p0_item(a.in[20], DM, DM, DM, nullptr, (bf16_t*)(ws + WS_WOUT), 0, 0, scr, r, F.lane); continue; } r -= I_WOUT;
        if (r < I_C1) { const int j = r / 128; p0_item(a.in[18] + (size_t)j * 2048 * 256, 256, 256, 2048, nullptr, (bf16_t*)(ws + WS_WC1) + (size_t)j * 256 * 2048, 0, 0, scr, r % 128, F.lane); continue; } r -= I_C1;
        if (r < I_PP) { const int L = r / 64; p0_item(a.in[28] + (size_t)L * PLE * DM, DM, DM, PLE, nullptr, (bf16_t*)(ws + WS_WPP) + (size_t)L * DM * PLE, 0, 0, scr, r % 64, F.lane); continue; } r -= I_PP;
        { const int L = r / 256; p0_item(a.in[29] + (size_t)L * DM * DM, DM, DM, DM, a.in[5] + (size_t)L * DM, (bf16_t*)(ws + WS_WPG) + (size_t)L * DM * DM, 0, 0, scr, r % 256, F.lane); }
    }
    { u32x4* z = (u32x4*)((bf16_t*)(ws + WS_WIN) + (size_t)2616 * DM); const int n16 = (NWIN_PAD - 2616) * DM / 8;
      for (int i = F.vcu * 512 + F.tid; i < n16; i += F.G * 512) z[i] = (u32x4){0u, 0u, 0u, 0u};
      u32x4* z2 = (u32x4*)((bf16_t*)(ws + WS_WIN) + (size_t)2600 * DM);
      for (int i = F.vcu * 512 + F.tid; i < 8 * DM / 8; i += F.G * 512) z2[i] = (u32x4){0u, 0u, 0u, 0u}; }
    { bf16_t* rw = (bf16_t*)(ws + WS_RW);
      for (int i = F.vcu * 512 + F.tid; i < 2 * 48 * 1024; i += F.G * 512) {
          const int L = i / (48 * 1024), j = (i / 1024) % 48, k = i & 1023;
          float w = 0.f;
          if (j < 4) w = a.in[21][((size_t)L * DM + k) * 4 + j]; else if (j < 36) w = a.in[23][((size_t)L * DM + k) * 32 + (j - 4)];
          w *= a.in[4][(size_t)L * DM + k];
          const unsigned hi = pk2(w, 0.f) & 0xffffu; const float lo = w - bflo(hi);
          rw[((size_t)(L * 2 + 0) * 48 + j) * 1024 + k] = (bf16_t)hi; rw[((size_t)(L * 2 + 1) * 48 + j) * 1024 + k] = (bf16_t)(pk2(lo, 0.f) & 0xffffu); } }
    { bf16_t* w2t = (bf16_t*)(ws + WS_W2T);
      for (int i = F.vcu * 512 + F.tid; i < 2 * 64 * 256; i += F.G * 512) { const int j = i >> 14, n = (i >> 8) & 63, k = i & 255; w2t[i] = (bf16_t)(pk2(a.in[19][(size_t)(j * 256 + k) * 64 + n], 0.f) & 0xffffu); } }
    for (int it = gw; it < 2 * 4 * 32; it += NGW) {
        const int j = it >> 7, cg = (it >> 5) & 3, kr = it & 31;
        const float* pe = a.in[17] + (size_t)j * 2048 + kr * 64; const float* w1 = a.in[18] + ((size_t)j * 2048 + kr * 64) * 256 + cg * 64 + F.lane;
        float s = 0.f;
#pragma unroll 16
        for (int k = 0; k < 64; ++k) s += pe[k] * w1[(size_t)k * 256];
        ((float*)(ws + WS_CBP))[(j * 32 + kr) * 256 + cg * 64 + F.lane] = s; }
    { float* rope = (float*)(ws + WS_ROPE); const int* pos = (const int*)a.in[2];
      for (int i = F.vcu * 512 + F.tid; i < NTOK * 32; i += F.G * 512) {
          const int row = i >> 5, fi = i & 31;
          const float ang = (float)pos[row] * a.inv_freq[fi];
          const double rev = (double)ang * 0.15915494309189533577; const float fr = (float)(rev - floor(rev));
          rope[(size_t)row * 64 + fi] = __builtin_amdgcn_cosf(fr); rope[(size_t)row * 64 + 32 + fi] = __builtin_amdgcn_sinf(fr); } }
    { const float* x = a.in[0]; bf16_t* ha = (bf16_t*)(ws + WS_HA); float* rs0 = (float*)(ws + WS_RS0);
      f32x4 va[4], vb[4], na[4], nb[4];
#define XR(m_, j_) (((const f32x4*)(x + (size_t)(m_) * DM) + F.lane)[64 * (j_)])
      if (gw < NTOK) {
#pragma unroll
          for (int j = 0; j < 4; ++j) { na[j] = XR(gw, j); nb[j] = (gw + NGW < NTOK) ? XR(gw + NGW, j) : (f32x4){0.f, 0.f, 0.f, 0.f}; } }
      for (int m = gw; m < NTOK; m += 2 * NGW) {
#pragma unroll
          for (int j = 0; j < 4; ++j) { va[j] = na[j]; vb[j] = nb[j]; }
          if (m + 2 * NGW < NTOK) {
#pragma unroll
              for (int j = 0; j < 4; ++j) { na[j] = XR(m + 2 * NGW, j); nb[j] = (m + 3 * NGW < NTOK) ? XR(m + 3 * NGW, j) : (f32x4){0.f, 0.f, 0.f, 0.f}; } }
          float sa = 0.f, sb = 0.f;
#pragma unroll
          for (int j = 0; j < 4; ++j) { sa += (va[j][0] * va[j][0] + va[j][1] * va[j][1]) + (va[j][2] * va[j][2] + va[j][3] * va[j][3]); sb += (vb[j][0] * vb[j][0] + vb[j][1] * vb[j][1]) + (vb[j][2] * vb[j][2] + vb[j][3] * vb[j][3]); }
          sa = wave_sum(sa); sb = wave_sum(sb);
          u32x2* oa = (u32x2*)(ha + (size_t)m * DM) + F.lane; u32x2* ob = (u32x2*)(ha + (size_t)(m + NGW) * DM) + F.lane;
#pragma unroll
          for (int j = 0; j < 4; ++j) { oa[64 * j] = pack4(va[j]); if (m + NGW < NTOK) ob[64 * j] = pack4(vb[j]); }
          if (F.lane == 0) { rs0[m] = 1.0f / sqrtf(sa * (1.0f / DM) + EPS); if (m + NGW < NTOK) rs0[m + NGW] = 1.0f / sqrtf(sb * (1.0f / DM) + EPS); } }
#undef XR
      }

}

using pg8::Unit;
typedef f32x4 AccT[2][2][4][2];
struct ProbBase { const char* A; const char* Bt; int K; unsigned ldb; int G, c; };

#define EPI_FENCE() asm volatile("" ::: "memory")
struct ProbPw1 : ProbBase {
    const float* __restrict__ rstd; const float* __restrict__ bias; bf16_t* __restrict__ U;
    DEVI bool next(int i, Unit& u) const { const int L = i * G + c; if (L >= 128 * 8) return false; u.pm = L >> 3; u.pn = L & 7; u.e = 0; u.v = 256; return true; }
    DEVI unsigned a_off(const Unit& u, int R) const { return (unsigned)(u.pm * 256 + R) * 2048u; }
    DEVI size_t b_off(const Unit& u) const { return (size_t)u.pn * 256 * ldb; }
    DEVI void epi(const AccT& acc, const Unit& u, int wr, int wc, int fr, int fq) const {
        const int q0 = 32 * wc + 8 * fq;
        f32x4 ba[2], bg[2]; float rs[2][4];
#pragma unroll
        for (int n = 0; n < 2; ++n) { ba[n] = *(const f32x4*)(bias + 128 * u.pn + q0 + 4 * n); bg[n] = *(const f32x4*)(bias + 1024 + 128 * u.pn + q0 + 4 * n); }
#pragma unroll
        for (int ai = 0; ai < 2; ++ai)
#pragma unroll
            for (int m = 0; m < 4; ++m) rs[ai][m] = rstd[u.pm * 256 + 128 * ai + 64 * wr + 16 * m + fr];
        EPI_FENCE();
#pragma unroll
        for (int ai = 0; ai < 2; ++ai)
#pragma unroll
            for (int m = 0; m < 4; ++m) {
                const int row = u.pm * 256 + 128 * ai + 64 * wr + 16 * m + fr;
                f32x4 o[2];
#pragma unroll
                for (int n = 0; n < 2; ++n) {
                    const f32x4 av = acc[ai][0][m][n] * rs[ai][m] + ba[n], gv = acc[ai][1][m][n] * rs[ai][m] + bg[n];
#pragma unroll
                    for (int j = 0; j < 4; ++j) o[n][j] = av[j] * sigmoid_f(gv[j]); }
                *(u32x4*)(U + (size_t)row * DM + 128 * u.pn + q0) = pack8(o[0], o[1]); }
    }
};
constexpr int PP_SPLIT = 288;
struct ProbPP : ProbBase {
    bf16_t* O; int tail_lo, base, cnt;
    DEVI bool next(int i, Unit& u) const { if (c < tail_lo) return false; int L = i * (G - tail_lo) + (c - tail_lo); if (L >= cnt) return false; L += base; u.pm = L >> 2; u.pn = L & 3; u.e = 0; u.v = 256; return true; }
    DEVI unsigned a_off(const Unit& u, int R) const { return (unsigned)(u.pm * 256 + R) * 512u; }
    DEVI size_t b_off(const Unit& u) const { return (size_t)u.pn * 256 * ldb; }
    DEVI void epi(const AccT& acc, const Unit& u, int wr, int wc, int fr, int fq) const {
#pragma unroll
        for (int ai = 0; ai < 2; ++ai)
#pragma unroll
            for (int m = 0; m < 4; ++m) {
                const int row = u.pm * 256 + 128 * ai + 64 * wr + 16 * m + fr;
#pragma unroll
                for (int bj = 0; bj < 2; ++bj) *(u32x4*)(O + (size_t)row * DM + 256 * u.pn + 128 * bj + 32 * wc + 8 * fq) = pack8(acc[ai][bj][m][0], acc[ai][bj][m][1]); }
    }
};
struct ProbRes : ProbBase {
    const bf16_t* __restrict__ RES; bf16_t* __restrict__ OUT; const float* __restrict__ bias;
    DEVI bool next(int i, Unit& u) const { const int L = i * G + c; if (L >= 128 * 4) return false; u.pm = L >> 2; u.pn = L & 3; u.e = 0; u.v = 256; return true; }
    DEVI unsigned a_off(const Unit& u, int R) const { return (unsigned)(u.pm * 256 + R) * 2048u; }
    DEVI size_t b_off(const Unit& u) const { return (size_t)u.pn * 256 * ldb; }
    DEVI void epi(const AccT& acc, const Unit& u, int wr, int wc, int fr, int fq) const {
        const int col0 = 256 * u.pn + 32 * wc + 8 * fq;
        f32x4 bv[2][2];
#pragma unroll
        for (int bj = 0; bj < 2; ++bj)
#pragma unroll
            for (int n = 0; n < 2; ++n) bv[bj][n] = bias ? *(const f32x4*)(bias + col0 + 128 * bj + 4 * n) : (f32x4){0.f, 0.f, 0.f, 0.f};
#ifdef EPI_REPS
        for (int rep_ = 0; rep_ < EPI_REPS; ++rep_)
#endif
#pragma unroll
        for (int ai = 0; ai < 2; ++ai) {
            u32x4 r[4][2];
#pragma unroll
            for (int m = 0; m < 4; ++m) { const size_t o = (size_t)(u.pm * 256 + 128 * ai + 64 * wr + 16 * m + fr) * DM + col0;
#pragma unroll
                for (int bj = 0; bj < 2; ++bj) r[m][bj] = *(const u32x4*)(RES + o + 128 * bj); }
            EPI_FENCE();
#pragma unroll
            for (int m = 0; m < 4; ++m) { const size_t o = (size_t)(u.pm * 256 + 128 * ai + 64 * wr + 16 * m + fr) * DM + col0;
#pragma unroll
                for (int bj = 0; bj < 2; ++bj) { const u32x4 rr = r[m][bj];
                    *(u32x4*)(OUT + o + 128 * bj) = pack8(unpack4((u32x2){rr.x, rr.y}) + acc[ai][bj][m][0] + bv[bj][0], unpack4((u32x2){rr.z, rr.w}) + acc[ai][bj][m][1] + bv[bj][1]); } }
            EPI_FENCE();
        }
    }
};
struct ProbPle : ProbBase {
    const bf16_t* __restrict__ H2; const bf16_t* __restrict__ PPp; const float* __restrict__ rstd; bf16_t* __restrict__ OUTB; float* __restrict__ OUTF; float* __restrict__ ssq; int last;
    DEVI bool next(int i, Unit& u) const { const int L = i * G + c; if (L >= 128 * 4) return false; u.pm = L >> 2; u.pn = L & 3; u.e = 0; u.v = 256; return true; }
    DEVI unsigned a_off(const Unit& u, int R) const { return (unsigned)(u.pm * 256 + R) * 2048u; }
    DEVI size_t b_off(const Unit& u) const { return (size_t)u.pn * 256 * ldb; }
    DEVI void epi(const AccT& acc, const Unit& u, int wr, int wc, int fr, int fq) const {
        const int col0 = 256 * u.pn + 32 * wc + 8 * fq;
#pragma unroll
        for (int ai = 0; ai < 2; ++ai) {
            u32x4 h[4][2], q[4][2]; float rs[4];
#pragma unroll
            for (int m = 0; m < 4; ++m) { const int row = u.pm * 256 + 128 * ai + 64 * wr + 16 * m + fr; const size_t o = (size_t)row * DM + col0; rs[m] = rstd[row];
#pragma unroll
                for (int bj = 0; bj < 2; ++bj) { h[m][bj] = *(const u32x4*)(H2 + o + 128 * bj); q[m][bj] = *(const u32x4*)(PPp + o + 128 * bj); } }
            EPI_FENCE();
#pragma unroll
            for (int m = 0; m < 4; ++m) { const int row = u.pm * 256 + 128 * ai + 64 * wr + 16 * m + fr; const size_t o = (size_t)row * DM + col0; float ss = 0.f;
#pragma unroll
                for (int bj = 0; bj < 2; ++bj) { f32x4 v[2];
#pragma unroll
                    for (int n = 0; n < 2; ++n) {
                        const f32x4 h2 = unpack4(n ? (u32x2){h[m][bj].z, h[m][bj].w} : (u32x2){h[m][bj].x, h[m][bj].y}), pp = unpack4(n ? (u32x2){q[m][bj].z, q[m][bj].w} : (u32x2){q[m][bj].x, q[m][bj].y}), a4 = acc[ai][bj][m][n] * rs[m];
#pragma unroll
                        for (int j = 0; j < 4; ++j) v[n][j] = h2[j] + sigmoid_f(a4[j]) * pp[j];
                        if (!last) ss += (v[n][0] * v[n][0] + v[n][1] * v[n][1]) + (v[n][2] * v[n][2] + v[n][3] * v[n][3]); }
                    if (last) { *(f32x4*)(OUTF + o + 128 * bj) = v[0]; *(f32x4*)(OUTF + o + 128 * bj + 4) = v[1]; }
                    else *(u32x4*)(OUTB + o + 128 * bj) = pack8(v[0], v[1]); }
                if (!last) { ss += __shfl_xor(ss, 16); ss += __shfl_xor(ss, 32); if (fq == 0) ssq[(size_t)row * 16 + u.pn * 4 + wc] = ss; } }
            EPI_FENCE();
        }
    }
};
struct ProbGateUp : ProbBase {
    const LAS int* tab_row; const LAS int* tab_ev; int nblk;
    const LAS unsigned* goff;
    const float* __restrict__ slot_rs; bf16_t* __restrict__ HBUF;
    DEVI bool next(int i, Unit& u) const { const int L = i * G + c; if (L >= nblk * 4) return false; const int b = L >> 2; u.pn = L & 3; u.pm = tab_row[b]; const int ev = tab_ev[b]; u.e = (ev >> 9) | (i << 8); u.v = ev & 511; return true; }
    DEVI unsigned a_off(const Unit& u, int R) const { return goff[(u.e >> 8) * 256 + R]; }
    DEVI size_t b_off(const Unit& u) const { return ((size_t)(u.e & 255) * 1024 + (size_t)u.pn * 256) * ldb; }
    DEVI void epi(const AccT& acc, const Unit& u, int wr, int wc, int fr, int fq) const {
        float rsv[2][4];
#pragma unroll
        for (int ai = 0; ai < 2; ++ai)
#pragma unroll
            for (int m = 0; m < 4; ++m) rsv[ai][m] = slot_rs[u.pm + 128 * ai + 64 * wr + 16 * m + fr];
        EPI_FENCE();
#pragma unroll
        for (int ai = 0; ai < 2; ++ai)
#pragma unroll
            for (int m = 0; m < 4; ++m) {
                const int R = 128 * ai + 64 * wr + 16 * m + fr;
                if (R < u.v) { const int slot = u.pm + R; const float rs = rsv[ai][m];
                    f32x4 o[2];
#pragma unroll
                    for (int n = 0; n < 2; ++n) { const f32x4 g = acc[ai][0][m][n] * rs, up = acc[ai][1][m][n] * rs;
#pragma unroll
                        for (int j = 0; j < 4; ++j) o[n][j] = g[j] * sigmoid_f(g[j]) * up[j]; }
                    *(u32x4*)(HBUF + (size_t)slot * DEXP + 128 * u.pn + 32 * wc + 8 * fq) = pack8(o[0], o[1]); } }
    }
};
struct ProbDown : ProbBase {
    const LAS int* tab_row; const LAS int* tab_ev; int nblk;
    const float* __restrict__ slot_w; bf16_t* __restrict__ YB;
    DEVI bool next(int i, Unit& u) const { const int L = i * G + c; if (L >= nblk * 4) return false; const int b = L >> 2; u.pn = L & 3; u.pm = tab_row[b]; const int ev = tab_ev[b]; u.e = ev >> 9; u.v = ev & 511; return true; }
    DEVI unsigned a_off(const Unit& u, int R) const { return (unsigned)(u.pm + R) * 1024u; }
    DEVI size_t b_off(const Unit& u) const { return ((size_t)u.e * 1024 + (size_t)u.pn * 256) * ldb; }
    DEVI void epi(const AccT& acc, const Unit& u, int wr, int wc, int fr, int fq) const {
        float wv[2][4];
#pragma unroll
        for (int ai = 0; ai < 2; ++ai)
#pragma unroll
            for (int m = 0; m < 4; ++m) wv[ai][m] = slot_w[u.pm + 128 * ai + 64 * wr + 16 * m + fr];
        EPI_FENCE();
#pragma unroll
        for (int ai = 0; ai < 2; ++ai)
#pragma unroll
            for (int m = 0; m < 4; ++m) {
                const int R = 128 * ai + 64 * wr + 16 * m + fr;
                if (R < u.v) { const int slot = u.pm + R; const float w = wv[ai][m];
#pragma unroll
                    for (int bj = 0; bj < 2; ++bj) *(u32x4*)(YB + (size_t)slot * DM + 256 * u.pn + 128 * bj + 32 * wc + 8 * fq) = pack8(acc[ai][bj][m][0] * w, acc[ai][bj][m][1] * w); } }
    }
};
struct ProbWin : ProbBase {
    const float* __restrict__ rstd; const float* __restrict__ rope; const float* __restrict__ qnorm; const float* __restrict__ knorm; bf16_t* __restrict__ Q; bf16_t* __restrict__ KV; float* __restrict__ gates;
    const LAS float* lrs;
    DEVI bool next(int i, Unit& u) const { const int L = i * G + c; if (L >= 128 * 11) return false; u.pm = L / 11; u.pn = L % 11; u.e = i; u.v = 256; return true; }
    DEVI unsigned a_off(const Unit& u, int R) const { return (unsigned)(u.pm * 256 + R) * 2048u; }
    DEVI size_t b_off(const Unit& u) const { return (size_t)u.pn * 256 * ldb; }
    DEVI void epi(const AccT& acc, const Unit& u, int wr, int wc, int fr, int fq) const {
        const int pn = u.pn;
        float rsv[2][4];
#pragma unroll
        for (int ai = 0; ai < 2; ++ai)
#pragma unroll
            for (int m = 0; m < 4; ++m) rsv[ai][m] = lrs[u.e * 256 + 128 * ai + 64 * wr + 16 * m + fr];
        if (pn == 10) {
            EPI_FENCE();
            if (wc < 2) {
#pragma unroll
                for (int ai = 0; ai < 2; ++ai)
#pragma unroll
                    for (int m = 0; m < 4; ++m) {
                        const int row = u.pm * 256 + 128 * ai + 64 * wr + 16 * m + fr; const float rs = rsv[ai][m];
#pragma unroll
                        for (int n = 0; n < 2; ++n) if (wc == 0 || fq < 2) { const f32x4 a4 = acc[ai][0][m][n] * rs; f32x4 o;
#pragma unroll
                            for (int j = 0; j < 4; ++j) o[j] = sigmoid_f(a4[j]);
                            *(f32x4*)(gates + (size_t)row * 48 + 32 * wc + 8 * fq + 4 * n) = o; } } }
            return;
        }
        const bool isq = pn < 4, dorope = isq || pn == 6 || pn == 8;
        const float* gvec = isq ? qnorm : (knorm + (pn == 6 ? 64 : 128));
        f32x4 g1[2], g2[2];
#pragma unroll
        for (int n = 0; n < 2; ++n) { g1[n] = *(const f32x4*)(gvec + 8 * fq + 4 * n); g2[n] = *(const f32x4*)(gvec + 32 + 8 * fq + 4 * n); }
        const float oscale = isq ? C2 : 1.0f;
#pragma unroll
        for (int g = 0; g < 8; ++g) { const int ai = g >> 2, m = g & 3;
            const int row = u.pm * 256 + 128 * ai + 64 * wr + 16 * m + fr; const float rs = rsv[ai][m];
            f32x4 cs[2], sn[2];
            if (dorope) { const size_t ro = (size_t)row * 64 + 8 * fq;
#pragma unroll
                for (int n = 0; n < 2; ++n) { cs[n] = *(const f32x4*)(rope + ro + 4 * n); sn[n] = *(const f32x4*)(rope + ro + 32 + 4 * n); } }
            f32x4 x1[2], x2[2];
#pragma unroll
            for (int n = 0; n < 2; ++n) { x1[n] = acc[ai][0][m][n] * rs; x2[n] = acc[ai][1][m][n] * rs; }
            if (dorope) {
                float ss = 0.f;
#pragma unroll
                for (int n = 0; n < 2; ++n)
#pragma unroll
                    for (int j = 0; j < 4; ++j) ss += x1[n][j] * x1[n][j] + x2[n][j] * x2[n][j];
                ss += __shfl_xor(ss, 16); ss += __shfl_xor(ss, 32);
                const float inv = 1.0f / sqrtf(ss * (1.0f / 64.0f) + EPS);
#pragma unroll
                for (int n = 0; n < 2; ++n) {
                    const f32x4 y1 = x1[n] * inv * g1[n], y2 = x2[n] * inv * g2[n];
                    x1[n] = (y1 * cs[n] - y2 * sn[n]) * oscale; x2[n] = (y2 * cs[n] + y1 * sn[n]) * oscale; } }
            bf16_t* dst;
            if (isq) dst = Q + (size_t)row * DM + (4 * pn + wc) * 64;
            else { const int b = row >> 11, t = row & 2047; dst = KV + (size_t)(pn - 4) * KVS + ((size_t)(b * 4 + wc) * SEQ + t) * 64; }
            *(u32x4*)(dst + 8 * fq) = pack8(x1[0], x1[1]); *(u32x4*)(dst + 32 + 8 * fq) = pack8(x2[0], x2[1]);
        }
    }
};
struct ProbCmp : ProbBase {
    float* CP;
    DEVI bool next(int i, Unit& u) const { const int L = i * G + c; if (L >= 256) return false; u.e = L >> 7; u.pm = (L >> 2) & 31; u.v = L & 3; u.pn = 0; return true; }
    DEVI unsigned a_off(const Unit& u, int R) const { return (unsigned)u.e * (unsigned)(KVS * 2) + (unsigned)(u.pm * 256 + R) * 2048u + (unsigned)u.v * 1024u; }
    DEVI size_t b_off(const Unit& u) const { return (size_t)u.e * 256 * ldb + (size_t)u.v * 1024; }
    DEVI void epi(const AccT& acc, const Unit& u, int wr, int wc, int fr, int fq) const {
        float* base = CP + ((size_t)(u.e * 4 + u.v) * 8192) * 256;
#pragma unroll
        for (int ai = 0; ai < 2; ++ai)
#pragma unroll
            for (int m = 0; m < 4; ++m) {
                const int rho = u.pm * 256 + 128 * ai + 64 * wr + 16 * m + fr;
#pragma unroll
                for (int bj = 0; bj < 2; ++bj)
#pragma unroll
                    for (int n = 0; n < 2; ++n) *(f32x4*)(base + (size_t)rho * 256 + 128 * bj + 32 * wc + 8 * fq + 4 * n) = acc[ai][bj][m][n]; }
    }
};

#define CONV_BAR() asm volatile("s_waitcnt lgkmcnt(0)\n\ts_barrier" ::: "memory")
DEVI void conv_phase(const Frame& F, const Args& a) {
    const bf16_t* U = (const bf16_t*)(F.ws + WS_U); bf16_t* V = (bf16_t*)(F.ws + WS_V);
    LAS float* red = (LAS float*)(F.lds + SCR_OFF);
    LAS float* fin = red + 256;
    const int tid = F.tid, c0 = 2 * tid;
    f32x2 w2[31];
#pragma unroll
    for (int k = 0; k < 31; ++k) w2[k] = *(const f32x2*)(a.in[8] + (size_t)k * DM + c0);
    const f32x2 bdw = *(const f32x2*)(a.in[9] + c0), lg = *(const f32x2*)(a.in[10] + c0), lb = *(const f32x2*)(a.in[11] + c0);
    for (int ch = F.vcu; ch < 256; ch += F.G) {
        const int tokbase = ch * 128, t0 = tokbase & (SEQ - 1);
        const unsigned* Up = (const unsigned*)U + (size_t)tokbase * 512 + tid;
        unsigned win[46];
#pragma unroll
        for (int i = 0; i < 46; ++i) { const int rel = i - 30; win[i] = (rel >= 0 || t0 != 0) ? Up[(ptrdiff_t)rel * 512] : 0u; }
#pragma unroll
        for (int s = 0; s < 8; ++s) {
            unsigned nxt[16];
            if (s < 7) {
#pragma unroll
                for (int i = 0; i < 16; ++i) nxt[i] = Up[(ptrdiff_t)(16 * (s + 1) + i) * 512]; }
            f32x2 y[16];
#pragma unroll
            for (int tt = 0; tt < 16; ++tt) y[tt] = bdw;
#pragma unroll
            for (int rr = 0; rr < 46; ++rr) {
                const f32x2 v = {bflo(win[rr]), bfhi(win[rr])};
#pragma unroll
                for (int tt = 0; tt < 16; ++tt) { const int k = rr - tt; if (k >= 0 && k <= 30) y[tt] += w2[k] * v; }
            }
            float v16[16];
            { const bool h5 = (F.lane & 32) != 0;
#pragma unroll
              for (int i = 0; i < 16; ++i) { const float sA = y[i][0] + y[i][1], sB = y[i][0] * y[i][0] + y[i][1] * y[i][1]; const float keep = h5 ? sB : sA, send = h5 ? sA : sB; v16[i] = keep + __shfl_xor(send, 32); } }
            float v8[8], v4[4], v2[2], v1r;
            { const bool h = (F.lane & 16) != 0;
#pragma unroll
              for (int i = 0; i < 8; ++i) { const float keep = h ? v16[i + 8] : v16[i], send = h ? v16[i] : v16[i + 8]; v8[i] = keep + __shfl_xor(send, 16); } }
            { const bool h = (F.lane & 8) != 0;
#pragma unroll
              for (int i = 0; i < 4; ++i) { const float keep = h ? v8[i + 4] : v8[i], send = h ? v8[i] : v8[i + 4]; v4[i] = keep + __shfl_xor(send, 8); } }
            { const bool h = (F.lane & 4) != 0;
#pragma unroll
              for (int i = 0; i < 2; ++i) { const float keep = h ? v4[i + 2] : v4[i], send = h ? v4[i] : v4[i + 2]; v2[i] = keep + __shfl_xor(send, 4); } }
            { const bool h = (F.lane & 2) != 0; const float keep = h ? v2[1] : v2[0], send = h ? v2[0] : v2[1]; v1r = keep + __shfl_xor(send, 2); }
            v1r += __shfl_xor(v1r, 1);
            CONV_BAR();
            if ((F.lane & 1) == 0) red[F.wave * 32 + (F.lane >> 1)] = v1r;
            CONV_BAR();
            if (tid < 16) { float t = 0.f, q = 0.f;
#pragma unroll
                for (int w = 0; w < 8; ++w) { t += red[w * 32 + tid]; q += red[w * 32 + 16 + tid]; }
                const float mean = t * (1.0f / DM), var = q * (1.0f / DM) - mean * mean;
                fin[tid] = mean; fin[16 + tid] = 1.0f / sqrtf(var + EPS); }
            CONV_BAR();
#pragma unroll
            for (int tt = 0; tt < 16; ++tt) {
                const float mean = fin[tt], rstd = fin[16 + tt];
                const float z0 = (y[tt][0] - mean) * rstd * lg[0] + lb[0], z1 = (y[tt][1] - mean) * rstd * lg[1] + lb[1];
                *(unsigned*)(V + (size_t)(tokbase + 16 * s + tt) * DM + c0) = pk2(z0 * sigmoid_f(z0), z1 * sigmoid_f(z1)); }
            if (s < 7) {
#pragma unroll
                for (int i = 0; i < 30; ++i) win[i] = win[i + 16];
#pragma unroll
                for (int i = 0; i < 16; ++i) win[30 + i] = nxt[i]; }
        }
    }
}
DEVI void router_phase(const Frame& F, const Args& a, int L, const bf16_t* H) {
    const bf16_t* rw = (const bf16_t*)(F.ws + WS_RW) + (size_t)(L * 2) * 48 * 1024;
    float* rs1 = (float*)(F.ws + WS_RS1); int* asg_e = (int*)(F.ws + WS_ASGE); int* asg_r = (int*)(F.ws + WS_ASGR); float* asg_w = (float*)(F.ws + WS_ASGW); int* cnt = (int*)(F.ws + WS_CNT);
    LAS unsigned char* wst = F.lds + RING_OFF;
    LAS float* lg = (LAS float*)(F.lds + RING_OFF + 65536) + F.wave * (16 * 48);
    LAS int* elist = (LAS int*)(F.lds + RING_OFF + 98304);
    LAS float* bias = (LAS float*)(F.lds + RING_OFF + 98304 + 1024);
    if (F.tid < 4) bias[F.tid] = a.in[22][L * 4 + F.tid]; else if (F.tid < 36) bias[F.tid] = a.in[24][L * 32 + F.tid - 4];
    const LAS float* brg = bias; const LAS float* bre = bias + 4;
    const int fr = F.lane & 15, fq = F.lane >> 4;
    for (int ch = F.vcu; ch < 256; ch += F.G) {
        const int tok0 = ch * 128 + F.wave * 16;
        f32x4 acc[3];
#pragma unroll
        for (int t = 0; t < 3; ++t) acc[t] = (f32x4){0.f, 0.f, 0.f, 0.f};
        float ss = 0.f;
        const bf16_t* hp = H + (size_t)(tok0 + fr) * DM + 8 * fq;
        for (int kc4 = 0; kc4 < 4; ++kc4) {
            const int kc = (kc4 + F.vcu) & 3;
            bf16x8 hf[8];
#pragma unroll
            for (int sl = 0; sl < 8; ++sl) hf[sl] = *(const bf16x8*)(hp + kc * 256 + 32 * sl);
            u32x4 wv[6];
#pragma unroll
            for (int i = 0; i < 6; ++i) { const int idx = F.tid + 512 * i, hl = idx / 1536, rem = idx % 1536, row = rem >> 5, c = rem & 31;
                wv[i] = *(const u32x4*)(rw + ((size_t)(hl * 48 + row)) * 1024 + kc * 256 + c * 8); }
            wg_sync();
#pragma unroll
            for (int i = 0; i < 6; ++i) { const int idx = F.tid + 512 * i, hl = idx / 1536, rem = idx % 1536, row = rem >> 5, c = rem & 31;
                *(LAS u32x4*)(wst + hl * 25344 + row * 528 + c * 16) = wv[i]; }
            wg_sync();
#pragma unroll
            for (int sl = 0; sl < 8; ++sl) {
#pragma unroll
                for (int t = 0; t < 3; ++t) {
                    const bf16x8 wh = *(const LAS bf16x8*)(wst + (16 * t + fr) * 528 + (32 * sl + 8 * fq) * 2), wl = *(const LAS bf16x8*)(wst + 25344 + (16 * t + fr) * 528 + (32 * sl + 8 * fq) * 2);
                    acc[t] = __builtin_amdgcn_mfma_f32_16x16x32_bf16(wh, hf[sl], acc[t], 0, 0, 0);
                    acc[t] = __builtin_amdgcn_mfma_f32_16x16x32_bf16(wl, hf[sl], acc[t], 0, 0, 0); }
                const u32x4 hu = __builtin_bit_cast(u32x4, hf[sl]);
#pragma unroll
                for (int j = 0; j < 4; ++j) { const float x0 = bflo(hu[j]), x1 = bfhi(hu[j]); ss += x0 * x0 + x1 * x1; }
            }
        }
        ss += __shfl_xor(ss, 16); ss += __shfl_xor(ss, 32);
        const float rs = 1.0f / sqrtf(ss * (1.0f / DM) + EPS);
        if (fq == 0) rs1[tok0 + fr] = rs;
#pragma unroll
        for (int t = 0; t < 3; ++t)
#pragma unroll
            for (int r = 0; r < 4; ++r) lg[fr * 48 + 16 * t + 4 * fq + r] = acc[t][r] * rs;
        LDS_WAIT();
        if (F.lane < 16) {
            const LAS float* my = lg + F.lane * 48;
            float g[4]; int gi = 0; float gm;
#pragma unroll
            for (int j = 0; j < 4; ++j) g[j] = my[j] + brg[j];
            gm = g[0];
#pragma unroll
            for (int j = 1; j < 4; ++j) if (g[j] > gm) { gm = g[j]; gi = j; }
            float den = 0.f;
#pragma unroll
            for (int j = 0; j < 4; ++j) den += __expf(g[j] - gm);
            const float pg = 1.0f / den;
            float v1 = -INFINITY, v2 = -INFINITY; int i1 = 0, i2 = 0;
            for (int j = 0; j < 8; ++j) { const float v = my[4 + gi * 8 + j] + bre[gi * 8 + j];
                if (v > v1) { v2 = v1; i2 = i1; v1 = v; i1 = j; } else if (v > v2) { v2 = v; i2 = j; } }
            const float e2 = __expf(v2 - v1), wa = pg / (1.0f + e2), wb = pg * e2 / (1.0f + e2);
            const int tl = F.wave * 16 + F.lane;
            elist[2 * tl] = gi * 8 + i1; elist[2 * tl + 1] = gi * 8 + i2;
            asg_w[(size_t)ch * 256 + 2 * tl] = wa; asg_w[(size_t)ch * 256 + 2 * tl + 1] = wb;
        }
        wg_sync();
        if (F.tid < 288) {
            const bool isr = F.tid < 256; const int e = isr ? elist[F.tid] : F.tid - 256, lim = isr ? F.tid : 256; int r = 0;
            typedef int i32x4 __attribute__((ext_vector_type(4)));
#pragma unroll 8
            for (int q = 0; q < 256; q += 4) { const i32x4 v = *(const LAS i32x4*)(elist + q);
                r += ((v[0] == e) & (q < lim)) + ((v[1] == e) & (q + 1 < lim)) + ((v[2] == e) & (q + 2 < lim)) + ((v[3] == e) & (q + 3 < lim)); }
            if (isr) { asg_e[(size_t)ch * 256 + F.tid] = e; asg_r[(size_t)ch * 256 + F.tid] = r; } else cnt[ch * 32 + e] = r; }
        wg_sync();
    }
}
DEVI void fill_phase(const Frame& F) {
    const int* cnt = (const int*)(F.ws + WS_CNT); const int* asg_e = (const int*)(F.ws + WS_ASGE); const int* asg_r = (const int*)(F.ws + WS_ASGR); const float* asg_w = (const float*)(F.ws + WS_ASGW);
    const float* rs1 = (const float*)(F.ws + WS_RS1);
    int* tslot = (int*)(F.ws + WS_TSLOT); int* stok = (int*)(F.ws + WS_STOK); float* sw = (float*)(F.ws + WS_SW); float* srs = (float*)(F.ws + WS_SRS); int* mtot = (int*)(F.ws + WS_MTOT);
    LAS int* ptot = (LAS int*)(F.lds + RING_OFF);
    LAS int* ppre = ptot + 512;
    LAS int* tot = ppre + 512; LAS int* start = tot + 32; LAS int* pre = start + 32;
    for (int ch = F.vcu; ch < 256; ch += F.G) {
        wg_sync();
        { const int e = F.tid & 31, part = F.tid >> 5; int t = 0, p = 0;
          for (int w = part * 16; w < part * 16 + 16; ++w) { const int c = cnt[w * 32 + e]; t += c; if (w < ch) p += c; }
          ptot[part * 32 + e] = t; ppre[part * 32 + e] = p; }
        wg_sync();
        if (F.tid < 32) { int t = 0, p = 0;
#pragma unroll
            for (int q = 0; q < 16; ++q) { t += ptot[q * 32 + F.tid]; p += ppre[q * 32 + F.tid]; }
            tot[F.tid] = t; pre[F.tid] = p; }
        wg_sync();
        if (F.tid == 0) { int s = 0; for (int e = 0; e < 32; ++e) { start[e] = s; s += tot[e]; } }
        wg_sync();
        if (F.tid < 256) { const size_t ag = (size_t)ch * 256 + F.tid; const int e = asg_e[ag], slot = start[e] + pre[e] + asg_r[ag], tok = ch * 128 + (F.tid >> 1);
            stok[slot] = tok; sw[slot] = asg_w[ag]; srs[slot] = rs1[tok]; tslot[ag] = slot; }
        if (ch == 0) {
            if (F.tid < 32) { mtot[F.tid] = tot[F.tid]; mtot[32 + F.tid] = start[F.tid]; }
            if (F.tid >= 256) { const int i = NSLOT + F.tid - 256; stok[i] = 0; sw[i] = 0.f; srs[i] = 0.f; }
            { const float* cbp = (const float*)(F.ws + WS_CBP); const int j = F.tid >> 8, c = F.tid & 255; float s2 = 0.f;
              for (int kr = 0; kr < 32; ++kr) s2 += cbp[(j * 32 + kr) * 256 + c];
              ((float*)(F.ws + WS_CB))[F.tid] = s2; } }
    }
}
DEVI int build_moe_table(const Frame& F) {
    const int* mtot = (const int*)(F.ws + WS_MTOT);
    LAS int* trow = (LAS int*)(F.lds + TAB_OFF); LAS int* tev = trow + 320; LAS int* tn = tev + 320;
    LAS int* mt = (LAS int*)(F.lds + SCR_OFF);
    if (F.tid < 64) mt[F.tid] = mtot[F.tid];
    wg_sync();
    if (F.tid == 0) { int nb = 0;
        for (int e = 0; e < 32; ++e) { const int t = mt[e], s = mt[32 + e];
            for (int o = 0; o < t; o += 256) { trow[nb] = s + o; tev[nb] = e * 512 + ((t - o) < 256 ? (t - o) : 256); ++nb; } }
        tn[0] = nb; }
    wg_sync();
    return tn[0];
}
DEVI void combine_phase(const Frame& F, const bf16_t* H, bf16_t* OUT, int zero_y) {
    const bf16_t* YB = (const bf16_t*)(F.ws + WS_YB); const int* tslot = (const int*)(F.ws + WS_TSLOT); float* rs2 = (float*)(F.ws + WS_RS2);
    const int gw = F.vcu * NWAVES + F.wave, NGW = F.G * NWAVES;
    for (int row = gw; row < NTOK; row += NGW) {
        const int s0 = tslot[2 * row], s1 = tslot[2 * row + 1]; float ss = 0.f;
#pragma unroll
        for (int hx = 0; hx < 2; ++hx) {
            const int col = 512 * hx + 8 * F.lane;
            const u32x4 h = *(const u32x4*)(H + (size_t)row * DM + col), y0 = *(const u32x4*)(YB + (size_t)s0 * DM + col), y1 = *(const u32x4*)(YB + (size_t)s1 * DM + col); u32x4 o;
#pragma unroll
            for (int j = 0; j < 4; ++j) { float lo = bflo(h[j]) + bflo(y0[j]) + bflo(y1[j]), hi = bfhi(h[j]) + bfhi(y0[j]) + bfhi(y1[j]); if (zero_y) { lo = bflo(h[j]); hi = bfhi(h[j]); } ss += lo * lo + hi * hi; o[j] = pk2(lo, hi); }
            *(u32x4*)(OUT + (size_t)row * DM + col) = o; }
        ss = wave_sum(ss);
        if (F.lane == 0) rs2[row] = 1.0f / sqrtf(ss * (1.0f / DM) + EPS);
    }
}
DEVI void rstd_from_partials(const Frame& F) {
    const float* ssq = (const float*)(F.ws + WS_SSQ); float* rs0 = (float*)(F.ws + WS_RS0);
    for (int row = F.vcu * 512 + F.tid; row < NTOK; row += F.G * 512) {
        const f32x4* p = (const f32x4*)(ssq + (size_t)row * 16); float s = 0.f;
#pragma unroll
        for (int q = 0; q < 4; ++q) { const f32x4 v = p[q]; s += (v[0] + v[1]) + (v[2] + v[3]); }
        rs0[row] = 1.0f / sqrtf(s * (1.0f / DM) + EPS); }
}
DEVI void cmpb_phase(const Frame& F, const Args& a) {
    const float* CP = (const float*)(F.ws + WS_CP); const float* CB = (const float*)(F.ws + WS_CB); const float* rope = (const float*)(F.ws + WS_ROPE);
    const bf16_t* W2T = (const bf16_t*)(F.ws + WS_W2T);
    bf16_t* KC = (bf16_t*)(F.ws + WS_KC); bf16_t* VC = (bf16_t*)(F.ws + WS_VC);
    LAS unsigned char* hl = F.lds + RING_OFF;
    LAS float* ol = (LAS float*)(F.lds + RING_OFF + 65536);
    const float kn = a.in[16][F.lane];
    const int fr = F.lane & 15, fq = F.lane >> 4;
    for (int wg = F.vcu; wg < 256; wg += F.G) {
        const int row0 = wg * 64, j = row0 >> 13, rho0 = row0 & 8191;
        { const int r = F.tid >> 3, c0 = (F.tid & 7) * 32;
          f32x4 acc8[8];
#pragma unroll
          for (int q = 0; q < 8; ++q) acc8[q] = *(const f32x4*)(CB + j * 256 + c0 + 4 * q);
#pragma unroll
          for (int ks = 0; ks < 4; ++ks) { const float* src = CP + ((size_t)(j * 4 + ks) * 8192 + rho0 + r) * 256 + c0;
#pragma unroll
              for (int q = 0; q < 8; ++q) acc8[q] += *(const f32x4*)(src + 4 * q); }
#pragma unroll
          for (int q = 0; q < 8; ++q) { f32x4 g;
#pragma unroll
              for (int e = 0; e < 4; ++e) { const float x = acc8[q][e], uu = 0.7978845608028654f * (x + 0.044715f * x * x * x); g[e] = x * sigmoid_f(2.0f * uu); }
              *(LAS u32x2*)(hl + r * 528 + (c0 + 4 * q) * 2) = pack4(g); } }
        wg_sync();
        { const int mt = F.wave & 3, np = F.wave >> 2;
          f32x4 d[2]; d[0] = (f32x4){0.f, 0.f, 0.f, 0.f}; d[1] = d[0];
#pragma unroll
          for (int st = 0; st < 8; ++st) {
              const bf16x8 hf = *(const LAS bf16x8*)(hl + (16 * mt + fr) * 528 + (32 * st + 8 * fq) * 2);
#pragma unroll
              for (int t = 0; t < 2; ++t) { const bf16x8 wf = *(const bf16x8*)(W2T + ((size_t)(j * 64 + 32 * np + 16 * t + fr)) * 256 + 32 * st + 8 * fq);
                  d[t] = __builtin_amdgcn_mfma_f32_16x16x32_bf16(wf, hf, d[t], 0, 0, 0); } }
#pragma unroll
          for (int t = 0; t < 2; ++t) *(LAS f32x4*)(ol + (16 * mt + fr) * 64 + 32 * np + 16 * t + 4 * fq) = d[t]; }
        wg_sync();
#pragma unroll
        for (int q = 0; q < 8; ++q) {
            const int r = F.wave * 8 + q, rho = rho0 + r, bg = rho >> 7, n = rho & 127;
            bf16_t* dst = (j == 0 ? KC : VC) + (size_t)rho * 64 + F.lane;
            float o = ol[r * 64 + F.lane];
            if (n == 127) { *dst = 0; continue; }
            if (j == 0) {
                const float ms = wave_sum(o * o) * (1.0f / 64.0f); const float y = o * (1.0f / sqrtf(ms + EPS)) * kn;
                const float other = __shfl_xor(y, 32);
                const int row = (bg >> 2) * SEQ + 16 * n + 31; const float cs = rope[(size_t)row * 64 + (F.lane & 31)], sn = rope[(size_t)row * 64 + 32 + (F.lane & 31)];
                o = (F.lane < 32) ? (y * cs - other * sn) : (y * cs + other * sn);
            }
            *dst = (bf16_t)(pk2(o, 0.f) & 0xffffu);
        }
        wg_sync();
    }
}

#ifndef ATT_REP
#define ATT_REP 1
#endif
namespace att {
constexpr int KS0 = 0, VS0 = 24576, WSF = 49152, OFN = 51200, UNI = 116736;
typedef const LAS char* lptr;
DEVI int crow(int r, int hi) { return (r & 3) + 8 * (r >> 2) + 4 * hi; }
DEVI void glds16(const void* gsrc, unsigned lds_dst) { unsigned keep;
    asm volatile("s_mov_b32 %0, m0\n\ts_mov_b32 m0, %2\n\ts_nop 0\n\tglobal_load_lds_dwordx4 %1, off\n\ts_mov_b32 m0, %0" : "=&s"(keep) : "v"(gsrc), "s"(lds_dst) : "memory"); }
DEVI float xlane32(float v) { return __shfl_xor(v, 32); }
DEVI void qkt(f32x16& p0, f32x16& p1, lptr Kslot, const bf16x8* qr, float cinit, int r32, int hi) {
    lptr kb = Kslot + hi * 1024 + r32 * 16;
#pragma unroll
    for (int r = 0; r < 16; ++r) { p0[r] = cinit; p1[r] = cinit; }
#pragma unroll
    for (int d0 = 0; d0 < 4; ++d0) {
        const bf16x8 b0 = *(const LAS bf16x8*)(kb + d0 * 2048), b1 = *(const LAS bf16x8*)(kb + d0 * 2048 + 512);
        p0 = __builtin_amdgcn_mfma_f32_32x32x16_bf16(b0, qr[d0], p0, 0, 0, 0); p1 = __builtin_amdgcn_mfma_f32_32x32x16_bf16(b1, qr[d0], p1, 0, 0, 0); }
}
DEVI float rowmax(const f32x16& p0, const f32x16& p1) {
    float m = fmaxf(p0[0], p1[0]);
#pragma unroll
    for (int r = 1; r < 16; ++r) m = fmaxf(m, fmaxf(p0[r], p1[r]));
    return fmaxf(m, xlane32(m));
}
DEVI float max3f(float a, float b, float c) { float r; asm("v_max3_f32 %0, %1, %2, %3" : "=v"(r) : "v"(a), "v"(b), "v"(c)); return r; }
DEVI float rowmax3(const f32x16& p0, const f32x16& p1) {
    float a = max3f(p0[0], p0[1], p1[0]), b = max3f(p0[2], p0[3], p1[1]); a = max3f(a, p1[2], p1[3]);
#pragma unroll
    for (int r = 4; r < 16; r += 4) { a = max3f(a, p0[r], p0[r + 1]); b = max3f(b, p0[r + 2], p0[r + 3]); a = max3f(a, p1[r], p1[r + 1]); b = max3f(b, p1[r + 2], p1[r + 3]); }
    const float m = max3f(a, b, b);
    return max3f(m, xlane32(m), m);
}
DEVI void qk2(f32x16& p0, f32x16& p1, lptr Kslot, const bf16x8* qr, const f32x16& negm, int r32, int hi) {
    lptr kb = Kslot + hi * 1024 + r32 * 16;
    bf16x8 kf[8];
#pragma unroll
    for (int d0 = 0; d0 < 4; ++d0) { kf[2 * d0] = *(const LAS bf16x8*)(kb + d0 * 2048); kf[2 * d0 + 1] = *(const LAS bf16x8*)(kb + d0 * 2048 + 512); }
    asm volatile("s_waitcnt lgkmcnt(0)" : "+v"(kf[0]), "+v"(kf[1]), "+v"(kf[2]), "+v"(kf[3]), "+v"(kf[4]), "+v"(kf[5]), "+v"(kf[6]), "+v"(kf[7]) :: "memory");
    p0 = __builtin_amdgcn_mfma_f32_32x32x16_bf16(kf[0], qr[0], negm, 0, 0, 0); p1 = __builtin_amdgcn_mfma_f32_32x32x16_bf16(kf[1], qr[0], negm, 0, 0, 0);
#pragma unroll
    for (int d0 = 1; d0 < 4; ++d0) { p0 = __builtin_amdgcn_mfma_f32_32x32x16_bf16(kf[2 * d0], qr[d0], p0, 0, 0, 0); p1 = __builtin_amdgcn_mfma_f32_32x32x16_bf16(kf[2 * d0 + 1], qr[d0], p1, 0, 0, 0); }
}
DEVI void pv(f32x16* o, int vb, bf16x8 pa0, bf16x8 pa1, bf16x8 pa2, bf16x8 pa3) {
#pragma unroll
    for (int d0 = 0; d0 < 2; ++d0) { s16x4 lo[4], hi[4];
#pragma unroll
        for (int ks = 0; ks < 4; ++ks) {
            asm volatile("ds_read_b64_tr_b16 %0,%1 offset:%c2" : "=&v"(lo[ks]) : "v"(vb), "i"(d0 * 4096 + ks * 1024) : "memory");
            asm volatile("ds_read_b64_tr_b16 %0,%1 offset:%c2" : "=&v"(hi[ks]) : "v"(vb), "i"(d0 * 4096 + ks * 1024 + 512) : "memory"); }
        asm volatile("s_waitcnt lgkmcnt(0)" ::: "memory"); __builtin_amdgcn_sched_barrier(0);
#define ATT_PK(k) (bf16x8){lo[k][0], lo[k][1], lo[k][2], lo[k][3], hi[k][0], hi[k][1], hi[k][2], hi[k][3]}
        o[d0] = __builtin_amdgcn_mfma_f32_32x32x16_bf16(pa0, ATT_PK(0), o[d0], 0, 0, 0);
        o[d0] = __builtin_amdgcn_mfma_f32_32x32x16_bf16(pa1, ATT_PK(1), o[d0], 0, 0, 0);
        o[d0] = __builtin_amdgcn_mfma_f32_32x32x16_bf16(pa2, ATT_PK(2), o[d0], 0, 0, 0);
        o[d0] = __builtin_amdgcn_mfma_f32_32x32x16_bf16(pa3, ATT_PK(3), o[d0], 0, 0, 0);
#undef ATT_PK
    }
}
DEVI bf16x8 packp(const f32x16& p, int b) { u32x4 w; w.x = pk2(p[b], p[b + 1]); w.y = pk2(p[b + 2], p[b + 3]); w.z = pk2(p[b + 4], p[b + 5]); w.w = pk2(p[b + 6], p[b + 7]); return __builtin_bit_cast(bf16x8, w); }
DEVI void scale_rows(f32x16* o, LAS float* wsf, float fac, int r32, int hi) {
    if (hi == 0) wsf[r32] = fac;
    LDS_WAIT();
#pragma unroll
    for (int r = 0; r < 16; ++r) { const float f = wsf[crow(r, hi)]; o[0][r] *= f; o[1][r] *= f; }
    LDS_WAIT();
}
DEVI void fold_rows(const f32x16* o, LAS float* ofl, LAS float* wsf, float fac, int r32, int hi) {
    if (hi == 0) wsf[r32] = fac;
    LDS_WAIT();
#pragma unroll
    for (int r = 0; r < 16; ++r) { const int q = crow(r, hi); const float f = wsf[q]; ofl[q * 64 + r32] += o[0][r] * f; ofl[q * 64 + 32 + r32] += o[1][r] * f; }
    LDS_WAIT();
}
DEVI void tile_step(f32x16* o, float& m, float& l, const bf16x8* qr, lptr Kslot, int vb, LAS float* wsf, int r32, int hi, float cinit, bool domask, int kbase, int lo, int hi_) {
    f32x16 p0, p1;
    qkt(p0, p1, Kslot, qr, cinit, r32, hi);
    if (domask) {
#pragma unroll
        for (int r = 0; r < 16; ++r) { const int kp = kbase + crow(r, hi); if (kp < lo || kp > hi_) p0[r] = -INFINITY; if (kp + 32 < lo || kp + 32 > hi_) p1[r] = -INFINITY; } }
    const float rm = rowmax(p0, p1);
    if (__builtin_amdgcn_ballot_w64(rm > m + 8.0f) != 0ull) {
        const float mn = fmaxf(m, rm), f = __builtin_amdgcn_exp2f(m - mn); m = mn;
        l *= f;
        scale_rows(o, wsf, f, r32, hi);
    }
    float ps = 0.f;
#pragma unroll
    for (int r = 0; r < 16; ++r) { p0[r] = __builtin_amdgcn_exp2f(p0[r] - m); p1[r] = __builtin_amdgcn_exp2f(p1[r] - m); ps += p0[r] + p1[r]; }
    l += ps;
    pv(o, vb, packp(p0, 0), packp(p0, 8), packp(p1, 0), packp(p1, 8));
}

template<bool nomax>
DEVI void attn_unit(int b, int g, int qb, const bf16_t* Q, const bf16_t* KV, const bf16_t* KC, const bf16_t* VC, const float* gates, bf16_t* O, LAS char* shm) {
    const int tid = threadIdx.x, lane = tid & 63, r32 = lane & 31, hi = lane >> 5; const int wid = __builtin_amdgcn_readfirstlane(tid >> 6);
    const int tl = r32 >> 2, head = r32 & 3, tq0 = qb * 64, tq = tq0 + 8 * wid + tl, row = b * SEQ + tq, bg = b * 4 + g;
    const unsigned lds0 = (unsigned)(uintptr_t)shm;
    LAS float* wsf = (LAS float*)(shm + WSF) + wid * 64;
    const bf16_t* Ks = KV + 2 * KVS + (size_t)bg * SEQ * 64; const bf16_t* Vs = KV + 3 * KVS + (size_t)bg * SEQ * 64;
    const bf16_t* Kw = KV + 4 * KVS + (size_t)bg * SEQ * 64; const bf16_t* Vw = KV + 5 * KVS + (size_t)bg * SEQ * 64;
    const bf16_t* Kc = KC + (size_t)bg * 128 * 64; const bf16_t* Vc = VC + (size_t)bg * 128 * 64;
    const int koff = lane * 64 + wid * 8, voff = (16 * (wid & 3) + (lane >> 2)) * 64 + (wid >> 2) * 32 + (lane & 3) * 8;
#define ATT_DMA(Kt, Vt, slot) do { glds16((Kt) + koff, (unsigned)__builtin_amdgcn_readfirstlane(lds0 + KS0 + (slot) * 8192 + wid * 1024)); \
                                   glds16((Vt) + voff, (unsigned)__builtin_amdgcn_readfirstlane(lds0 + VS0 + (slot) * 8192 + wid * 1024)); } while (0)
#define ATT_WAITBAR() asm volatile("s_waitcnt vmcnt(0) lgkmcnt(0)\n\ts_barrier" ::: "memory")
    const int vb0 = (int)(lds0 + VS0) + ((lane >> 4) & 1) * 32 + (lane & 3) * 8 + (4 * hi + ((lane & 15) >> 2)) * 64;
    const lptr kslot0 = (lptr)(shm + KS0);
#ifdef ATT_TSEG
    unsigned long long tsa_ = __builtin_amdgcn_s_memrealtime(), tsb_ = 0, tsc_ = 0, tsd_ = 0, tsx_ = 0, tacc_ = 0;
#define TSB(k) do { if (ATT_TSEG == (k)) tsx_ = __builtin_amdgcn_s_memrealtime(); } while (0)
#define TSE(k) do { if (ATT_TSEG == (k)) tacc_ += __builtin_amdgcn_s_memrealtime() - tsx_; } while (0)
#else
#define TSB(k) do { } while (0)
#define TSE(k) do { } while (0)
#endif
    ATT_WAITBAR();
    const int nC = (qb >= 16) ? 2 : 1;
    const int wlo = qb >= 8 ? qb - 8 : 0, nW = qb - wlo + 1;
    bf16x8 qr[4];
    { const bf16_t* qp = Q + (size_t)row * DM + (4 * g + head) * 64 + 8 * hi;
#pragma unroll
      for (int d0 = 0; d0 < 4; ++d0) qr[d0] = *(const bf16x8*)(qp + 16 * d0); }
    const float* gp = gates + (size_t)row * 48 + (g * 4 + head) * 3; const float gate_c = (PROBE == 4) ? 0.f : gp[0], gate_s = (PROBE == 5) ? 0.f : gp[1], gate_w = (PROBE == 6) ? 0.f : gp[2];
    ATT_DMA(Kc, Vc, 0); if (nC == 2) ATT_DMA(Kc + 64 * 64, Vc + 64 * 64, 1);
    ATT_DMA(Kw + (size_t)wlo * 4096, Vw + (size_t)wlo * 4096, 2);
    f32x16 o[2];
    LAS float* ofl = (LAS float*)(shm + OFN) + wid * 2048;
#pragma unroll
    for (int r = 0; r < 16; ++r) { ofl[crow(r, hi) * 64 + r32] = 0.f; ofl[crow(r, hi) * 64 + 32 + r32] = 0.f; }
    unsigned selmask = (qb == 31) ? 0xffffffffu : ((2u << qb) - 1u);
    asm volatile("s_waitcnt vmcnt(2) lgkmcnt(0)\n\ts_barrier" ::: "memory");
#ifdef ATT_TSEG
    tsb_ = __builtin_amdgcn_s_memrealtime();
#endif
    {
        const int nmax = (tq - 31) >> 4;
        f32x16 pa0, pa1, pb0, pb1;
        qkt(pa0, pa1, kslot0, qr, 0.f, r32, hi);
        if (nC == 2) qkt(pb0, pb1, kslot0 + 8192, qr, 0.f, r32, hi);
#pragma unroll
        for (int r = 0; r < 16; ++r) { const int n0 = crow(r, hi); if (n0 > nmax) pa0[r] = -INFINITY; if (n0 + 32 > nmax) pa1[r] = -INFINITY; }
        float m = rowmax(pa0, pa1), ps = 0.f;
        if (nC == 2) {
#pragma unroll
            for (int r = 0; r < 16; ++r) { const int n0 = crow(r, hi); if (n0 + 64 > nmax) pb0[r] = -INFINITY; if (n0 + 96 > nmax) pb1[r] = -INFINITY; }
            m = fmaxf(m, rowmax(pb0, pb1)); }
        if (m == -INFINITY) m = 0.f;
#pragma unroll
        for (int r = 0; r < 16; ++r) { pa0[r] = __builtin_amdgcn_exp2f(pa0[r] - m); pa1[r] = __builtin_amdgcn_exp2f(pa1[r] - m); ps += pa0[r] + pa1[r]; }
        if (nC == 2) {
#pragma unroll
            for (int r = 0; r < 16; ++r) { pb0[r] = __builtin_amdgcn_exp2f(pb0[r] - m); pb1[r] = __builtin_amdgcn_exp2f(pb1[r] - m); ps += pb0[r] + pb1[r]; } }
        ps += xlane32(ps);
        const float inv = ps > 0.f ? __builtin_amdgcn_rcpf(ps) : 0.f;
#pragma unroll
        for (int r = 0; r < 16; ++r) { o[0][r] = 0.f; o[1][r] = 0.f; }
        pv(o, vb0, packp(pa0, 0), packp(pa0, 8), packp(pa1, 0), packp(pa1, 8));
        if (nC == 2) pv(o, vb0 + 8192, packp(pb0, 0), packp(pb0, 8), packp(pb1, 0), packp(pb1, 8));
        fold_rows(o, ofl, wsf, gate_c * inv, r32, hi);
        if (qb >= 16) {
#define ATT_QSUM(x) do { float t_ = (x) * inv; t_ += __builtin_bit_cast(float, __builtin_amdgcn_update_dpp(0, __builtin_bit_cast(int, t_), 0xB1, 0xf, 0xf, false)); \
                         t_ += __builtin_bit_cast(float, __builtin_amdgcn_update_dpp(0, __builtin_bit_cast(int, t_), 0x4E, 0xf, 0xf, false)); (x) = t_; } while (0)
#pragma unroll
            for (int r = 0; r < 16; ++r) { ATT_QSUM(pa0[r]); ATT_QSUM(pa1[r]); ATT_QSUM(pb0[r]); ATT_QSUM(pb1[r]); }
#undef ATT_QSUM
            float sc[16], fo[16];
#define ATT_H4(h4, r) ((h4) == 0 ? pa0[r] : (h4) == 1 ? pa1[r] : (h4) == 2 ? pb0[r] : pb1[r])
#pragma unroll
            for (int h4 = 0; h4 < 4; ++h4)
#pragma unroll
                for (int gq = 0; gq < 4; ++gq) fo[h4 * 4 + gq] = xlane32(ATT_H4(h4, 4 * gq));
#pragma unroll
            for (int h4 = 0; h4 < 4; ++h4)
#pragma unroll
                for (int gq = 0; gq < 4; ++gq) {
                    const int s = h4 * 4 + gq;
                    const float nxt_lo = fo[s];
                    const float nxt_hi = (s < 15) ? fo[s + 1] : 0.f;
                    float v = ATT_H4(h4, 4 * gq) + 2.0f * (ATT_H4(h4, 4 * gq + 1) + ATT_H4(h4, 4 * gq + 2) + ATT_H4(h4, 4 * gq + 3)) + (hi ? nxt_hi : nxt_lo);
                    const int j = 8 * h4 + 2 * gq + hi;
                    if (j == 0 || j == qb || j == qb - 1) v = INFINITY; else if (j > qb) v = -INFINITY;
                    sc[s] = v; }
#undef ATT_H4
            float so[16];
#pragma unroll
            for (int s = 0; s < 16; ++s) so[s] = xlane32(sc[s]);
            float x4[4];
#pragma unroll
            for (int i = 0; i < 4; ++i) x4[i] = (head == 0) ? sc[4 * i] : (head == 1) ? sc[4 * i + 1] : (head == 2) ? sc[4 * i + 2] : sc[4 * i + 3];
            unsigned own = 0u;
#pragma unroll
            for (int i = 0; i < 4; ++i) {
                int rk = 0; const float xv = x4[i];
#pragma unroll
                for (int s2 = 0; s2 < 16; ++s2) {
                    const int g2 = s2 >> 2, q2 = s2 & 3;
                    if (g2 < i) { rk += (sc[s2] >= xv) ? 1 : 0; rk += (so[s2] >= xv) ? 1 : 0; }
                    else if (g2 > i) { rk += (sc[s2] > xv) ? 1 : 0; rk += (so[s2] > xv) ? 1 : 0; }
                    else { const bool lt = q2 < head, eq = q2 == head;
                        rk += eq ? 0 : (lt ? ((sc[s2] >= xv) ? 1 : 0) : ((sc[s2] > xv) ? 1 : 0));
                        rk += (lt || (eq && hi)) ? ((so[s2] >= xv) ? 1 : 0) : ((so[s2] > xv) ? 1 : 0); }
                }
                if (rk < 16) own |= 1u << (8 * i);
            }
            own <<= 2 * head;
            own |= (unsigned)__builtin_amdgcn_update_dpp(0, (int)own, 0xB1, 0xf, 0xf, false);
            own |= (unsigned)__builtin_amdgcn_update_dpp(0, (int)own, 0x4E, 0xf, 0xf, false);
            own <<= hi;
            selmask = own | (unsigned)__shfl_xor((int)own, 32);
        }
    }
    unsigned uni = selmask, wuni = selmask;
    if (qb >= 16) {
#pragma unroll
        for (int off = 1; off < 64; off <<= 1) uni |= (unsigned)__shfl_xor((int)uni, off);
        wuni = (unsigned)__builtin_amdgcn_readfirstlane((int)uni);
        LAS unsigned* uw = (LAS unsigned*)(shm + UNI);
        if (lane == 0) uw[wid] = uni;
        ATT_WAITBAR();
        uni = 0u;
#pragma unroll
        for (int w = 0; w < 8; ++w) uni |= uw[w];
        uni = (unsigned)__builtin_amdgcn_readfirstlane((int)uni);
    } else { ATT_WAITBAR(); }
    uni = (unsigned)__builtin_amdgcn_readfirstlane((int)uni); wuni = (unsigned)__builtin_amdgcn_readfirstlane((int)wuni);
#ifdef ATT_TSEG
    tsc_ = __builtin_amdgcn_s_memrealtime();
#endif
    const unsigned smask = uni & ((qb == 31) ? 0xffffffffu : ((2u << qb) - 1u));
    const int nS = __builtin_popcount(smask), nT = nW + nS;
    unsigned rem_issue = smask, rem_qk = smask;
#define ATT_ISSUE(tt) do { const int sl_ = ((tt) + 2) % 3; \
        if ((tt) < nW) { const int j_ = wlo + (tt); ATT_DMA(Kw + (size_t)j_ * 4096, Vw + (size_t)j_ * 4096, sl_); } \
        else { const int j_ = __builtin_ctz(rem_issue); rem_issue &= rem_issue - 1u; ATT_DMA(Ks + (size_t)j_ * 4096, Vs + (size_t)j_ * 4096, sl_); } } while (0)
    if (nT > 1) ATT_ISSUE(1);
    ATT_WAITBAR();
    if (nT > 2) ATT_ISSUE(2);
    float mref = 0.f, l = 0.f;
#pragma unroll
    for (int r = 0; r < 16; ++r) { o[0][r] = 0.f; o[1][r] = 0.f; }
    f32x16 pc0, pc1, negm;
#pragma unroll
    for (int r = 0; r < 16; ++r) negm[r] = 0.f;
    qk2(pc0, pc1, kslot0 + 2 * 8192, qr, negm, r32, hi);
    int jc = wlo; bool cS = false, cskip = false;
    f32x16 pd0, pd1;
#define ATT_STEP(t, pc0, pc1, pn0, pn1) do { \
        const bool hasn = t + 1 < nT; int jn = 0; bool nSel = false, nskip = true; \
        if (hasn) { if (t + 1 < nW) { jn = wlo + t + 1; nskip = false; } else { jn = __builtin_ctz(rem_qk); rem_qk &= rem_qk - 1u; nSel = true; nskip = ((wuni >> jn) & 1u) == 0u; } } \
        TSB(4); if (t > 0) { ATT_WAITBAR(); if (t + 2 < nT) ATT_ISSUE(t + 2); } TSE(4); \
        TSB(5); if (!nskip) { \
            const float nm = (nSel && ((selmask >> jn) & 1u) == 0u) ? -INFINITY : -mref; \
_Pragma("unroll") \
            for (int r = 0; r < 16; ++r) negm[r] = nm; \
            qk2(pn0, pn1, kslot0 + ((t + 3) % 3) * 8192, qr, negm, r32, hi); \
        } \
        TSE(5); if (!cskip) { TSB(6); \
            const bool dm = cS ? (jc == qb) : ((jc == qb) || (jc + 8 == qb)); \
            if (dm) { const int lo = cS ? 0 : tq - 511, kbase = 64 * jc; \
_Pragma("unroll") \
                for (int r = 0; r < 16; ++r) { const int kp = kbase + crow(r, hi); if (kp < lo || kp > tq) pc0[r] = -INFINITY; if (kp + 32 < lo || kp + 32 > tq) pc1[r] = -INFINITY; } } \
            const float rm = nomax ? 0.f : rowmax3(pc0, pc1); \
            if (!nomax && __builtin_amdgcn_ballot_w64(rm > 8.0f) != 0ull) { \
                const float dl = fmaxf(rm, 0.f), f = __builtin_amdgcn_exp2f(-dl); mref += dl; l *= f; \
_Pragma("unroll") \
                for (int r = 0; r < 16; ++r) { pc0[r] -= dl; pc1[r] -= dl; } \
                if (!nskip) { \
_Pragma("unroll") \
                    for (int r = 0; r < 16; ++r) { pn0[r] -= dl; pn1[r] -= dl; } } \
                scale_rows(o, wsf, f, r32, hi); \
            } \
            TSE(6); TSB(7); float ps = 0.f; \
_Pragma("unroll") \
            for (int r = 0; r < 16; ++r) { pc0[r] = __builtin_amdgcn_exp2f(pc0[r]); pc1[r] = __builtin_amdgcn_exp2f(pc1[r]); ps = (ps + pc0[r]) + pc1[r]; } \
            l += ps; TSE(7); TSB(8); \
            pv(o, vb0 + ((t + 2) % 3) * 8192, packp(pc0, 0), packp(pc0, 8), packp(pc1, 0), packp(pc1, 8)); TSE(8); \
        } \
        if (t + 1 == nW) { \
            l += xlane32(l); fold_rows(o, ofl, wsf, gate_w * (l > 0.f ? __builtin_amdgcn_rcpf(l) : 0.f), r32, hi); \
_Pragma("unroll") \
            for (int r = 0; r < 16; ++r) { o[0][r] = 0.f; o[1][r] = 0.f; } \
            l = 0.f; } \
        jc = jn; cS = nSel; cskip = nskip; } while (0)
    for (int t = 0; t < nT; t += 2) {
        ATT_STEP(t, pc0, pc1, pd0, pd1);
        if (t + 1 >= nT) break;
        ATT_STEP(t + 1, pd0, pd1, pc0, pc1);
    }
#undef ATT_STEP
#undef ATT_ISSUE
    l += xlane32(l); fold_rows(o, ofl, wsf, gate_s * (l > 0.f ? __builtin_amdgcn_rcpf(l) : 0.f), r32, hi);
#ifdef ATT_TSEG
    tsd_ = __builtin_amdgcn_s_memrealtime();
    { const unsigned long long seg_ = (ATT_TSEG >= 4) ? tacc_ : (ATT_TSEG == 1) ? (tsb_ - tsa_) : (ATT_TSEG == 2) ? (tsc_ - tsb_) : (tsd_ - tsc_);
      LAS unsigned* tw_ = (LAS unsigned*)(shm + UNI + 64) + wid; if (lane == 0) tw_[0] += (unsigned)seg_; }
#endif
    {
#pragma unroll
      for (int i = 0; i < 4; ++i) { const int q = i * 8 + (lane >> 3), chn = lane & 7; const f32x4 v0 = *(const LAS f32x4*)(ofl + q * 64 + chn * 8), v1 = *(const LAS f32x4*)(ofl + q * 64 + chn * 8 + 4);
          u32x4 v; v.x = pk2(v0[0], v0[1]); v.y = pk2(v0[2], v0[3]); v.z = pk2(v1[0], v1[1]); v.w = pk2(v1[2], v1[3]);
          *(u32x4*)(O + (size_t)(b * SEQ + tq0 + 8 * wid + (q >> 2)) * DM + (4 * g + (q & 3)) * 64 + chn * 8) = v; }
      LDS_WAIT(); }
#undef ATT_DMA
#undef ATT_WAITBAR
}
DEVI void attn_phase(const Frame& F, const Args& args) {
    const bf16_t* Q = (const bf16_t*)(F.ws + WS_Q); const bf16_t* KV = (const bf16_t*)(F.ws + WS_KV); const bf16_t* KC = (const bf16_t*)(F.ws + WS_KC); const bf16_t* VC = (const bf16_t*)(F.ws + WS_VC);
    const float* gates = (const float*)(F.ws + WS_GATES); bf16_t* O = (bf16_t*)(F.ws + WS_O);
#if PROBE == 1
    { u32x4* z = (u32x4*)O; for (size_t i = (size_t)F.vcu * 512 + F.tid; i < (size_t)NTOK * DM / 8; i += (size_t)F.G * 512) z[i] = (u32x4){0u, 0u, 0u, 0u}; return; }
#endif
#ifdef ATT_TSEG
    { LAS unsigned* tw_ = (LAS unsigned*)(F.lds + RING_OFF + UNI + 64); if (F.tid < 8) tw_[F.tid] = 0u; asm volatile("s_waitcnt lgkmcnt(0)\n\ts_barrier" ::: "memory"); }
#endif
    bool nomax;
    { const float* qn = args.in[15]; const float* kn = args.in[16];
      float gq = fabsf(qn[F.lane]), gk = fmaxf(fabsf(kn[64 + F.lane]), fabsf(kn[128 + F.lane]));
#pragma unroll
      for (int off = 1; off < 64; off <<= 1) { gq = fmaxf(gq, __shfl_xor(gq, off)); gk = fmaxf(gk, __shfl_xor(gk, off)); }
      const float bound = 11.5416f * gq * gk;
      nomax = __builtin_amdgcn_readfirstlane((bound <= 40.0f) ? 1 : 0) != 0; }
    for (int i = 0;; ++i) {
        const int idx = (i / ATT_REP) * F.G + F.vcu; if (idx >= 2048) break;
        const int ii = idx >> 8, bgq = idx & 255, bg = bgq >> 2, qt = bgq & 3;
        const int qbc = (ii & 1) ? (8 * (ii >> 1) + 7 - qt) : (8 * (ii >> 1) + qt);
        if (nomax) attn_unit<true>(bg >> 2, bg & 3, qbc, Q, KV, KC, VC, gates, O, (LAS char*)(F.lds + RING_OFF));
        else attn_unit<false>(bg >> 2, bg & 3, qbc, Q, KV, KC, VC, gates, O, (LAS char*)(F.lds + RING_OFF));
        const int qb = qbc;
        (void)qb;
    }
    asm volatile("s_waitcnt vmcnt(0) lgkmcnt(0)\n\ts_barrier" ::: "memory");
#ifdef ATT_TSEG
    { LAS unsigned* tw_ = (LAS unsigned*)(F.lds + RING_OFF + UNI + 64); const unsigned long long d_ = (unsigned long long)tw_[0] * 3ull; const unsigned long long t1_ = __builtin_amdgcn_s_memrealtime();
      while (__builtin_amdgcn_s_memrealtime() - t1_ < d_) __builtin_amdgcn_s_sleep(8); }
#endif
}
}

#ifndef PH_MASK
#define PH_MASK 0xffffffffu
#endif
#ifndef REP_MASK
#define REP_MASK 0u
#endif
#define PH(k) (((PH_MASK) >> (k)) & 1u)
#define REPB(k) (((REP_MASK) >> (k)) & 1u)
#define GRID_BAR() xcd_barrier(bar)
#define REFRESH() do { int t_ = threadIdx.x; asm volatile("" : "+v"(t_)); F.tid = t_; F.lane = t_ & 63; F.wave = __builtin_amdgcn_readfirstlane(t_ >> 6); } while (0)
template <int K, int L>
DEVI void phase(Frame& F, const Args& args, int nblk) {
    unsigned char* ws = args.ws;
    LAS unsigned char* ring = F.lds + RING_OFF;
    bf16_t* const HA = (bf16_t*)(ws + WS_HA); bf16_t* const HB = (bf16_t*)(ws + WS_HB);
    bf16_t* const hin = (L == 0) ? HA : HB;
    bf16_t* const hmx = (L == 0) ? HB : HA;
    REFRESH();
    if constexpr (K == 0) p0_prologue(F, args);
    if constexpr (K == 2) { ProbPw1 P; P.A = (const char*)HA; P.Bt = (const char*)(ws + WS_WPW1); P.K = DM; P.ldb = 2048; P.G = F.G; P.c = F.vcu;
          P.rstd = (const float*)(ws + WS_RS0); P.bias = args.in[7]; P.U = (bf16_t*)(ws + WS_U);
          pg8::gemm_phase(ring, P); }
    if constexpr (K == 3) {
        if (F.vcu & 1) { prep_layer(F, args, 0); wg_sync(); conv_phase(F, args); }
        else { conv_phase(F, args); wg_sync(); prep_layer(F, args, 0); } }
    if constexpr (K == 4) { ProbRes P; P.A = (const char*)(ws + WS_V); P.Bt = (const char*)(ws + WS_WPW2); P.K = DM; P.ldb = 2048; P.G = F.G; P.c = F.vcu;
          P.RES = HA; P.OUT = HB; P.bias = args.in[13];
          pg8::gemm_phase(ring, P); }
    if constexpr (K == 5) { ProbWin P; P.A = (const char*)HB; P.Bt = (const char*)(ws + WS_WIN); P.K = DM; P.ldb = 2048; P.G = F.G; P.c = F.vcu;
          P.rstd = (const float*)(ws + WS_SSQ); P.rope = (const float*)(ws + WS_ROPE); P.qnorm = args.in[15]; P.knorm = args.in[16];
          P.Q = (bf16_t*)(ws + WS_Q); P.KV = (bf16_t*)(ws + WS_KV); P.gates = (float*)(ws + WS_GATES);
          { LAS float* lr = (LAS float*)(F.lds + SCR_OFF);
            for (int idx = F.tid; idx < 8 * 256; idx += 512) { const int Lq = (idx >> 8) * F.G + F.vcu;
                if (Lq < 128 * 11) { const f32x4* pp = (const f32x4*)(P.rstd + (size_t)((Lq / 11) * 256 + (idx & 255)) * 16); const f32x4 st = (pp[0] + pp[1]) + (pp[2] + pp[3]);
                    lr[idx] = 1.0f / sqrtf(((st[0] + st[1]) + (st[2] + st[3])) * (1.0f / DM) + EPS); } }
            wg_sync(); P.lrs = lr; }
          pg8::gemm_phase(ring, P); }
    if constexpr (K == 6) { ProbCmp P; P.A = (const char*)(ws + WS_KV); P.Bt = (const char*)(ws + WS_WC1); P.K = 512; P.ldb = 4096; P.G = F.G; P.c = F.vcu;
          P.CP = (float*)(ws + WS_CP);
          pg8::gemm_phase(ring, P); }
    if constexpr (K == 7) cmpb_phase(F, args);
    if constexpr (K == 8) {
        if (F.vcu & 1) { prep_layer(F, args, 1); wg_sync(); REFRESH(); }
        att::attn_phase(F, args);
        if (!(F.vcu & 1)) { REFRESH(); prep_layer(F, args, 1); } }
    if constexpr (K == 9) { ProbRes P; P.A = (const char*)(ws + WS_O); P.Bt = (const char*)(ws + WS_WOUT); P.K = DM; P.ldb = 2048; P.G = F.G; P.c = F.vcu;
          P.RES = HB; P.OUT = HA; P.bias = nullptr;
          pg8::gemm_phase(ring, P); }
    if constexpr (K == 11) router_phase(F, args, L, hmx);
    if constexpr (K == 12) fill_phase(F);
    if constexpr (K == 13) { ProbGateUp P; P.A = (const char*)hmx; P.Bt = (const char*)(ws + WS_WGU); P.K = DM; P.ldb = 2048; P.G = F.G; P.c = F.vcu;
          P.tab_row = (const LAS int*)(F.lds + TAB_OFF); P.tab_ev = P.tab_row + 320; P.nblk = nblk;
          P.slot_rs = (const float*)(ws + WS_SRS); P.HBUF = (bf16_t*)(ws + WS_HBUF);
          { LAS unsigned* go = (LAS unsigned*)(F.lds + SCR_OFF); const int* stok = (const int*)(ws + WS_STOK);
            for (int idx = F.tid; idx < 8 * 256; idx += 512) { const int Lq = (idx >> 8) * F.G + F.vcu; if (Lq < nblk * 4) go[idx] = (unsigned)stok[P.tab_row[Lq >> 2] + (idx & 255)] * 2048u; }
            wg_sync(); P.goff = go; }
          pg8::gemm_phase(ring, P);
          ProbPP Q2; Q2.A = (const char*)(ws + WS_PB); Q2.Bt = (const char*)(ws + WS_WPP) + (size_t)L * DM * PLE * 2; Q2.K = PLE; Q2.ldb = 512; Q2.G = F.G; Q2.c = F.vcu;
          Q2.O = (bf16_t*)(ws + WS_PP);
          { const int nun = nblk * 4, maxu = (nun + F.G - 1) / F.G; int tl = nun - (maxu - 1) * F.G; if (tl >= F.G || tl < 0) tl = 0; Q2.tail_lo = tl; }
          Q2.base = 0; Q2.cnt = PP_SPLIT;
          pg8::gemm_phase(ring, Q2); }
    if constexpr (K == 14) { ProbDown P; P.A = (const char*)(ws + WS_HBUF); P.Bt = (const char*)(ws + WS_WDN); P.K = DEXP; P.ldb = 1024; P.G = F.G; P.c = F.vcu;
          P.tab_row = (const LAS int*)(F.lds + TAB_OFF); P.tab_ev = P.tab_row + 320; P.nblk = nblk;
          P.slot_w = (const float*)(ws + WS_SW); P.YB = (bf16_t*)(ws + WS_YB);
          pg8::gemm_phase(ring, P);
          ProbPP Q2; Q2.A = (const char*)(ws + WS_PB); Q2.Bt = (const char*)(ws + WS_WPP) + (size_t)L * DM * PLE * 2; Q2.K = PLE; Q2.ldb = 512; Q2.G = F.G; Q2.c = F.vcu;
          Q2.O = (bf16_t*)(ws + WS_PP);
          { const int nun = nblk * 4, maxu = (nun + F.G - 1) / F.G; int tl = nun - (maxu - 1) * F.G; if (tl >= F.G || tl < 0) tl = 0; Q2.tail_lo = tl; }
          Q2.base = PP_SPLIT; Q2.cnt = 128 * 4 - PP_SPLIT;
          pg8::gemm_phase(ring, Q2); }
    if constexpr (K == 15) combine_phase(F, hmx, hin, (PROBE == 2 && L == 1) || (PROBE == 3 && L == 0));
#ifdef STAGGER_US
    if constexpr (K == STAGGER_PH) { if (F.vcu & 1) { const unsigned long long t0_ = __builtin_amdgcn_s_memrealtime(); while (__builtin_amdgcn_s_memrealtime() - t0_ < (unsigned long long)(STAGGER_US) * 100ull) __builtin_amdgcn_s_sleep(8); } }
#endif
    if constexpr (K == 16) { ProbPle P; P.A = (const char*)hin; P.Bt = (const char*)(ws + WS_WPG) + (size_t)L * DM * DM * 2; P.K = DM; P.ldb = 2048; P.G = F.G; P.c = F.vcu;
          P.H2 = hin; P.PPp = (const bf16_t*)(ws + WS_PP); P.rstd = (const float*)(ws + WS_RS2); P.OUTB = hmx; P.OUTF = args.out; P.ssq = (float*)(ws + WS_SSQ); P.last = L;
          pg8::gemm_phase(ring, P); }
}
#if defined(TPHASE)
#define PHASE(k) do { const bool tp_ = ((k) == TPHASE) && (L == TLAYER); const unsigned long long t0_ = tp_ ? __builtin_amdgcn_s_memrealtime() : 0ull; \
    if (PH(k)) phase<k, L>(F, args, nblk); \
    if (tp_) { asm volatile("s_waitcnt vmcnt(0) lgkmcnt(0)" ::: "memory"); const unsigned long long t1_ = __builtin_amdgcn_s_memrealtime(); const unsigned long long d_ = (t1_ - t0_) * TALPHA; \
        while (__builtin_amdgcn_s_memrealtime() - t1_ < d_) __builtin_amdgcn_s_sleep(8); } } while (0)
#else
#define PHASE(k) do { if (PH(k)) phase<k, L>(F, args, nblk); if (PH(k) && REPB(k)) phase<k, L>(F, args, nblk); } while (0)
#endif
template <int L>
DEVI void layer_program(Frame& F, const Args& args, const XcdBarrier& bar) {
    int nblk = 0;
    if (L == 0) {
        PHASE(2); GRID_BAR();
        PHASE(3); GRID_BAR();
        PHASE(4);
    } else {
        PHASE(5); GRID_BAR();
        PHASE(6); GRID_BAR();
        PHASE(7); GRID_BAR();
        PHASE(8); GRID_BAR();
        PHASE(9);
    }
    GRID_BAR();
    PHASE(11); GRID_BAR();
    PHASE(12); GRID_BAR();
    REFRESH(); nblk = build_moe_table(F);
    PHASE(13); GRID_BAR();
    PHASE(14); GRID_BAR();
    PHASE(15); GRID_BAR();
    PHASE(16);
    if (L == 0) GRID_BAR();
}
__global__ void __launch_bounds__(NWAVES * 64, 2) hybrid_fwd(Args args) {
    extern __shared__ __attribute__((aligned(16))) unsigned char lds[];
    Frame F;
    F.lds = (LAS unsigned char*)lds; F.ws = args.ws; F.ctl = (gu32*)(args.ws + WS_CTL);
    F.tid = threadIdx.x; F.lane = F.tid & 63; F.wave = __builtin_amdgcn_readfirstlane(F.tid >> 6);
    F.G = gridDim.x; { const int bx = blockIdx.x; F.vcu = (F.G % 8 == 0) ? (bx % 8) * (F.G / 8) + bx / 8 : bx; }
    for (int u = F.tid; u < (LDS_BYTES - LDSCTL_OFF) / 4; u += NWAVES * 64) ((LAS unsigned*)(F.lds + LDSCTL_OFF))[u] = 0u;
    __syncthreads();
    XcdBarrier bar = xcd_barrier_post((unsigned*)(F.ctl + CW_BAR), (volatile LAS unsigned*)(F.lds + MISC_OFF) + 8);
    { constexpr int L = 0; const int nblk = 0; PHASE(0); }
    GRID_BAR();
#ifdef EXTRA_BARS
    GRID_BAR(); GRID_BAR(); GRID_BAR(); GRID_BAR(); GRID_BAR(); GRID_BAR(); GRID_BAR(); GRID_BAR(); GRID_BAR(); GRID_BAR();
#endif
    layer_program<0>(F, args, bar);
    layer_program<1>(F, args, bar);
}
#undef GRID_BAR

extern "C" void kernel_launch(void* const* d_in, const int* in_sizes, int n_in, void* d_out, int out_size, void* d_ws, size_t ws_size, hipStream_t stream) {
    static int grid = 0;
    if (grid == 0) {
        if (n_in != 30 || out_size != NTOK * DM || ws_size < WS_END) { fprintf(stderr, "kernel_launch: unexpected shapes (n_in %d, out %d, ws %zu < %zu)\n", n_in, out_size, ws_size, (size_t)WS_END); grid = -1; return; }
        int dev = 0, cus = 0, per_cu = 0;
        if (hipGetDevice(&dev) != hipSuccess || hipDeviceGetAttribute(&cus, hipDeviceAttributeMultiprocessorCount, dev) != hipSuccess) { grid = -1; return; }
        if (hipFuncSetAttribute((const void*)hybrid_fwd, hipFuncAttributeMaxDynamicSharedMemorySize, LDS_BYTES) != hipSuccess) { fprintf(stderr, "kernel_launch: hipFuncSetAttribute failed\n"); grid = -1; return; }
        if (hipOccupancyMaxActiveBlocksPerMultiprocessor(&per_cu, (const void*)hybrid_fwd, NWAVES * 64, LDS_BYTES) != hipSuccess || per_cu < 1)
            fprintf(stderr, "kernel_launch: occupancy query reports %d workgroups per CU\n", per_cu);
        (void)hipGetLastError();
        grid = cus;
    }
    if (grid < 0) return;
    if (hipMemsetAsync((char*)d_ws + WS_CTL, 0, CTL_ZERO_BYTES, stream) != hipSuccess) return;
    Args a{};
    for (int i = 0; i < 30; ++i) a.in[i] = (const float*)d_in[i];
    a.out = (float*)d_out; a.ws = (unsigned char*)d_ws;
    for (int i = 0; i < 32; ++i) { const float p = powf(10000.0f, (float)i / 32.0f); a.inv_freq[i] = 1.0f / p; }
    hipLaunchKernelGGL(hybrid_fwd, dim3(grid), dim3(NWAVES * 64), LDS_BYTES, stream, a);
}
```

```cpp
#define PROBE 0
#define REP_MASK 0u
#include <hip/hip_runtime.h>
#include <hip/hip_bf16.h>
#include <cstdio>
#include <cstdint>
#include <cmath>

#ifndef PROBE
#define PROBE 0
#endif
#define DEVI __device__ __forceinline__
#define GAS __attribute__((address_space(1)))
#define LAS __attribute__((address_space(3)))
typedef unsigned short bf16_t;
typedef short bf16x8 __attribute__((ext_vector_type(8)));
typedef short s16x4 __attribute__((ext_vector_type(4)));
typedef float f32x2 __attribute__((ext_vector_type(2)));
typedef float f32x4 __attribute__((ext_vector_type(4)));
typedef float f32x16 __attribute__((ext_vector_type(16)));
typedef unsigned u32x2 __attribute__((ext_vector_type(2)));
typedef unsigned u32x4 __attribute__((ext_vector_type(4)));
typedef __bf16 bf16x2_t __attribute__((ext_vector_type(2)));
typedef GAS unsigned gu32;

#define LDS_WAIT() asm volatile("s_waitcnt lgkmcnt(0)" ::: "memory")
#define VM_WAIT() asm volatile("s_waitcnt vmcnt(0)" ::: "memory")
#define RLX_AGENT __ATOMIC_RELAXED, __HIP_MEMORY_SCOPE_AGENT

DEVI unsigned pk2(float lo, float hi) { f32x2 v = {lo, hi}; bf16x2_t b = __builtin_convertvector(v, bf16x2_t); return __builtin_bit_cast(unsigned, b); }
DEVI float bflo(unsigned u) { return __uint_as_float(u << 16); }
DEVI float bfhi(unsigned u) { return __uint_as_float(u & 0xffff0000u); }
DEVI f32x4 unpack4(u32x2 w) { return (f32x4){bflo(w.x), bfhi(w.x), bflo(w.y), bfhi(w.y)}; }
DEVI u32x2 pack4(f32x4 v) { u32x2 w; w.x = pk2(v[0], v[1]); w.y = pk2(v[2], v[3]); return w; }
DEVI float sigmoid_f(float x) { return __builtin_amdgcn_rcpf(1.0f + __expf(-x)); }
DEVI const char* sgpr_ptr(const char* p) { const unsigned long long u = (unsigned long long)p; const unsigned lo = (unsigned)__builtin_amdgcn_readfirstlane((int)(unsigned)u), hi = (unsigned)__builtin_amdgcn_readfirstlane((int)(unsigned)(u >> 32)); return (const char*)(((unsigned long long)hi << 32) | lo); }
DEVI float wave_sum(float v) {
#pragma unroll
    for (int o = 1; o < 64; o <<= 1) v += __shfl_xor(v, o);
    return v;
}

namespace pg8 {
constexpr int BM = 256, BK = 64, HALF = 128, HTB = HALF * BK * 2  , STAGE_BYTES = 8 * HTB;
DEVI int lds_byte(int r, int c) { const int st = (r >> 4) * 2 + (c >> 5), rr = r & 15, cc = c & 31, ob = rr * 64 + cc * 2; return st * 1024 + (ob ^ (((ob >> 9) & 1) << 5)); }
DEVI void stage_rc(int b, int& R, int& C) { const int st = b / 1024, sb = b % 1024, swz = sb ^ (((sb >> 9) & 1) << 5); R = (st >> 1) * 16 + swz / 64; C = (st & 1) * 32 + (swz % 64) / 2; }
struct Unit { int pm, pn, e, v; };

template <class P>
DEVI void gemm_phase(LAS unsigned char* lds, const P& S) {
    int tid = threadIdx.x; asm volatile("" : "+v"(tid));
    const int wid = __builtin_amdgcn_readfirstlane(tid >> 6), lane = tid & 63, wr = wid >> 2, wc = wid & 3, fr = lane & 15, fq = lane >> 4;
    const int nt = S.K / BK;
    int Rp[2], Cp[2]; unsigned voffB[2];
#pragma unroll
    for (int i = 0; i < 2; ++i) { stage_rc(tid * 16 + i * 8192, Rp[i], Cp[i]); voffB[i] = (unsigned)Rp[i] * S.ldb + (unsigned)Cp[i] * 2u; }
    const size_t hstepB = (size_t)HALF * S.ldb;
    const unsigned ldsw = (unsigned)wid * 1024u;
    const int aoff = lds_byte(wr * 64 + fr, fq * 8), boff = lds_byte(wc * 32 + fr, fq * 8);
    const char* const Abase = S.A;
#define PG8_SA(b, h) (((b) * 2 + (h)) * HTB)
#define PG8_SB(b, h) ((4 + (b) * 2 + (h)) * HTB)
#define PG8_STAGE_A(bufoff, ao, sp) do { _Pragma("unroll") for (int _i = 0; _i < 2; ++_i) \
        __builtin_amdgcn_global_load_lds((const unsigned*)((sp) + (ao)[_i]), (LAS unsigned*)(lds + (bufoff) + ldsw + _i * 8192), 16, 0, 0); } while (0)
#define PG8_PIN(p) do { (p) = sgpr_ptr(p); asm volatile("" : "+s"(p)); } while (0)
#define PG8_STAGE_B(bufoff, bp) do { _Pragma("unroll") for (int _i = 0; _i < 2; ++_i) \
        __builtin_amdgcn_global_load_lds((const unsigned*)((bp) + voffB[_i]), (LAS unsigned*)(lds + (bufoff) + ldsw + _i * 8192), 16, 0, 0); } while (0)
#define PG8_LDA(dst, b, h) do { _Pragma("unroll") for (int m = 0; m < 4; ++m) _Pragma("unroll") for (int k = 0; k < 2; ++k) dst[m][k] = *(const LAS bf16x8*)(lds + PG8_SA(b, h) + aoff + m * 2048 + k * 1024); } while (0)
#define PG8_LDB(dst, b, h) do { _Pragma("unroll") for (int n = 0; n < 2; ++n) _Pragma("unroll") for (int k = 0; k < 2; ++k) dst[n][k] = *(const LAS bf16x8*)(lds + PG8_SB(b, h) + boff + n * 2048 + k * 1024); } while (0)
#define PG8_MMA(ai, bj, At, Bt) do { __builtin_amdgcn_s_setprio(1); _Pragma("unroll") for (int m = 0; m < 4; ++m) _Pragma("unroll") for (int n = 0; n < 2; ++n) _Pragma("unroll") for (int k = 0; k < 2; ++k) \
        acc[ai][bj][m][n] = __builtin_amdgcn_mfma_f32_16x16x32_bf16(Bt[n][k], At[m][k], acc[ai][bj][m][n], 0, 0, 0); __builtin_amdgcn_s_setprio(0); } while (0)
#define PG8_WAIT_V(n) asm volatile("s_waitcnt vmcnt(" #n ")" ::: "memory")
#define PG8_WAIT_L(n) asm volatile("s_waitcnt lgkmcnt(" #n ")" ::: "memory")
#define PG8_BAR __builtin_amdgcn_s_barrier()
#define PG8_SCHED __builtin_amdgcn_sched_barrier(0)
    Unit cur, nxt; int ui = 0;
    if (!S.next(0, cur)) return;
    f32x4 acc[2][2][4][2];
#pragma unroll
    for (int a = 0; a < 2; ++a)
#pragma unroll
        for (int b = 0; b < 2; ++b)
#pragma unroll
            for (int m = 0; m < 4; ++m)
#pragma unroll
                for (int n = 0; n < 2; ++n) acc[a][b][m][n] = (f32x4){0.f, 0.f, 0.f, 0.f};
    bf16x8 At[4][2], B0[2][2], B1[2][2];
    unsigned ac0[2], ac1[2], an0[2], an1[2];
#pragma unroll
    for (int i = 0; i < 2; ++i) { ac0[i] = S.a_off(cur, Rp[i]) + (unsigned)Cp[i] * 2u; ac1[i] = S.a_off(cur, Rp[i] + HALF) + (unsigned)Cp[i] * 2u; }
    const char* cB = S.Bt + S.b_off(cur);
    { const char* q0 = cB; const char* q1 = cB + hstepB; const char* q2 = Abase; const char* q3 = cB + 128; const char* q4 = Abase + 128; const char* q5 = cB + hstepB + 128;
      PG8_PIN(q0); PG8_PIN(q1); PG8_PIN(q2); PG8_PIN(q3); PG8_PIN(q4); PG8_PIN(q5);
    PG8_STAGE_B(PG8_SB(0, 0), q0); PG8_STAGE_B(PG8_SB(0, 1), q1); PG8_STAGE_A(PG8_SA(0, 0), ac0, q2); PG8_STAGE_A(PG8_SA(0, 1), ac1, q2);
    if (wr == 1) PG8_BAR;
    PG8_WAIT_V(2); PG8_BAR;
    PG8_STAGE_B(PG8_SB(1, 0), q3); PG8_STAGE_A(PG8_SA(1, 0), ac0, q4); PG8_STAGE_B(PG8_SB(1, 1), q5);
    PG8_WAIT_V(6); PG8_BAR; }
    for (;;) {
        const bool has_next = S.next(ui + 1, nxt);
        const char* nB = cB;
        if (has_next) {
#pragma unroll
            for (int i = 0; i < 2; ++i) { an0[i] = S.a_off(nxt, Rp[i]) + (unsigned)Cp[i] * 2u; an1[i] = S.a_off(nxt, Rp[i] + HALF) + (unsigned)Cp[i] * 2u; }
            nB = S.Bt + S.b_off(nxt);
        } else {
#pragma unroll
            for (int i = 0; i < 2; ++i) { an0[i] = ac0[i]; an1[i] = ac1[i]; }
        }
        for (int t = 0; t < nt; t += 2) {
            const bool last = (t == nt - 2);
            unsigned a20[2], a21[2];
#pragma unroll
            for (int i = 0; i < 2; ++i) { a20[i] = last ? an0[i] : ac0[i]; a21[i] = last ? an1[i] : ac1[i]; }
            const int k1 = (t + 1) * 128, k2 = last ? 0 : (t + 2) * 128;
            const char* b2 = last ? nB : cB + (size_t)(t + 2) * 128; const char* b3 = b2 + 128; const char* b2h = b2 + hstepB; const char* b3h = b3 + hstepB;
            const char* pa1 = Abase + k1; const char* pa2 = Abase + k2; const char* pa3 = pa2 + 128;
            PG8_PIN(b2); PG8_PIN(b3); PG8_PIN(b2h); PG8_PIN(b3h); PG8_PIN(pa1); PG8_PIN(pa2); PG8_PIN(pa3);
            PG8_LDB(B0, 0, 0); PG8_LDB(B1, 0, 1); PG8_SCHED; PG8_LDA(At, 0, 0); PG8_STAGE_A(PG8_SA(1, 1), ac1, pa1);
            PG8_WAIT_V(8); PG8_WAIT_L(0); PG8_BAR; PG8_MMA(0, 0, At, B0); PG8_MMA(0, 1, At, B1); PG8_BAR; PG8_SCHED;
            PG8_LDA(At, 0, 1); PG8_STAGE_B(PG8_SB(0, 0), b2); PG8_STAGE_B(PG8_SB(0, 1), b2h); PG8_STAGE_A(PG8_SA(0, 0), a20, pa2);
            PG8_WAIT_V(8); PG8_WAIT_L(0); PG8_BAR; PG8_MMA(1, 0, At, B0); PG8_MMA(1, 1, At, B1); PG8_BAR; PG8_SCHED;
            PG8_LDB(B0, 1, 0); PG8_LDB(B1, 1, 1); PG8_SCHED; PG8_LDA(At, 1, 0); PG8_STAGE_A(PG8_SA(0, 1), a21, pa2);
            PG8_WAIT_V(8); PG8_WAIT_L(0); PG8_BAR; PG8_MMA(0, 0, At, B0); PG8_MMA(0, 1, At, B1); PG8_BAR; PG8_SCHED;
            PG8_LDA(At, 1, 1); PG8_STAGE_B(PG8_SB(1, 0), b3); PG8_STAGE_B(PG8_SB(1, 1), b3h); PG8_STAGE_A(PG8_SA(1, 0), a20, pa3);
            PG8_WAIT_V(8); PG8_WAIT_L(0); PG8_BAR; PG8_MMA(1, 0, At, B0); PG8_MMA(1, 1, At, B1); PG8_BAR; PG8_SCHED;
        }
        if (wr == 0) PG8_BAR;
        S.epi(acc, cur, wr, wc, fr, fq);
        if (!has_next) break;
#pragma unroll
        for (int a = 0; a < 2; ++a)
#pragma unroll
            for (int b = 0; b < 2; ++b)
#pragma unroll
                for (int m = 0; m < 4; ++m)
#pragma unroll
                    for (int n = 0; n < 2; ++n) acc[a][b][m][n] = (f32x4){0.f, 0.f, 0.f, 0.f};
        cur = nxt; cB = nB; ++ui;
#pragma unroll
        for (int i = 0; i < 2; ++i) { ac0[i] = an0[i]; ac1[i] = an1[i]; }
        if (wr == 1) PG8_BAR;
    }
    PG8_WAIT_V(0);
    PG8_BAR;
#undef PG8_SA
#undef PG8_SB
#undef PG8_STAGE_A
#undef PG8_STAGE_B
#undef PG8_PIN
#undef PG8_LDA
#undef PG8_LDB
#undef PG8_MMA
#undef PG8_WAIT_V
#undef PG8_WAIT_L
#undef PG8_BAR
#undef PG8_SCHED
}
}
#define XB_TMO      128
#define XB_XCNT(j)  (256  + 64 * (j))
#define XB_XSUB(j)  (1280 + 64 * (j))
#define XB_XGEN(j)  (2304 + 64 * (j))
#define XB_TOP      3328
#define XB_TOPGEN   3392
#define XCD_BAR_WORDS 3456
#define XB_SPIN_CAP (1u << 18)

__device__ __forceinline__ unsigned xb_ld(unsigned* p)              { return __hip_atomic_load(p, __ATOMIC_RELAXED, __HIP_MEMORY_SCOPE_AGENT); }
__device__ __forceinline__ unsigned xb_add(unsigned* p, unsigned v) { return __hip_atomic_fetch_add(p, v, __ATOMIC_RELAXED, __HIP_MEMORY_SCOPE_AGENT); }
__device__ __forceinline__ unsigned xb_xcc_id() { return (unsigned)__builtin_amdgcn_s_getreg((3 << 11) | 20) & 0xFu; }
#define XB_SPIN(cond, bar) do { unsigned _sp = 0; while (cond) { __builtin_amdgcn_s_sleep(1); \
    if ((++_sp & 255u) == 0u) { if (xb_ld(&(bar)[XB_TMO])) break; if (_sp > XB_SPIN_CAP) { atomicAdd(&(bar)[XB_TMO], 1u); break; } } } } while (0)

struct XcdBarrier {
    unsigned* bar; unsigned x;
    volatile LAS unsigned* st;
};

__device__ __forceinline__ XcdBarrier xcd_barrier_post(unsigned* bar, volatile LAS unsigned* st) {
    XcdBarrier b; b.bar = bar; b.x = xb_xcc_id(); b.st = st;
    if (threadIdx.x == 0) (void)xb_add(&bar[XB_XCNT(b.x)], 1u);
    return b;
}
__device__ __forceinline__ void xcd_barrier_complete(unsigned* bar, unsigned x, unsigned& nloc, unsigned& nx) {
    const unsigned G = gridDim.x * gridDim.y * gridDim.z;
    unsigned sum, cnt, mine, sp = 0u;
    for (;;) {
        sum = 0u; cnt = 0u; mine = 0u;
#pragma unroll
        for (unsigned j = 0; j < 16; ++j) { const unsigned c = xb_ld(&bar[XB_XCNT(j)]); sum += c; cnt += (c > 0u) ? 1u : 0u; mine = (j == x) ? c : mine; }
        if (sum == G) break;
        __builtin_amdgcn_s_sleep(1);
        if ((++sp & 255u) == 0u) { if (xb_ld(&bar[XB_TMO])) break; if (sp > XB_SPIN_CAP) { atomicAdd(&bar[XB_TMO], 1u); break; } }
    }
    nloc = mine > 0u ? mine : 1u; nx = cnt > 0u ? cnt : 1u;
}

__device__ __forceinline__ void xcd_barrier(const XcdBarrier& b) {
    asm volatile("s_waitcnt vmcnt(0)" ::: "memory");
    __syncthreads();
    if (threadIdx.x == 0) {
        unsigned* bar = b.bar;
        __builtin_amdgcn_s_waitcnt(0);
        unsigned nloc = b.st[0], nx = b.st[1];
        if (nloc == 0u) { xcd_barrier_complete(bar, b.x, nloc, nx); b.st[0] = nloc; b.st[1] = nx; }
        const unsigned old = xb_add(&bar[XB_XSUB(b.x)], 1u);
        const unsigned gen = old / nloc;
        if (old + 1u == (gen + 1u) * nloc) {
            __builtin_amdgcn_fence(__ATOMIC_RELEASE, "agent");
            asm volatile("s_waitcnt vmcnt(0)" ::: "memory");
            const unsigned og = xb_add(&bar[XB_TOP], 1u);
            const unsigned tg = og / nx;
            if (og + 1u == (tg + 1u) * nx) xb_add(&bar[XB_TOPGEN], 1u);
            else XB_SPIN(xb_ld(&bar[XB_TOPGEN]) == tg, bar);
            __builtin_amdgcn_fence(__ATOMIC_ACQUIRE, "agent");
            xb_add(&bar[XB_XGEN(b.x)], 1u);
            asm volatile("s_waitcnt vmcnt(0)" ::: "memory");
        } else {
            XB_SPIN(xb_ld(&bar[XB_XGEN(b.x)]) == gen, bar);
            __builtin_amdgcn_fence(__ATOMIC_ACQUIRE, "agent");
            asm volatile("s_waitcnt vmcnt(0)" ::: "memory");
        }
    }
    __syncthreads();
}

constexpr int NTOK = 32768, DM = 1024, SEQ = 2048, NBATCH = 16, NEXP = 32, DEXP = 512, PLE = 256;
constexpr int NWIN = 2608, NWIN_PAD = 2816;
constexpr float EPS = 1e-6f;
constexpr float C2 = 0.125f * 1.4426950408889634f;
constexpr int NWAVES = 8;

constexpr size_t MiB = 1u << 20;
constexpr size_t WS_CTL = 0, CTL_ZERO_BYTES = 32768;
constexpr int CW_TMO = 0, CW_BAR = 4096;
constexpr size_t WS_RS0 = 1 * MiB;
constexpr size_t WS_RS1 = WS_RS0 + 131072;
constexpr size_t WS_RS2 = WS_RS1 + 131072;
constexpr size_t WS_ASGE = WS_RS2 + 131072;
constexpr size_t WS_ASGR = WS_ASGE + 262144;
constexpr size_t WS_ASGW = WS_ASGR + 262144;
constexpr size_t WS_TSLOT = WS_ASGW + 262144;
constexpr int NSLOT = 2 * NTOK, NSLOT_PAD = NSLOT + 256;
constexpr size_t WS_STOK = WS_TSLOT + 262144;
constexpr size_t WS_SW = WS_STOK + 266240;
constexpr size_t WS_SRS = WS_SW + 266240;
constexpr size_t WS_CNT = WS_SRS + 266240;
constexpr size_t WS_MTOT = WS_CNT + 32768;
constexpr size_t WS_CBP = WS_MTOT + 1024;
constexpr size_t WS_RW = WS_CBP + 65536;
constexpr size_t WS_CB = WS_RW + 393216;
constexpr size_t WS_W2T = WS_CB + 2048;
constexpr size_t WS_SSQ = 4 * MiB;
constexpr size_t WS_ROPE = 6 * MiB;
static_assert(WS_W2T + 2 * 64 * 256 * 2 <= WS_SSQ, "tables");
constexpr size_t WS_WPW1 = 16 * MiB, WS_WPW2 = 20 * MiB, WS_WIN = 22 * MiB, WS_WOUT = 28 * MiB, WS_WC1 = 30 * MiB, WS_WPP = 32 * MiB, WS_WPG = 33 * MiB;
constexpr size_t WS_WGU = 40 * MiB, WS_WDN = 104 * MiB;
constexpr size_t WS_HA = 136 * MiB, WS_HB = 200 * MiB, WS_PP = 264 * MiB, WS_PB = 328 * MiB;
constexpr size_t WS_YB = 344 * MiB, WS_HBUF = 473 * MiB;
constexpr size_t WS_U = 344 * MiB, WS_V = 408 * MiB;
constexpr size_t WS_Q = WS_PP, WS_KV = 344 * MiB, WS_O = 440 * MiB, WS_CP = WS_HA  , WS_GATES = 504 * MiB, WS_KC = 510 * MiB, WS_VC = 511 * MiB;
constexpr size_t WS_END = 538 * MiB;
constexpr size_t KVS = (size_t)NTOK * 256;

constexpr int RING_OFF = 0, RING_BYTES = 131072;
constexpr int LDSCTL_OFF = RING_BYTES;
constexpr int MISC_OFF = LDSCTL_OFF + 320;
constexpr int TAB_OFF = LDSCTL_OFF + 1024;
constexpr int SCR_OFF = LDSCTL_OFF + 4096;
constexpr int LDS_BYTES = 147456;

struct Args { const float* in[30]; float* out; unsigned char* ws; float inv_freq[32]; };
struct Frame {
    LAS unsigned char* lds;
    gu32* ctl;
    unsigned char* ws;
    int tid, lane, wave, vcu, G;
};
DEVI void wg_sync() { __syncthreads(); }

DEVI int perm32(int r) { return (r & ~31) | (((r >> 2) & 1) << 4) | (((r >> 3) & 3) << 2) | (r & 3); }
DEVI int rowmap(int mode, int half, int n) {
    if (mode == 0) return perm32(n);
    if (mode == 1) return perm32(256 * (n >> 7) + 128 * half + (n & 127));
    if (n < 2560) { const int hd = n >> 6, d = n & 63; return perm32(256 * (hd >> 2) + 128 * (d >> 5) + 32 * (hd & 3) + (d & 31)); }
    return perm32(n);
}
DEVI u32x4 pack8(const f32x4& a, const f32x4& b) { const u32x2 x = pack4(a), y = pack4(b); return (u32x4){x.x, x.y, y.x, y.y}; }
DEVI void p0_item(const float* W, int ld, int ncols, int K, const float* gain, bf16_t* dst, int mode, int half, LAS unsigned char* scr, int item, int lane) {
    const int nblk = (ncols + 63) >> 6, kb = item / nblk, nb = item % nblk, k0 = 64 * kb, n0 = 64 * nb;
    const int lr = lane >> 4, lc = 4 * (lane & 15);
    f32x4 v[16];
#pragma unroll
    for (int i = 0; i < 16; ++i) v[i] = (n0 + lc < ncols) ? *(const f32x4*)(W + (size_t)(k0 + 4 * i + lr) * ld + n0 + lc) : (f32x4){0.f, 0.f, 0.f, 0.f};
#pragma unroll
    for (int i = 0; i < 16; ++i) { const float g = gain ? gain[k0 + 4 * i + lr] : 1.0f; const f32x4 x = v[i] * g; *(LAS u32x2*)(scr + (4 * i + lr) * 136 + lc * 2) = pack4(x); }
    LDS_WAIT();
    const int c = lane & 7;
#pragma unroll
    for (int j = 0; j < 8; ++j) { const int n = (lane >> 3) + 8 * j; const LAS unsigned short* t = (const LAS unsigned short*)(scr + (8 * c) * 136 + n * 2);
        u32x4 o; o.x = (unsigned)t[0 * 68] | ((unsigned)t[1 * 68] << 16); o.y = (unsigned)t[2 * 68] | ((unsigned)t[3 * 68] << 16); o.z = (unsigned)t[4 * 68] | ((unsigned)t[5 * 68] << 16); o.w = (unsigned)t[6 * 68] | ((unsigned)t[7 * 68] << 16);
        if (n0 + n < ncols) *(u32x4*)(dst + (size_t)rowmap(mode, half, n0 + n) * K + k0 + 8 * c) = o; }
    LDS_WAIT();
}
DEVI void p0_load(f32x4 (&v)[16], const float* W, int ld, int ncols, int item, int lane) {
    const int nblk = (ncols + 63) >> 6, kb = item / nblk, nb = item % nblk, k0 = 64 * kb, n0 = 64 * nb, lr = lane >> 4, lc = 4 * (lane & 15);
#pragma unroll
    for (int i = 0; i < 16; ++i) v[i] = (n0 + lc < ncols) ? *(const f32x4*)(W + (size_t)(k0 + 4 * i + lr) * ld + n0 + lc) : (f32x4){0.f, 0.f, 0.f, 0.f};
}
DEVI void p0_finish(const f32x4 (&v)[16], int ncols, int K, const float* gain, bf16_t* dst, int mode, int half, LAS unsigned char* scr, int item, int lane) {
    const int nblk = (ncols + 63) >> 6, kb = item / nblk, nb = item % nblk, k0 = 64 * kb, n0 = 64 * nb, lr = lane >> 4, lc = 4 * (lane & 15);
#pragma unroll
    for (int i = 0; i < 16; ++i) { const float g = gain ? gain[k0 + 4 * i + lr] : 1.0f; const f32x4 x = v[i] * g; *(LAS u32x2*)(scr + (4 * i + lr) * 136 + lc * 2) = pack4(x); }
    LDS_WAIT();
    const int c = lane & 7;
#pragma unroll
    for (int j = 0; j < 8; ++j) { const int n = (lane >> 3) + 8 * j; const LAS unsigned short* t = (const LAS unsigned short*)(scr + (8 * c) * 136 + n * 2);
        u32x4 o; o.x = (unsigned)t[0 * 68] | ((unsigned)t[1 * 68] << 16); o.y = (unsigned)t[2 * 68] | ((unsigned)t[3 * 68] << 16); o.z = (unsigned)t[4 * 68] | ((unsigned)t[5 * 68] << 16); o.w = (unsigned)t[6 * 68] | ((unsigned)t[7 * 68] << 16);
        if (n0 + n < ncols) *(u32x4*)(dst + (size_t)rowmap(mode, half, n0 + n) * K + k0 + 8 * c) = o; }
    LDS_WAIT();
}
DEVI void prep_layer(const Frame& F, const Args& a, int L, int it0 = 0, int it1 = NEXP * 384, int wgi = -1, int nwg = 0, bool do_p = true) {
    LAS unsigned char* scr = F.lds + RING_OFF + F.wave * 16384;
    if (wgi < 0) { wgi = F.vcu; nwg = F.G; }
    const int gw = wgi * NWAVES + F.wave, NGW = nwg * NWAVES;
    const float* gf = a.in[4] + (size_t)L * DM;
    bf16_t* wgu = (bf16_t*)(F.ws + WS_WGU); bf16_t* wdn = (bf16_t*)(F.ws + WS_WDN);
#define PREP_SRC(it_) ((((it_) % 384) >> 7) == 0 ? a.in[25] + ((size_t)L * NEXP + (it_) / 384) * DM * DEXP : (((it_) % 384) >> 7) == 1 ? a.in[26] + ((size_t)L * NEXP + (it_) / 384) * DM * DEXP : a.in[27] + ((size_t)L * NEXP + (it_) / 384) * DEXP * DM)
    f32x4 vc[16], vn[16];
    int it = it0 + gw;
    if (it < it1) { const int wh = (it % 384) >> 7; p0_load(vc, PREP_SRC(it), wh == 2 ? DM : DEXP, wh == 2 ? DM : DEXP, it & 127, F.lane); }
    for (; it < it1; it += NGW) {
        const int itn = it + NGW;
        if (itn < it1) { const int wh = (itn % 384) >> 7; p0_load(vn, PREP_SRC(itn), wh == 2 ? DM : DEXP, wh == 2 ? DM : DEXP, itn & 127, F.lane); }
        { const int e = it / 384, wh = (it % 384) >> 7, item = it & 127;
          if (wh == 2) p0_finish(vc, DM, DEXP, nullptr, wdn + (size_t)e * 1024 * 512, 0, 0, scr, item, F.lane);
          else p0_finish(vc, DEXP, DM, gf, wgu + (size_t)e * 1024 * 1024, 1, wh, scr, item, F.lane); }
#pragma unroll
        for (int i = 0; i < 16; ++i) vc[i] = vn[i];
    }
#undef PREP_SRC
    if (!do_p) return;
    const float* p = a.in[1] + (size_t)L * NTOK * PLE; bf16_t* pb = (bf16_t*)(F.ws + WS_PB);
    const size_t n8 = (size_t)NTOK * PLE / 8;
#pragma unroll 4
    for (size_t i = (size_t)F.vcu * 512 + F.tid; i < n8; i += (size_t)F.G * 512) {
        const f32x4 v0 = *(const f32x4*)(p + i * 8), v1 = *(const f32x4*)(p + i * 8 + 4);
        u32x4 o; o.x = pk2(v0[0], v0[1]); o.y = pk2(v0[2], v0[3]); o.z = pk2(v1[0], v1[1]); o.w = pk2(v1[2], v1[3]);
        *(u32x4*)(pb + i * 8) = o; }
}
DEVI void p0_prologue(const Frame& F, const Args& a) {
    LAS unsigned char* scr = F.lds + RING_OFF + F.wave * 16384;
    const int gw = F.vcu * NWAVES + F.wave, NGW = F.G * NWAVES;
    unsigned char* ws = F.ws;
    const float* x = a.in[0];
    f32x4 na[4], nb[4];
#define XR(m_, j_) (((const f32x4*)(x + (size_t)(m_) * DM) + F.lane)[64 * (j_)])
    if (gw < NTOK) {
#pragma unroll
        for (int j = 0; j < 4; ++j) { na[j] = XR(gw, j); nb[j] = (gw + NGW < NTOK) ? XR(gw + NGW, j) : (f32x4){0.f, 0.f, 0.f, 0.f}; } }
    constexpr int I_PW1 = 16 * 16 * 2, I_PW2 = 16 * 16, I_WIN = 16 * 41, I_WOUT = 16 * 16, I_C1 = 32 * 4 * 2, I_PP = 4 * 16 * 2, I_PG = 16 * 16 * 2;
    constexpr int NIT = I_PW1 + I_PW2 + I_WIN + I_WOUT + I_C1 + I_PP + I_PG;
    for (int it = gw; it < NIT; it += NGW) {
        int r = it;
        if (r < I_PW1) { const int half = r / 256; p0_item(a.in[6] + half * 1024, 2048, 1024, DM, a.in[3], (bf16_t*)(ws + WS_WPW1), 1, half, scr, r % 256, F.lane); continue; } r -= I_PW1;
        if (r < I_PW2) { p0_item(a.in[12], DM, DM, DM, nullptr, (bf16_t*)(ws + WS_WPW2), 0, 0, scr, r, F.lane); continue; } r -= I_PW2;
        if (r < I_WIN) { p0_item(a.in[14], NWIN, NWIN, DM, a.in[3] + DM, (bf16_t*)(ws + WS_WIN), 2, 0, scr, r, F.lane); continue; } r -= I_WIN;
        if (r < I_WOUT) { p0_item(a.in[20], DM, DM, DM, nullptr, (bf16_t*)(ws + WS_WOUT), 0, 0, scr, r, F.lane); continue; } r -= I_WOUT;
        if (r < I_C1) { const int j = r / 128; p0_item(a.in[18] + (size_t)j * 2048 * 256, 256, 256, 2048, nullptr, (bf16_t*)(ws + WS_WC1) + (size_t)j * 256 * 2048, 0, 0, scr, r % 128, F.lane); continue; } r -= I_C1;
        if (r < I_PP) { const int L = r / 64; p0_item(a.in[28] + (size_t)L * PLE * DM, DM, DM, PLE, nullptr, (bf16_t*)(ws + WS_WPP) + (size_t)L * DM * PLE, 0, 0, scr, r % 64, F.lane); continue; } r -= I_PP;
        { const int L = r / 256; p0_item(a.in[29] + (size_t)L * DM * DM, DM, DM, DM, a.in[5] + (size_t)L * DM, (bf16_t*)(ws + WS_WPG) + (size_t)L * DM * DM, 0, 0, scr, r % 256, F.lane); }
    }
    { u32x4* z = (u32x4*)((bf16_t*)(ws + WS_WIN) + (size_t)2616 * DM); const int n16 = (NWIN_PAD - 2616) * DM / 8;
      for (int i = F.vcu * 512 + F.tid; i < n16; i += F.G * 512) z[i] = (u32x4){0u, 0u, 0u, 0u};
      u32x4* z2 = (u32x4*)((bf16_t*)(ws + WS_WIN) + (size_t)2600 * DM);
      for (int i = F.vcu * 512 + F.tid; i < 8 * DM / 8; i += F.G * 512) z2[i] = (u32x4){0u, 0u, 0u, 0u}; }
    { bf16_t* rw = (bf16_t*)(ws + WS_RW);
      for (int i = F.vcu * 512 + F.tid; i < 2 * 48 * 1024; i += F.G * 512) {
          const int L = i / (48 * 1024), j = (i / 1024) % 48, k = i & 1023;
          float w = 0.f;
          if (j < 4) w = a.in[21][((size_t)L * DM + k) * 4 + j]; else if (j < 36) w = a.in[23][((size_t)L * DM + k) * 32 + (j - 4)];
          w *= a.in[4][(size_t)L * DM + k];
          const unsigned hi = pk2(w, 0.f) & 0xffffu; const float lo = w - bflo(hi);
          rw[((size_t)(L * 2 + 0) * 48 + j) * 1024 + k] = (bf16_t)hi; rw[((size_t)(L * 2 + 1) * 48 + j) * 1024 + k] = (bf16_t)(pk2(lo, 0.f) & 0xffffu); } }
    { bf16_t* w2t = (bf16_t*)(ws + WS_W2T);
      for (int i = F.vcu * 512 + F.tid; i < 2 * 64 * 256; i += F.G * 512) { const int j = i >> 14, n = (i >> 8) & 63, k = i & 255; w2t[i] = (bf16_t)(pk2(a.in[19][(size_t)(j * 256 + k) * 64 + n], 0.f) & 0xffffu); } }
    for (int it = gw; it < 2 * 4 * 32; it += NGW) {
        const int j = it >> 7, cg = (it >> 5) & 3, kr = it & 31;
        const float* pe = a.in[17] + (size_t)j * 2048 + kr * 64; const float* w1 = a.in[18] + ((size_t)j * 2048 + kr * 64) * 256 + cg * 64 + F.lane;
        float s = 0.f;
#pragma unroll 16
        for (int k = 0; k < 64; ++k) s += pe[k] * w1[(size_t)k * 256];
        ((float*)(ws + WS_CBP))[(j * 32 + kr) * 256 + cg * 64 + F.lane] = s; }
    { float* rope = (float*)(ws + WS_ROPE); const int* pos = (const int*)a.in[2];
      const int st = F.vcu * 512 + F.tid, SNT = F.G * 512;
      for (int i0 = st; i0 < NTOK * 32; i0 += 8 * SNT) {
          int pv_[8];
#pragma unroll
          for (int u = 0; u < 8; ++u) { const int i = i0 + u * SNT; pv_[u] = pos[(i < NTOK * 32 ? i : st) >> 5]; }
#pragma unroll
          for (int u = 0; u < 8; ++u) { const int i = i0 + u * SNT; if (i < NTOK * 32) {
              const int row = i >> 5, fi = i & 31;
              const float ang = (float)pv_[u] * a.inv_freq[fi];
              const double rev = (double)ang * 0.15915494309189533577; const float fr = (float)(rev - floor(rev));
              rope[(size_t)row * 64 + fi] = __builtin_amdgcn_cosf(fr); rope[(size_t)row * 64 + 32 + fi] = __builtin_amdgcn_sinf(fr); } } } }
    { bf16_t* ha = (bf16_t*)(ws + WS_HA); float* rs0 = (float*)(ws + WS_RS0);
      f32x4 va[4], vb[4];
      for (int m = gw; m < NTOK; m += 2 * NGW) {
#pragma unroll
          for (int j = 0; j < 4; ++j) { va[j] = na[j]; vb[j] = nb[j]; }
          if (m + 2 * NGW < NTOK) {
#pragma unroll
              for (int j = 0; j < 4; ++j) { na[j] = XR(m + 2 * NGW, j); nb[j] = (m + 3 * NGW < NTOK) ? XR(m + 3 * NGW, j) : (f32x4){0.f, 0.f, 0.f, 0.f}; } }
          float sa = 0.f, sb = 0.f;
#pragma unroll
          for (int j = 0; j < 4; ++j) { sa += (va[j][0] * va[j][0] + va[j][1] * va[j][1]) + (va[j][2] * va[j][2] + va[j][3] * va[j][3]); sb += (vb[j][0] * vb[j][0] + vb[j][1] * vb[j][1]) + (vb[j][2] * vb[j][2] + vb[j][3] * vb[j][3]); }
          sa = wave_sum(sa); sb = wave_sum(sb);
          u32x2* oa = (u32x2*)(ha + (size_t)m * DM) + F.lane; u32x2* ob = (u32x2*)(ha + (size_t)(m + NGW) * DM) + F.lane;
#pragma unroll
          for (int j = 0; j < 4; ++j) { oa[64 * j] = pack4(va[j]); if (m + NGW < NTOK) ob[64 * j] = pack4(vb[j]); }
          if (F.lane == 0) { rs0[m] = 1.0f / sqrtf(sa * (1.0f / DM) + EPS); if (m + NGW < NTOK) rs0[m + NGW] = 1.0f / sqrtf(sb * (1.0f / DM) + EPS); } }
#undef XR
      }

}

using pg8::Unit;
typedef f32x4 AccT[2][2][4][2];
struct ProbBase { const char* A; const char* Bt; int K; unsigned ldb; int G, c; };

#define EPI_FENCE() asm volatile("" ::: "memory")
struct ProbPw1 : ProbBase {
    const float* __restrict__ rstd; const float* __restrict__ bias; bf16_t* __restrict__ U;
    DEVI bool next(int i, Unit& u) const { const int L = i * G + c; if (L >= 128 * 8) return false; u.pm = L >> 3; u.pn = L & 7; u.e = 0; u.v = 256; return true; }
    DEVI unsigned a_off(const Unit& u, int R) const { return (unsigned)(u.pm * 256 + R) * 2048u; }
    DEVI size_t b_off(const Unit& u) const { return (size_t)u.pn * 256 * ldb; }
    DEVI void epi(const AccT& acc, const Unit& u, int wr, int wc, int fr, int fq) const {
        const int q0 = 32 * wc + 8 * fq;
        f32x4 ba[2], bg[2]; float rs[2][4];
#pragma unroll
        for (int n = 0; n < 2; ++n) { ba[n] = *(const f32x4*)(bias + 128 * u.pn + q0 + 4 * n); bg[n] = *(const f32x4*)(bias + 1024 + 128 * u.pn + q0 + 4 * n); }
#pragma unroll
        for (int ai = 0; ai < 2; ++ai)
#pragma unroll
            for (int m = 0; m < 4; ++m) rs[ai][m] = rstd[u.pm * 256 + 128 * ai + 64 * wr + 16 * m + fr];
        EPI_FENCE();
#pragma unroll
        for (int ai = 0; ai < 2; ++ai)
#pragma unroll
            for (int m = 0; m < 4; ++m) {
                const int row = u.pm * 256 + 128 * ai + 64 * wr + 16 * m + fr;
                f32x4 o[2];
#pragma unroll
                for (int n = 0; n < 2; ++n) {
                    const f32x4 av = acc[ai][0][m][n] * rs[ai][m] + ba[n], gv = acc[ai][1][m][n] * rs[ai][m] + bg[n];
#pragma unroll
                    for (int j = 0; j < 4; ++j) o[n][j] = av[j] * sigmoid_f(gv[j]); }
                *(u32x4*)(U + (size_t)row * DM + 128 * u.pn + q0) = pack8(o[0], o[1]); }
    }
};
constexpr int PREP1_SPLIT = 16 * 384;
constexpr int PP_SPLIT = 288;
struct ProbPP : ProbBase {
    bf16_t* O; int tail_lo, base, cnt;
    DEVI bool next(int i, Unit& u) const { if (c < tail_lo) return false; int L = i * (G - tail_lo) + (c - tail_lo); if (L >= cnt) return false; L += base; u.pm = L >> 2; u.pn = L & 3; u.e = 0; u.v = 256; return true; }
    DEVI unsigned a_off(const Unit& u, int R) const { return (unsigned)(u.pm * 256 + R) * 512u; }
    DEVI size_t b_off(const Unit& u) const { return (size_t)u.pn * 256 * ldb; }
    DEVI void epi(const AccT& acc, const Unit& u, int wr, int wc, int fr, int fq) const {
#pragma unroll
        for (int ai = 0; ai < 2; ++ai)
#pragma unroll
            for (int m = 0; m < 4; ++m) {
                const int row = u.pm * 256 + 128 * ai + 64 * wr + 16 * m + fr;
#pragma unroll
                for (int bj = 0; bj < 2; ++bj) *(u32x4*)(O + (size_t)row * DM + 256 * u.pn + 128 * bj + 32 * wc + 8 * fq) = pack8(acc[ai][bj][m][0], acc[ai][bj][m][1]); }
    }
};
struct ProbRes : ProbBase {
    const bf16_t* __restrict__ RES; bf16_t* __restrict__ OUT; const float* __restrict__ bias;
    DEVI bool next(int i, Unit& u) const { const int L = i * G + c; if (L >= 128 * 4) return false; u.pm = L >> 2; u.pn = L & 3; u.e = 0; u.v = 256; return true; }
    DEVI unsigned a_off(const Unit& u, int R) const { return (unsigned)(u.pm * 256 + R) * 2048u; }
    DEVI size_t b_off(const Unit& u) const { return (size_t)u.pn * 256 * ldb; }
    DEVI void epi(const AccT& acc, const Unit& u, int wr, int wc, int fr, int fq) const {
        const int col0 = 256 * u.pn + 32 * wc + 8 * fq;
        f32x4 bv[2][2];
#pragma unroll
        for (int bj = 0; bj < 2; ++bj)
#pragma unroll
            for (int n = 0; n < 2; ++n) bv[bj][n] = bias ? *(const f32x4*)(bias + col0 + 128 * bj + 4 * n) : (f32x4){0.f, 0.f, 0.f, 0.f};
#ifdef EPI_REPS
        for (int rep_ = 0; rep_ < EPI_REPS; ++rep_)
#endif
#pragma unroll
        for (int ai = 0; ai < 2; ++ai) {
            u32x4 r[4][2];
#pragma unroll
            for (int m = 0; m < 4; ++m) { const size_t o = (size_t)(u.pm * 256 + 128 * ai + 64 * wr + 16 * m + fr) * DM + col0;
#pragma unroll
                for (int bj = 0; bj < 2; ++bj) r[m][bj] = *(const u32x4*)(RES + o + 128 * bj); }
            EPI_FENCE();
#pragma unroll
            for (int m = 0; m < 4; ++m) { const size_t o = (size_t)(u.pm * 256 + 128 * ai + 64 * wr + 16 * m + fr) * DM + col0;
#pragma unroll
                for (int bj = 0; bj < 2; ++bj) { const u32x4 rr = r[m][bj];
                    *(u32x4*)(OUT + o + 128 * bj) = pack8(unpack4((u32x2){rr.x, rr.y}) + acc[ai][bj][m][0] + bv[bj][0], unpack4((u32x2){rr.z, rr.w}) + acc[ai][bj][m][1] + bv[bj][1]); } }
            EPI_FENCE();
        }
    }
};
struct ProbPle : ProbBase {
    const bf16_t* __restrict__ H2; const bf16_t* __restrict__ PPp; const float* __restrict__ rstd; bf16_t* __restrict__ OUTB; float* __restrict__ OUTF; float* __restrict__ ssq; int last;
    DEVI bool next(int i, Unit& u) const { const int L = i * G + c; if (L >= 128 * 4) return false; u.pm = L >> 2; u.pn = L & 3; u.e = 0; u.v = 256; return true; }
    DEVI unsigned a_off(const Unit& u, int R) const { return (unsigned)(u.pm * 256 + R) * 2048u; }
    DEVI size_t b_off(const Unit& u) const { return (size_t)u.pn * 256 * ldb; }
    DEVI void epi(const AccT& acc, const Unit& u, int wr, int wc, int fr, int fq) const {
        const int col0 = 256 * u.pn + 32 * wc + 8 * fq;
#pragma unroll
        for (int ai = 0; ai < 2; ++ai) {
            u32x4 h[4][2], q[4][2]; float rs[4];
#pragma unroll
            for (int m = 0; m < 4; ++m) { const int row = u.pm * 256 + 128 * ai + 64 * wr + 16 * m + fr; const size_t o = (size_t)row * DM + col0; rs[m] = rstd[row];
#pragma unroll
                for (int bj = 0; bj < 2; ++bj) { h[m][bj] = *(const u32x4*)(H2 + o + 128 * bj); q[m][bj] = *(const u32x4*)(PPp + o + 128 * bj); } }
            EPI_FENCE();
#pragma unroll
            for (int m = 0; m < 4; ++m) { const int row = u.pm * 256 + 128 * ai + 64 * wr + 16 * m + fr; const size_t o = (size_t)row * DM + col0; float ss = 0.f;
#pragma unroll
                for (int bj = 0; bj < 2; ++bj) { f32x4 v[2];
#pragma unroll
                    for (int n = 0; n < 2; ++n) {
                        const f32x4 h2 = unpack4(n ? (u32x2){h[m][bj].z, h[m][bj].w} : (u32x2){h[m][bj].x, h[m][bj].y}), pp = unpack4(n ? (u32x2){q[m][bj].z, q[m][bj].w} : (u32x2){q[m][bj].x, q[m][bj].y}), a4 = acc[ai][bj][m][n] * rs[m];
#pragma unroll
                        for (int j = 0; j < 4; ++j) v[n][j] = h2[j] + sigmoid_f(a4[j]) * pp[j];
                        if (!last) ss += (v[n][0] * v[n][0] + v[n][1] * v[n][1]) + (v[n][2] * v[n][2] + v[n][3] * v[n][3]); }
                    if (last) { *(f32x4*)(OUTF + o + 128 * bj) = v[0]; *(f32x4*)(OUTF + o + 128 * bj + 4) = v[1]; }
                    else *(u32x4*)(OUTB + o + 128 * bj) = pack8(v[0], v[1]); }
                if (!last) { ss += __shfl_xor(ss, 16); ss += __shfl_xor(ss, 32); if (fq == 0) ssq[(size_t)row * 16 + u.pn * 4 + wc] = ss; } }
            EPI_FENCE();
        }
    }
};
struct ProbGateUp : ProbBase {
    const LAS int* tab_row; const LAS int* tab_ev; int nblk;
    const LAS float* lrs;
    const LAS unsigned* goff;
    const float* __restrict__ slot_rs; bf16_t* __restrict__ HBUF;
    DEVI bool next(int i, Unit& u) const { const int L = i * G + c; if (L >= nblk * 4) return false; const int b = L >> 2; u.pn = L & 3; u.pm = tab_row[b]; const int ev = tab_ev[b]; u.e = (ev >> 9) | (i << 8); u.v = ev & 511; return true; }
    DEVI unsigned a_off(const Unit& u, int R) const { return goff[(u.e >> 8) * 256 + R]; }
    DEVI size_t b_off(const Unit& u) const { return ((size_t)(u.e & 255) * 1024 + (size_t)u.pn * 256) * ldb; }
    DEVI void epi(const AccT& acc, const Unit& u, int wr, int wc, int fr, int fq) const {
        float rsv[2][4];
#pragma unroll
        for (int ai = 0; ai < 2; ++ai)
#pragma unroll
            for (int m = 0; m < 4; ++m) rsv[ai][m] = lrs[(u.e >> 8) * 256 + 128 * ai + 64 * wr + 16 * m + fr];
#pragma unroll
        for (int ai = 0; ai < 2; ++ai)
#pragma unroll
            for (int m = 0; m < 4; ++m) {
                const int R = 128 * ai + 64 * wr + 16 * m + fr;
                if (R < u.v) { const int slot = u.pm + R; const float rs = rsv[ai][m];
                    f32x4 o[2];
#pragma unroll
                    for (int n = 0; n < 2; ++n) { const f32x4 g = acc[ai][0][m][n] * rs, up = acc[ai][1][m][n] * rs;
#pragma unroll
                        for (int j = 0; j < 4; ++j) o[n][j] = g[j] * sigmoid_f(g[j]) * up[j]; }
                    *(u32x4*)(HBUF + (size_t)slot * DEXP + 128 * u.pn + 32 * wc + 8 * fq) = pack8(o[0], o[1]); } }
    }
};
struct ProbDown : ProbBase {
    const LAS int* tab_row; const LAS int* tab_ev; int nblk;
    const float* __restrict__ slot_w; bf16_t* __restrict__ YB;
    const LAS float* lsw;
    DEVI bool next(int i, Unit& u) const { const int L = i * G + c; if (L >= nblk * 4) return false; const int b = L >> 2; u.pn = L & 3; u.pm = tab_row[b]; const int ev = tab_ev[b]; u.e = (ev >> 9) | (i << 8); u.v = ev & 511; return true; }
    DEVI unsigned a_off(const Unit& u, int R) const { return (unsigned)(u.pm + R) * 1024u; }
    DEVI size_t b_off(const Unit& u) const { return ((size_t)(u.e & 255) * 1024 + (size_t)u.pn * 256) * ldb; }
    DEVI void epi(const AccT& acc, const Unit& u, int wr, int wc, int fr, int fq) const {
        float wv[2][4];
#pragma unroll
        for (int ai = 0; ai < 2; ++ai)
#pragma unroll
            for (int m = 0; m < 4; ++m) wv[ai][m] = lsw[(u.e >> 8) * 256 + 128 * ai + 64 * wr + 16 * m + fr];
#pragma unroll
        for (int ai = 0; ai < 2; ++ai)
#pragma unroll
            for (int m = 0; m < 4; ++m) {
                const int R = 128 * ai + 64 * wr + 16 * m + fr;
                if (R < u.v) { const int slot = u.pm + R; const float w = wv[ai][m];
#pragma unroll
                    for (int bj = 0; bj < 2; ++bj) *(u32x4*)(YB + (size_t)slot * DM + 256 * u.pn + 128 * bj + 32 * wc + 8 * fq) = pack8(acc[ai][bj][m][0] * w, acc[ai][bj][m][1] * w); } }
    }
};
struct ProbWin : ProbBase {
    const float* __restrict__ rstd; const float* __restrict__ rope; const float* __restrict__ qnorm; const float* __restrict__ knorm; bf16_t* __restrict__ Q; bf16_t* __restrict__ KV; float* __restrict__ gates;
    const LAS float* lrs;
    DEVI bool next(int i, Unit& u) const { const int L = i * G + c; if (L >= 128 * 11) return false; u.pm = L / 11; u.pn = (int)((0xA9758634210ull >> (4 * (L % 11))) & 15ull); u.e = i; u.v = 256; return true; }
    DEVI unsigned a_off(const Unit& u, int R) const { return (unsigned)(u.pm * 256 + R) * 2048u; }
    DEVI size_t b_off(const Unit& u) const { return (size_t)u.pn * 256 * ldb; }
    DEVI void epi(const AccT& acc, const Unit& u, int wr, int wc, int fr, int fq) const {
        const int pn = u.pn;
        float rsv[2][4];
#pragma unroll
        for (int ai = 0; ai < 2; ++ai)
#pragma unroll
            for (int m = 0; m < 4; ++m) rsv[ai][m] = lrs[u.e * 256 + 128 * ai + 64 * wr + 16 * m + fr];
        if (pn == 10) {
            EPI_FENCE();
            if (wc < 2) {
#pragma unroll
                for (int ai = 0; ai < 2; ++ai)
#pragma unroll
                    for (int m = 0; m < 4; ++m) {
                        const int row = u.pm * 256 + 128 * ai + 64 * wr + 16 * m + fr; const float rs = rsv[ai][m];
#pragma unroll
                        for (int n = 0; n < 2; ++n) if (wc == 0 || fq < 2) { const f32x4 a4 = acc[ai][0][m][n] * rs; f32x4 o;
#pragma unroll
                            for (int j = 0; j < 4; ++j) o[j] = sigmoid_f(a4[j]);
                            *(f32x4*)(gates + (size_t)row * 48 + 32 * wc + 8 * fq + 4 * n) = o; } } }
            return;
        }
        const bool isq = pn < 4, dorope = isq || pn == 6 || pn == 8;
        const float* gvec = isq ? qnorm : (knorm + (pn == 6 ? 64 : 128));
        f32x4 g1[2], g2[2];
#pragma unroll
        for (int n = 0; n < 2; ++n) { g1[n] = *(const f32x4*)(gvec + 8 * fq + 4 * n); g2[n] = *(const f32x4*)(gvec + 32 + 8 * fq + 4 * n); }
        const float oscale = isq ? C2 : 1.0f;
#pragma unroll
        for (int g = 0; g < 8; ++g) { const int ai = g >> 2, m = g & 3;
            const int row = u.pm * 256 + 128 * ai + 64 * wr + 16 * m + fr; const float rs = rsv[ai][m];
            f32x4 cs[2], sn[2];
            if (dorope) { const size_t ro = (size_t)row * 64 + 8 * fq;
#pragma unroll
                for (int n = 0; n < 2; ++n) { cs[n] = *(const f32x4*)(rope + ro + 4 * n); sn[n] = *(const f32x4*)(rope + ro + 32 + 4 * n); } }
            f32x4 x1[2], x2[2];
#pragma unroll
            for (int n = 0; n < 2; ++n) { x1[n] = acc[ai][0][m][n] * rs; x2[n] = acc[ai][1][m][n] * rs; }
            if (dorope) {
                float ss = 0.f;
#pragma unroll
                for (int n = 0; n < 2; ++n)
#pragma unroll
                    for (int j = 0; j < 4; ++j) ss += x1[n][j] * x1[n][j] + x2[n][j] * x2[n][j];
                ss += __shfl_xor(ss, 16); ss += __shfl_xor(ss, 32);
                const float inv = 1.0f / sqrtf(ss * (1.0f / 64.0f) + EPS);
#pragma unroll
                for (int n = 0; n < 2; ++n) {
                    const f32x4 y1 = x1[n] * inv * g1[n], y2 = x2[n] * inv * g2[n];
                    x1[n] = (y1 * cs[n] - y2 * sn[n]) * oscale; x2[n] = (y2 * cs[n] + y1 * sn[n]) * oscale; } }
            bf16_t* dst;
            if (isq) dst = Q + (size_t)row * DM + (4 * pn + wc) * 64;
            else { const int b = row >> 11, t = row & 2047; dst = KV + (size_t)(pn - 4) * KVS + ((size_t)(b * 4 + wc) * SEQ + t) * 64; }
            *(u32x4*)(dst + 8 * fq) = pack8(x1[0], x1[1]); *(u32x4*)(dst + 32 + 8 * fq) = pack8(x2[0], x2[1]);
        }
    }
};
struct ProbCmp : ProbBase {
    float* CP;
    DEVI bool next(int i, Unit& u) const { const int L = i * G + c; if (L >= 256) return false; u.e = L >> 7; u.pm = (L >> 2) & 31; u.v = L & 3; u.pn = 0; return true; }
    DEVI unsigned a_off(const Unit& u, int R) const { return (unsigned)u.e * (unsigned)(KVS * 2) + (unsigned)(u.pm * 256 + R) * 2048u + (unsigned)u.v * 1024u; }
    DEVI size_t b_off(const Unit& u) const { return (size_t)u.e * 256 * ldb + (size_t)u.v * 1024; }
    DEVI void epi(const AccT& acc, const Unit& u, int wr, int wc, int fr, int fq) const {
        float* base = CP + ((size_t)(u.e * 4 + u.v) * 8192) * 256;
#pragma unroll
        for (int ai = 0; ai < 2; ++ai)
#pragma unroll
            for (int m = 0; m < 4; ++m) {
                const int rho = u.pm * 256 + 128 * ai + 64 * wr + 16 * m + fr;
#pragma unroll
                for (int bj = 0; bj < 2; ++bj)
#pragma unroll
                    for (int n = 0; n < 2; ++n) *(f32x4*)(base + (size_t)rho * 256 + 128 * bj + 32 * wc + 8 * fq + 4 * n) = acc[ai][bj][m][n]; }
    }
};

#define CONV_BAR() asm volatile("s_waitcnt lgkmcnt(0)\n\ts_barrier" ::: "memory")
DEVI void conv_phase(const Frame& F, const Args& a) {
    const bf16_t* U = (const bf16_t*)(F.ws + WS_U); bf16_t* V = (bf16_t*)(F.ws + WS_V);
    LAS float* red = (LAS float*)(F.lds + SCR_OFF);
    LAS float* fin = red + 256;
    const int tid = F.tid, c0 = 2 * tid;
    f32x2 w2[31];
#pragma unroll
    for (int k = 0; k < 31; ++k) w2[k] = *(const f32x2*)(a.in[8] + (size_t)k * DM + c0);
    const f32x2 bdw = *(const f32x2*)(a.in[9] + c0), lg = *(const f32x2*)(a.in[10] + c0), lb = *(const f32x2*)(a.in[11] + c0);
    for (int ch = F.vcu; ch < 256; ch += F.G) {
        const int tokbase = ch * 128, t0 = tokbase & (SEQ - 1);
        const unsigned* Up = (const unsigned*)U + (size_t)tokbase * 512 + tid;
        unsigned win[46];
#pragma unroll
        for (int i = 0; i < 46; ++i) { const int rel = i - 30; win[i] = (rel >= 0 || t0 != 0) ? Up[(ptrdiff_t)rel * 512] : 0u; }
#pragma unroll
        for (int s = 0; s < 8; ++s) {
            unsigned nxt[16];
            if (s < 7) {
#pragma unroll
                for (int i = 0; i < 16; ++i) nxt[i] = Up[(ptrdiff_t)(16 * (s + 1) + i) * 512]; }
            f32x2 y[16];
#pragma unroll
            for (int tt = 0; tt < 16; ++tt) y[tt] = bdw;
#pragma unroll
            for (int rr = 0; rr < 46; ++rr) {
                const f32x2 v = {bflo(win[rr]), bfhi(win[rr])};
#pragma unroll
                for (int tt = 0; tt < 16; ++tt) { const int k = rr - tt; if (k >= 0 && k <= 30) y[tt] += w2[k] * v; }
            }
            float v16[16];
            { const bool h5 = (F.lane & 32) != 0;
#pragma unroll
              for (int i = 0; i < 16; ++i) { const float sA = y[i][0] + y[i][1], sB = y[i][0] * y[i][0] + y[i][1] * y[i][1]; const float keep = h5 ? sB : sA, send = h5 ? sA : sB; v16[i] = keep + __shfl_xor(send, 32); } }
            float v8[8], v4[4], v2[2], v1r;
            { const bool h = (F.lane & 16) != 0;
#pragma unroll
              for (int i = 0; i < 8; ++i) { const float keep = h ? v16[i + 8] : v16[i], send = h ? v16[i] : v16[i + 8]; v8[i] = keep + __shfl_xor(send, 16); } }
            { const bool h = (F.lane & 8) != 0;
#pragma unroll
              for (int i = 0; i < 4; ++i) { const float keep = h ? v8[i + 4] : v8[i], send = h ? v8[i] : v8[i + 4]; v4[i] = keep + __shfl_xor(send, 8); } }
            { const bool h = (F.lane & 4) != 0;
#pragma unroll
              for (int i = 0; i < 2; ++i) { const float keep = h ? v4[i + 2] : v4[i], send = h ? v4[i] : v4[i + 2]; v2[i] = keep + __shfl_xor(send, 4); } }
            { const bool h = (F.lane & 2) != 0; const float keep = h ? v2[1] : v2[0], send = h ? v2[0] : v2[1]; v1r = keep + __shfl_xor(send, 2); }
            v1r += __shfl_xor(v1r, 1);
            CONV_BAR();
            if ((F.lane & 1) == 0) red[F.wave * 32 + (F.lane >> 1)] = v1r;
            CONV_BAR();
            if (tid < 16) { float t = 0.f, q = 0.f;
#pragma unroll
                for (int w = 0; w < 8; ++w) { t += red[w * 32 + tid]; q += red[w * 32 + 16 + tid]; }
                const float mean = t * (1.0f / DM), var = q * (1.0f / DM) - mean * mean;
                fin[tid] = mean; fin[16 + tid] = 1.0f / sqrtf(var + EPS); }
            CONV_BAR();
#pragma unroll
            for (int tt = 0; tt < 16; ++tt) {
                const float mean = fin[tt], rstd = fin[16 + tt];
                const float z0 = (y[tt][0] - mean) * rstd * lg[0] + lb[0], z1 = (y[tt][1] - mean) * rstd * lg[1] + lb[1];
                *(unsigned*)(V + (size_t)(tokbase + 16 * s + tt) * DM + c0) = pk2(z0 * sigmoid_f(z0), z1 * sigmoid_f(z1)); }
            if (s < 7) {
#pragma unroll
                for (int i = 0; i < 30; ++i) win[i] = win[i + 16];
#pragma unroll
                for (int i = 0; i < 16; ++i) win[30 + i] = nxt[i]; }
        }
    }
}
DEVI void router_phase(const Frame& F, const Args& a, int L, const bf16_t* H) {
    const bf16_t* rw = (const bf16_t*)(F.ws + WS_RW) + (size_t)(L * 2) * 48 * 1024;
    float* rs1 = (float*)(F.ws + WS_RS1); int* asg_e = (int*)(F.ws + WS_ASGE); int* asg_r = (int*)(F.ws + WS_ASGR); float* asg_w = (float*)(F.ws + WS_ASGW); int* cnt = (int*)(F.ws + WS_CNT);
    LAS unsigned char* wst = F.lds + RING_OFF;
    LAS float* lg = (LAS float*)(F.lds + RING_OFF + 65536) + F.wave * (16 * 48);
    LAS int* elist = (LAS int*)(F.lds + RING_OFF + 98304);
    LAS float* bias = (LAS float*)(F.lds + RING_OFF + 98304 + 1024);
    if (F.tid < 4) bias[F.tid] = a.in[22][L * 4 + F.tid]; else if (F.tid < 36) bias[F.tid] = a.in[24][L * 32 + F.tid - 4];
    const LAS float* brg = bias; const LAS float* bre = bias + 4;
    const int fr = F.lane & 15, fq = F.lane >> 4;
    for (int ch = F.vcu; ch < 256; ch += F.G) {
        const int tok0 = ch * 128 + F.wave * 16;
        f32x4 acc[3];
#pragma unroll
        for (int t = 0; t < 3; ++t) acc[t] = (f32x4){0.f, 0.f, 0.f, 0.f};
        float ss = 0.f;
        const bf16_t* hp = H + (size_t)(tok0 + fr) * DM + 8 * fq;
#define RT_LOAD(hf, wv, kc4_) do { const int kc_ = ((kc4_) + F.vcu) & 3; \
            _Pragma("unroll") for (int sl = 0; sl < 8; ++sl) hf[sl] = *(const bf16x8*)(hp + kc_ * 256 + 32 * sl); \
            _Pragma("unroll") for (int i = 0; i < 6; ++i) { const int idx = F.tid + 512 * i, hl = idx / 1536, rem = idx % 1536, row = rem >> 5, c = rem & 31; \
                wv[i] = *(const u32x4*)(rw + ((size_t)(hl * 48 + row)) * 1024 + kc_ * 256 + c * 8); } } while (0)
#define RT_COMP(hf, wv) do { \
            wg_sync(); \
            _Pragma("unroll") for (int i = 0; i < 6; ++i) { const int idx = F.tid + 512 * i, hl = idx / 1536, rem = idx % 1536, row = rem >> 5, c = rem & 31; \
                *(LAS u32x4*)(wst + hl * 25344 + row * 528 + c * 16) = wv[i]; } \
            wg_sync(); \
            _Pragma("unroll") for (int sl = 0; sl < 8; ++sl) { \
                _Pragma("unroll") for (int t = 0; t < 3; ++t) { \
                    const bf16x8 wh = *(const LAS bf16x8*)(wst + (16 * t + fr) * 528 + (32 * sl + 8 * fq) * 2), wl = *(const LAS bf16x8*)(wst + 25344 + (16 * t + fr) * 528 + (32 * sl + 8 * fq) * 2); \
                    acc[t] = __builtin_amdgcn_mfma_f32_16x16x32_bf16(wh, hf[sl], acc[t], 0, 0, 0); \
                    acc[t] = __builtin_amdgcn_mfma_f32_16x16x32_bf16(wl, hf[sl], acc[t], 0, 0, 0); } \
                const u32x4 hu = __builtin_bit_cast(u32x4, hf[sl]); \
                _Pragma("unroll") for (int j = 0; j < 4; ++j) { const float x0 = bflo(hu[j]), x1 = bfhi(hu[j]); ss += x0 * x0 + x1 * x1; } } } while (0)
        { bf16x8 hfA[8], hfB[8]; u32x4 wvA[6], wvB[6];
          RT_LOAD(hfA, wvA, 0);
          RT_LOAD(hfB, wvB, 1); RT_COMP(hfA, wvA);
          RT_LOAD(hfA, wvA, 2); RT_COMP(hfB, wvB);
          RT_LOAD(hfB, wvB, 3); RT_COMP(hfA, wvA);
          RT_COMP(hfB, wvB); }
#undef RT_LOAD
#undef RT_COMP
        ss += __shfl_xor(ss, 16); ss += __shfl_xor(ss, 32);
        const float rs = 1.0f / sqrtf(ss * (1.0f / DM) + EPS);
        if (fq == 0) rs1[tok0 + fr] = rs;
#pragma unroll
        for (int t = 0; t < 3; ++t)
#pragma unroll
            for (int r = 0; r < 4; ++r) lg[fr * 48 + 16 * t + 4 * fq + r] = acc[t][r] * rs;
        LDS_WAIT();
        if (F.lane < 16) {
            const LAS float* my = lg + F.lane * 48;
            float g[4]; int gi = 0; float gm;
#pragma unroll
            for (int j = 0; j < 4; ++j) g[j] = my[j] + brg[j];
            gm = g[0];
#pragma unroll
            for (int j = 1; j < 4; ++j) if (g[j] > gm) { gm = g[j]; gi = j; }
            float den = 0.f;
#pragma unroll
            for (int j = 0; j < 4; ++j) den += __expf(g[j] - gm);
            const float pg = 1.0f / den;
            float v1 = -INFINITY, v2 = -INFINITY; int i1 = 0, i2 = 0;
            for (int j = 0; j < 8; ++j) { const float v = my[4 + gi * 8 + j] + bre[gi * 8 + j];
                if (v > v1) { v2 = v1; i2 = i1; v1 = v; i1 = j; } else if (v > v2) { v2 = v; i2 = j; } }
            const float e2 = __expf(v2 - v1), wa = pg / (1.0f + e2), wb = pg * e2 / (1.0f + e2);
            const int tl = F.wave * 16 + F.lane;
            elist[2 * tl] = gi * 8 + i1; elist[2 * tl + 1] = gi * 8 + i2;
            asg_w[(size_t)ch * 256 + 2 * tl] = wa; asg_w[(size_t)ch * 256 + 2 * tl + 1] = wb;
        }
        wg_sync();
        if (F.tid < 288) {
            const bool isr = F.tid < 256; const int e = isr ? elist[F.tid] : F.tid - 256, lim = isr ? F.tid : 256; int r = 0;
            typedef int i32x4 __attribute__((ext_vector_type(4)));
#pragma unroll 8
            for (int q = 0; q < 256; q += 4) { const i32x4 v = *(const LAS i32x4*)(elist + q);
                r += ((v[0] == e) & (q < lim)) + ((v[1] == e) & (q + 1 < lim)) + ((v[2] == e) & (q + 2 < lim)) + ((v[3] == e) & (q + 3 < lim)); }
            if (isr) { asg_e[(size_t)ch * 256 + F.tid] = e; asg_r[(size_t)ch * 256 + F.tid] = r; } else cnt[ch * 32 + e] = r; }
        wg_sync();
    }
}
DEVI void fill_phase(const Frame& F) {
    const int* cnt = (const int*)(F.ws + WS_CNT); const int* asg_e = (const int*)(F.ws + WS_ASGE); const int* asg_r = (const int*)(F.ws + WS_ASGR); const float* asg_w = (const float*)(F.ws + WS_ASGW);
    const float* rs1 = (const float*)(F.ws + WS_RS1);
    int* tslot = (int*)(F.ws + WS_TSLOT); int* stok = (int*)(F.ws + WS_STOK); float* sw = (float*)(F.ws + WS_SW); float* srs = (float*)(F.ws + WS_SRS); int* mtot = (int*)(F.ws + WS_MTOT);
    LAS int* ptot = (LAS int*)(F.lds + RING_OFF);
    LAS int* ppre = ptot + 512;
    LAS int* tot = ppre + 512; LAS int* start = tot + 32; LAS int* pre = start + 32;
    for (int ch = F.vcu; ch < 256; ch += F.G) {
        wg_sync();
        int ae_ = 0, ar_ = 0; float aw_ = 0.f, ars_ = 0.f;
        if (F.tid < 256) { const size_t ag = (size_t)ch * 256 + F.tid; ae_ = asg_e[ag]; ar_ = asg_r[ag]; aw_ = asg_w[ag]; ars_ = rs1[ch * 128 + (F.tid >> 1)]; }
        { const int e = F.tid & 31, part = F.tid >> 5; int t = 0, p = 0;
#pragma unroll
          for (int w = part * 16; w < part * 16 + 16; ++w) { const int c = cnt[w * 32 + e]; t += c; if (w < ch) p += c; }
          ptot[part * 32 + e] = t; ppre[part * 32 + e] = p; }
        wg_sync();
        if (F.tid < 32) { int t = 0, p = 0;
#pragma unroll
            for (int q = 0; q < 16; ++q) { t += ptot[q * 32 + F.tid]; p += ppre[q * 32 + F.tid]; }
            tot[F.tid] = t; pre[F.tid] = p; }
        wg_sync();
        if (F.tid < 64) { const int t = (F.tid < 32) ? tot[F.tid & 31] : 0; int inc = t;
#pragma unroll
            for (int off = 1; off < 32; off <<= 1) { const int v = __shfl_up(inc, off); if (F.lane >= off) inc += v; }
            if (F.tid < 32) start[F.tid] = inc - t; }
        wg_sync();
        if (F.tid < 256) { const size_t ag = (size_t)ch * 256 + F.tid; const int e = ae_, slot = start[e] + pre[e] + ar_, tok = ch * 128 + (F.tid >> 1);
            stok[slot] = tok; sw[slot] = aw_; srs[slot] = ars_; tslot[ag] = slot; }
        if (ch == 0) {
            if (F.tid < 32) { mtot[F.tid] = tot[F.tid]; mtot[32 + F.tid] = start[F.tid]; }
            if (F.tid >= 256) { const int i = NSLOT + F.tid - 256; stok[i] = 0; sw[i] = 0.f; srs[i] = 0.f; }
            { const float* cbp = (const float*)(F.ws + WS_CBP); const int j = F.tid >> 8, c = F.tid & 255; float s2 = 0.f;
              for (int kr = 0; kr < 32; ++kr) s2 += cbp[(j * 32 + kr) * 256 + c];
              ((float*)(F.ws + WS_CB))[F.tid] = s2; } }
    }
}
DEVI int build_moe_table(const Frame& F) {
    const int* mtot = (const int*)(F.ws + WS_MTOT);
    LAS int* trow = (LAS int*)(F.lds + TAB_OFF); LAS int* tev = trow + 320; LAS int* tn = tev + 320;
    LAS int* mt = (LAS int*)(F.lds + SCR_OFF);
    if (F.tid < 64) mt[F.tid] = mtot[F.tid];
    wg_sync();
    if (F.tid < 64) {
        const int e = F.tid & 31, t = (F.tid < 32) ? mt[e] : 0, st = mt[32 + e], nbe = (t + 255) >> 8;
        int inc = nbe;
#pragma unroll
        for (int off = 1; off < 32; off <<= 1) { const int v = __shfl_up(inc, off); if (F.lane >= off) inc += v; }
        const int base = inc - nbe;
        if (F.tid < 32) { int k = 0; for (int o = 0; o < t; o += 256, ++k) { trow[base + k] = st + o; tev[base + k] = e * 512 + ((t - o) < 256 ? (t - o) : 256); } }
        if (F.tid == 31) tn[0] = inc; }
    wg_sync();
    return tn[0];
}
DEVI void combine_phase(const Frame& F, const bf16_t* H, bf16_t* OUT, int zero_y) {
    const bf16_t* YB = (const bf16_t*)(F.ws + WS_YB); const int* tslot = (const int*)(F.ws + WS_TSLOT); float* rs2 = (float*)(F.ws + WS_RS2);
    const int gw = F.vcu * NWAVES + F.wave, NGW = F.G * NWAVES;
#define CB_LOADS(v, row_, s0_, s1_) do { _Pragma("unroll") for (int hx = 0; hx < 2; ++hx) { const int col = 512 * hx + 8 * F.lane; \
        v[3 * hx] = *(const u32x4*)(H + (size_t)(row_) * DM + col); v[3 * hx + 1] = *(const u32x4*)(YB + (size_t)(s0_) * DM + col); v[3 * hx + 2] = *(const u32x4*)(YB + (size_t)(s1_) * DM + col); } } while (0)
    u32x4 cur[6], nxt[6]; int t0 = 0, t1 = 0;
    if (gw < NTOK) { const int s0 = tslot[2 * gw], s1 = tslot[2 * gw + 1]; CB_LOADS(cur, gw, s0, s1); if (gw + NGW < NTOK) { t0 = tslot[2 * (gw + NGW)]; t1 = tslot[2 * (gw + NGW) + 1]; } }
    for (int row = gw; row < NTOK; row += NGW) {
        const int rown = row + NGW;
        if (rown < NTOK) { CB_LOADS(nxt, rown, t0, t1); if (rown + NGW < NTOK) { t0 = tslot[2 * (rown + NGW)]; t1 = tslot[2 * (rown + NGW) + 1]; } }
        float ss = 0.f;
#pragma unroll
        for (int hx = 0; hx < 2; ++hx) {
            const int col = 512 * hx + 8 * F.lane;
            const u32x4 h = cur[3 * hx], y0 = cur[3 * hx + 1], y1 = cur[3 * hx + 2]; u32x4 o;
#pragma unroll
            for (int j = 0; j < 4; ++j) { float lo = bflo(h[j]) + bflo(y0[j]) + bflo(y1[j]), hi = bfhi(h[j]) + bfhi(y0[j]) + bfhi(y1[j]); if (zero_y) { lo = bflo(h[j]); hi = bfhi(h[j]); } ss += lo * lo + hi * hi; o[j] = pk2(lo, hi); }
            *(u32x4*)(OUT + (size_t)row * DM + col) = o; }
        ss = wave_sum(ss);
        if (F.lane == 0) rs2[row] = 1.0f / sqrtf(ss * (1.0f / DM) + EPS);
#pragma unroll
        for (int q = 0; q < 6; ++q) cur[q] = nxt[q];
    }
#undef CB_LOADS
}
DEVI void rstd_from_partials(const Frame& F) {
    const float* ssq = (const float*)(F.ws + WS_SSQ); float* rs0 = (float*)(F.ws + WS_RS0);
    for (int row = F.vcu * 512 + F.tid; row < NTOK; row += F.G * 512) {
        const f32x4* p = (const f32x4*)(ssq + (size_t)row * 16); float s = 0.f;
#pragma unroll
        for (int q = 0; q < 4; ++q) { const f32x4 v = p[q]; s += (v[0] + v[1]) + (v[2] + v[3]); }
        rs0[row] = 1.0f / sqrtf(s * (1.0f / DM) + EPS); }
}
DEVI void cmpb_phase(const Frame& F, const Args& a) {
    const float* CP = (const float*)(F.ws + WS_CP); const float* CB = (const float*)(F.ws + WS_CB); const float* rope = (const float*)(F.ws + WS_ROPE);
    const bf16_t* W2T = (const bf16_t*)(F.ws + WS_W2T);
    bf16_t* KC = (bf16_t*)(F.ws + WS_KC); bf16_t* VC = (bf16_t*)(F.ws + WS_VC);
    LAS unsigned char* hl = F.lds + RING_OFF;
    LAS float* ol = (LAS float*)(F.lds + RING_OFF + 65536);
    const float kn = a.in[16][F.lane];
    const int fr = F.lane & 15, fq = F.lane >> 4;
    for (int wg = F.vcu; wg < 256; wg += F.G) {
        const int row0 = wg * 64, j = row0 >> 13, rho0 = row0 & 8191;
        { const int r = F.tid >> 3, c0 = (F.tid & 7) * 32;
          f32x4 acc8[8];
#pragma unroll
          for (int q = 0; q < 8; ++q) acc8[q] = *(const f32x4*)(CB + j * 256 + c0 + 4 * q);
#pragma unroll
          for (int ks = 0; ks < 4; ++ks) { const float* src = CP + ((size_t)(j * 4 + ks) * 8192 + rho0 + r) * 256 + c0;
#pragma unroll
              for (int q = 0; q < 8; ++q) acc8[q] += *(const f32x4*)(src + 4 * q); }
#pragma unroll
          for (int q = 0; q < 8; ++q) { f32x4 g;
#pragma unroll
              for (int e = 0; e < 4; ++e) { const float x = acc8[q][e], uu = 0.7978845608028654f * (x + 0.044715f * x * x * x); g[e] = x * sigmoid_f(2.0f * uu); }
              *(LAS u32x2*)(hl + r * 528 + (c0 + 4 * q) * 2) = pack4(g); } }
        wg_sync();
        { const int mt = F.wave & 3, np = F.wave >> 2;
          f32x4 d[2]; d[0] = (f32x4){0.f, 0.f, 0.f, 0.f}; d[1] = d[0];
#pragma unroll
          for (int st = 0; st < 8; ++st) {
              const bf16x8 hf = *(const LAS bf16x8*)(hl + (16 * mt + fr) * 528 + (32 * st + 8 * fq) * 2);
#pragma unroll
              for (int t = 0; t < 2; ++t) { const bf16x8 wf = *(const bf16x8*)(W2T + ((size_t)(j * 64 + 32 * np + 16 * t + fr)) * 256 + 32 * st + 8 * fq);
                  d[t] = __builtin_amdgcn_mfma_f32_16x16x32_bf16(wf, hf, d[t], 0, 0, 0); } }
#pragma unroll
          for (int t = 0; t < 2; ++t) *(LAS f32x4*)(ol + (16 * mt + fr) * 64 + 32 * np + 16 * t + 4 * fq) = d[t]; }
        wg_sync();
#pragma unroll
        for (int q = 0; q < 8; ++q) {
            const int r = F.wave * 8 + q, rho = rho0 + r, bg = rho >> 7, n = rho & 127;
            bf16_t* dst = (j == 0 ? KC : VC) + (size_t)rho * 64 + F.lane;
            float o = ol[r * 64 + F.lane];
            if (n == 127) { *dst = 0; continue; }
            if (j == 0) {
                const float ms = wave_sum(o * o) * (1.0f / 64.0f); const float y = o * (1.0f / sqrtf(ms + EPS)) * kn;
                const float other = __shfl_xor(y, 32);
                const int row = (bg >> 2) * SEQ + 16 * n + 31; const float cs = rope[(size_t)row * 64 + (F.lane & 31)], sn = rope[(size_t)row * 64 + 32 + (F.lane & 31)];
                o = (F.lane < 32) ? (y * cs - other * sn) : (y * cs + other * sn);
            }
            *dst = (bf16_t)(pk2(o, 0.f) & 0xffffu);
        }
        wg_sync();
    }
}

#ifndef ATT_REP
#define ATT_REP 1
#endif
namespace att {
constexpr int KS0 = 0, VS0 = 24576, WSF = 49152, OFN = 51200, UNI = 116736;
typedef const LAS char* lptr;
DEVI int crow(int r, int hi) { return (r & 3) + 8 * (r >> 2) + 4 * hi; }
DEVI void glds16(const void* gsrc, unsigned lds_dst) { unsigned keep;
    asm volatile("s_mov_b32 %0, m0\n\ts_mov_b32 m0, %2\n\ts_nop 0\n\tglobal_load_lds_dwordx4 %1, off\n\ts_mov_b32 m0, %0" : "=&s"(keep) : "v"(gsrc), "s"(lds_dst) : "memory"); }
DEVI float xlane32(float v) { return __shfl_xor(v, 32); }
DEVI void qkt(f32x16& p0, f32x16& p1, lptr Kslot, const bf16x8* qr, float cinit, int r32, int hi) {
    lptr kb = Kslot + hi * 1024 + r32 * 16;
#pragma unroll
    for (int r = 0; r < 16; ++r) { p0[r] = cinit; p1[r] = cinit; }
#pragma unroll
    for (int d0 = 0; d0 < 4; ++d0) {
        const bf16x8 b0 = *(const LAS bf16x8*)(kb + d0 * 2048), b1 = *(const LAS bf16x8*)(kb + d0 * 2048 + 512);
        p0 = __builtin_amdgcn_mfma_f32_32x32x16_bf16(b0, qr[d0], p0, 0, 0, 0); p1 = __builtin_amdgcn_mfma_f32_32x32x16_bf16(b1, qr[d0], p1, 0, 0, 0); }
}
DEVI float rowmax(const f32x16& p0, const f32x16& p1) {
    float m = fmaxf(p0[0], p1[0]);
#pragma unroll
    for (int r = 1; r < 16; ++r) m = fmaxf(m, fmaxf(p0[r], p1[r]));
    return fmaxf(m, xlane32(m));
}
DEVI float max3f(float a, float b, float c) { float r; asm("v_max3_f32 %0, %1, %2, %3" : "=v"(r) : "v"(a), "v"(b), "v"(c)); return r; }
DEVI float rowmax3(const f32x16& p0, const f32x16& p1) {
    float a = max3f(p0[0], p0[1], p1[0]), b = max3f(p0[2], p0[3], p1[1]); a = max3f(a, p1[2], p1[3]);
#pragma unroll
    for (int r = 4; r < 16; r += 4) { a = max3f(a, p0[r], p0[r + 1]); b = max3f(b, p0[r + 2], p0[r + 3]); a = max3f(a, p1[r], p1[r + 1]); b = max3f(b, p1[r + 2], p1[r + 3]); }
    const float m = max3f(a, b, b);
    return max3f(m, xlane32(m), m);
}
DEVI void qk2(f32x16& p0, f32x16& p1, lptr Kslot, const bf16x8* qr, const f32x16& negm, int r32, int hi) {
    lptr kb = Kslot + hi * 1024 + r32 * 16;
    bf16x8 kf[8];
#pragma unroll
    for (int d0 = 0; d0 < 4; ++d0) { kf[2 * d0] = *(const LAS bf16x8*)(kb + d0 * 2048); kf[2 * d0 + 1] = *(const LAS bf16x8*)(kb + d0 * 2048 + 512); }
    asm volatile("s_waitcnt lgkmcnt(0)" : "+v"(kf[0]), "+v"(kf[1]), "+v"(kf[2]), "+v"(kf[3]), "+v"(kf[4]), "+v"(kf[5]), "+v"(kf[6]), "+v"(kf[7]) :: "memory");
    p0 = __builtin_amdgcn_mfma_f32_32x32x16_bf16(kf[0], qr[0], negm, 0, 0, 0); p1 = __builtin_amdgcn_mfma_f32_32x32x16_bf16(kf[1], qr[0], negm, 0, 0, 0);
#pragma unroll
    for (int d0 = 1; d0 < 4; ++d0) { p0 = __builtin_amdgcn_mfma_f32_32x32x16_bf16(kf[2 * d0], qr[d0], p0, 0, 0, 0); p1 = __builtin_amdgcn_mfma_f32_32x32x16_bf16(kf[2 * d0 + 1], qr[d0], p1, 0, 0, 0); }
}
DEVI void pv(f32x16* o, int vb, bf16x8 pa0, bf16x8 pa1, bf16x8 pa2, bf16x8 pa3) {
#pragma unroll
    for (int d0 = 0; d0 < 2; ++d0) { s16x4 lo[4], hi[4];
#pragma unroll
        for (int ks = 0; ks < 4; ++ks) {
            asm volatile("ds_read_b64_tr_b16 %0,%1 offset:%c2" : "=&v"(lo[ks]) : "v"(vb), "i"(d0 * 4096 + ks * 1024) : "memory");
            asm volatile("ds_read_b64_tr_b16 %0,%1 offset:%c2" : "=&v"(hi[ks]) : "v"(vb), "i"(d0 * 4096 + ks * 1024 + 512) : "memory"); }
        asm volatile("s_waitcnt lgkmcnt(0)" ::: "memory"); __builtin_amdgcn_sched_barrier(0);
#define ATT_PK(k) (bf16x8){lo[k][0], lo[k][1], lo[k][2], lo[k][3], hi[k][0], hi[k][1], hi[k][2], hi[k][3]}
        o[d0] = __builtin_amdgcn_mfma_f32_32x32x16_bf16(pa0, ATT_PK(0), o[d0], 0, 0, 0);
        o[d0] = __builtin_amdgcn_mfma_f32_32x32x16_bf16(pa1, ATT_PK(1), o[d0], 0, 0, 0);
        o[d0] = __builtin_amdgcn_mfma_f32_32x32x16_bf16(pa2, ATT_PK(2), o[d0], 0, 0, 0);
        o[d0] = __builtin_amdgcn_mfma_f32_32x32x16_bf16(pa3, ATT_PK(3), o[d0], 0, 0, 0);
#undef ATT_PK
    }
}
DEVI bf16x8 packp(const f32x16& p, int b) { u32x4 w; w.x = pk2(p[b], p[b + 1]); w.y = pk2(p[b + 2], p[b + 3]); w.z = pk2(p[b + 4], p[b + 5]); w.w = pk2(p[b + 6], p[b + 7]); return __builtin_bit_cast(bf16x8, w); }
DEVI void scale_rows(f32x16* o, LAS float* wsf, float fac, int r32, int hi) {
    if (hi == 0) wsf[r32] = fac;
    LDS_WAIT();
#pragma unroll
    for (int r = 0; r < 16; ++r) { const float f = wsf[crow(r, hi)]; o[0][r] *= f; o[1][r] *= f; }
    LDS_WAIT();
}
DEVI void fold_rows(const f32x16* o, LAS float* ofl, LAS float* wsf, float fac, int r32, int hi) {
    if (hi == 0) wsf[r32] = fac;
    LDS_WAIT();
#pragma unroll
    for (int r = 0; r < 16; ++r) { const int q = crow(r, hi); const float f = wsf[q]; ofl[q * 64 + r32] += o[0][r] * f; ofl[q * 64 + 32 + r32] += o[1][r] * f; }
    LDS_WAIT();
}
DEVI void tile_step(f32x16* o, float& m, float& l, const bf16x8* qr, lptr Kslot, int vb, LAS float* wsf, int r32, int hi, float cinit, bool domask, int kbase, int lo, int hi_) {
    f32x16 p0, p1;
    qkt(p0, p1, Kslot, qr, cinit, r32, hi);
    if (domask) {
#pragma unroll
        for (int r = 0; r < 16; ++r) { const int kp = kbase + crow(r, hi); if (kp < lo || kp > hi_) p0[r] = -INFINITY; if (kp + 32 < lo || kp + 32 > hi_) p1[r] = -INFINITY; } }
    const float rm = rowmax(p0, p1);
    if (__builtin_amdgcn_ballot_w64(rm > m + 8.0f) != 0ull) {
        const float mn = fmaxf(m, rm), f = __builtin_amdgcn_exp2f(m - mn); m = mn;
        l *= f;
        scale_rows(o, wsf, f, r32, hi);
    }
    float ps = 0.f;
#pragma unroll
    for (int r = 0; r < 16; ++r) { p0[r] = __builtin_amdgcn_exp2f(p0[r] - m); p1[r] = __builtin_amdgcn_exp2f(p1[r] - m); ps += p0[r] + p1[r]; }
    l += ps;
    pv(o, vb, packp(p0, 0), packp(p0, 8), packp(p1, 0), packp(p1, 8));
}

template<bool nomax>
DEVI void attn_unit(int b, int g, int qb, const bf16_t* Q, const bf16_t* KV, const bf16_t* KC, const bf16_t* VC, const float* gates, bf16_t* O, LAS char* shm) {
    const int tid = threadIdx.x, lane = tid & 63, r32 = lane & 31, hi = lane >> 5; const int wid = __builtin_amdgcn_readfirstlane(tid >> 6);
    const int tl = r32 >> 2, head = r32 & 3, tq0 = qb * 64, tq = tq0 + 8 * wid + tl, row = b * SEQ + tq, bg = b * 4 + g;
    const unsigned lds0 = (unsigned)(uintptr_t)shm;
    LAS float* wsf = (LAS float*)(shm + WSF) + wid * 64;
    const bf16_t* Ks = KV + 2 * KVS + (size_t)bg * SEQ * 64; const bf16_t* Vs = KV + 3 * KVS + (size_t)bg * SEQ * 64;
    const bf16_t* Kw = KV + 4 * KVS + (size_t)bg * SEQ * 64; const bf16_t* Vw = KV + 5 * KVS + (size_t)bg * SEQ * 64;
    const bf16_t* Kc = KC + (size_t)bg * 128 * 64; const bf16_t* Vc = VC + (size_t)bg * 128 * 64;
    const int koff = lane * 64 + wid * 8, voff = (16 * (wid & 3) + (lane >> 2)) * 64 + (wid >> 2) * 32 + (lane & 3) * 8;
#define ATT_DMA(Kt, Vt, slot) do { glds16((Kt) + koff, (unsigned)__builtin_amdgcn_readfirstlane(lds0 + KS0 + (slot) * 8192 + wid * 1024)); \
                                   glds16((Vt) + voff, (unsigned)__builtin_amdgcn_readfirstlane(lds0 + VS0 + (slot) * 8192 + wid * 1024)); } while (0)
#define ATT_WAITBAR() asm volatile("s_waitcnt vmcnt(0) lgkmcnt(0)\n\ts_barrier" ::: "memory")
    const int vb0 = (int)(lds0 + VS0) + ((lane >> 4) & 1) * 32 + (lane & 3) * 8 + (4 * hi + ((lane & 15) >> 2)) * 64;
    const lptr kslot0 = (lptr)(shm + KS0);
#ifdef ATT_TSEG
    unsigned long long tsa_ = __builtin_amdgcn_s_memrealtime(), tsb_ = 0, tsc_ = 0, tsd_ = 0, tsx_ = 0, tacc_ = 0;
#define TSB(k) do { if (ATT_TSEG == (k)) tsx_ = __builtin_amdgcn_s_memrealtime(); } while (0)
#define TSE(k) do { if (ATT_TSEG == (k)) tacc_ += __builtin_amdgcn_s_memrealtime() - tsx_; } while (0)
#else
#define TSB(k) do { } while (0)
#define TSE(k) do { } while (0)
#endif
    ATT_WAITBAR();
    const int nC = (qb >= 16) ? 2 : 1;
    const int wlo = qb >= 8 ? qb - 8 : 0, nW = qb - wlo + 1;
    bf16x8 qr[4];
    { const bf16_t* qp = Q + (size_t)row * DM + (4 * g + head) * 64 + 8 * hi;
#pragma unroll
      for (int d0 = 0; d0 < 4; ++d0) qr[d0] = *(const bf16x8*)(qp + 16 * d0); }
    const float* gp = gates + (size_t)row * 48 + (g * 4 + head) * 3; const float gate_c = (PROBE == 4) ? 0.f : gp[0], gate_s = (PROBE == 5) ? 0.f : gp[1], gate_w = (PROBE == 6) ? 0.f : gp[2];
    ATT_DMA(Kc, Vc, 0); if (nC == 2) ATT_DMA(Kc + 64 * 64, Vc + 64 * 64, 1);
    ATT_DMA(Kw + (size_t)wlo * 4096, Vw + (size_t)wlo * 4096, 2);
    f32x16 o[2];
    LAS float* ofl = (LAS float*)(shm + OFN) + wid * 2048;
#pragma unroll
    for (int r = 0; r < 16; ++r) { ofl[crow(r, hi) * 64 + r32] = 0.f; ofl[crow(r, hi) * 64 + 32 + r32] = 0.f; }
    unsigned selmask = (qb == 31) ? 0xffffffffu : ((2u << qb) - 1u);
    asm volatile("s_waitcnt vmcnt(2) lgkmcnt(0)\n\ts_barrier" ::: "memory");
#ifdef ATT_TSEG
    tsb_ = __builtin_amdgcn_s_memrealtime();
#endif
    {
        const int nmax = (tq - 31) >> 4;
        f32x16 pa0, pa1, pb0, pb1;
        qkt(pa0, pa1, kslot0, qr, 0.f, r32, hi);
        if (nC == 2) qkt(pb0, pb1, kslot0 + 8192, qr, 0.f, r32, hi);
#pragma unroll
        for (int r = 0; r < 16; ++r) { const int n0 = crow(r, hi); if (n0 > nmax) pa0[r] = -INFINITY; if (n0 + 32 > nmax) pa1[r] = -INFINITY; }
        float m = rowmax(pa0, pa1), ps = 0.f;
        if (nC == 2) {
#pragma unroll
            for (int r = 0; r < 16; ++r) { const int n0 = crow(r, hi); if (n0 + 64 > nmax) pb0[r] = -INFINITY; if (n0 + 96 > nmax) pb1[r] = -INFINITY; }
            m = fmaxf(m, rowmax(pb0, pb1)); }
        if (m == -INFINITY) m = 0.f;
#pragma unroll
        for (int r = 0; r < 16; ++r) { pa0[r] = __builtin_amdgcn_exp2f(pa0[r] - m); pa1[r] = __builtin_amdgcn_exp2f(pa1[r] - m); ps += pa0[r] + pa1[r]; }
        if (nC == 2) {
#pragma unroll
            for (int r = 0; r < 16; ++r) { pb0[r] = __builtin_amdgcn_exp2f(pb0[r] - m); pb1[r] = __builtin_amdgcn_exp2f(pb1[r] - m); ps += pb0[r] + pb1[r]; } }
        ps += xlane32(ps);
        const float inv = ps > 0.f ? __builtin_amdgcn_rcpf(ps) : 0.f;
#pragma unroll
        for (int r = 0; r < 16; ++r) { o[0][r] = 0.f; o[1][r] = 0.f; }
        pv(o, vb0, packp(pa0, 0), packp(pa0, 8), packp(pa1, 0), packp(pa1, 8));
        if (nC == 2) pv(o, vb0 + 8192, packp(pb0, 0), packp(pb0, 8), packp(pb1, 0), packp(pb1, 8));
        fold_rows(o, ofl, wsf, gate_c * inv, r32, hi);
        if (qb >= 16) {
#define ATT_QSUM(x) do { float t_ = (x) * inv; t_ += __builtin_bit_cast(float, __builtin_amdgcn_update_dpp(0, __builtin_bit_cast(int, t_), 0xB1, 0xf, 0xf, false)); \
                         t_ += __builtin_bit_cast(float, __builtin_amdgcn_update_dpp(0, __builtin_bit_cast(int, t_), 0x4E, 0xf, 0xf, false)); (x) = t_; } while (0)
#pragma unroll
            for (int r = 0; r < 16; ++r) { ATT_QSUM(pa0[r]); ATT_QSUM(pa1[r]); ATT_QSUM(pb0[r]); ATT_QSUM(pb1[r]); }
#undef ATT_QSUM
            float sc[16], fo[16];
#define ATT_H4(h4, r) ((h4) == 0 ? pa0[r] : (h4) == 1 ? pa1[r] : (h4) == 2 ? pb0[r] : pb1[r])
#pragma unroll
            for (int h4 = 0; h4 < 4; ++h4)
#pragma unroll
                for (int gq = 0; gq < 4; ++gq) fo[h4 * 4 + gq] = xlane32(ATT_H4(h4, 4 * gq));
#pragma unroll
            for (int h4 = 0; h4 < 4; ++h4)
#pragma unroll
                for (int gq = 0; gq < 4; ++gq) {
                    const int s = h4 * 4 + gq;
                    const float nxt_lo = fo[s];
                    const float nxt_hi = (s < 15) ? fo[s + 1] : 0.f;
                    float v = ATT_H4(h4, 4 * gq) + 2.0f * (ATT_H4(h4, 4 * gq + 1) + ATT_H4(h4, 4 * gq + 2) + ATT_H4(h4, 4 * gq + 3)) + (hi ? nxt_hi : nxt_lo);
                    const int j = 8 * h4 + 2 * gq + hi;
                    if (j == 0 || j == qb || j == qb - 1) v = INFINITY; else if (j > qb) v = -INFINITY;
                    sc[s] = v; }
#undef ATT_H4
            float so[16];
#pragma unroll
            for (int s = 0; s < 16; ++s) so[s] = xlane32(sc[s]);
            float x4[4];
#pragma unroll
            for (int i = 0; i < 4; ++i) x4[i] = (head == 0) ? sc[4 * i] : (head == 1) ? sc[4 * i + 1] : (head == 2) ? sc[4 * i + 2] : sc[4 * i + 3];
            unsigned own = 0u;
#pragma unroll
            for (int i = 0; i < 4; ++i) {
                int rk = 0; const float xv = x4[i];
#pragma unroll
                for (int s2 = 0; s2 < 16; ++s2) {
                    const int g2 = s2 >> 2, q2 = s2 & 3;
                    if (g2 < i) { rk += (sc[s2] >= xv) ? 1 : 0; rk += (so[s2] >= xv) ? 1 : 0; }
                    else if (g2 > i) { rk += (sc[s2] > xv) ? 1 : 0; rk += (so[s2] > xv) ? 1 : 0; }
                    else { const bool lt = q2 < head, eq = q2 == head;
                        rk += eq ? 0 : (lt ? ((sc[s2] >= xv) ? 1 : 0) : ((sc[s2] > xv) ? 1 : 0));
                        rk += (lt || (eq && hi)) ? ((so[s2] >= xv) ? 1 : 0) : ((so[s2] > xv) ? 1 : 0); }
                }
                if (rk < 16) own |= 1u << (8 * i);
            }
            own <<= 2 * head;
            own |= (unsigned)__builtin_amdgcn_update_dpp(0, (int)own, 0xB1, 0xf, 0xf, false);
            own |= (unsigned)__builtin_amdgcn_update_dpp(0, (int)own, 0x4E, 0xf, 0xf, false);
            own <<= hi;
            selmask = own | (unsigned)__shfl_xor((int)own, 32);
        }
    }
    unsigned uni = selmask, wuni = selmask;
    if (qb >= 16) {
#pragma unroll
        for (int off = 1; off < 64; off <<= 1) uni |= (unsigned)__shfl_xor((int)uni, off);
        wuni = (unsigned)__builtin_amdgcn_readfirstlane((int)uni);
        LAS unsigned* uw = (LAS unsigned*)(shm + UNI);
        if (lane == 0) uw[wid] = uni;
        ATT_WAITBAR();
        uni = 0u;
#pragma unroll
        for (int w = 0; w < 8; ++w) uni |= uw[w];
        uni = (unsigned)__builtin_amdgcn_readfirstlane((int)uni);
    } else { ATT_WAITBAR(); }
    uni = (unsigned)__builtin_amdgcn_readfirstlane((int)uni); wuni = (unsigned)__builtin_amdgcn_readfirstlane((int)wuni);
#ifdef ATT_TSEG
    tsc_ = __builtin_amdgcn_s_memrealtime();
#endif
    const unsigned smask = uni & ((qb == 31) ? 0xffffffffu : ((2u << qb) - 1u));
    const int nS = __builtin_popcount(smask), nT = nW + nS;
    unsigned rem_issue = smask, rem_qk = smask;
#define ATT_ISSUE(tt) do { const int sl_ = ((tt) + 2) % 3; \
        if ((tt) < nW) { const int j_ = wlo + (tt); ATT_DMA(Kw + (size_t)j_ * 4096, Vw + (size_t)j_ * 4096, sl_); } \
        else { const int j_ = __builtin_ctz(rem_issue); rem_issue &= rem_issue - 1u; ATT_DMA(Ks + (size_t)j_ * 4096, Vs + (size_t)j_ * 4096, sl_); } } while (0)
    if (nT > 1) ATT_ISSUE(1);
    ATT_WAITBAR();
    if (nT > 2) ATT_ISSUE(2);
    float mref = 0.f, l = 0.f;
#pragma unroll
    for (int r = 0; r < 16; ++r) { o[0][r] = 0.f; o[1][r] = 0.f; }
    f32x16 pc0, pc1, negm;
#pragma unroll
    for (int r = 0; r < 16; ++r) negm[r] = 0.f;
    qk2(pc0, pc1, kslot0 + 2 * 8192, qr, negm, r32, hi);
    int jc = wlo; bool cS = false, cskip = false;
    f32x16 pd0, pd1;
#define ATT_STEP(t, pc0, pc1, pn0, pn1) do { \
        const bool hasn = t + 1 < nT; int jn = 0; bool nSel = false, nskip = true; \
        if (hasn) { if (t + 1 < nW) { jn = wlo + t + 1; nskip = false; } else { jn = __builtin_ctz(rem_qk); rem_qk &= rem_qk - 1u; nSel = true; nskip = ((wuni >> jn) & 1u) == 0u; } } \
        TSB(4); if (t > 0) { ATT_WAITBAR(); if (t + 2 < nT) ATT_ISSUE(t + 2); } TSE(4); \
        TSB(5); if (!nskip) { \
            const float nm = (nSel && ((selmask >> jn) & 1u) == 0u) ? -INFINITY : -mref; \
_Pragma("unroll") \
            for (int r = 0; r < 16; ++r) negm[r] = nm; \
            qk2(pn0, pn1, kslot0 + ((t + 3) % 3) * 8192, qr, negm, r32, hi); \
        } \
        TSE(5); if (!cskip) { TSB(6); \
            const bool dm = cS ? (jc == qb) : ((jc == qb) || (jc + 8 == qb)); \
            if (dm) { const int lo = cS ? 0 : tq - 511, kbase = 64 * jc; \
_Pragma("unroll") \
                for (int r = 0; r < 16; ++r) { const int kp = kbase + crow(r, hi); if (kp < lo || kp > tq) pc0[r] = -INFINITY; if (kp + 32 < lo || kp + 32 > tq) pc1[r] = -INFINITY; } } \
            const float rm = nomax ? 0.f : rowmax3(pc0, pc1); \
            if (!nomax && __builtin_amdgcn_ballot_w64(rm > 8.0f) != 0ull) { \
                const float dl = fmaxf(rm, 0.f), f = __builtin_amdgcn_exp2f(-dl); mref += dl; l *= f; \
_Pragma("unroll") \
                for (int r = 0; r < 16; ++r) { pc0[r] -= dl; pc1[r] -= dl; } \
                if (!nskip) { \
_Pragma("unroll") \
                    for (int r = 0; r < 16; ++r) { pn0[r] -= dl; pn1[r] -= dl; } } \
                scale_rows(o, wsf, f, r32, hi); \
            } \
            TSE(6); TSB(7); float ps = 0.f; \
_Pragma("unroll") \
            for (int r = 0; r < 16; ++r) { pc0[r] = __builtin_amdgcn_exp2f(pc0[r]); pc1[r] = __builtin_amdgcn_exp2f(pc1[r]); ps = (ps + pc0[r]) + pc1[r]; } \
            l += ps; TSE(7); TSB(8); \
            pv(o, vb0 + ((t + 2) % 3) * 8192, packp(pc0, 0), packp(pc0, 8), packp(pc1, 0), packp(pc1, 8)); TSE(8); \
        } \
        if (t + 1 == nW) { \
            l += xlane32(l); fold_rows(o, ofl, wsf, gate_w * (l > 0.f ? __builtin_amdgcn_rcpf(l) : 0.f), r32, hi); \
_Pragma("unroll") \
            for (int r = 0; r < 16; ++r) { o[0][r] = 0.f; o[1][r] = 0.f; } \
            l = 0.f; } \
        jc = jn; cS = nSel; cskip = nskip; } while (0)
    for (int t = 0; t < nT; t += 2) {
        ATT_STEP(t, pc0, pc1, pd0, pd1);
        if (t + 1 >= nT) break;
        ATT_STEP(t + 1, pd0, pd1, pc0, pc1);
    }
#undef ATT_STEP
#undef ATT_ISSUE
    l += xlane32(l); fold_rows(o, ofl, wsf, gate_s * (l > 0.f ? __builtin_amdgcn_rcpf(l) : 0.f), r32, hi);
#ifdef ATT_TSEG
    tsd_ = __builtin_amdgcn_s_memrealtime();
    { const unsigned long long seg_ = (ATT_TSEG >= 4) ? tacc_ : (ATT_TSEG == 1) ? (tsb_ - tsa_) : (ATT_TSEG == 2) ? (tsc_ - tsb_) : (tsd_ - tsc_);
      LAS unsigned* tw_ = (LAS unsigned*)(shm + UNI + 64) + wid; if (lane == 0) tw_[0] += (unsigned)seg_; }
#endif
    {
#pragma unroll
      for (int i = 0; i < 4; ++i) { const int q = i * 8 + (lane >> 3), chn = lane & 7; const f32x4 v0 = *(const LAS f32x4*)(ofl + q * 64 + chn * 8), v1 = *(const LAS f32x4*)(ofl + q * 64 + chn * 8 + 4);
          u32x4 v; v.x = pk2(v0[0], v0[1]); v.y = pk2(v0[2], v0[3]); v.z = pk2(v1[0], v1[1]); v.w = pk2(v1[2], v1[3]);
          *(u32x4*)(O + (size_t)(b * SEQ + tq0 + 8 * wid + (q >> 2)) * DM + (4 * g + (q & 3)) * 64 + chn * 8) = v; }
      LDS_WAIT(); }
#undef ATT_DMA
#undef ATT_WAITBAR
}
DEVI void attn_phase(const Frame& F, const Args& args) {
    const bf16_t* Q = (const bf16_t*)(F.ws + WS_Q); const bf16_t* KV = (const bf16_t*)(F.ws + WS_KV); const bf16_t* KC = (const bf16_t*)(F.ws + WS_KC); const bf16_t* VC = (const bf16_t*)(F.ws + WS_VC);
    const float* gates = (const float*)(F.ws + WS_GATES); bf16_t* O = (bf16_t*)(F.ws + WS_O);
#if PROBE == 1
    { u32x4* z = (u32x4*)O; for (size_t i = (size_t)F.vcu * 512 + F.tid; i < (size_t)NTOK * DM / 8; i += (size_t)F.G * 512) z[i] = (u32x4){0u, 0u, 0u, 0u}; return; }
#endif
#ifdef ATT_TSEG
    { LAS unsigned* tw_ = (LAS unsigned*)(F.lds + RING_OFF + UNI + 64); if (F.tid < 8) tw_[F.tid] = 0u; asm volatile("s_waitcnt lgkmcnt(0)\n\ts_barrier" ::: "memory"); }
#endif
    bool nomax;
    { const float* qn = args.in[15]; const float* kn = args.in[16];
      float gq = fabsf(qn[F.lane]), gk = fmaxf(fabsf(kn[64 + F.lane]), fabsf(kn[128 + F.lane]));
#pragma unroll
      for (int off = 1; off < 64; off <<= 1) { gq = fmaxf(gq, __shfl_xor(gq, off)); gk = fmaxf(gk, __shfl_xor(gk, off)); }
      const float bound = 11.5416f * gq * gk;
      nomax = __builtin_amdgcn_readfirstlane((bound <= 40.0f) ? 1 : 0) != 0; }
    for (int i = 0;; ++i) {
        const int idx = (i / ATT_REP) * F.G + F.vcu; if (idx >= 2048) break;
        const int ii = idx >> 8, bgq = idx & 255, bg = bgq >> 2, qt = bgq & 3;
        const int qbc = (ii & 1) ? (8 * (ii >> 1) + 7 - qt) : (8 * (ii >> 1) + qt);
        if (nomax) attn_unit<true>(bg >> 2, bg & 3, qbc, Q, KV, KC, VC, gates, O, (LAS char*)(F.lds + RING_OFF));
        else attn_unit<false>(bg >> 2, bg & 3, qbc, Q, KV, KC, VC, gates, O, (LAS char*)(F.lds + RING_OFF));
        const int qb = qbc;
        (void)qb;
    }
    asm volatile("s_waitcnt vmcnt(0) lgkmcnt(0)\n\ts_barrier" ::: "memory");
#ifdef ATT_TSEG
    { LAS unsigned* tw_ = (LAS unsigned*)(F.lds + RING_OFF + UNI + 64); const unsigned long long d_ = (unsigned long long)tw_[0] * 3ull; const unsigned long long t1_ = __builtin_amdgcn_s_memrealtime();
      while (__builtin_amdgcn_s_memrealtime() - t1_ < d_) __builtin_amdgcn_s_sleep(8); }
#endif
}
}

#ifndef PH_MASK
#define PH_MASK 0xffffffffu
#endif
#ifndef REP_MASK
#define REP_MASK 0u
#endif
#define PH(k) (((PH_MASK) >> (k)) & 1u)
#define REPB(k) (((REP_MASK) >> (k)) & 1u)
#define GRID_BAR() xcd_barrier(bar)
#define REFRESH() do { int t_ = threadIdx.x; asm volatile("" : "+v"(t_)); F.tid = t_; F.lane = t_ & 63; F.wave = __builtin_amdgcn_readfirstlane(t_ >> 6); } while (0)
template <int K, int L>
DEVI void phase(Frame& F, const Args& args, int nblk) {
    unsigned char* ws = args.ws;
    LAS unsigned char* ring = F.lds + RING_OFF;
    bf16_t* const HA = (bf16_t*)(ws + WS_HA); bf16_t* const HB = (bf16_t*)(ws + WS_HB);
    bf16_t* const hin = (L == 0) ? HA : HB;
    bf16_t* const hmx = (L == 0) ? HB : HA;
    REFRESH();
    if constexpr (K == 0) p0_prologue(F, args);
    if constexpr (K == 2) { ProbPw1 P; P.A = (const char*)HA; P.Bt = (const char*)(ws + WS_WPW1); P.K = DM; P.ldb = 2048; P.G = F.G; P.c = F.vcu;
          P.rstd = (const float*)(ws + WS_RS0); P.bias = args.in[7]; P.U = (bf16_t*)(ws + WS_U);
          pg8::gemm_phase(ring, P); }
    if constexpr (K == 3) {
        if (F.vcu & 1) { prep_layer(F, args, 0); wg_sync(); conv_phase(F, args); }
        else { conv_phase(F, args); wg_sync(); prep_layer(F, args, 0); } }
    if constexpr (K == 4) { ProbRes P; P.A = (const char*)(ws + WS_V); P.Bt = (const char*)(ws + WS_WPW2); P.K = DM; P.ldb = 2048; P.G = F.G; P.c = F.vcu;
          P.RES = HA; P.OUT = HB; P.bias = args.in[13];
          pg8::gemm_phase(ring, P); }
    if constexpr (K == 5) { ProbWin P; P.A = (const char*)HB; P.Bt = (const char*)(ws + WS_WIN); P.K = DM; P.ldb = 2048; P.G = F.G; P.c = F.vcu;
          P.rstd = (const float*)(ws + WS_SSQ); P.rope = (const float*)(ws + WS_ROPE); P.qnorm = args.in[15]; P.knorm = args.in[16];
          P.Q = (bf16_t*)(ws + WS_Q); P.KV = (bf16_t*)(ws + WS_KV); P.gates = (float*)(ws + WS_GATES);
          { LAS float* lr = (LAS float*)(F.lds + SCR_OFF);
            { f32x4 st_[4]; bool ok_[4];
#pragma unroll
              for (int q = 0; q < 4; ++q) { const int idx = F.tid + 512 * q, Lq = (idx >> 8) * F.G + F.vcu; ok_[q] = Lq < 128 * 11;
                  const f32x4* pp = (const f32x4*)(P.rstd + (size_t)((ok_[q] ? Lq / 11 : 0) * 256 + (idx & 255)) * 16); st_[q] = (pp[0] + pp[1]) + (pp[2] + pp[3]); }
#pragma unroll
              for (int q = 0; q < 4; ++q) { const int idx = F.tid + 512 * q; if (ok_[q]) lr[idx] = 1.0f / sqrtf(((st_[q][0] + st_[q][1]) + (st_[q][2] + st_[q][3])) * (1.0f / DM) + EPS); } }
            wg_sync(); P.lrs = lr; }
          pg8::gemm_phase(ring, P);
          if (F.G == 256 && F.vcu >= 128) { REFRESH(); prep_layer(F, args, 1, 0, PREP1_SPLIT, F.vcu - 128, 128, false); } }
    if constexpr (K == 6) { ProbCmp P; P.A = (const char*)(ws + WS_KV); P.Bt = (const char*)(ws + WS_WC1); P.K = 512; P.ldb = 4096; P.G = F.G; P.c = F.vcu;
          P.CP = (float*)(ws + WS_CP);
          pg8::gemm_phase(ring, P); }
    if constexpr (K == 7) cmpb_phase(F, args);
    if constexpr (K == 8) {
        const int p0_ = (F.G == 256) ? PREP1_SPLIT : 0;
        if (F.vcu & 1) { prep_layer(F, args, 1, p0_, NEXP * 384); wg_sync(); REFRESH(); }
        att::attn_phase(F, args);
        if (!(F.vcu & 1)) { REFRESH(); prep_layer(F, args, 1, p0_, NEXP * 384); } }
    if constexpr (K == 9) { ProbRes P; P.A = (const char*)(ws + WS_O); P.Bt = (const char*)(ws + WS_WOUT); P.K = DM; P.ldb = 2048; P.G = F.G; P.c = F.vcu;
          P.RES = HB; P.OUT = HA; P.bias = nullptr;
          pg8::gemm_phase(ring, P); }
    if constexpr (K == 11) router_phase(F, args, L, hmx);
    if constexpr (K == 12) fill_phase(F);
    if constexpr (K == 13) { ProbGateUp P; P.A = (const char*)hmx; P.Bt = (const char*)(ws + WS_WGU); P.K = DM; P.ldb = 2048; P.G = F.G; P.c = F.vcu;
          P.tab_row = (const LAS int*)(F.lds + TAB_OFF); P.tab_ev = P.tab_row + 320; P.nblk = nblk;
          P.slot_rs = (const float*)(ws + WS_SRS); P.HBUF = hin;
          { LAS unsigned* go = (LAS unsigned*)(F.lds + SCR_OFF); const int* stok = (const int*)(ws + WS_STOK);
            LAS float* rl = (LAS float*)(F.lds + SCR_OFF + 6144);
            { int tr_[3]; unsigned gv_[3]; float rv_[3];
#pragma unroll
              for (int q = 0; q < 3; ++q) { const int idx = F.tid + 512 * q, Lq = (idx >> 8) * F.G + F.vcu; tr_[q] = (Lq < nblk * 4) ? P.tab_row[Lq >> 2] : -1; }
#pragma unroll
              for (int q = 0; q < 3; ++q) { const int idx = F.tid + 512 * q; const int sl = (tr_[q] >= 0 ? tr_[q] : 0) + (idx & 255); gv_[q] = (unsigned)stok[sl] * 2048u; rv_[q] = P.slot_rs[sl]; }
#pragma unroll
              for (int q = 0; q < 3; ++q) { const int idx = F.tid + 512 * q; if (tr_[q] >= 0) { go[idx] = gv_[q]; rl[idx] = rv_[q]; } } }
            wg_sync(); P.goff = go; P.lrs = rl; }
          pg8::gemm_phase(ring, P);
          ProbPP Q2; Q2.A = (const char*)(ws + WS_PB); Q2.Bt = (const char*)(ws + WS_WPP) + (size_t)L * DM * PLE * 2; Q2.K = PLE; Q2.ldb = 512; Q2.G = F.G; Q2.c = F.vcu;
          Q2.O = (bf16_t*)(ws + WS_PP);
          { const int nun = nblk * 4, maxu = (nun + F.G - 1) / F.G; int tl = nun - (maxu - 1) * F.G; if (tl >= F.G || tl < 0) tl = 0; Q2.tail_lo = tl; }
          Q2.base = 0; Q2.cnt = PP_SPLIT;
          pg8::gemm_phase(ring, Q2); }
    if constexpr (K == 14) { ProbDown P; P.A = (const char*)hin; P.Bt = (const char*)(ws + WS_WDN); P.K = DEXP; P.ldb = 1024; P.G = F.G; P.c = F.vcu;
          P.tab_row = (const LAS int*)(F.lds + TAB_OFF); P.tab_ev = P.tab_row + 320; P.nblk = nblk;
          P.slot_w = (const float*)(ws + WS_SW); P.YB = (bf16_t*)(ws + WS_YB);
          { LAS float* wl = (LAS float*)(F.lds + SCR_OFF); int tr_[3]; float wv_[3];
#pragma unroll
            for (int q = 0; q < 3; ++q) { const int idx = F.tid + 512 * q, Lq = (idx >> 8) * F.G + F.vcu; tr_[q] = (Lq < nblk * 4) ? P.tab_row[Lq >> 2] : -1; }
#pragma unroll
            for (int q = 0; q < 3; ++q) { const int idx = F.tid + 512 * q; wv_[q] = P.slot_w[(tr_[q] >= 0 ? tr_[q] : 0) + (idx & 255)]; }
#pragma unroll
            for (int q = 0; q < 3; ++q) { const int idx = F.tid + 512 * q; if (tr_[q] >= 0) wl[idx] = wv_[q]; }
            wg_sync(); P.lsw = wl; }
          pg8::gemm_phase(ring, P);
          ProbPP Q2; Q2.A = (const char*)(ws + WS_PB); Q2.Bt = (const char*)(ws + WS_WPP) + (size_t)L * DM * PLE * 2; Q2.K = PLE; Q2.ldb = 512; Q2.G = F.G; Q2.c = F.vcu;
          Q2.O = (bf16_t*)(ws + WS_PP);
          { const int nun = nblk * 4, maxu = (nun + F.G - 1) / F.G; int tl = nun - (maxu - 1) * F.G; if (tl >= F.G || tl < 0) tl = 0; Q2.tail_lo = tl; }
          Q2.base = PP_SPLIT; Q2.cnt = 128 * 4 - PP_SPLIT;
          pg8::gemm_phase(ring, Q2); }
    if constexpr (K == 15) combine_phase(F, hmx, hin, (PROBE == 2 && L == 1) || (PROBE == 3 && L == 0));
#ifdef STAGGER_US
    if constexpr (K == STAGGER_PH) { if (F.vcu & 1) { const unsigned long long t0_ = __builtin_amdgcn_s_memrealtime(); while (__builtin_amdgcn_s_memrealtime() - t0_ < (unsigned long long)(STAGGER_US) * 100ull) __builtin_amdgcn_s_sleep(8); } }
#endif
    if constexpr (K == 16) { ProbPle P; P.A = (const char*)hin; P.Bt = (const char*)(ws + WS_WPG) + (size_t)L * DM * DM * 2; P.K = DM; P.ldb = 2048; P.G = F.G; P.c = F.vcu;
          P.H2 = hin; P.PPp = (const bf16_t*)(ws + WS_PP); P.rstd = (const float*)(ws + WS_RS2); P.OUTB = hmx; P.OUTF = args.out; P.ssq = (float*)(ws + WS_SSQ); P.last = L;
          pg8::gemm_phase(ring, P); }
}
#if defined(TPHASE)
#define PHASE(k) do { const bool tp_ = ((k) == TPHASE) && (L == TLAYER); const unsigned long long t0_ = tp_ ? __builtin_amdgcn_s_memrealtime() : 0ull; \
    if (PH(k)) phase<k, L>(F, args, nblk); \
    if (tp_) { asm volatile("s_waitcnt vmcnt(0) lgkmcnt(0)" ::: "memory"); const unsigned long long t1_ = __builtin_amdgcn_s_memrealtime(); const unsigned long long d_ = (t1_ - t0_) * TALPHA; \
        while (__builtin_amdgcn_s_memrealtime() - t1_ < d_) __builtin_amdgcn_s_sleep(8); } } while (0)
#else
#define PHASE(k) do { if (PH(k)) phase<k, L>(F, args, nblk); if (PH(k) && REPB(k)) phase<k, L>(F, args, nblk); } while (0)
#endif
template <int L>
DEVI void layer_program(Frame& F, const Args& args, const XcdBarrier& bar) {
    int nblk = 0;
    if (L == 0) {
        PHASE(2); GRID_BAR();
        PHASE(3); GRID_BAR();
        PHASE(4);
    } else {
        PHASE(5); GRID_BAR();
        PHASE(6); GRID_BAR();
        PHASE(7); GRID_BAR();
        PHASE(8); GRID_BAR();
        PHASE(9);
    }
    GRID_BAR();
    PHASE(11); GRID_BAR();
    PHASE(12); GRID_BAR();
    REFRESH(); nblk = build_moe_table(F);
    PHASE(13); GRID_BAR();
    PHASE(14); GRID_BAR();
    PHASE(15); GRID_BAR();
    PHASE(16);
    if (L == 0) GRID_BAR();
}
__global__ void __launch_bounds__(NWAVES * 64, 2) hybrid_fwd(Args args) {
    extern __shared__ __attribute__((aligned(16))) unsigned char lds[];
    Frame F;
    F.lds = (LAS unsigned char*)lds; F.ws = args.ws; F.ctl = (gu32*)(args.ws + WS_CTL);
    F.tid = threadIdx.x; F.lane = F.tid & 63; F.wave = __builtin_amdgcn_readfirstlane(F.tid >> 6);
    F.G = gridDim.x; { const int bx = blockIdx.x; F.vcu = (F.G % 8 == 0) ? (bx % 8) * (F.G / 8) + bx / 8 : bx; }
    for (int u = F.tid; u < (LDS_BYTES - LDSCTL_OFF) / 4; u += NWAVES * 64) ((LAS unsigned*)(F.lds + LDSCTL_OFF))[u] = 0u;
    __syncthreads();
    XcdBarrier bar = xcd_barrier_post((unsigned*)(F.ctl + CW_BAR), (volatile LAS unsigned*)(F.lds + MISC_OFF) + 8);
    { constexpr int L = 0; const int nblk = 0; PHASE(0); }
    GRID_BAR();
#ifdef EXTRA_BARS
    GRID_BAR(); GRID_BAR(); GRID_BAR(); GRID_BAR(); GRID_BAR(); GRID_BAR(); GRID_BAR(); GRID_BAR(); GRID_BAR(); GRID_BAR();
#endif
    layer_program<0>(F, args, bar);
    layer_program<1>(F, args, bar);
}
#undef GRID_BAR

extern "C" void kernel_launch(void* const* d_in, const int* in_sizes, int n_in, void* d_out, int out_size, void* d_ws, size_t ws_size, hipStream_t stream) {
    static int grid = 0;
    if (grid == 0) {
        if (n_in != 30 || out_size != NTOK * DM || ws_size < WS_END) { fprintf(stderr, "kernel_launch: unexpected shapes (n_in %d, out %d, ws %zu < %zu)\n", n_in, out_size, ws_size, (size_t)WS_END); grid = -1; return; }
        int dev = 0, cus = 0, per_cu = 0;
        if (hipGetDevice(&dev) != hipSuccess || hipDeviceGetAttribute(&cus, hipDeviceAttributeMultiprocessorCount, dev) != hipSuccess) { grid = -1; return; }
        if (hipFuncSetAttribute((const void*)hybrid_fwd, hipFuncAttributeMaxDynamicSharedMemorySize, LDS_BYTES) != hipSuccess) { fprintf(stderr, "kernel_launch: hipFuncSetAttribute failed\n"); grid = -1; return; }
        if (hipOccupancyMaxActiveBlocksPerMultiprocessor(&per_cu, (const void*)hybrid_fwd, NWAVES * 64, LDS_BYTES) != hipSuccess || per_cu < 1)
            fprintf(stderr, "kernel_launch: occupancy query reports %d workgroups per CU\n", per_cu);
        (void)hipGetLastError();
        grid = cus;
    }
    if (grid < 0) return;
    if (hipMemsetAsync((char*)d_ws + WS_CTL, 0, CTL_ZERO_BYTES, stream) != hipSuccess) return;
    Args a{};
    for (int i = 0; i < 30; ++i) a.in[i] = (const float*)d_in[i];
    a.out = (float*)d_out; a.ws = (unsigned char*)d_ws;
    for (int i = 0; i < 32; ++i) { const float p = powf(10000.0f, (float)i / 32.0f); a.inv_freq[i] = 1.0f / p; }
    hipLaunchKernelGGL(hybrid_fwd, dim3(grid), dim3(NWAVES * 64), LDS_BYTES, stream, a);
}
```
